# Optimizing an MI355X kernel written in HIP

```python
import jax, jax.numpy as jnp
from jax import lax
import numpy as np

D_MODEL = 2048
BATCH = 2
SEQ = 8192
DEPTH = 1

ATTN_HEAD_DIM = 64
ATTN_HEADS = D_MODEL // (2 * ATTN_HEAD_DIM)
ATTN_KV_HEADS = max(ATTN_HEADS // 8, 1)
WINDOW = 128
ATTN_BLOCK = 128
ROPE_THETA = 500000.0
ROPE_DIM = ATTN_HEAD_DIM // 4
MLSTM_HEADS = 4
MLSTM_V_DIM = D_MODEL // (2 * MLSTM_HEADS)
MLSTM_QK_DIM = MLSTM_V_DIM // 2
MLSTM_CHUNK = 128
CONV_WIDTH = 4
GATE_SOFTCAP = 15.0
N_EXPERTS = 32
TOP_K = 4
D_FF = D_MODEL
SWIGLU_ALPHA = 1.702
SWIGLU_LIMIT = 7.0
MOE_BLOCK = 128
NORM_EPS = 1e-6

ATTN_Q_W = ATTN_HEADS * ATTN_HEAD_DIM
ATTN_KV_W = ATTN_KV_HEADS * ATTN_HEAD_DIM
MLSTM_QK_W = MLSTM_HEADS * MLSTM_QK_DIM
MLSTM_V_W = MLSTM_HEADS * MLSTM_V_DIM
IN_SIZES = (ATTN_Q_W, ATTN_KV_W, ATTN_KV_W, MLSTM_QK_W, MLSTM_QK_W, MLSTM_V_W, MLSTM_V_W, MLSTM_HEADS, MLSTM_HEADS, D_MODEL, D_MODEL)
IN_WIDTH = sum(IN_SIZES)
FGATE_OFFSET = sum(IN_SIZES[:8])

kernel_name = 'hybrid_swa_mlstm_moe_block'


def rms_norm(x, g):
    xf = x.astype(jnp.float32)
    y = xf * lax.rsqrt(jnp.mean(xf * xf, axis=-1, keepdims=True) + NORM_EPS)
    return (y * g.astype(jnp.float32)).astype(x.dtype)


def partial_rope(x, positions):
    half = ROPE_DIM // 2
    inv_freq = ROPE_THETA ** (-jnp.arange(half, dtype=jnp.float32) / half)
    ang = positions.astype(jnp.float32)[..., None] * inv_freq
    cos = jnp.cos(ang)[:, :, None, :]
    sin = jnp.sin(ang)[:, :, None, :]
    xr = x[..., :ROPE_DIM].astype(jnp.float32)
    x1, x2 = xr[..., :half], xr[..., half:]
    rot = jnp.concatenate([x1 * cos - x2 * sin, x2 * cos + x1 * sin], axis=-1)
    return jnp.concatenate([rot.astype(x.dtype), x[..., ROPE_DIM:]], axis=-1)


def sliding_window_attention(q, k, v, sinks):
    B, S, Hq, Dh = q.shape
    Hkv = k.shape[2]
    G = Hq // Hkv
    L = ATTN_BLOCK
    nb = S // L
    qb = q.reshape(B, nb, L, Hkv, G, Dh)
    kb = k.reshape(B, nb, L, Hkv, Dh)
    vb = v.reshape(B, nb, L, Hkv, Dh)
    zpad = jnp.zeros_like(kb[:, :1])
    k2 = jnp.concatenate([jnp.concatenate([zpad, kb[:, :-1]], axis=1), kb], axis=2)
    v2 = jnp.concatenate([jnp.concatenate([zpad, vb[:, :-1]], axis=1), vb], axis=2)
    s = jnp.einsum('bnqhgd,bnkhd->bnhgqk', qb, k2, preferred_element_type=jnp.float32) * (Dh ** -0.5)
    qi = jnp.arange(L)[:, None]
    kj = jnp.arange(2 * L)[None, :]
    diff = qi + L - kj
    band = (diff >= 0) & (diff < WINDOW)
    blk = jnp.arange(nb)[:, None, None]
    mask = band[None] & ((blk > 0) | (kj >= L)[None])
    s = jnp.where(mask[None, :, None, None], s, -jnp.inf)
    sink = sinks.astype(jnp.float32).reshape(Hkv, G)[None, None, :, :, None, None]
    m = jnp.maximum(jnp.max(s, axis=-1, keepdims=True), sink)
    p = jnp.exp(s - m)
    p = p / (jnp.sum(p, axis=-1, keepdims=True) + jnp.exp(sink - m))
    o = jnp.einsum('bnhgqk,bnkhd->bnqhgd', p.astype(v.dtype), v2)
    return o.reshape(B, S, Hq * Dh)


def causal_depthwise_conv(x, w):
    C = x.shape[-1]
    return lax.conv_general_dilated(x, w.astype(x.dtype)[:, None, :], window_strides=(1,),
                                    padding=[(CONV_WIDTH - 1, 0)],
                                    dimension_numbers=('NWC', 'WIO', 'NWC'),
                                    feature_group_count=C)


def softcap(z):
    return GATE_SOFTCAP * jnp.tanh(z / GATE_SOFTCAP)


def mlstm_chunkwise(q, k, v, i_pre, f_pre):
    B, S, H, dqk = q.shape
    dv = v.shape[-1]
    L = MLSTM_CHUNK
    nc = S // L
    f32 = jnp.float32

    def to_chunks(t):
        return t.astype(f32).reshape(B, nc, L, H, t.shape[-1]).transpose(0, 3, 1, 2, 4)

    qc = to_chunks(q)
    kc = to_chunks(k) * (dqk ** -0.5)
    vc = to_chunks(v)
    log_i = softcap(i_pre.astype(f32)).reshape(B, nc, L, H).transpose(0, 3, 1, 2)
    log_f = jax.nn.log_sigmoid(softcap(f_pre.astype(f32))).reshape(B, nc, L, H).transpose(0, 3, 1, 2)
    b = jnp.cumsum(log_f, axis=-1)
    b_last = b[..., -1]
    a = b_last[..., None] - b + log_i

    def step(carry, xs):
        C, n, m = carry
        k_c, v_c, a_c, g_c = xs
        m_new = jnp.maximum(g_c + m, jnp.max(a_c, axis=-1))
        decay = jnp.exp(g_c + m - m_new)
        wk = jnp.exp(a_c - m_new[..., None])[..., None] * k_c
        C_new = decay[..., None, None] * C + jnp.einsum('bhsk,bhsv->bhkv', wk, v_c)
        n_new = decay[..., None] * n + jnp.sum(wk, axis=2)
        return (C_new, n_new, m_new), (C, n, m)

    init = (jnp.zeros((B, H, dqk, dv), f32), jnp.zeros((B, H, dqk), f32), jnp.zeros((B, H), f32))
    xs = (jnp.moveaxis(kc, 2, 0), jnp.moveaxis(vc, 2, 0), jnp.moveaxis(a, 2, 0), jnp.moveaxis(b_last, 2, 0))
    _, (C_prev, n_prev, m_prev) = lax.scan(step, init, xs)
    C_prev = jnp.moveaxis(C_prev, 0, 2)
    n_prev = jnp.moveaxis(n_prev, 0, 2)
    m_prev = jnp.moveaxis(m_prev, 0, 2)

    causal = jnp.tril(jnp.ones((L, L), dtype=bool))
    d_log = jnp.where(causal, b[..., :, None] - b[..., None, :] + log_i[..., None, :], -jnp.inf)
    inter = b + m_prev[..., None]
    m = jnp.maximum(inter, jnp.max(d_log, axis=-1))
    s_qk = jnp.einsum('bhctk,bhcsk->bhcts', qc, kc) * jnp.exp(d_log - m[..., None])
    inter_w = jnp.exp(inter - m)
    num = jnp.einsum('bhcts,bhcsv->bhctv', s_qk, vc) + inter_w[..., None] * jnp.einsum('bhctk,bhckv->bhctv', qc, C_prev)
    den = jnp.sum(s_qk, axis=-1) + inter_w * jnp.einsum('bhctk,bhck->bhct', qc, n_prev)
    h = num / jnp.maximum(jnp.abs(den), jnp.exp(-m))[..., None]
    return h.transpose(0, 2, 3, 1, 4).reshape(B, S, H, dv)


def hybrid_mixer(h, positions, w_in, b_in, conv_qk, sinks, g_mlstm, w_attn_proj, w_mlstm_proj, w_out):
    B, S, _ = h.shape
    proj = h @ w_in + b_in
    split_idx = np.cumsum(IN_SIZES)[:-1].tolist()
    aq, ak, av, mq, mk, mv, mo, mi, mf, ga, gm = jnp.split(proj, split_idx, axis=-1)
    aq = partial_rope(aq.reshape(B, S, ATTN_HEADS, ATTN_HEAD_DIM), positions)
    ak = partial_rope(ak.reshape(B, S, ATTN_KV_HEADS, ATTN_HEAD_DIM), positions)
    av = av.reshape(B, S, ATTN_KV_HEADS, ATTN_HEAD_DIM)
    y_attn = sliding_window_attention(aq, ak, av, sinks) @ w_attn_proj
    qk = jax.nn.silu(causal_depthwise_conv(jnp.concatenate([mq, mk], axis=-1), conv_qk))
    mq, mk = jnp.split(qk, [MLSTM_QK_W], axis=-1)
    hm = mlstm_chunkwise(mq.reshape(B, S, MLSTM_HEADS, MLSTM_QK_DIM), mk.reshape(B, S, MLSTM_HEADS, MLSTM_QK_DIM),
                         mv.reshape(B, S, MLSTM_HEADS, MLSTM_V_DIM), mi, mf).astype(h.dtype)
    hm = rms_norm(hm, g_mlstm.reshape(MLSTM_HEADS, MLSTM_V_DIM)).reshape(B, S, MLSTM_V_W)
    y_mlstm = (jax.nn.sigmoid(mo) * hm) @ w_mlstm_proj
    merged = jax.nn.sigmoid(ga) * y_attn + jax.nn.sigmoid(gm) * y_mlstm
    return merged @ w_out


def moe_ffn(h, w_router, b_router, w_gate_up, b_gate_up, w_down, b_down):
    B, S, D = h.shape
    N = B * S
    NK = N * TOP_K
    hf = h.reshape(N, D)
    logits = (hf @ w_router).astype(jnp.float32) + b_router.astype(jnp.float32)
    top_logits, top_idx = lax.top_k(logits, TOP_K)
    top_w = jax.nn.softmax(top_logits, axis=-1)
    flat_e = top_idx.reshape(NK)
    flat_tok = jnp.arange(NK, dtype=jnp.int32) // TOP_K
    flat_w = top_w.reshape(NK)
    order = jnp.argsort(flat_e)
    sorted_e = flat_e[order]
    sorted_tok = flat_tok[order]
    sorted_w = flat_w[order]
    counts = jnp.bincount(flat_e, length=N_EXPERTS)
    starts = jnp.cumsum(counts) - counts
    padded = (counts + MOE_BLOCK - 1) // MOE_BLOCK * MOE_BLOCK
    pad_ends = jnp.cumsum(padded)
    pad_starts = pad_ends - padded
    dest = pad_starts[sorted_e] + (jnp.arange(NK) - starts[sorted_e])
    P = NK + N_EXPERTS * MOE_BLOCK
    nblk = P // MOE_BLOCK
    row_tok = jnp.zeros((P,), jnp.int32).at[dest].set(sorted_tok)
    row_w = jnp.zeros((P,), jnp.float32).at[dest].set(sorted_w)
    blk_e = jnp.minimum(jnp.searchsorted(pad_ends, jnp.arange(nblk) * MOE_BLOCK, side='right'), N_EXPERTS - 1)

    def expert_block(args):
        tok, wgt, e = args
        xb = hf[tok]
        gu = xb @ w_gate_up[e] + b_gate_up[e]
        glu = jnp.minimum(gu[:, 0::2], SWIGLU_LIMIT)
        lin = jnp.clip(gu[:, 1::2], -SWIGLU_LIMIT, SWIGLU_LIMIT)
        act = glu * jax.nn.sigmoid(SWIGLU_ALPHA * glu) * (lin + 1)
        y = act @ w_down[e] + b_down[e]
        return y.astype(jnp.float32) * wgt[:, None]

    y_rows = lax.map(expert_block, (row_tok.reshape(nblk, MOE_BLOCK), row_w.reshape(nblk, MOE_BLOCK), blk_e))
    out = jnp.zeros((N, D), jnp.float32).at[row_tok].add(y_rows.reshape(P, D))
    return out.astype(h.dtype).reshape(B, S, D)


def setup_inputs(seed: int = 0) -> dict:
    key = jax.random.key(seed)
    ks = jax.random.split(key, 24)
    D = D_MODEL
    nrm = jax.random.normal
    x = nrm(ks[0], (BATCH, SEQ, D), jnp.float32)
    c = nrm(ks[1], (BATCH, D), jnp.float32)
    offset = jax.random.randint(ks[2], (BATCH, 1), 0, 1024, dtype=jnp.int32)
    positions = offset + jnp.arange(SEQ, dtype=jnp.int32)[None, :]
    w_ada = nrm(ks[3], (DEPTH, D, 6 * D), jnp.float32) * D ** -0.5
    b_ada = 0.01 * nrm(ks[4], (DEPTH, 6 * D), jnp.float32)
    g_pre_mix = 1.0 + 0.02 * nrm(ks[5], (DEPTH, D), jnp.float32)
    g_post_mix = 1.0 + 0.02 * nrm(ks[6], (DEPTH, D), jnp.float32)
    g_pre_ffn = 1.0 + 0.02 * nrm(ks[7], (DEPTH, D), jnp.float32)
    g_post_ffn = 1.0 + 0.02 * nrm(ks[8], (DEPTH, D), jnp.float32)
    w_in = nrm(ks[9], (DEPTH, D, IN_WIDTH), jnp.float32) * D ** -0.5
    fbias = jnp.linspace(3.0, 6.0, MLSTM_HEADS, dtype=jnp.float32)
    b_in = (0.01 * nrm(ks[10], (DEPTH, IN_WIDTH), jnp.float32)).at[:, FGATE_OFFSET:FGATE_OFFSET + MLSTM_HEADS].add(fbias)
    conv_qk = nrm(ks[11], (DEPTH, CONV_WIDTH, 2 * MLSTM_QK_W), jnp.float32) * CONV_WIDTH ** -0.5
    sinks = nrm(ks[12], (DEPTH, ATTN_HEADS), jnp.float32)
    g_mlstm = 1.0 + 0.02 * nrm(ks[13], (DEPTH, MLSTM_V_W), jnp.float32)
    w_attn_proj = nrm(ks[14], (DEPTH, ATTN_Q_W, D), jnp.float32) * ATTN_Q_W ** -0.5
    w_mlstm_proj = nrm(ks[15], (DEPTH, MLSTM_V_W, D), jnp.float32) * MLSTM_V_W ** -0.5
    w_out = nrm(ks[16], (DEPTH, D, D), jnp.float32) * D ** -0.5
    w_router = nrm(ks[17], (DEPTH, D, N_EXPERTS), jnp.float32) * D ** -0.5
    b_router = 0.01 * nrm(ks[18], (DEPTH, N_EXPERTS), jnp.float32)
    w_gate_up = nrm(ks[19], (DEPTH, N_EXPERTS, D, 2 * D_FF), jnp.float32) * D ** -0.5
    b_gate_up = 0.01 * nrm(ks[20], (DEPTH, N_EXPERTS, 2 * D_FF), jnp.float32)
    w_down = nrm(ks[21], (DEPTH, N_EXPERTS, D_FF, D), jnp.float32) * D_FF ** -0.5
    b_down = 0.01 * nrm(ks[22], (DEPTH, N_EXPERTS, D), jnp.float32)
    return {'x': x, 'c': c, 'positions': positions, 'w_ada': w_ada, 'b_ada': b_ada,
            'g_pre_mix': g_pre_mix, 'g_post_mix': g_post_mix, 'g_pre_ffn': g_pre_ffn, 'g_post_ffn': g_post_ffn,
            'w_in': w_in, 'b_in': b_in, 'conv_qk': conv_qk, 'sinks': sinks, 'g_mlstm': g_mlstm,
            'w_attn_proj': w_attn_proj, 'w_mlstm_proj': w_mlstm_proj, 'w_out': w_out,
            'w_router': w_router, 'b_router': b_router, 'w_gate_up': w_gate_up, 'b_gate_up': b_gate_up,
            'w_down': w_down, 'b_down': b_down}


def reference(x, c, positions, w_ada, b_ada, g_pre_mix, g_post_mix, g_pre_ffn, g_post_ffn,
              w_in, b_in, conv_qk, sinks, g_mlstm, w_attn_proj, w_mlstm_proj, w_out,
              w_router, b_router, w_gate_up, b_gate_up, w_down, b_down):
    cond = jax.nn.silu(c)
    for l in range(DEPTH):
        mod = cond @ w_ada[l] + b_ada[l]
        sh1, sc1, gt1, sh2, sc2, gt2 = [t[:, None, :] for t in jnp.split(mod, 6, axis=-1)]
        h = rms_norm(x, g_pre_mix[l]) * (1 + sc1) + sh1
        y = hybrid_mixer(h, positions, w_in[l], b_in[l], conv_qk[l], sinks[l], g_mlstm[l],
                         w_attn_proj[l], w_mlstm_proj[l], w_out[l])
        x = x + gt1 * rms_norm(y, g_post_mix[l])
        h = rms_norm(x, g_pre_ffn[l]) * (1 + sc2) + sh2
        y = moe_ffn(h, w_router[l], b_router[l], w_gate_up[l], b_gate_up[l], w_down[l], b_down[l])
        x = x + gt2 * rms_norm(y, g_post_ffn[l])
    return x
```

```cpp
#include <hip/hip_runtime.h>
#include <stdint.h>
#include <math.h>

namespace cfg {
constexpr int D = 2048, NB = 2, S = 8192, NTOK = NB * S;
constexpr int HQ = 16, HKV = 2, HD = 64, QW = 1024;
constexpr int MH = 4, MDV = 256, MDK = 128, MQKW = 512, MVW = 1024, CL = 128, NC = S / CL;
constexpr int NE = 32, TOPK = 4, DFF = 2048, NPAIR = NTOK * TOPK;
constexpr int INW = 8456;
constexpr int OFF_AQ = 0, OFF_AK = 1024, OFF_AV = 1152, OFF_MQ = 1280, OFF_MK = 1792, OFF_MV = 2304, OFF_MO = 3328,
              OFF_MI = 4352, OFF_MF = 4356, OFF_GA = 4360, OFF_GM = 6408;
constexpr float EPS = 1e-6f;
constexpr int MOD_SH1 = 0, MOD_SC1 = 2048, MOD_GT1 = 4096, MOD_SH2 = 6144, MOD_SC2 = 8192, MOD_GT2 = 10240, MODW = 12288;
}
using namespace cfg;

__device__ __forceinline__ float silu_f(float x) { return x / (1.f + expf(-x)); }
__device__ __forceinline__ float sigmoid_f(float x) { return 1.f / (1.f + expf(-x)); }
__device__ __forceinline__ float wave_sum(float v) {
#pragma unroll
    for (int o = 32; o > 0; o >>= 1) v += __shfl_xor(v, o);
    return v;
}
__device__ __forceinline__ float wave_max(float v) {
#pragma unroll
    for (int o = 32; o > 0; o >>= 1) v = fmaxf(v, __shfl_xor(v, o));
    return v;
}
__device__ __forceinline__ float block_sum256(float v, float* red) {
    v = wave_sum(v);
    __syncthreads();
    if ((threadIdx.x & 63) == 0) red[threadIdx.x >> 6] = v;
    __syncthreads();
    return red[0] + red[1] + red[2] + red[3];
}
__device__ __forceinline__ float block_max256(float v, float* red) {
    v = wave_max(v);
    __syncthreads();
    if ((threadIdx.x & 63) == 0) red[threadIdx.x >> 6] = v;
    __syncthreads();
    return fmaxf(fmaxf(red[0], red[1]), fmaxf(red[2], red[3]));
}
__device__ __forceinline__ void rope_cs(int pos, int i, float& c, float& s) {
    const float invf[8] = {1.0f, 0.1939227432012558f, 0.03760603070259094f, 0.007292664609849453f,
                           0.0014142135623842478f, 0.00027424818836152554f, 5.3182957344688475e-05f, 1.0313385246263351e-05f};
    float f = i == 0 ? invf[0] : i == 1 ? invf[1] : i == 2 ? invf[2] : i == 3 ? invf[3] : i == 4 ? invf[4] : i == 5 ? invf[5] : i == 6 ? invf[6] : invf[7];
    float ang = (float)pos * f;
    double t = (double)ang * 0.15915494309189535;
    t -= rint(t);
    float tf = (float)t;
    s = __builtin_amdgcn_sinf(tf);
    c = __builtin_amdgcn_cosf(tf);
}

__global__ void __launch_bounds__(256) k_mod_partial(const float* __restrict__ c, const float* __restrict__ w_ada, float* __restrict__ part) {
    int j = blockIdx.x * 256 + threadIdx.x;
    int k0 = blockIdx.y * 128;
    float a0 = 0.f, a1 = 0.f;
    for (int k = k0; k < k0 + 128; ++k) {
        float w = w_ada[(size_t)k * MODW + j];
        a0 += silu_f(c[k]) * w;
        a1 += silu_f(c[D + k]) * w;
    }
    part[(size_t)(blockIdx.y * 2 + 0) * MODW + j] = a0;
    part[(size_t)(blockIdx.y * 2 + 1) * MODW + j] = a1;
}
__global__ void __launch_bounds__(256) k_mod_final(const float* __restrict__ part, const float* __restrict__ b_ada, float* __restrict__ mod) {
    int i = blockIdx.x * 256 + threadIdx.x;
    int b = i / MODW, j = i % MODW;
    float a = b_ada[j];
    for (int p = 0; p < 16; ++p) a += part[(size_t)(p * 2 + b) * MODW + j];
    mod[i] = a;
}

__global__ void __launch_bounds__(256) k_norm1(const float* __restrict__ x, const float* __restrict__ g, const float* __restrict__ mod, float* __restrict__ h1) {
    __shared__ float red[8];
    int row = blockIdx.x, b = row / S, t = threadIdx.x;
    const float* xr = x + (size_t)row * D;
    float v[8], ss = 0.f;
#pragma unroll
    for (int i = 0; i < 8; ++i) { v[i] = xr[t + i * 256]; ss += v[i] * v[i]; }
    ss = block_sum256(ss, red);
    float r = rsqrtf(ss / D + EPS);
#pragma unroll
    for (int i = 0; i < 8; ++i) {
        int c = t + i * 256;
        h1[(size_t)row * D + c] = v[i] * r * g[c] * (1.f + mod[b * MODW + MOD_SC1 + c]) + mod[b * MODW + MOD_SH1 + c];
    }
}

template <int MODE>
__device__ __forceinline__ void gemm_tile_ref(const float* __restrict__ A, int lda, const float* __restrict__ Bm, int ldb, const float* __restrict__ bias,
                                              float* __restrict__ C, int ldc, int N, int K, int n0, const int* srcrow, const int* dstrow, const float* rowscale,
                                              float (*As)[132], float (*Bs)[128]) {
    const int tid = threadIdx.x, ty = tid >> 4, tx = tid & 15;
    float acc[8][8];
#pragma unroll
    for (int i = 0; i < 8; ++i)
#pragma unroll
        for (int j = 0; j < 8; ++j) acc[i][j] = 0.f;
    const int ar0 = tid >> 2, akq = (tid & 3) * 4;
    const int s0 = srcrow[ar0], s1 = srcrow[ar0 + 64];
    const int bk0 = tid >> 5, bnq = (tid & 31) * 4;
    for (int k0 = 0; k0 < K; k0 += 16) {
        float4 a0 = make_float4(0.f, 0.f, 0.f, 0.f), a1 = a0, b0 = a0, b1 = a0;
        if (s0 >= 0) a0 = *(const float4*)(A + (size_t)s0 * lda + k0 + akq);
        if (s1 >= 0) a1 = *(const float4*)(A + (size_t)s1 * lda + k0 + akq);
        if (n0 + bnq < N) {
            b0 = *(const float4*)(Bm + (size_t)(k0 + bk0) * ldb + n0 + bnq);
            b1 = *(const float4*)(Bm + (size_t)(k0 + bk0 + 8) * ldb + n0 + bnq);
        }
        __syncthreads();
        As[akq + 0][ar0] = a0.x; As[akq + 1][ar0] = a0.y; As[akq + 2][ar0] = a0.z; As[akq + 3][ar0] = a0.w;
        As[akq + 0][ar0 + 64] = a1.x; As[akq + 1][ar0 + 64] = a1.y; As[akq + 2][ar0 + 64] = a1.z; As[akq + 3][ar0 + 64] = a1.w;
        *(float4*)&Bs[bk0][bnq] = b0;
        *(float4*)&Bs[bk0 + 8][bnq] = b1;
        __syncthreads();
#pragma unroll
        for (int k = 0; k < 16; ++k) {
            float av[8], bv[8];
            *(float4*)&av[0] = *(const float4*)&As[k][ty * 8];
            *(float4*)&av[4] = *(const float4*)&As[k][ty * 8 + 4];
            *(float4*)&bv[0] = *(const float4*)&Bs[k][tx * 8];
            *(float4*)&bv[4] = *(const float4*)&Bs[k][tx * 8 + 4];
#pragma unroll
            for (int i = 0; i < 8; ++i)
#pragma unroll
                for (int j = 0; j < 8; ++j) acc[i][j] = fmaf(av[i], bv[j], acc[i][j]);
        }
    }
    const int nc = n0 + tx * 8;
    if (nc < N) {
        float bb[8];
#pragma unroll
        for (int j = 0; j < 8; ++j) bb[j] = bias ? bias[nc + j] : 0.f;
#pragma unroll
        for (int i = 0; i < 8; ++i) {
            const int dr = dstrow[ty * 8 + i];
            if (dr < 0) continue;
            const float rs = rowscale ? rowscale[dr] : 1.f;
            if (MODE == 0) {
                float4 o0, o1;
                o0.x = (acc[i][0] + bb[0]) * rs; o0.y = (acc[i][1] + bb[1]) * rs; o0.z = (acc[i][2] + bb[2]) * rs; o0.w = (acc[i][3] + bb[3]) * rs;
                o1.x = (acc[i][4] + bb[4]) * rs; o1.y = (acc[i][5] + bb[5]) * rs; o1.z = (acc[i][6] + bb[6]) * rs; o1.w = (acc[i][7] + bb[7]) * rs;
                *(float4*)(C + (size_t)dr * ldc + nc) = o0;
                *(float4*)(C + (size_t)dr * ldc + nc + 4) = o1;
            } else {
                float o[4];
#pragma unroll
                for (int j = 0; j < 4; ++j) {
                    float gu = acc[i][2 * j] + bb[2 * j], li = acc[i][2 * j + 1] + bb[2 * j + 1];
                    float glu = fminf(gu, 7.0f);
                    float lin = fminf(fmaxf(li, -7.0f), 7.0f);
                    o[j] = glu * sigmoid_f(1.702f * glu) * (lin + 1.f);
                }
                *(float4*)(C + (size_t)dr * ldc + (nc >> 1)) = make_float4(o[0], o[1], o[2], o[3]);
            }
        }
    }
}

__global__ void __launch_bounds__(256) k_gemm_ref(const float* __restrict__ A, int lda, const float* __restrict__ Bm, int ldb, const float* __restrict__ bias,
                                                  float* __restrict__ C, int ldc, int N, int K) {
    __shared__ float As[16][132];
    __shared__ float Bs[16][128];
    __shared__ int rows[128];
    if (threadIdx.x < 128) rows[threadIdx.x] = blockIdx.y * 128 + threadIdx.x;
    __syncthreads();
    gemm_tile_ref<0>(A, lda, Bm, ldb, bias, C, ldc, N, K, blockIdx.x * 128, rows, rows, nullptr, As, Bs);
}

constexpr int MOE_MAXT = NPAIR / 128 + NE;
template <int MODE>
__global__ void __launch_bounds__(256) k_moe_gemm_ref(const float* __restrict__ A, int lda, int a_shift, const float* __restrict__ W, size_t w_stride, int ldb,
                                                      const float* __restrict__ bias, int bias_stride, float* __restrict__ C, int ldc, int N, int K,
                                                      const int* __restrict__ cnt, const int* __restrict__ list, const float* __restrict__ rowscale) {
    __shared__ float As[16][132];
    __shared__ float Bs[16][128];
    __shared__ int srow[128], drow[128];
    __shared__ int se, sm0, scnt;
    if (threadIdx.x == 0) {
        int t = blockIdx.y, e = 0, found = -1, m0 = 0, ce = 0;
        for (e = 0; e < NE; ++e) {
            int c = cnt[e], nt = (c + 127) / 128;
            if (t < nt) { found = e; m0 = t * 128; ce = c; break; }
            t -= nt;
        }
        se = found; sm0 = m0; scnt = ce;
    }
    __syncthreads();
    const int e = se;
    if (e < 0) return;
    if (threadIdx.x < 128) {
        int r = sm0 + threadIdx.x;
        int p = r < scnt ? list[(size_t)e * NPAIR + r] : -1;
        drow[threadIdx.x] = p;
        srow[threadIdx.x] = p < 0 ? -1 : (p >> a_shift);
    }
    __syncthreads();
    gemm_tile_ref<MODE>(A, lda, W + (size_t)e * w_stride, ldb, bias + (size_t)e * bias_stride, C, ldc, N, K, blockIdx.x * 128, srow, drow, rowscale, As, Bs);
}

__global__ void __launch_bounds__(256) k_rope_ref(const float* __restrict__ proj, const int* __restrict__ positions, float* __restrict__ qr, float* __restrict__ kr) {
    int tok = blockIdx.x, pos = positions[tok];
    for (int c = threadIdx.x; c < 1152; c += 256) {
        int d = c & 63;
        float v = proj[(size_t)tok * INW + c];
        float o = v;
        if (d < 16) {
            int i = d & 7; float cs, sn; rope_cs(pos, i, cs, sn);
            if (d < 8) { float x2 = proj[(size_t)tok * INW + c + 8]; o = v * cs - x2 * sn; }
            else { float x1 = proj[(size_t)tok * INW + c - 8]; o = v * cs + x1 * sn; }
        }
        if (c < 1024) qr[(size_t)tok * 1024 + c] = o; else kr[(size_t)tok * 128 + (c - 1024)] = o;
    }
}
__global__ void __launch_bounds__(256) k_attn_ref(const float* __restrict__ qr, const float* __restrict__ kr, const float* __restrict__ proj, const float* __restrict__ sinks, float* __restrict__ O) {
    __shared__ float qs[4][64];
    __shared__ float ps[4][128];
    const int w = threadIdx.x >> 6, lane = threadIdx.x & 63;
    const int item = blockIdx.x * 4 + w;
    const int tok = item >> 4, h = item & 15, b = tok / S, s = tok % S, hk = h >> 3;
    qs[w][lane] = qr[(size_t)tok * 1024 + h * 64 + lane];
    __syncthreads();
    float sc[2];
#pragma unroll
    for (int u = 0; u < 2; ++u) {
        int j = s - 127 + lane + 64 * u;
        float a = -INFINITY;
        if (j >= 0) {
            const float* kp = kr + (size_t)(b * S + j) * 128 + hk * 64;
            a = 0.f;
            for (int d = 0; d < 64; ++d) a += qs[w][d] * kp[d];
            a *= 0.125f;
        }
        sc[u] = a;
    }
    const float sink = sinks[h];
    float m = fmaxf(wave_max(fmaxf(sc[0], sc[1])), sink);
    float p0 = sc[0] == -INFINITY ? 0.f : expf(sc[0] - m), p1 = sc[1] == -INFINITY ? 0.f : expf(sc[1] - m);
    float den = wave_sum(p0 + p1) + expf(sink - m);
    ps[w][lane] = p0; ps[w][lane + 64] = p1;
    __syncthreads();
    float o = 0.f;
    for (int jj = 0; jj < 128; ++jj) {
        int j = s - 127 + jj;
        if (j >= 0) o += ps[w][jj] * proj[(size_t)(b * S + j) * INW + OFF_AV + hk * 64 + lane];
    }
    O[(size_t)tok * 1024 + h * 64 + lane] = o / den;
}

__global__ void __launch_bounds__(256) k_convsilu_ref(const float* __restrict__ proj, const float* __restrict__ conv, float* __restrict__ qc, float* __restrict__ kc) {
    int tok = blockIdx.x, s = tok % S;
    for (int c = threadIdx.x; c < 1024; c += 256) {
        float a = 0.f;
#pragma unroll
        for (int j = 0; j < 4; ++j) { int ss = s - 3 + j; if (ss >= 0) a += conv[j * 1024 + c] * proj[(size_t)(tok - 3 + j) * INW + OFF_MQ + c]; }
        a = silu_f(a);
        if (c < 512) qc[(size_t)tok * 512 + c] = a; else kc[(size_t)tok * 512 + (c - 512)] = a * 0.08838834764831845f;
    }
}
__device__ __forceinline__ float softcap_f(float z) { return 15.f * tanhf(z / 15.f); }
__device__ __forceinline__ float logsigmoid_f(float z) { return fminf(z, 0.f) - log1pf(expf(-fabsf(z))); }
__global__ void k_gates_ref(const float* __restrict__ proj, float* __restrict__ bcum, float* __restrict__ logi, float* __restrict__ gsum, float* __restrict__ mloc) {
    int id = blockIdx.x * blockDim.x + threadIdx.x;
    if (id >= NB * MH * NC) return;
    int bh = id / NC, c = id % NC, b = bh / MH, h = bh % MH;
    float cum = 0.f;
    for (int s = 0; s < CL; ++s) {
        size_t tok = (size_t)b * S + c * CL + s;
        float li = softcap_f(proj[tok * INW + OFF_MI + h]);
        float lf = logsigmoid_f(softcap_f(proj[tok * INW + OFF_MF + h]));
        cum += lf;
        bcum[(size_t)bh * S + c * CL + s] = cum;
        logi[(size_t)bh * S + c * CL + s] = li;
    }
    float mx = -INFINITY;
    for (int s = 0; s < CL; ++s) mx = fmaxf(mx, cum - bcum[(size_t)bh * S + c * CL + s] + logi[(size_t)bh * S + c * CL + s]);
    gsum[id] = cum; mloc[id] = mx;
}
__global__ void k_mscan_ref(const float* __restrict__ gsum, const float* __restrict__ mloc, float* __restrict__ mprev, float* __restrict__ decay, float* __restrict__ scl) {
    int bh = threadIdx.x;
    if (bh >= NB * MH) return;
    float m = 0.f;
    for (int c = 0; c < NC; ++c) {
        float g = gsum[bh * NC + c], ml = mloc[bh * NC + c];
        mprev[bh * NC + c] = m;
        float mn = fmaxf(g + m, ml);
        decay[bh * NC + c] = expf(g + m - mn);
        scl[bh * NC + c] = expf(ml - mn);
        m = mn;
    }
}
__global__ void __launch_bounds__(256) k_dC_ref(const float* __restrict__ kc, const float* __restrict__ proj, const float* __restrict__ bcum, const float* __restrict__ logi,
                                                const float* __restrict__ gsum, const float* __restrict__ mloc, float* __restrict__ dC, float* __restrict__ dn) {
    __shared__ float wk[128];
    int id = blockIdx.x, dk = blockIdx.y, bh = id / NC, c = id % NC, b = bh / MH, h = bh % MH, dv = threadIdx.x;
    if (threadIdx.x < 128) {
        int s = threadIdx.x;
        float a = gsum[id] - bcum[(size_t)bh * S + c * CL + s] + logi[(size_t)bh * S + c * CL + s];
        wk[s] = expf(a - mloc[id]) * kc[((size_t)b * S + c * CL + s) * 512 + h * 128 + dk];
    }
    __syncthreads();
    float acc = 0.f, accn = 0.f;
    for (int s = 0; s < CL; ++s) {
        acc += wk[s] * proj[((size_t)b * S + c * CL + s) * INW + OFF_MV + h * 256 + dv];
        accn += wk[s];
    }
    dC[((size_t)id * MDK + dk) * MDV + dv] = acc;
    if (dv == 0) dn[(size_t)id * MDK + dk] = accn;
}
__global__ void __launch_bounds__(256) k_Cscan_ref(const float* __restrict__ dC, const float* __restrict__ dn, const float* __restrict__ decay, const float* __restrict__ scl,
                                                   float* __restrict__ Cprev, float* __restrict__ nprev) {
    int bh = blockIdx.x / MDK, dk = blockIdx.x % MDK, dv = threadIdx.x;
    float C = 0.f, n = 0.f;
    for (int c = 0; c < NC; ++c) {
        size_t id = (size_t)bh * NC + c;
        Cprev[(id * MDK + dk) * MDV + dv] = C;
        C = decay[id] * C + scl[id] * dC[(id * MDK + dk) * MDV + dv];
        if (dv == 0) { nprev[id * MDK + dk] = n; n = decay[id] * n + scl[id] * dn[id * MDK + dk]; }
    }
}
__global__ void __launch_bounds__(256) k_mlstm_out_ref(const float* __restrict__ qc, const float* __restrict__ kc, const float* __restrict__ proj, const float* __restrict__ bcum,
                                                       const float* __restrict__ logi, const float* __restrict__ mprev, const float* __restrict__ Cprev, const float* __restrict__ nprev,
                                                       const float* __restrict__ g_mlstm, float* __restrict__ hm) {
    __shared__ float red[8];
    __shared__ float qs[128];
    __shared__ float Ss[128];
    int t = blockIdx.x % CL, id = blockIdx.x / CL, bh = id / NC, c = id % NC, b = bh / MH, h = bh % MH, tid = threadIdx.x;
    size_t tok = (size_t)b * S + c * CL + t;
    if (tid < 128) qs[tid] = qc[tok * 512 + h * 128 + tid];
    __syncthreads();
    const float bt = bcum[(size_t)bh * S + c * CL + t], mp = mprev[id], inter = bt + mp;
    float dl = -INFINITY;
    if (tid < 128 && tid <= t) dl = bt - bcum[(size_t)bh * S + c * CL + tid] + logi[(size_t)bh * S + c * CL + tid];
    const float mt = fmaxf(inter, block_max256(dl, red));
    float sv = 0.f, qn = 0.f;
    if (tid < 128) {
        if (tid <= t) {
            const float* kp = kc + ((size_t)b * S + c * CL + tid) * 512 + h * 128;
            float dot = 0.f;
            for (int d = 0; d < 128; ++d) dot += qs[d] * kp[d];
            sv = dot * expf(dl - mt);
        }
        Ss[tid] = sv;
        qn = qs[tid] * nprev[(size_t)id * MDK + tid];
    }
    const float iw = expf(inter - mt);
    const float ssum = block_sum256(sv, red);
    const float qnsum = block_sum256(qn, red);
    const float den = ssum + iw * qnsum;
    float num = 0.f;
    for (int s = 0; s <= t; ++s) num += Ss[s] * proj[((size_t)b * S + c * CL + s) * INW + OFF_MV + h * 256 + tid];
    float qC = 0.f;
    for (int d = 0; d < 128; ++d) qC += qs[d] * Cprev[((size_t)id * MDK + d) * MDV + tid];
    num += iw * qC;
    const float hv = num / fmaxf(fabsf(den), expf(-mt));
    const float r = rsqrtf(block_sum256(hv * hv, red) / 256.f + EPS);
    const float hn = hv * r * g_mlstm[h * 256 + tid];
    hm[tok * 1024 + h * 256 + tid] = sigmoid_f(proj[tok * INW + OFF_MO + h * 256 + tid]) * hn;
}

__global__ void __launch_bounds__(256) k_merge_ref(const float* __restrict__ proj, const float* __restrict__ ya, const float* __restrict__ ym, float* __restrict__ mg) {
    size_t i = (size_t)blockIdx.x * 256 + threadIdx.x;
    size_t tok = i / D; int c = (int)(i % D);
    mg[i] = sigmoid_f(proj[tok * INW + OFF_GA + c]) * ya[i] + sigmoid_f(proj[tok * INW + OFF_GM + c]) * ym[i];
}

__global__ void __launch_bounds__(256) k_row2_ref(const float* __restrict__ x, const float* __restrict__ y, const float* __restrict__ mod, const float* __restrict__ g_post, const float* __restrict__ g_pre,
                                                  const float* __restrict__ w_router, const float* __restrict__ b_router, float* __restrict__ x1, float* __restrict__ h2,
                                                  int* __restrict__ topi, float* __restrict__ topw) {
    __shared__ float red[8];
    __shared__ float hs[D];
    __shared__ float lg[8][32];
    int row = blockIdx.x, b = row / S, t = threadIdx.x;
    float yv[8], xv[8], ss = 0.f;
#pragma unroll
    for (int i = 0; i < 8; ++i) { yv[i] = y[(size_t)row * D + t + i * 256]; ss += yv[i] * yv[i]; }
    float r1 = rsqrtf(block_sum256(ss, red) / D + EPS);
    ss = 0.f;
#pragma unroll
    for (int i = 0; i < 8; ++i) {
        int c = t + i * 256;
        xv[i] = x[(size_t)row * D + c] + mod[b * MODW + MOD_GT1 + c] * (yv[i] * r1 * g_post[c]);
        x1[(size_t)row * D + c] = xv[i];
        ss += xv[i] * xv[i];
    }
    float r2 = rsqrtf(block_sum256(ss, red) / D + EPS);
#pragma unroll
    for (int i = 0; i < 8; ++i) {
        int c = t + i * 256;
        float hv = xv[i] * r2 * g_pre[c] * (1.f + mod[b * MODW + MOD_SC2 + c]) + mod[b * MODW + MOD_SH2 + c];
        h2[(size_t)row * D + c] = hv;
        hs[c] = hv;
    }
    __syncthreads();
    {
        int e = t & 31, part = t >> 5;
        float a = 0.f;
        for (int k = part * 256; k < part * 256 + 256; ++k) a += hs[k] * w_router[k * 32 + e];
        lg[part][e] = a;
    }
    __syncthreads();
    if (t < 32) {
        float a = b_router[t];
#pragma unroll
        for (int p = 0; p < 8; ++p) a += lg[p][t];
        lg[0][t] = a;
    }
    __syncthreads();
    if (t == 0) {
        int idx[4]; float val[4];
        unsigned used = 0u;
#pragma unroll
        for (int k = 0; k < 4; ++k) {
            float best = -INFINITY; int bi = 0;
            for (int e = 0; e < 32; ++e) { float v = lg[0][e]; if (!((used >> e) & 1u) && v > best) { best = v; bi = e; } }
            used |= 1u << bi; idx[k] = bi; val[k] = best;
        }
        float mx = val[0], sum = 0.f, ex[4];
#pragma unroll
        for (int k = 0; k < 4; ++k) { ex[k] = expf(val[k] - mx); sum += ex[k]; }
#pragma unroll
        for (int k = 0; k < 4; ++k) { topi[row * 4 + k] = idx[k]; topw[row * 4 + k] = ex[k] / sum; }
    }
}

__global__ void __launch_bounds__(64) k_dispatch_ref(const int* __restrict__ topi, int* __restrict__ cnt, int* __restrict__ list) {
    int e = blockIdx.x, lane = threadIdx.x, n = 0;
    for (int base = 0; base < NPAIR; base += 64) {
        bool f = topi[base + lane] == e;
        unsigned long long mask = __ballot(f);
        int pos = n + __popcll(mask & ((1ull << lane) - 1ull));
        if (f) list[(size_t)e * NPAIR + pos] = base + lane;
        n += __popcll(mask);
    }
    if (lane == 0) cnt[e] = n;
}

__global__ void __launch_bounds__(256) k_final_ref(const float* __restrict__ x1, const float* __restrict__ yp, const float* __restrict__ mod, const float* __restrict__ g_post, float* __restrict__ out) {
    __shared__ float red[8];
    int row = blockIdx.x, b = row / S, t = threadIdx.x;
    float yv[8], ss = 0.f;
#pragma unroll
    for (int i = 0; i < 8; ++i) {
        int c = t + i * 256;
        float a = 0.f;
#pragma unroll
        for (int k = 0; k < 4; ++k) a += yp[((size_t)row * 4 + k) * D + c];
        yv[i] = a; ss += a * a;
    }
    float r = rsqrtf(block_sum256(ss, red) / D + EPS);
#pragma unroll
    for (int i = 0; i < 8; ++i) {
        int c = t + i * 256;
        out[(size_t)row * D + c] = x1[(size_t)row * D + c] + mod[b * MODW + MOD_GT2 + c] * (yv[i] * r * g_post[c]);
    }
}

namespace wsr {
constexpr size_t A256(size_t x) { return (x + 63) & ~(size_t)63; }
constexpr size_t MODP = 0;
constexpr size_t MOD = A256(MODP + 16 * 2 * MODW);
constexpr size_t H1 = A256(MOD + 2 * MODW);
constexpr size_t PROJ = A256(H1 + (size_t)NTOK * D);
constexpr size_t QR = A256(PROJ + (size_t)NTOK * INW);
constexpr size_t KR = A256(QR + (size_t)NTOK * 1024);
constexpr size_t OAT = A256(KR + (size_t)NTOK * 128);
constexpr size_t QC = A256(OAT + (size_t)NTOK * 1024);
constexpr size_t KC = A256(QC + (size_t)NTOK * 512);
constexpr size_t BCUM = A256(KC + (size_t)NTOK * 512);
constexpr size_t LOGI = A256(BCUM + (size_t)8 * S);
constexpr size_t GSUM = A256(LOGI + (size_t)8 * S);
constexpr size_t MLOC = A256(GSUM + 512);
constexpr size_t MPREV = A256(MLOC + 512);
constexpr size_t DECAY = A256(MPREV + 512);
constexpr size_t SCL = A256(DECAY + 512);
constexpr size_t DC = A256(SCL + 512);
constexpr size_t DN = A256(DC + (size_t)512 * 128 * 256);
constexpr size_t CPREV = A256(DN + (size_t)512 * 128);
constexpr size_t NPREV = A256(CPREV + (size_t)512 * 128 * 256);
constexpr size_t HM = A256(NPREV + (size_t)512 * 128);
constexpr size_t YA = A256(HM + (size_t)NTOK * 1024);
constexpr size_t YM = A256(YA + (size_t)NTOK * D);
constexpr size_t MG = A256(YM + (size_t)NTOK * D);
constexpr size_t Y = A256(MG + (size_t)NTOK * D);
constexpr size_t X1 = A256(Y + (size_t)NTOK * D);
constexpr size_t H2 = A256(X1 + (size_t)NTOK * D);
constexpr size_t TOPI = A256(H2 + (size_t)NTOK * D);
constexpr size_t TOPW = A256(TOPI + NPAIR);
constexpr size_t CNT = A256(TOPW + NPAIR);
constexpr size_t LIST = A256(CNT + 64);
constexpr size_t ACT = A256(LIST + (size_t)NE * NPAIR);
constexpr size_t YP = A256(ACT + (size_t)NPAIR * DFF);
constexpr size_t END = A256(YP + (size_t)NPAIR * D);
}

extern "C" void kernel_launch(void* const* d_in, const int* in_sizes, int n_in, void* d_out, int out_size, void* d_ws, size_t ws_size, hipStream_t stream) {
    const float* x = (const float*)d_in[0];
    const float* c = (const float*)d_in[1];
    const int* positions = (const int*)d_in[2];
    const float* w_ada = (const float*)d_in[3];
    const float* b_ada = (const float*)d_in[4];
    const float* g_pre_mix = (const float*)d_in[5];
    const float* g_post_mix = (const float*)d_in[6];
    const float* g_pre_ffn = (const float*)d_in[7];
    const float* g_post_ffn = (const float*)d_in[8];
    const float* w_in = (const float*)d_in[9];
    const float* b_in = (const float*)d_in[10];
    const float* conv_qk = (const float*)d_in[11];
    const float* sinks = (const float*)d_in[12];
    const float* g_mlstm = (const float*)d_in[13];
    const float* w_attn_proj = (const float*)d_in[14];
    const float* w_mlstm_proj = (const float*)d_in[15];
    const float* w_out = (const float*)d_in[16];
    const float* w_router = (const float*)d_in[17];
    const float* b_router = (const float*)d_in[18];
    const float* w_gate_up = (const float*)d_in[19];
    const float* b_gate_up = (const float*)d_in[20];
    const float* w_down = (const float*)d_in[21];
    const float* b_down = (const float*)d_in[22];
    float* out = (float*)d_out;
    float* W = (float*)d_ws;
    if (ws_size < wsr::END * 4) return;

    k_mod_partial<<<dim3(MODW / 256, 16), 256, 0, stream>>>(c, w_ada, W + wsr::MODP);
    k_mod_final<<<2 * MODW / 256, 256, 0, stream>>>(W + wsr::MODP, b_ada, W + wsr::MOD);
    k_norm1<<<NTOK, 256, 0, stream>>>(x, g_pre_mix, W + wsr::MOD, W + wsr::H1);
    k_gemm_ref<<<dim3((INW + 127) / 128, NTOK / 128), 256, 0, stream>>>(W + wsr::H1, D, w_in, INW, b_in, W + wsr::PROJ, INW, INW, D);
    k_rope_ref<<<NTOK, 256, 0, stream>>>(W + wsr::PROJ, positions, W + wsr::QR, W + wsr::KR);
    k_attn_ref<<<NTOK * HQ / 4, 256, 0, stream>>>(W + wsr::QR, W + wsr::KR, W + wsr::PROJ, sinks, W + wsr::OAT);
    k_convsilu_ref<<<NTOK, 256, 0, stream>>>(W + wsr::PROJ, conv_qk, W + wsr::QC, W + wsr::KC);
    k_gates_ref<<<(NB * MH * NC + 63) / 64, 64, 0, stream>>>(W + wsr::PROJ, W + wsr::BCUM, W + wsr::LOGI, W + wsr::GSUM, W + wsr::MLOC);
    k_mscan_ref<<<1, 64, 0, stream>>>(W + wsr::GSUM, W + wsr::MLOC, W + wsr::MPREV, W + wsr::DECAY, W + wsr::SCL);
    k_dC_ref<<<dim3(NB * MH * NC, MDK), 256, 0, stream>>>(W + wsr::KC, W + wsr::PROJ, W + wsr::BCUM, W + wsr::LOGI, W + wsr::GSUM, W + wsr::MLOC, W + wsr::DC, W + wsr::DN);
    k_Cscan_ref<<<NB * MH * MDK, 256, 0, stream>>>(W + wsr::DC, W + wsr::DN, W + wsr::DECAY, W + wsr::SCL, W + wsr::CPREV, W + wsr::NPREV);
    k_mlstm_out_ref<<<NB * MH * NC * CL, 256, 0, stream>>>(W + wsr::QC, W + wsr::KC, W + wsr::PROJ, W + wsr::BCUM, W + wsr::LOGI, W + wsr::MPREV, W + wsr::CPREV, W + wsr::NPREV, g_mlstm, W + wsr::HM);
    k_gemm_ref<<<dim3(D / 128, NTOK / 128), 256, 0, stream>>>(W + wsr::OAT, 1024, w_attn_proj, D, nullptr, W + wsr::YA, D, D, 1024);
    k_gemm_ref<<<dim3(D / 128, NTOK / 128), 256, 0, stream>>>(W + wsr::HM, 1024, w_mlstm_proj, D, nullptr, W + wsr::YM, D, D, 1024);
    k_merge_ref<<<(size_t)NTOK * D / 256, 256, 0, stream>>>(W + wsr::PROJ, W + wsr::YA, W + wsr::YM, W + wsr::MG);
    k_gemm_ref<<<dim3(D / 128, NTOK / 128), 256, 0, stream>>>(W + wsr::MG, D, w_out, D, nullptr, W + wsr::Y, D, D, D);
    k_row2_ref<<<NTOK, 256, 0, stream>>>(x, W + wsr::Y, W + wsr::MOD, g_post_mix, g_pre_ffn, w_router, b_router, W + wsr::X1, W + wsr::H2, (int*)(W + wsr::TOPI), W + wsr::TOPW);
    k_dispatch_ref<<<NE, 64, 0, stream>>>((const int*)(W + wsr::TOPI), (int*)(W + wsr::CNT), (int*)(W + wsr::LIST));
    k_moe_gemm_ref<1><<<dim3(2 * DFF / 128, MOE_MAXT), 256, 0, stream>>>(W + wsr::H2, D, 2, w_gate_up, (size_t)D * 2 * DFF, 2 * DFF, b_gate_up, 2 * DFF, W + wsr::ACT, DFF, 2 * DFF, D,
                                                                          (const int*)(W + wsr::CNT), (const int*)(W + wsr::LIST), nullptr);
    k_moe_gemm_ref<0><<<dim3(D / 128, MOE_MAXT), 256, 0, stream>>>(W + wsr::ACT, DFF, 0, w_down, (size_t)DFF * D, D, b_down, D, W + wsr::YP, D, D, DFF,
                                                                   (const int*)(W + wsr::CNT), (const int*)(W + wsr::LIST), W + wsr::TOPW);
    k_final_ref<<<NTOK, 256, 0, stream>>>(W + wsr::X1, W + wsr::YP, W + wsr::MOD, g_post_ffn, out);
}
```

```cpp
#include <hip/hip_runtime.h>
#include <stdint.h>
#include <math.h>
#define NPH 12
namespace cfg {
constexpr int D = 2048, NB = 2, S = 8192, NTOK = NB * S;
constexpr int HQ = 16, HKV = 2, HD = 64, QW = 1024;
constexpr int MH = 4, MDV = 256, MDK = 128, MQKW = 512, MVW = 1024, CL = 128, NC = S / CL;
constexpr int NE = 32, TOPK = 4, DFF = 2048, NPAIR = NTOK * TOPK;
constexpr int INW = 8456;
constexpr int OFF_AQ = 0, OFF_AK = 1024, OFF_AV = 1152, OFF_MQ = 1280, OFF_MK = 1792, OFF_MV = 2304, OFF_MO = 3328,
              OFF_MI = 4352, OFF_MF = 4356, OFF_GA = 4360, OFF_GM = 6408;
constexpr float EPS = 1e-6f;
constexpr int MOD_SH1 = 0, MOD_SC1 = 2048, MOD_GT1 = 4096, MOD_SH2 = 6144, MOD_SC2 = 8192, MOD_GT2 = 10240, MODW = 12288;
}
using namespace cfg;
__device__ __forceinline__ float silu_f(float x) { return x / (1.f + expf(-x)); }
__device__ __forceinline__ float sigmoid_f(float x) { return 1.f / (1.f + expf(-x)); }
__device__ __forceinline__ void rope_cs(int pos, int i, float& c, float& s) {
    const float invf[8] = {1.0f, 0.1939227432012558f, 0.03760603070259094f, 0.007292664609849453f,
                           0.0014142135623842478f, 0.00027424818836152554f, 5.3182957344688475e-05f, 1.0313385246263351e-05f};
    float f = i == 0 ? invf[0] : i == 1 ? invf[1] : i == 2 ? invf[2] : i == 3 ? invf[3] : i == 4 ? invf[4] : i == 5 ? invf[5] : i == 6 ? invf[6] : invf[7];
    float ang = (float)pos * f;
    double t = (double)ang * 0.15915494309189535;
    t -= rint(t);
    float tf = (float)t;
    s = __builtin_amdgcn_sinf(tf);
    c = __builtin_amdgcn_cosf(tf);
}
__device__ __forceinline__ float softcap_f(float z) { return 15.f * tanhf(z / 15.f); }
__device__ __forceinline__ float logsigmoid_f(float z) { return fminf(z, 0.f) - log1pf(expf(-fabsf(z))); }
#define GAS __attribute__((address_space(1)))
#define LAS __attribute__((address_space(3)))
typedef unsigned short bf16_t;
typedef short bf16x8 __attribute__((ext_vector_type(8)));
typedef short bf16x4 __attribute__((ext_vector_type(4)));
typedef float f32x4 __attribute__((ext_vector_type(4)));
typedef float f32x2 __attribute__((ext_vector_type(2)));
typedef unsigned u32x4 __attribute__((ext_vector_type(4)));
typedef unsigned u32x2 __attribute__((ext_vector_type(2)));
#define RLX_AGENT __ATOMIC_RELAXED, __HIP_MEMORY_SCOPE_AGENT
#define LDS_WAIT() asm volatile("s_waitcnt lgkmcnt(0)" ::: "memory")
#define VM_WAIT() asm volatile("s_waitcnt vmcnt(0)" ::: "memory")

__device__ __forceinline__ unsigned f2bf(float f) { unsigned u = __builtin_bit_cast(unsigned, f); return (u + 0x7fffu + ((u >> 16) & 1u)) >> 16; }
__device__ __forceinline__ unsigned pk2(float lo, float hi) { return f2bf(lo) | (f2bf(hi) << 16); }
__device__ __forceinline__ float bf2f(unsigned short h) { return __builtin_bit_cast(float, (unsigned)h << 16); }
__device__ __forceinline__ float bflo(unsigned w) { return __builtin_bit_cast(float, w << 16); }
__device__ __forceinline__ float bfhi(unsigned w) { return __builtin_bit_cast(float, w & 0xffff0000u); }
__device__ __forceinline__ float fast_sigmoid(float x) { return __builtin_amdgcn_rcpf(1.f + __builtin_amdgcn_exp2f(-1.4426950408889634f * x)); }

namespace fp {
constexpr int NW = 8, NT = NW * 64;
constexpr int NIN = 8448;
constexpr int PB_Q = 0, PB_K = 1024, PB_V = 1152, PB_MQ = 1280, PB_MK = 1792, PB_MV = 2304, PB_MO = 3328, PB_GA = 4352, PB_GM = 6400;
constexpr float QSCALE = 0.125f * 1.4426950408889634f;
constexpr float LOG2E = 1.4426950408889634f;
}

namespace wsf {
constexpr size_t AL(size_t x) { return (x + 255) & ~(size_t)255; }
constexpr size_t CTL = 0, CTL_BYTES = 1u << 20;
constexpr size_t MODP = CTL + CTL_BYTES;
constexpr size_t MOD = AL(MODP + (size_t)16 * 2 * MODW * 4);
constexpr size_t BINP = AL(MOD + (size_t)2 * MODW * 4);
constexpr size_t CS = AL(BINP + (size_t)fp::NIN * 4);
constexpr size_t WRT = AL(CS + (size_t)NTOK * 8 * 8);
constexpr size_t WIN_T = AL(WRT + (size_t)2 * 32 * 2048 * 2);
constexpr size_t WAP_T = AL(WIN_T + (size_t)fp::NIN * 2048 * 2);
constexpr size_t WMP_T = AL(WAP_T + (size_t)2048 * 1024 * 2);
constexpr size_t WOUT_T = AL(WMP_T + (size_t)2048 * 1024 * 2);
constexpr size_t WGU_T = AL(WOUT_T + (size_t)2048 * 2048 * 2);
constexpr size_t WDN_T = AL(WGU_T + (size_t)32 * 4096 * 2048 * 2);
constexpr size_t GATES = AL(WDN_T + (size_t)32 * 2048 * 2048 * 2);
constexpr size_t BCUM = AL(GATES + (size_t)NTOK * 8 * 4);
constexpr size_t LOGI = AL(BCUM + (size_t)8 * S * 4);
constexpr size_t GSUM = AL(LOGI + (size_t)8 * S * 4);
constexpr size_t MLOC = AL(GSUM + 512 * 4);
constexpr size_t MPREV = AL(MLOC + 512 * 4);
constexpr size_t DN = AL(MPREV + 512 * 4);
constexpr size_t NPREV = AL(DN + (size_t)512 * 128 * 4);
constexpr size_t DCT = AL(NPREV + (size_t)512 * 128 * 4);
constexpr size_t Y = AL(DCT + (size_t)512 * 256 * 128 * 4);
constexpr size_t X1 = AL(Y + (size_t)NTOK * 2048 * 2);
constexpr size_t H2 = AL(X1 + (size_t)NTOK * 2048 * 4);
constexpr size_t TOPI = AL(H2 + (size_t)NTOK * 2048 * 2);
constexpr size_t TOPW = AL(TOPI + (size_t)NPAIR * 4);
constexpr size_t LIST = AL(TOPW + (size_t)NPAIR * 4);
constexpr size_t PROJB = AL(LIST + (size_t)NE * NPAIR * 4);
constexpr size_t ACT = PROJB;
constexpr size_t YPREG = AL(PROJB + (size_t)NTOK * fp::NIN * 2);
constexpr size_t H1 = YPREG;
constexpr size_t MG = AL(H1 + (size_t)NTOK * 2048 * 2);
constexpr size_t OAT = AL(MG + (size_t)NTOK * 2048 * 2);
constexpr size_t HM = AL(OAT + (size_t)NTOK * 1024 * 2);
constexpr size_t QC = AL(HM + (size_t)NTOK * 1024 * 2);
constexpr size_t KC = AL(QC + (size_t)NTOK * 512 * 2);
constexpr size_t CPT = AL(KC + (size_t)NTOK * 512 * 2);
constexpr size_t YP = YPREG;
constexpr size_t END = AL(CPT + (size_t)512 * 256 * 128 * 2) > AL(YP + (size_t)NPAIR * 2048 * 2) ? AL(CPT + (size_t)512 * 256 * 128 * 2) : AL(YP + (size_t)NPAIR * 2048 * 2);
static_assert((size_t)NPAIR * 2048 * 2 <= (size_t)NTOK * fp::NIN * 2, "ACT fits over PROJB");
constexpr int CW_BAR = 4096;
constexpr int CW_CNT = 8192;
}

constexpr int RING_BYTES = 131072;
constexpr int LDS_TAB = RING_BYTES;
constexpr int LDS_MISC = RING_BYTES + 8192;
constexpr int LDS_BYTES = 147456;

#define XB_TMO      128
#define XB_XCNT(j)  (256  + 64 * (j))
#define XB_XSUB(j)  (1280 + 64 * (j))
#define XB_XGEN(j)  (2304 + 64 * (j))
#define XB_TOP      3328
#define XB_TOPGEN   3392
#define XCD_BAR_WORDS 3456
#define XB_SPIN_CAP (1u << 18)
__device__ __forceinline__ unsigned xb_ld(unsigned* p)              { return __hip_atomic_load(p, __ATOMIC_RELAXED, __HIP_MEMORY_SCOPE_AGENT); }
__device__ __forceinline__ unsigned xb_add(unsigned* p, unsigned v) { return __hip_atomic_fetch_add(p, v, __ATOMIC_RELAXED, __HIP_MEMORY_SCOPE_AGENT); }
__device__ __forceinline__ unsigned xb_xcc_id() { return (unsigned)__builtin_amdgcn_s_getreg((3 << 11) | 20) & 0xFu; }
#define XB_SPIN(cond, bar) do { unsigned _sp = 0; while (cond) { __builtin_amdgcn_s_sleep(1); \
    if ((++_sp & 255u) == 0u) { if (xb_ld(&(bar)[XB_TMO])) break; if (_sp > XB_SPIN_CAP) { atomicAdd(&(bar)[XB_TMO], 1u); break; } } } } while (0)
struct XcdBarrier { unsigned* bar; unsigned x; volatile LAS unsigned* st; };
__device__ __forceinline__ XcdBarrier xcd_barrier_post(unsigned* bar, volatile LAS unsigned* st, bool t0) {
    XcdBarrier b; b.bar = bar; b.x = xb_xcc_id(); b.st = st;
    if (t0) (void)xb_add(&bar[XB_XCNT(b.x)], 1u);
    return b;
}
__device__ __forceinline__ void xcd_barrier_complete(unsigned* bar, unsigned x, unsigned& nloc, unsigned& nx) {
    const unsigned G = gridDim.x * gridDim.y * gridDim.z;
    unsigned sum, cnt, mine, sp = 0u;
    for (;;) {
        sum = 0u; cnt = 0u; mine = 0u;
#pragma unroll
        for (unsigned j = 0; j < 16; ++j) { const unsigned c = xb_ld(&bar[XB_XCNT(j)]); sum += c; cnt += (c > 0u) ? 1u : 0u; mine = (j == x) ? c : mine; }
        if (sum == G) break;
        __builtin_amdgcn_s_sleep(1);
        if ((++sp & 255u) == 0u) { if (xb_ld(&bar[XB_TMO])) break; if (sp > XB_SPIN_CAP) { atomicAdd(&bar[XB_TMO], 1u); break; } }
    }
    nloc = mine > 0u ? mine : 1u; nx = cnt > 0u ? cnt : 1u;
}
__device__ __forceinline__ void xcd_barrier(const XcdBarrier& b, bool t0) {
    asm volatile("s_waitcnt vmcnt(0)" ::: "memory");
    __syncthreads();
    if (t0) {
        unsigned* bar = b.bar;
        __builtin_amdgcn_s_waitcnt(0);
        unsigned nloc = b.st[0], nx = b.st[1];
        if (nloc == 0u) { xcd_barrier_complete(bar, b.x, nloc, nx); b.st[0] = nloc; b.st[1] = nx; }
        const unsigned old = xb_add(&bar[XB_XSUB(b.x)], 1u);
        const unsigned gen = old / nloc;
        if (old + 1u == (gen + 1u) * nloc) {
            __builtin_amdgcn_fence(__ATOMIC_RELEASE, "agent");
            asm volatile("s_waitcnt vmcnt(0)" ::: "memory");
            const unsigned og = xb_add(&bar[XB_TOP], 1u);
            const unsigned tg = og / nx;
            if (og + 1u == (tg + 1u) * nx) xb_add(&bar[XB_TOPGEN], 1u);
            else XB_SPIN(xb_ld(&bar[XB_TOPGEN]) == tg, bar);
            __builtin_amdgcn_fence(__ATOMIC_ACQUIRE, "agent");
            xb_add(&bar[XB_XGEN(b.x)], 1u);
            asm volatile("s_waitcnt vmcnt(0)" ::: "memory");
        } else {
            XB_SPIN(xb_ld(&bar[XB_XGEN(b.x)]) == gen, bar);
            __builtin_amdgcn_fence(__ATOMIC_ACQUIRE, "agent");
            asm volatile("s_waitcnt vmcnt(0)" ::: "memory");
        }
    }
    __syncthreads();
}

namespace pg8 {
constexpr int BM = 256, BK = 64, HALF = 128, HTB = HALF * BK * 2, STAGE_BYTES = 8 * HTB, NXCD = 8, WGM = 8;
__host__ __device__ __forceinline__ int lds_byte(int r, int c) { const int st = (r >> 4) * 2 + (c >> 5), rr = r & 15, cc = c & 31, ob = rr * 64 + cc * 2; return st * 1024 + (ob ^ (((ob >> 9) & 1) << 5)); }
__host__ __device__ __forceinline__ void stage_rc(int b, int& R, int& C) { const int st = b / 1024, sb = b % 1024, swz = sb ^ (((sb >> 9) & 1) << 5); R = (st >> 1) * 16 + swz / 64; C = (st & 1) * 32 + (swz % 64) / 2; }
__host__ __device__ __forceinline__ int perm32(int rho) { const int n = rho >> 4, i = rho & 15; return 8 * (i >> 2) + 4 * n + (i & 3); }
__device__ __forceinline__ unsigned cvt_pk_bf16(float lo, float hi) { unsigned r; asm volatile("v_cvt_pk_bf16_f32 %0, %1, %2" : "=v"(r) : "v"(lo), "v"(hi)); return r; }

__device__ __forceinline__ bool static_tile(int L, int nM, int nN, int& pm, int& pn) {
    const int nwg = nM * nN; if (L >= nwg) return false;
    int wgid = L; { const int q = nwg / NXCD, r = nwg % NXCD, xcd = wgid % NXCD, off = wgid / NXCD; wgid = (xcd < r ? xcd * (q + 1) : r * (q + 1) + (xcd - r) * q) + off; }
    const int nig = WGM * nN, gid = wgid / nig, fm = gid * WGM, gsz = (nM - fm) < WGM ? (nM - fm) : WGM;
    pm = fm + ((wgid % nig) % gsz); pn = (wgid % nig) / gsz; return true;
}

template <class Epi, class Sched>
__device__ __forceinline__ void gemm_phase(LAS unsigned char* lds, const Sched& S, const Epi& E) {
    typedef typename Sched::UnitT Unit;
    const int wid = S.wave, lane = (int)__builtin_amdgcn_mbcnt_hi(~0u, __builtin_amdgcn_mbcnt_lo(~0u, 0u)), tid = (wid << 6) | lane, wr = wid >> 2, wc = wid & 3, fr = lane & 15, fq = lane >> 4;
    const int K = S.K, nt = K / BK;
    int R[2], C[2];
    unsigned voffB[2];
#pragma unroll
    for (int i = 0; i < 2; ++i) { stage_rc(tid * 16 + i * 8192, R[i], C[i]); const int Rb = (R[i] & ~31) + perm32(R[i] & 31); voffB[i] = (unsigned)(Rb * K + C[i]) * 2u; }
    const size_t kstep = (size_t)(BK * 2);
    const size_t hstepB = (size_t)HALF * K * 2;
    const unsigned ldsw = (unsigned)wid * 1024u;
    const int aoff = lds_byte(wr * 64 + fr, fq * 8), boff = lds_byte(wc * 32 + fr, fq * 8);
#define PG8_SA(b, h) (((b) * 2 + (h)) * HTB)
#define PG8_SB(b, h) ((4 + (b) * 2 + (h)) * HTB)
#define PG8_STAGE2(bufoff, gbase, o0, o1) do { \
        __builtin_amdgcn_global_load_lds((const unsigned*)((const char*)(gbase) + (o0)), (LAS unsigned*)(lds + (bufoff) + ldsw), 16, 0, 0); \
        __builtin_amdgcn_global_load_lds((const unsigned*)((const char*)(gbase) + (o1)), (LAS unsigned*)(lds + (bufoff) + ldsw + 8192), 16, 0, 0); } while (0)
#define PG8_STAGEB(bufoff, gbase) PG8_STAGE2(bufoff, gbase, voffB[0], voffB[1])
#define PG8_LDA(dst, b, h) do { _Pragma("unroll") for (int m = 0; m < 4; ++m) _Pragma("unroll") for (int k = 0; k < 2; ++k) dst[m][k] = *(const LAS bf16x8*)(lds + PG8_SA(b, h) + aoff + m * 2048 + k * 1024); } while (0)
#define PG8_LDB(dst, b, h) do { _Pragma("unroll") for (int n = 0; n < 2; ++n) _Pragma("unroll") for (int k = 0; k < 2; ++k) dst[n][k] = *(const LAS bf16x8*)(lds + PG8_SB(b, h) + boff + n * 2048 + k * 1024); } while (0)
#define PG8_MMA(ai, bj, At, Bt) do { __builtin_amdgcn_s_setprio(1); _Pragma("unroll") for (int m = 0; m < 4; ++m) _Pragma("unroll") for (int n = 0; n < 2; ++n) _Pragma("unroll") for (int k = 0; k < 2; ++k) \
        acc[ai][bj][m][n] = __builtin_amdgcn_mfma_f32_16x16x32_bf16(Bt[n][k], At[m][k], acc[ai][bj][m][n], 0, 0, 0); __builtin_amdgcn_s_setprio(0); } while (0)
#define PG8_WAIT_V(n) asm volatile("s_waitcnt vmcnt(" #n ")" ::: "memory")
#define PG8_WAIT_L(n) asm volatile("s_waitcnt lgkmcnt(" #n ")" ::: "memory")
#define PG8_BAR __builtin_amdgcn_s_barrier()
#define PG8_SCHED __builtin_amdgcn_sched_barrier(0)
    Unit cur, nxt; int ui = 0;
    if (!S.next(0, cur)) return;
    f32x4 acc[2][2][4][2];
#pragma unroll
    for (int a = 0; a < 2; ++a)
#pragma unroll
        for (int b = 0; b < 2; ++b)
#pragma unroll
            for (int m = 0; m < 4; ++m)
#pragma unroll
                for (int n = 0; n < 2; ++n) { float z0, z1, z2, z3; asm volatile("v_mov_b32 %0, 0\n\tv_mov_b32 %1, 0\n\tv_mov_b32 %2, 0\n\tv_mov_b32 %3, 0" : "=v"(z0), "=v"(z1), "=v"(z2), "=v"(z3)); acc[a][b][m][n] = (f32x4){z0, z1, z2, z3}; }
    bf16x8 At[4][2], B0[2][2], B1[2][2];
    unsigned ca[4], na[4];
    S.a_offs(cur, R[0], R[1], C[0], C[1], ca);
    const char* cA = S.a_base(cur); const char* cB = S.b_base(cur);
    PG8_STAGEB(PG8_SB(0, 0), cB); PG8_STAGEB(PG8_SB(0, 1), cB + hstepB); PG8_STAGE2(PG8_SA(0, 0), cA, ca[0], ca[1]); PG8_STAGE2(PG8_SA(0, 1), cA, ca[2], ca[3]);
    if (wr == 1) PG8_BAR;
    PG8_WAIT_V(2); PG8_BAR;
    PG8_STAGEB(PG8_SB(1, 0), cB + kstep); PG8_STAGE2(PG8_SA(1, 0), cA + kstep, ca[0], ca[1]); PG8_STAGEB(PG8_SB(1, 1), cB + hstepB + kstep);
    PG8_WAIT_V(6); PG8_BAR;
    for (;;) {
        const bool has_next = S.next(ui + 1, nxt);
        const char* nA = cA; const char* nB = cB;
#pragma unroll
        for (int i = 0; i < 4; ++i) na[i] = ca[i];
        if (has_next) { nA = S.a_base(nxt); nB = S.b_base(nxt); S.a_offs(nxt, R[0], R[1], C[0], C[1], na); }
        for (int t = 0; t < nt; t += 2) {
            const bool last = (t == nt - 2);
            const char* a1 = cA + (size_t)(t + 1) * kstep;
            const char* a2 = last ? nA : cA + (size_t)(t + 2) * kstep; const char* b2 = last ? nB : cB + (size_t)(t + 2) * kstep;
            const char* a3 = a2 + kstep; const char* b3 = b2 + kstep;
            const unsigned x0 = last ? na[0] : ca[0], x1 = last ? na[1] : ca[1], x2 = last ? na[2] : ca[2], x3 = last ? na[3] : ca[3];
            PG8_LDB(B0, 0, 0); PG8_LDB(B1, 0, 1); PG8_SCHED; PG8_LDA(At, 0, 0); PG8_STAGE2(PG8_SA(1, 1), a1, ca[2], ca[3]);
            PG8_WAIT_V(8); PG8_WAIT_L(0); PG8_BAR; PG8_MMA(0, 0, At, B0); PG8_MMA(0, 1, At, B1); PG8_BAR; PG8_SCHED;
            PG8_LDA(At, 0, 1); PG8_STAGEB(PG8_SB(0, 0), b2); PG8_STAGEB(PG8_SB(0, 1), b2 + hstepB); PG8_STAGE2(PG8_SA(0, 0), a2, x0, x1);
            PG8_WAIT_V(8); PG8_WAIT_L(0); PG8_BAR; PG8_MMA(1, 0, At, B0); PG8_MMA(1, 1, At, B1); PG8_BAR; PG8_SCHED;
            PG8_LDB(B0, 1, 0); PG8_LDB(B1, 1, 1); PG8_SCHED; PG8_LDA(At, 1, 0); PG8_STAGE2(PG8_SA(0, 1), a2, x2, x3);
            PG8_WAIT_V(8); PG8_WAIT_L(0); PG8_BAR; PG8_MMA(0, 0, At, B0); PG8_MMA(0, 1, At, B1); PG8_BAR; PG8_SCHED;
            PG8_LDA(At, 1, 1); PG8_STAGEB(PG8_SB(1, 0), b3); PG8_STAGEB(PG8_SB(1, 1), b3 + hstepB); PG8_STAGE2(PG8_SA(1, 0), a3, x0, x1);
            PG8_WAIT_V(8); PG8_WAIT_L(0); PG8_BAR; PG8_MMA(1, 0, At, B0); PG8_MMA(1, 1, At, B1); PG8_BAR; PG8_SCHED;
        }
        if (wr == 0) PG8_BAR;
        E(acc, cur, wr, wc, fr, fq);
        if (!has_next) break;
#pragma unroll
        for (int a = 0; a < 2; ++a)
#pragma unroll
            for (int b = 0; b < 2; ++b)
#pragma unroll
                for (int m = 0; m < 4; ++m)
#pragma unroll
                    for (int n = 0; n < 2; ++n) { float z0, z1, z2, z3; asm volatile("v_mov_b32 %0, 0\n\tv_mov_b32 %1, 0\n\tv_mov_b32 %2, 0\n\tv_mov_b32 %3, 0" : "=v"(z0), "=v"(z1), "=v"(z2), "=v"(z3)); acc[a][b][m][n] = (f32x4){z0, z1, z2, z3}; }
        cur = nxt; cA = nA; cB = nB; ++ui;
#pragma unroll
        for (int i = 0; i < 4; ++i) ca[i] = na[i];
        if (wr == 1) PG8_BAR;
    }
    PG8_WAIT_V(0);
    PG8_BAR;
#undef PG8_SA
#undef PG8_SB
#undef PG8_STAGE2
#undef PG8_STAGEB
#undef PG8_LDA
#undef PG8_LDB
#undef PG8_MMA
#undef PG8_WAIT_V
#undef PG8_WAIT_L
#undef PG8_BAR
#undef PG8_SCHED
}
}

struct DenseUnit { int pm, pn; };
struct DenseSched {
    typedef DenseUnit UnitT;
    const bf16_t* A; const bf16_t* Bt; int lda; int K; int nM, nN, G, c, wave;
    __device__ __forceinline__ bool next(int i, DenseUnit& u) const { return pg8::static_tile(i * G + c, nM, nN, u.pm, u.pn); }
    __device__ __forceinline__ const char* a_base(const DenseUnit& u) const { return (const char*)(A + (size_t)u.pm * 256 * lda); }
    __device__ __forceinline__ const char* b_base(const DenseUnit& u) const { return (const char*)(Bt + (size_t)u.pn * 256 * K); }
    __device__ __forceinline__ void a_offs(const DenseUnit&, int R0, int R1, int C0, int C1, unsigned (&o)[4]) const {
        o[0] = (unsigned)(R0 * lda + C0) * 2u; o[1] = (unsigned)(R1 * lda + C1) * 2u; o[2] = (unsigned)((R0 + 128) * lda + C0) * 2u; o[3] = (unsigned)((R1 + 128) * lda + C1) * 2u;
    }
};
struct MkArgs {
    const float* x; const float* c; const int* positions; const float* w_ada; const float* b_ada;
    const float* g_pre_mix; const float* g_post_mix; const float* g_pre_ffn; const float* g_post_ffn;
    const float* w_in; const float* b_in; const float* conv_qk; const float* sinks; const float* g_mlstm;
    const float* w_attn_proj; const float* w_mlstm_proj; const float* w_out; const float* w_router; const float* b_router;
    const float* w_gate_up; const float* b_gate_up; const float* w_down; const float* b_down;
    float* out; unsigned char* ws;
    const int* route_i; const float* route_w;
    int ph_lo, ph_hi;
};

struct Frame {
    LAS unsigned char* lds;
    int G, bid, vcu, wave;
};
__device__ __forceinline__ int lane_id() { return (int)__builtin_amdgcn_mbcnt_hi(~0u, __builtin_amdgcn_mbcnt_lo(~0u, 0u)); }
__device__ __forceinline__ int fresh_tid(const Frame& F) { return (F.wave << 6) | lane_id(); }

__device__ __forceinline__ float wave_sum_f(float v) {
#pragma unroll
    for (int o = 1; o < 64; o <<= 1) v += __shfl_xor(v, o);
    return v;
}
__device__ __forceinline__ float wave_max_f(float v) {
#pragma unroll
    for (int o = 1; o < 64; o <<= 1) v = fmaxf(v, __shfl_xor(v, o));
    return v;
}

__device__ __forceinline__ int in_src_col(int n) {
    if (n < 1152) { const int d = n & 63; if (d < 16) return (n & ~63) + (d >> 1) + 8 * (d & 1); return n; }
    if (n < 4352) return n;
    return n + 8;
}

template <bool MAP>
__device__ __forceinline__ void p0_transpose_item(const float* __restrict__ W, int K, int N, bf16_t* WT, LAS float* scr, int kb, int nb, int lane) {
    const int k0 = 64 * kb, n0 = 32 * nb;
    const int sc = MAP ? in_src_col(n0 + (lane & 31)) : n0 + (lane & 31);
#pragma unroll 8
    for (int i = 0; i < 32; ++i) { const int kk = 2 * i + (lane >> 5); scr[kk * 33 + (lane & 31)] = W[(size_t)(k0 + kk) * N + sc]; }
    LDS_WAIT(); asm volatile("" ::: "memory");
    const int c = lane & 7;
#pragma unroll
    for (int j = 0; j < 4; ++j) { const int n = (lane >> 3) + 8 * j; const LAS float* s = scr + (8 * c) * 33 + n;
        u32x4 o; o.x = pk2(s[0 * 33], s[1 * 33]); o.y = pk2(s[2 * 33], s[3 * 33]); o.z = pk2(s[4 * 33], s[5 * 33]); o.w = pk2(s[6 * 33], s[7 * 33]);
        *(u32x4*)(WT + (size_t)(n0 + n) * K + k0 + 8 * c) = o; }
    LDS_WAIT(); asm volatile("" ::: "memory");
}

__device__ __forceinline__ void phase0(const MkArgs& a, Frame& F) {
    const int f_tid = fresh_tid(F), f_lane = f_tid & 63, f_wave = F.wave;
    unsigned char* ws = a.ws;
    LAS float* scr = (LAS float*)(F.lds + f_wave * 16384);
    const int gw = F.vcu * fp::NW + f_wave, NGW = F.G * fp::NW;
    constexpr int I_IN = 32 * (fp::NIN / 32), I_AP = 16 * 64, I_MP = 16 * 64, I_OUT = 32 * 64, I_GU = 32 * 128, I_DN = 32 * 64;
    constexpr int NITEMS = I_IN + I_AP + I_MP + I_OUT + NE * I_GU + NE * I_DN;
    for (int it = gw; it < NITEMS; it += NGW) {
        int r = it;
        if (r < I_IN) { const int nblk = fp::NIN / 32; p0_transpose_item<true>(a.w_in, 2048, INW, (bf16_t*)(ws + wsf::WIN_T), scr, r / nblk, r % nblk, f_lane); continue; } r -= I_IN;
        if (r < I_AP) { p0_transpose_item<false>(a.w_attn_proj, 1024, 2048, (bf16_t*)(ws + wsf::WAP_T), scr, r / 64, r % 64, f_lane); continue; } r -= I_AP;
        if (r < I_MP) { p0_transpose_item<false>(a.w_mlstm_proj, 1024, 2048, (bf16_t*)(ws + wsf::WMP_T), scr, r / 64, r % 64, f_lane); continue; } r -= I_MP;
        if (r < I_OUT) { p0_transpose_item<false>(a.w_out, 2048, 2048, (bf16_t*)(ws + wsf::WOUT_T), scr, r / 64, r % 64, f_lane); continue; } r -= I_OUT;
        if (r < NE * I_GU) { const int e = r / I_GU, q = r % I_GU; p0_transpose_item<false>(a.w_gate_up + (size_t)e * 2048 * 4096, 2048, 4096, (bf16_t*)(ws + wsf::WGU_T) + (size_t)e * 4096 * 2048, scr, q / 128, q % 128, f_lane); continue; } r -= NE * I_GU;
        { const int e = r / I_DN, q = r % I_DN; p0_transpose_item<false>(a.w_down + (size_t)e * 2048 * 2048, 2048, 2048, (bf16_t*)(ws + wsf::WDN_T) + (size_t)e * 2048 * 2048, scr, q / 64, q % 64, f_lane); }
    }
    {
        float* part = (float*)(ws + wsf::MODP);
        for (int it = gw; it < (MODW / 64) * 16; it += NGW) {
            const int jb = it % (MODW / 64), ks = it / (MODW / 64), j = jb * 64 + f_lane, k0 = ks * 128;
            float a0 = 0.f, a1 = 0.f;
            for (int k = k0; k < k0 + 128; ++k) { const float w = a.w_ada[(size_t)k * MODW + j]; a0 += silu_f(a.c[k]) * w; a1 += silu_f(a.c[D + k]) * w; }
            part[(size_t)(ks * 2 + 0) * MODW + j] = a0; part[(size_t)(ks * 2 + 1) * MODW + j] = a1;
        }
    }
    const int gt = F.vcu * fp::NT + f_tid, NGT = F.G * fp::NT;
    for (int i = gt; i < NTOK * 8; i += NGT) { float cs, sn; rope_cs(a.positions[i >> 3], i & 7, cs, sn); ((f32x2*)(ws + wsf::CS))[i] = (f32x2){cs, sn}; }
    for (int i = gt; i < fp::NIN; i += NGT) ((float*)(ws + wsf::BINP))[i] = a.b_in[in_src_col(i)];
    for (int i = gt; i < 32 * 2048; i += NGT) {
        const int e = i >> 11, k = i & 2047; const float w = a.w_router[k * 32 + e]; const unsigned hi = f2bf(w); const float rem = w - __builtin_bit_cast(float, hi << 16);
        ((bf16_t*)(ws + wsf::WRT))[i] = (bf16_t)hi; ((bf16_t*)(ws + wsf::WRT))[32 * 2048 + i] = (bf16_t)f2bf(rem);
    }
}

__device__ __forceinline__ void phase1(const MkArgs& a, Frame& F) {
    const int f_tid = fresh_tid(F), f_lane = f_tid & 63, f_wave = F.wave;
    unsigned char* ws = a.ws;
    const float* part = (const float*)(ws + wsf::MODP);
    float* mod = (float*)(ws + wsf::MOD);
    { const int per = (2 * MODW) / F.G;
      for (int i = f_tid; i < per; i += fp::NT) { const int idx = F.vcu * per + i, b = idx / MODW, j = idx % MODW; float s = a.b_ada[j];
#pragma unroll
          for (int p = 0; p < 16; ++p) s += part[(size_t)(p * 2 + b) * MODW + j];
          mod[idx] = s; }
      if (F.vcu == 0) for (int idx = per * F.G + f_tid; idx < 2 * MODW; idx += fp::NT) { const int b = idx / MODW, j = idx % MODW; float s = a.b_ada[j];
          for (int p = 0; p < 16; ++p) s += part[(size_t)(p * 2 + b) * MODW + j];
          mod[idx] = s; } }
    LAS float* lmod = (LAS float*)F.lds;
    LAS float* wg = (LAS float*)(F.lds + 32768);
    for (int i = f_tid; i < 2 * 4096; i += fp::NT) { const int b = i >> 12, j = i & 4095; float s = a.b_ada[j];
#pragma unroll
        for (int p = 0; p < 16; ++p) s += part[(size_t)(p * 2 + b) * MODW + j];
        lmod[i] = s; }
    for (int i = f_tid; i < 2048 * 8; i += fp::NT) wg[i] = a.w_in[(size_t)(i >> 3) * INW + OFF_MI + (i & 7)];
    __syncthreads();
    const int gw = F.vcu * fp::NW + f_wave, NGW = F.G * fp::NW;
    for (int m = gw; m < NTOK; m += NGW) {
        const int b = m / S;
        const GAS f32x4* xr = (const GAS f32x4*)(a.x + (size_t)m * D);
        float ss = 0.f;
#pragma unroll
        for (int j = 0; j < 8; ++j) { const f32x4 v = xr[64 * j + f_lane]; ss += (v.x * v.x + v.y * v.y) + (v.z * v.z + v.w * v.w); }
        const float r = rsqrtf(wave_sum_f(ss) * (1.f / D) + EPS);
        float g8[8];
#pragma unroll
        for (int e = 0; e < 8; ++e) g8[e] = 0.f;
        GAS u32x2* o8 = (GAS u32x2*)(ws + wsf::H1 + (size_t)m * D * 2);
#pragma unroll 1
        for (int j = 0; j < 8; ++j) {
            const int c0 = 4 * (64 * j + f_lane);
            const f32x4 v = xr[64 * j + f_lane];
            const f32x4 g = *(const f32x4*)(a.g_pre_mix + c0);
            const f32x4 sh = *(const LAS f32x4*)(lmod + b * 4096 + c0), sc = *(const LAS f32x4*)(lmod + b * 4096 + 2048 + c0);
            f32x4 h;
            h.x = v.x * r * g.x * (1.f + sc.x) + sh.x; h.y = v.y * r * g.y * (1.f + sc.y) + sh.y;
            h.z = v.z * r * g.z * (1.f + sc.z) + sh.z; h.w = v.w * r * g.w * (1.f + sc.w) + sh.w;
            o8[64 * j + f_lane] = (u32x2){pk2(h.x, h.y), pk2(h.z, h.w)};
#pragma unroll
            for (int q = 0; q < 4; ++q) {
                const f32x4 w0 = *(const LAS f32x4*)(wg + (c0 + q) * 8), w1 = *(const LAS f32x4*)(wg + (c0 + q) * 8 + 4);
                const float hv = h[q];
                g8[0] += hv * w0.x; g8[1] += hv * w0.y; g8[2] += hv * w0.z; g8[3] += hv * w0.w;
                g8[4] += hv * w1.x; g8[5] += hv * w1.y; g8[6] += hv * w1.z; g8[7] += hv * w1.w;
            }
        }
        float mine = 0.f;
#pragma unroll
        for (int e = 0; e < 8; ++e) { const float s = wave_sum_f(g8[e]); if (f_lane == e) mine = s; }
        if (f_lane < 8) ((float*)(ws + wsf::GATES))[(size_t)m * 8 + f_lane] = mine + a.b_in[OFF_MI + f_lane];
    }
}

struct EpiIn {
    bf16_t* O; const float* bias; const f32x2* cs;
    __device__ __forceinline__ void operator()(const f32x4 (&acc)[2][2][4][2], const DenseUnit& u, int wr, int wc, int fr, int fq) const {
        const int row0 = u.pm * 256 + wr * 64 + fr, col0 = u.pn * 256 + wc * 32 + 8 * fq;
        const int pn = u.pn;
        const bool ropelane = ((wc & 1) == 0) && fq < 2;
        const int i0 = fq * 4;
        f32x4 bv[2][2];
#pragma unroll
        for (int bj = 0; bj < 2; ++bj)
#pragma unroll
            for (int n = 0; n < 2; ++n) bv[bj][n] = *(const f32x4*)(bias + col0 + bj * 128 + 4 * n);
#pragma unroll
        for (int ai = 0; ai < 2; ++ai)
#pragma unroll
            for (int m = 0; m < 4; ++m) {
                const int row = row0 + ai * 128 + m * 16;
                bf16_t* rowp = O + (size_t)row * fp::NIN + col0;
#pragma unroll
                for (int bj = 0; bj < 2; ++bj) {
                    f32x4 v0 = acc[ai][bj][m][0] + bv[bj][0], v1 = acc[ai][bj][m][1] + bv[bj][1];
                    if (pn < 4 || (pn == 4 && bj == 0)) {
                        if (ropelane) {
                            const f32x4 ca = *(const f32x4*)(cs + (size_t)row * 8 + i0), cb = *(const f32x4*)(cs + (size_t)row * 8 + i0 + 2);
                            f32x4 r0, r1;
                            r0.x = v0.x * ca.x - v0.y * ca.y; r0.y = v0.y * ca.x + v0.x * ca.y;
                            r0.z = v0.z * ca.z - v0.w * ca.w; r0.w = v0.w * ca.z + v0.z * ca.w;
                            r1.x = v1.x * cb.x - v1.y * cb.y; r1.y = v1.y * cb.x + v1.x * cb.y;
                            r1.z = v1.z * cb.z - v1.w * cb.w; r1.w = v1.w * cb.z + v1.z * cb.w;
                            v0 = r0; v1 = r1;
                        }
                        if (pn < 4) { v0 = v0 * fp::QSCALE; v1 = v1 * fp::QSCALE; }
                    } else if (pn >= 13) {
#pragma unroll
                        for (int q = 0; q < 4; ++q) { v0[q] = fast_sigmoid(v0[q]); v1[q] = fast_sigmoid(v1[q]); }
                    }
                    u32x4 w; w.x = pg8::cvt_pk_bf16(v0[0], v0[1]); w.y = pg8::cvt_pk_bf16(v0[2], v0[3]); w.z = pg8::cvt_pk_bf16(v1[0], v1[1]); w.w = pg8::cvt_pk_bf16(v1[2], v1[3]);
                    *(u32x4*)(rowp + bj * 128) = w;
                }
            }
    }
};

__device__ __forceinline__ void phase2(const MkArgs& a, Frame& F) {
    const int f_tid = fresh_tid(F), f_lane = f_tid & 63, f_wave = F.wave;
    unsigned char* ws = a.ws;
    DenseSched S{(const bf16_t*)(ws + wsf::H1), (const bf16_t*)(ws + wsf::WIN_T), 2048, 2048, NTOK / 256, fp::NIN / 256, F.G, F.bid, F.wave};
    EpiIn E{(bf16_t*)(ws + wsf::PROJB), (const float*)(ws + wsf::BINP), (const f32x2*)(ws + wsf::CS)};
    pg8::gemm_phase<EpiIn, DenseSched>(F.lds, S, E);
}
__device__ __forceinline__ f32x4 mfma16(bf16x8 a, bf16x8 b, f32x4 c) { return __builtin_amdgcn_mfma_f32_16x16x32_bf16(a, b, c, 0, 0, 0); }
__device__ __forceinline__ float exp2_fast(float x) { return __builtin_amdgcn_exp2f(x); }

__device__ __forceinline__ void attn_unit(const MkArgs& a, Frame& F, int unit) {
    const int f_tid = fresh_tid(F), f_lane = f_tid & 63, f_wave = F.wave;
    const int b = unit >> 7, hk = (unit >> 6) & 1, n = unit & 63;
    const bf16_t* PB = (const bf16_t*)(a.ws + wsf::PROJB);
    bf16_t* OA = (bf16_t*)(a.ws + wsf::OAT);
    const size_t tok0 = (size_t)b * S + (size_t)n * 128;
    LAS bf16_t* Ks = (LAS bf16_t*)F.lds;
    LAS bf16_t* Vt = (LAS bf16_t*)(F.lds + 36864);
    LAS bf16_t* Pw = (LAS bf16_t*)(F.lds + 36864 + 35840 + f_wave * 5376);
#pragma unroll
    for (int i = 0; i < 4; ++i) {
        const int q = f_tid + 512 * i, row = q >> 3, ch = q & 7;
        u32x4 kv = (u32x4){0u, 0u, 0u, 0u}, vv = kv;
        if (n > 0 || row >= 128) {
            const bf16_t* src = PB + (tok0 - 128 + row) * fp::NIN + hk * 64 + ch * 8;
            kv = *(const u32x4*)(src + fp::PB_K); vv = *(const u32x4*)(src + fp::PB_V);
        }
        *(LAS u32x4*)(Ks + row * 72 + ch * 8) = kv;
        LAS bf16_t* vd = Vt + (ch * 8) * 280 + row;
        vd[0 * 280] = (bf16_t)(vv.x & 0xffffu); vd[1 * 280] = (bf16_t)(vv.x >> 16); vd[2 * 280] = (bf16_t)(vv.y & 0xffffu); vd[3 * 280] = (bf16_t)(vv.y >> 16);
        vd[4 * 280] = (bf16_t)(vv.z & 0xffffu); vd[5 * 280] = (bf16_t)(vv.z >> 16); vd[6 * 280] = (bf16_t)(vv.w & 0xffffu); vd[7 * 280] = (bf16_t)(vv.w >> 16);
    }
    for (int i = f_tid; i < 64 * 24; i += fp::NT) Vt[(i / 24) * 280 + 256 + (i % 24)] = (bf16_t)0;
    __syncthreads();
    const int c16 = f_lane & 15, grp = f_lane >> 4, h = hk * 8 + f_wave;
    const float sink2 = a.sinks[h] * fp::LOG2E;
#pragma unroll 1
    for (int tt = 0; tt < 8; ++tt) {
        const size_t qtok = tok0 + tt * 16 + c16;
        bf16x8 qf[2];
#pragma unroll
        for (int ks = 0; ks < 2; ++ks) qf[ks] = *(const bf16x8*)(PB + qtok * fp::NIN + fp::PB_Q + h * 64 + ks * 32 + grp * 8);
        f32x4 sacc[9];
#pragma unroll
        for (int jq = 0; jq < 9; ++jq) {
            sacc[jq] = (f32x4){0.f, 0.f, 0.f, 0.f};
#pragma unroll
            for (int ks = 0; ks < 2; ++ks) { const bf16x8 kf = *(const LAS bf16x8*)(Ks + (16 * (tt + jq) + c16) * 72 + ks * 32 + grp * 8); sacc[jq] = mfma16(kf, qf[ks], sacc[jq]); }
        }
        float mx = sink2;
#pragma unroll
        for (int jq = 0; jq < 9; ++jq)
#pragma unroll
            for (int r = 0; r < 4; ++r) {
                const int diff = 128 + c16 - 16 * jq - 4 * grp - r, jrel = 16 * (tt + jq) + 4 * grp + r;
                const bool ok = diff >= 0 && diff < 128 && (n > 0 || jrel >= 128);
                sacc[jq][r] = ok ? sacc[jq][r] : -INFINITY;
                mx = fmaxf(mx, sacc[jq][r]);
            }
        mx = fmaxf(mx, __shfl_xor(mx, 16)); mx = fmaxf(mx, __shfl_xor(mx, 32));
        float ls = 0.f;
#pragma unroll
        for (int jq = 0; jq < 9; ++jq) {
            float p[4];
#pragma unroll
            for (int r = 0; r < 4; ++r) { p[r] = exp2_fast(sacc[jq][r] - mx); ls += p[r]; }
            *(LAS u32x2*)(Pw + c16 * 168 + 16 * jq + 4 * grp) = (u32x2){pk2(p[0], p[1]), pk2(p[2], p[3])};
        }
        *(LAS u32x2*)(Pw + c16 * 168 + 144 + 4 * grp) = (u32x2){0u, 0u};
        ls += __shfl_xor(ls, 16); ls += __shfl_xor(ls, 32);
        ls += exp2_fast(sink2 - mx);
        const float inv = 1.f / ls;
        LDS_WAIT();
        f32x4 oacc[4];
#pragma unroll
        for (int dt = 0; dt < 4; ++dt) oacc[dt] = (f32x4){0.f, 0.f, 0.f, 0.f};
#pragma unroll
        for (int k2 = 0; k2 < 5; ++k2) {
            const bf16x8 pb = *(const LAS bf16x8*)(Pw + c16 * 168 + 32 * k2 + 8 * grp);
#pragma unroll
            for (int dt = 0; dt < 4; ++dt) { const bf16x8 va = *(const LAS bf16x8*)(Vt + (16 * dt + c16) * 280 + 16 * tt + 32 * k2 + 8 * grp); oacc[dt] = mfma16(va, pb, oacc[dt]); }
        }
#pragma unroll
        for (int dt = 0; dt < 4; ++dt)
            *(u32x2*)(OA + qtok * 1024 + h * 64 + 16 * dt + 4 * grp) = (u32x2){pk2(oacc[dt][0] * inv, oacc[dt][1] * inv), pk2(oacc[dt][2] * inv, oacc[dt][3] * inv)};
        LDS_WAIT();
    }
    __syncthreads();
}

__device__ __forceinline__ void unpack8(const u32x4 v, float (&f)[8]) {
    f[0] = bflo(v.x); f[1] = bfhi(v.x); f[2] = bflo(v.y); f[3] = bfhi(v.y); f[4] = bflo(v.z); f[5] = bfhi(v.z); f[6] = bflo(v.w); f[7] = bfhi(v.w);
}
__device__ __forceinline__ void stage_vt(const bf16_t* PB, size_t tok0, int col0, LAS bf16_t* Vt, int tid) {
#pragma unroll
    for (int i = 0; i < 8; ++i) {
        const int q = tid + 512 * i, row = q >> 5, ch = q & 31;
        const u32x4 vv = *(const u32x4*)(PB + (tok0 + row) * fp::NIN + col0 + ch * 8);
        LAS bf16_t* vd = Vt + (ch * 8) * 136 + row;
        vd[0 * 136] = (bf16_t)(vv.x & 0xffffu); vd[1 * 136] = (bf16_t)(vv.x >> 16); vd[2 * 136] = (bf16_t)(vv.y & 0xffffu); vd[3 * 136] = (bf16_t)(vv.y >> 16);
        vd[4 * 136] = (bf16_t)(vv.z & 0xffffu); vd[5 * 136] = (bf16_t)(vv.z >> 16); vd[6 * 136] = (bf16_t)(vv.w & 0xffffu); vd[7 * 136] = (bf16_t)(vv.w >> 16);
    }
}

__device__ __forceinline__ void m1_unit(const MkArgs& a, Frame& F, int u) {
    const int f_tid = fresh_tid(F), f_lane = f_tid & 63, f_wave = F.wave;
    const int bh = u >> 6, c = u & 63, b = bh >> 2, h = bh & 3;
    const size_t tok0 = (size_t)b * S + (size_t)c * 128;
    unsigned char* ws = a.ws;
    const bf16_t* PB = (const bf16_t*)(ws + wsf::PROJB);
    LAS bf16_t* KwT = (LAS bf16_t*)F.lds;
    LAS bf16_t* Vt = (LAS bf16_t*)(F.lds + 34816);
    LAS float* gl = (LAS float*)(F.lds + 34816 + 69632);
    const float* GT = (const float*)(ws + wsf::GATES);
    const int tid = f_tid;
    float li = 0.f, lf = 0.f;
    if (tid < 128) { li = softcap_f(GT[(tok0 + tid) * 8 + h]); lf = logsigmoid_f(softcap_f(GT[(tok0 + tid) * 8 + 4 + h])); }
    float cum = lf;
#pragma unroll
    for (int o = 1; o < 64; o <<= 1) { const float t = __shfl_up(cum, o); if (f_lane >= o) cum += t; }
    if (tid == 63) gl[384] = cum;
    __syncthreads();
    if (tid >= 64 && tid < 128) cum += gl[384];
    if (tid == 127) gl[385] = cum;
    __syncthreads();
    const float g = gl[385];
    const float av = (tid < 128) ? (g - cum + li) : -INFINITY;
    const float wm = wave_max_f(av);
    if (f_lane == 0 && f_wave < 2) gl[386 + f_wave] = wm;
    __syncthreads();
    const float mloc = fmaxf(gl[386], gl[387]);
    if (tid < 128) {
        gl[256 + tid] = expf(av - mloc);
        ((float*)(ws + wsf::BCUM))[(size_t)bh * S + c * 128 + tid] = cum;
        ((float*)(ws + wsf::LOGI))[(size_t)bh * S + c * 128 + tid] = li;
    }
    if (tid == 0) { ((float*)(ws + wsf::GSUM))[u] = g; ((float*)(ws + wsf::MLOC))[u] = mloc; }
    __syncthreads();
#pragma unroll 1
    for (int i = 0; i < 8; ++i) {
        const int q = tid + 512 * i, row = q >> 5, ch = q & 31, isK = ch >= 16, cc = (ch & 15) * 8;
        const int colsrc = (isK ? fp::PB_MK : fp::PB_MQ) + h * 128 + cc, cwcol = (isK ? 512 : 0) + h * 128 + cc;
        float acc[8];
#pragma unroll
        for (int e = 0; e < 8; ++e) acc[e] = 0.f;
#pragma unroll
        for (int j = 0; j < 4; ++j) {
            const int sabs = c * 128 + row - 3 + j;
            if (sabs >= 0) {
                const u32x4 xv = *(const u32x4*)(PB + (tok0 + row - 3 + j) * fp::NIN + colsrc);
                float xf[8]; unpack8(xv, xf);
                const f32x4 w0 = *(const f32x4*)(a.conv_qk + j * 1024 + cwcol), w1 = *(const f32x4*)(a.conv_qk + j * 1024 + cwcol + 4);
                acc[0] += w0.x * xf[0]; acc[1] += w0.y * xf[1]; acc[2] += w0.z * xf[2]; acc[3] += w0.w * xf[3];
                acc[4] += w1.x * xf[4]; acc[5] += w1.y * xf[5]; acc[6] += w1.z * xf[6]; acc[7] += w1.w * xf[7];
            }
        }
        const float sc = isK ? 0.08838834764831845f : 1.f;
#pragma unroll
        for (int e = 0; e < 8; ++e) acc[e] = silu_f(acc[e]) * sc;
        const u32x4 o = (u32x4){pk2(acc[0], acc[1]), pk2(acc[2], acc[3]), pk2(acc[4], acc[5]), pk2(acc[6], acc[7])};
        bf16_t* dst = (bf16_t*)(ws + (isK ? wsf::KC : wsf::QC)) + (tok0 + row) * 512 + h * 128 + cc;
        *(u32x4*)dst = o;
        if (isK) {
            const float wr = gl[256 + row];
            LAS bf16_t* kd = KwT + cc * 136 + row;
#pragma unroll
            for (int e = 0; e < 8; ++e) kd[e * 136] = (bf16_t)f2bf(acc[e] * wr);
        }
    }
    stage_vt(PB, tok0, fp::PB_MV + h * 256, Vt, tid);
    __syncthreads();
    const int c16 = f_lane & 15, grp = f_lane >> 4, w = f_wave;
    f32x4 acc[8][2];
#pragma unroll
    for (int d = 0; d < 8; ++d) { acc[d][0] = (f32x4){0.f, 0.f, 0.f, 0.f}; acc[d][1] = acc[d][0]; }
#pragma unroll
    for (int ks = 0; ks < 4; ++ks) {
        bf16x8 bfr[2];
#pragma unroll
        for (int i = 0; i < 2; ++i) bfr[i] = *(const LAS bf16x8*)(Vt + (16 * (2 * w + i) + c16) * 136 + 32 * ks + 8 * grp);
#pragma unroll
        for (int d = 0; d < 8; ++d) {
            const bf16x8 af = *(const LAS bf16x8*)(KwT + (16 * d + c16) * 136 + 32 * ks + 8 * grp);
            acc[d][0] = mfma16(af, bfr[0], acc[d][0]); acc[d][1] = mfma16(af, bfr[1], acc[d][1]);
        }
    }
    float* dct = (float*)(ws + wsf::DCT) + (size_t)u * 256 * 128;
#pragma unroll
    for (int d = 0; d < 8; ++d)
#pragma unroll
        for (int i = 0; i < 2; ++i) *(f32x4*)(dct + (size_t)(16 * (2 * w + i) + c16) * 128 + 16 * d + 4 * grp) = acc[d][i];
    if (tid < 128) {
        float s = 0.f;
#pragma unroll
        for (int ch = 0; ch < 16; ++ch) { const u32x4 kv = *(const LAS u32x4*)(KwT + tid * 136 + ch * 8); float kf[8]; unpack8(kv, kf);
#pragma unroll
            for (int e = 0; e < 8; ++e) s += kf[e]; }
        ((float*)(ws + wsf::DN))[(size_t)u * 128 + tid] = s;
    }
    __syncthreads();
}

__device__ __forceinline__ void phase3(const MkArgs& a, Frame& F) {
    const int f_tid = fresh_tid(F), f_lane = f_tid & 63, f_wave = F.wave;
    for (int u = F.bid; u < NB * HKV * (S / 128); u += F.G) attn_unit(a, F, u);
    for (int u = F.bid; u < NB * MH * NC; u += F.G) m1_unit(a, F, u);
}

__device__ __forceinline__ void phase4(const MkArgs& a, Frame& F) {
    const int f_tid = fresh_tid(F), f_lane = f_tid & 63, f_wave = F.wave;
    unsigned char* ws = a.ws;
    LAS float* dec = (LAS float*)F.lds;
    LAS float* scl = dec + 512;
    if (f_tid < 8) {
        const int bh = f_tid; float m = 0.f;
        for (int c = 0; c < NC; ++c) {
            const float g = ((const float*)(ws + wsf::GSUM))[bh * NC + c], ml = ((const float*)(ws + wsf::MLOC))[bh * NC + c];
            if (F.bid == 0) ((float*)(ws + wsf::MPREV))[bh * NC + c] = m;
            const float mn = fmaxf(g + m, ml);
            dec[bh * 64 + c] = expf(g + m - mn); scl[bh * 64 + c] = expf(ml - mn); m = mn;
        }
    }
    __syncthreads();
    const int gt = F.vcu * fp::NT + f_tid, NGT = F.G * fp::NT;
    for (int it = gt; it < 8 * 16384; it += NGT) {
        const int bh = it >> 14, idx = it & 16383;
        const float* dct = (const float*)(ws + wsf::DCT) + (size_t)bh * 64 * 32768 + (size_t)idx * 2;
        bf16_t* cpt = (bf16_t*)(ws + wsf::CPT) + (size_t)bh * 64 * 32768 + (size_t)idx * 2;
        float C0 = 0.f, C1 = 0.f;
#pragma unroll 8
        for (int c = 0; c < NC; ++c) {
            const f32x2 d = *(const f32x2*)(dct + (size_t)c * 32768);
            *(unsigned*)(cpt + (size_t)c * 32768) = pk2(C0, C1);
            const float de = dec[bh * 64 + c], sc = scl[bh * 64 + c];
            C0 = de * C0 + sc * d.x; C1 = de * C1 + sc * d.y;
        }
    }
    for (int it = gt; it < 8 * 128; it += NGT) {
        const int bh = it >> 7, dk = it & 127; float nv = 0.f;
#pragma unroll 4
        for (int c = 0; c < NC; ++c) {
            const size_t id = (size_t)bh * NC + c;
            ((float*)(ws + wsf::NPREV))[id * 128 + dk] = nv;
            nv = dec[bh * 64 + c] * nv + scl[bh * 64 + c] * ((const float*)(ws + wsf::DN))[id * 128 + dk];
        }
    }
}

__device__ __forceinline__ void m3_unit(const MkArgs& a, Frame& F, int u) {
    const int f_tid = fresh_tid(F), f_lane = f_tid & 63, f_wave = F.wave;
    const int bh = u >> 6, c = u & 63, b = bh >> 2, h = bh & 3;
    const size_t tok0 = (size_t)b * S + (size_t)c * 128;
    unsigned char* ws = a.ws;
    const bf16_t* PB = (const bf16_t*)(ws + wsf::PROJB);
    const bf16_t* QCp = (const bf16_t*)(ws + wsf::QC);
    const bf16_t* KCp = (const bf16_t*)(ws + wsf::KC);
    LAS bf16_t* KP = (LAS bf16_t*)F.lds;
    LAS bf16_t* Vt = (LAS bf16_t*)(F.lds + 34816);
    LAS float* fl = (LAS float*)(F.lds + 104448);
    LAS float* f_us = fl, *f_M = fl + 128, *f_iw = fl + 256, *f_rd = fl + 384, *f_qn = fl + 512, *f_np = fl + 640, *f_en = fl + 768, *f_ssq = fl + 1024, *f_misc = fl + 896;
    const int tid = f_tid;
#pragma unroll
    for (int i = 0; i < 4; ++i) { const int q = tid + 512 * i, row = q >> 4, ch = q & 15;
        *(LAS u32x4*)(KP + row * 136 + ch * 8) = *(const u32x4*)(KCp + (tok0 + row) * 512 + h * 128 + ch * 8); }
    stage_vt(PB, tok0, fp::PB_MV + h * 256, Vt, tid);
    const float mp = ((const float*)(ws + wsf::MPREV))[u];
    float bt = 0.f, us = -INFINITY;
    if (tid < 128) { bt = ((const float*)(ws + wsf::BCUM))[(size_t)bh * S + c * 128 + tid]; us = ((const float*)(ws + wsf::LOGI))[(size_t)bh * S + c * 128 + tid] - bt;
        f_np[tid] = ((const float*)(ws + wsf::NPREV))[(size_t)u * 128 + tid]; }
    float pm = us;
#pragma unroll
    for (int o = 1; o < 64; o <<= 1) { const float t = __shfl_up(pm, o); if (f_lane >= o) pm = fmaxf(pm, t); }
    if (tid == 63) f_misc[0] = pm;
    __syncthreads();
    if (tid >= 64 && tid < 128) pm = fmaxf(pm, f_misc[0]);
    if (tid < 128) {
        const float Mt = fmaxf(mp, pm);
        f_us[tid] = us; f_M[tid] = Mt; f_iw[tid] = expf(mp - Mt); f_en[tid] = expf(-(bt + Mt));
        float s = 0.f;
#pragma unroll 4
        for (int ch = 0; ch < 16; ++ch) { const u32x4 qv = *(const u32x4*)(QCp + (tok0 + tid) * 512 + h * 128 + ch * 8); float qf[8]; unpack8(qv, qf);
#pragma unroll
            for (int e = 0; e < 8; ++e) s += qf[e] * f_np[ch * 8 + e]; }
        f_qn[tid] = s;
    }
    __syncthreads();
    const int c16 = f_lane & 15, grp = f_lane >> 4, w = f_wave;
    u32x2 pp[8]; float rs = 0.f;
    {
        bf16x8 qf[4];
#pragma unroll
        for (int ks = 0; ks < 4; ++ks) qf[ks] = *(const bf16x8*)(QCp + (tok0 + 16 * w + c16) * 512 + h * 128 + 32 * ks + 8 * grp);
        const float Mt = f_M[16 * w + c16];
        const int t = 16 * w + c16;
#pragma unroll
        for (int st = 0; st < 8; ++st) {
            pp[st] = (u32x2){0u, 0u};
            if (st <= w) {
                f32x4 acc = (f32x4){0.f, 0.f, 0.f, 0.f};
#pragma unroll
                for (int ks = 0; ks < 4; ++ks) { const bf16x8 kf = *(const LAS bf16x8*)(KP + (16 * st + c16) * 136 + 32 * ks + 8 * grp); acc = mfma16(kf, qf[ks], acc); }
                float p[4];
#pragma unroll
                for (int r = 0; r < 4; ++r) { const int s = 16 * st + 4 * grp + r; p[r] = (s <= t) ? acc[r] * expf(f_us[s] - Mt) : 0.f; rs += p[r]; }
                pp[st] = (u32x2){pk2(p[0], p[1]), pk2(p[2], p[3])};
            }
        }
        rs += __shfl_xor(rs, 16); rs += __shfl_xor(rs, 32);
        if (grp == 0) { const float den = rs + f_iw[t] * f_qn[t]; f_rd[t] = 1.f / fmaxf(fabsf(den), f_en[t]); }
    }
    __syncthreads();
#pragma unroll
    for (int st = 0; st < 8; ++st) *(LAS u32x2*)(KP + (16 * w + c16) * 136 + 16 * st + 4 * grp) = pp[st];
    __syncthreads();
    bf16x8 vf[2][4], cf[2][4];
    const bf16_t* cpt = (const bf16_t*)(ws + wsf::CPT) + (size_t)u * 256 * 128;
#pragma unroll
    for (int i = 0; i < 2; ++i)
#pragma unroll
        for (int ks = 0; ks < 4; ++ks) {
            vf[i][ks] = *(const LAS bf16x8*)(Vt + (16 * (2 * w + i) + c16) * 136 + 32 * ks + 8 * grp);
            cf[i][ks] = *(const bf16x8*)(cpt + (size_t)(16 * (2 * w + i) + c16) * 128 + 32 * ks + 8 * grp);
        }
    bf16_t* HMp = (bf16_t*)(ws + wsf::HM);
#pragma unroll 1
    for (int tt = 0; tt < 8; ++tt) {
        bf16x8 pf[4], qf[4];
#pragma unroll
        for (int ks = 0; ks < 4; ++ks) { pf[ks] = *(const LAS bf16x8*)(KP + (16 * tt + c16) * 136 + 32 * ks + 8 * grp);
            qf[ks] = *(const bf16x8*)(QCp + (tok0 + 16 * tt + c16) * 512 + h * 128 + 32 * ks + 8 * grp); }
        const int t = 16 * tt + c16; const float iw = f_iw[t], rd = f_rd[t];
        float ss = 0.f;
#pragma unroll
        for (int i = 0; i < 2; ++i) {
            f32x4 a1 = (f32x4){0.f, 0.f, 0.f, 0.f}, a2 = a1;
#pragma unroll
            for (int ks = 0; ks < 4; ++ks) { a1 = mfma16(vf[i][ks], pf[ks], a1); a2 = mfma16(cf[i][ks], qf[ks], a2); }
            const f32x4 hv = (a1 + a2 * iw) * rd;
            ss += (hv[0] * hv[0] + hv[1] * hv[1]) + (hv[2] * hv[2] + hv[3] * hv[3]);
            *(u32x2*)(HMp + (tok0 + t) * 1024 + h * 256 + 16 * (2 * w + i) + 4 * grp) = (u32x2){pk2(hv[0], hv[1]), pk2(hv[2], hv[3])};
        }
        ss += __shfl_xor(ss, 16); ss += __shfl_xor(ss, 32);
        if (grp == 0) f_ssq[t * 8 + w] = ss;
    }
    __syncthreads();
#pragma unroll 1
    for (int tt = 0; tt < 8; ++tt) {
        const int t = 16 * tt + c16;
        const f32x4 s0 = *(const LAS f32x4*)(f_ssq + t * 8), s1 = *(const LAS f32x4*)(f_ssq + t * 8 + 4);
        const float rn = rsqrtf(((s0.x + s0.y) + (s0.z + s0.w) + (s1.x + s1.y) + (s1.z + s1.w)) * (1.f / 256.f) + EPS);
#pragma unroll
        for (int i = 0; i < 2; ++i) {
            const int dv0 = 16 * (2 * w + i) + 4 * grp;
            const f32x4 g4 = *(const f32x4*)(a.g_mlstm + h * 256 + dv0);
            const u32x2 mo = *(const u32x2*)(PB + (tok0 + t) * fp::NIN + fp::PB_MO + h * 256 + dv0);
            u32x2* hp = (u32x2*)(HMp + (tok0 + t) * 1024 + h * 256 + dv0);
            const u32x2 hr = *hp;
            const float o0 = bflo(hr.x) * rn * g4.x * bflo(mo.x), o1 = bfhi(hr.x) * rn * g4.y * bfhi(mo.x);
            const float o2 = bflo(hr.y) * rn * g4.z * bflo(mo.y), o3 = bfhi(hr.y) * rn * g4.w * bfhi(mo.y);
            *hp = (u32x2){pk2(o0, o1), pk2(o2, o3)};
        }
    }
    __syncthreads();
}
__device__ __forceinline__ void phase5(const MkArgs& a, Frame& F) {
    const int f_tid = fresh_tid(F), f_lane = f_tid & 63, f_wave = F.wave;
    for (int u = F.bid; u < NB * MH * NC; u += F.G) m3_unit(a, F, u);
}
struct ProjUnit { int pm, pn, which; };
struct ProjSched {
    typedef ProjUnit UnitT;
    const bf16_t* A0; const bf16_t* A1; const bf16_t* B0; const bf16_t* B1; int K; int nM, nN, G, c, wave;
    __device__ __forceinline__ bool next(int i, ProjUnit& u) const { u.which = i & 1; return pg8::static_tile((i >> 1) * G + c, nM, nN, u.pm, u.pn); }
    __device__ __forceinline__ const char* a_base(const ProjUnit& u) const { return (const char*)((u.which ? A1 : A0) + (size_t)u.pm * 256 * K); }
    __device__ __forceinline__ const char* b_base(const ProjUnit& u) const { return (const char*)((u.which ? B1 : B0) + (size_t)u.pn * 256 * K); }
    __device__ __forceinline__ void a_offs(const ProjUnit&, int R0, int R1, int C0, int C1, unsigned (&o)[4]) const {
        o[0] = (unsigned)(R0 * K + C0) * 2u; o[1] = (unsigned)(R1 * K + C1) * 2u; o[2] = (unsigned)((R0 + 128) * K + C0) * 2u; o[3] = (unsigned)((R1 + 128) * K + C1) * 2u;
    }
};
struct EpiMerge {
    bf16_t* MG; const bf16_t* PB;
    __device__ __forceinline__ void operator()(const f32x4 (&acc)[2][2][4][2], const ProjUnit& u, int wr, int wc, int fr, int fq) const {
        const int row0 = u.pm * 256 + wr * 64 + fr, col0 = u.pn * 256 + wc * 32 + 8 * fq;
        const int gcol = (u.which ? fp::PB_GM : fp::PB_GA) + col0;
#pragma unroll
        for (int ai = 0; ai < 2; ++ai)
#pragma unroll
            for (int m = 0; m < 4; ++m) {
                const size_t row = (size_t)(row0 + ai * 128 + m * 16);
#pragma unroll
                for (int bj = 0; bj < 2; ++bj) {
                    const u32x4 gv = *(const u32x4*)(PB + row * fp::NIN + gcol + bj * 128);
                    float g[8]; unpack8(gv, g);
                    const f32x4 v0 = acc[ai][bj][m][0], v1 = acc[ai][bj][m][1];
                    float o[8] = {g[0] * v0[0], g[1] * v0[1], g[2] * v0[2], g[3] * v0[3], g[4] * v1[0], g[5] * v1[1], g[6] * v1[2], g[7] * v1[3]};
                    u32x4* dst = (u32x4*)(MG + row * 2048 + col0 + bj * 128);
                    if (u.which) { const u32x4 pv = *dst; float p[8]; unpack8(pv, p);
#pragma unroll
                        for (int e = 0; e < 8; ++e) o[e] += p[e]; }
                    *dst = (u32x4){pg8::cvt_pk_bf16(o[0], o[1]), pg8::cvt_pk_bf16(o[2], o[3]), pg8::cvt_pk_bf16(o[4], o[5]), pg8::cvt_pk_bf16(o[6], o[7])};
                }
            }
    }
};
__device__ __forceinline__ void phase6(const MkArgs& a, Frame& F) {
    const int f_tid = fresh_tid(F), f_lane = f_tid & 63, f_wave = F.wave;
    unsigned char* ws = a.ws;
    ProjSched S{(const bf16_t*)(ws + wsf::OAT), (const bf16_t*)(ws + wsf::HM), (const bf16_t*)(ws + wsf::WAP_T), (const bf16_t*)(ws + wsf::WMP_T), 1024, NTOK / 256, 2048 / 256, F.G, F.bid, F.wave};
    EpiMerge E{(bf16_t*)(ws + wsf::MG), (const bf16_t*)(ws + wsf::PROJB)};
    pg8::gemm_phase<EpiMerge, ProjSched>(F.lds, S, E);
}
struct EpiPlain {
    bf16_t* O; int ldc;
    __device__ __forceinline__ void operator()(const f32x4 (&acc)[2][2][4][2], const DenseUnit& u, int wr, int wc, int fr, int fq) const {
        const int row0 = u.pm * 256 + wr * 64 + fr, col0 = u.pn * 256 + wc * 32 + 8 * fq;
#pragma unroll
        for (int ai = 0; ai < 2; ++ai)
#pragma unroll
            for (int m = 0; m < 4; ++m)
#pragma unroll
                for (int bj = 0; bj < 2; ++bj) {
                    const f32x4 v0 = acc[ai][bj][m][0], v1 = acc[ai][bj][m][1];
                    *(u32x4*)(O + (size_t)(row0 + ai * 128 + m * 16) * ldc + col0 + bj * 128) =
                        (u32x4){pg8::cvt_pk_bf16(v0[0], v0[1]), pg8::cvt_pk_bf16(v0[2], v0[3]), pg8::cvt_pk_bf16(v1[0], v1[1]), pg8::cvt_pk_bf16(v1[2], v1[3])};
                }
    }
};
__device__ __forceinline__ void phase7(const MkArgs& a, Frame& F) {
    const int f_tid = fresh_tid(F), f_lane = f_tid & 63, f_wave = F.wave;
    unsigned char* ws = a.ws;
    DenseSched S{(const bf16_t*)(ws + wsf::MG), (const bf16_t*)(ws + wsf::WOUT_T), 2048, 2048, NTOK / 256, 2048 / 256, F.G, F.bid, F.wave};
    EpiPlain E{(bf16_t*)(ws + wsf::Y), 2048};
    pg8::gemm_phase<EpiPlain, DenseSched>(F.lds, S, E);
}

__device__ __forceinline__ void phase8(const MkArgs& a, Frame& F) {
    const int f_tid = fresh_tid(F), f_lane = f_tid & 63, f_wave = F.wave;
    unsigned char* ws = a.ws;
    LAS float* t_gt1 = (LAS float*)F.lds, *t_gpo = t_gt1 + 2048, *t_gpr = t_gt1 + 4096, *t_sc2 = t_gt1 + 6144, *t_sh2 = t_gt1 + 8192;
    LAS float* lgp = (LAS float*)(F.lds + 40960);
    LAS int* cntl = (LAS int*)(F.lds + 57344);
    LAS int* basel = cntl + 32;
    LAS int* esel = cntl + 64;
    LAS int* eslot = cntl + 320;
    const float* mod = (const float*)(ws + wsf::MOD);
    const bf16_t* Yp = (const bf16_t*)(ws + wsf::Y);
    bf16_t* H2p = (bf16_t*)(ws + wsf::H2);
    float* X1p = (float*)(ws + wsf::X1);
    const bf16_t* WR = (const bf16_t*)(ws + wsf::WRT);
    int* cntg = (int*)(ws + wsf::CTL) + wsf::CW_CNT;
    const int tid = f_tid, lane = f_lane, w = f_wave;
    for (int blk = F.vcu; blk < NTOK / 64; blk += F.G) {
        const int b = (blk * 64) / S;
        for (int i = tid; i < 2048; i += fp::NT) {
            t_gt1[i] = mod[b * MODW + MOD_GT1 + i]; t_gpo[i] = a.g_post_mix[i]; t_gpr[i] = a.g_pre_ffn[i];
            t_sc2[i] = mod[b * MODW + MOD_SC2 + i]; t_sh2[i] = mod[b * MODW + MOD_SH2 + i];
        }
        if (tid < 32) cntl[tid] = 0;
        __syncthreads();
#pragma unroll 1
        for (int rr = 0; rr < 8; ++rr) {
            const size_t row = (size_t)blk * 64 + w * 8 + rr;
            float yv[32]; float ss = 0.f;
#pragma unroll
            for (int j = 0; j < 4; ++j) { const u32x4 v = *(const u32x4*)(Yp + row * 2048 + 8 * (64 * j + lane)); float f[8]; unpack8(v, f);
#pragma unroll
                for (int e = 0; e < 8; ++e) { yv[8 * j + e] = f[e]; ss += f[e] * f[e]; } }
            const float r1 = rsqrtf(wave_sum_f(ss) * (1.f / D) + EPS);
            ss = 0.f;
#pragma unroll
            for (int j = 0; j < 4; ++j) {
                const int c0 = 8 * (64 * j + lane);
                const f32x4 xa = *(const f32x4*)(a.x + row * D + c0), xb = *(const f32x4*)(a.x + row * D + c0 + 4);
                const float xv[8] = {xa.x, xa.y, xa.z, xa.w, xb.x, xb.y, xb.z, xb.w};
#pragma unroll
                for (int e = 0; e < 8; ++e) { const float v = xv[e] + t_gt1[c0 + e] * (yv[8 * j + e] * r1 * t_gpo[c0 + e]); yv[8 * j + e] = v; ss += v * v; }
                *(f32x4*)(X1p + row * D + c0) = (f32x4){yv[8 * j], yv[8 * j + 1], yv[8 * j + 2], yv[8 * j + 3]};
                *(f32x4*)(X1p + row * D + c0 + 4) = (f32x4){yv[8 * j + 4], yv[8 * j + 5], yv[8 * j + 6], yv[8 * j + 7]};
            }
            const float r2 = rsqrtf(wave_sum_f(ss) * (1.f / D) + EPS);
#pragma unroll
            for (int j = 0; j < 4; ++j) {
                const int c0 = 8 * (64 * j + lane);
                float hv[8];
#pragma unroll
                for (int e = 0; e < 8; ++e) hv[e] = yv[8 * j + e] * r2 * t_gpr[c0 + e] * (1.f + t_sc2[c0 + e]) + t_sh2[c0 + e];
                *(u32x4*)(H2p + row * 2048 + c0) = (u32x4){pk2(hv[0], hv[1]), pk2(hv[2], hv[3]), pk2(hv[4], hv[5]), pk2(hv[6], hv[7])};
            }
        }
        VM_WAIT();
        __syncthreads();
        {
            const int c16 = lane & 15, grp = lane >> 4, rt = w & 3, kh = w >> 2;
            f32x4 acc[2] = {(f32x4){0.f, 0.f, 0.f, 0.f}, (f32x4){0.f, 0.f, 0.f, 0.f}};
            const bf16_t* ap = H2p + ((size_t)blk * 64 + 16 * rt + c16) * 2048 + 8 * grp;
#pragma unroll 4
            for (int ks = kh * 32; ks < kh * 32 + 32; ++ks) {
                const bf16x8 af = *(const bf16x8*)(ap + 32 * ks);
#pragma unroll
                for (int et = 0; et < 2; ++et) {
                    const bf16x8 bh = *(const bf16x8*)(WR + (size_t)(16 * et + c16) * 2048 + 32 * ks + 8 * grp);
                    const bf16x8 bl = *(const bf16x8*)(WR + (size_t)32 * 2048 + (size_t)(16 * et + c16) * 2048 + 32 * ks + 8 * grp);
                    acc[et] = mfma16(af, bh, acc[et]); acc[et] = mfma16(af, bl, acc[et]);
                }
            }
#pragma unroll
            for (int et = 0; et < 2; ++et)
#pragma unroll
                for (int r = 0; r < 4; ++r) lgp[kh * 2048 + (16 * rt + 4 * grp + r) * 32 + 16 * et + c16] = acc[et][r];
        }
        __syncthreads();
        if (tid < 64) {
            const size_t tok = (size_t)blk * 64 + tid;
            float lgv[32];
#pragma unroll
            for (int e = 0; e < 32; ++e) lgv[e] = lgp[tid * 32 + e] + lgp[2048 + tid * 32 + e] + a.b_router[e];
            int idx[4]; float val[4];
            unsigned used = 0u;
#pragma unroll
            for (int k = 0; k < 4; ++k) {
                float best = -INFINITY; int bi = 0;
#pragma unroll
                for (int e = 0; e < 32; ++e) { const bool c = !((used >> e) & 1u) && lgv[e] > best; best = c ? lgv[e] : best; bi = c ? e : bi; }
                used |= 1u << bi; idx[k] = bi; val[k] = best;
            }
            float ex[4], sum = 0.f;
#pragma unroll
            for (int k = 0; k < 4; ++k) { ex[k] = expf(val[k] - val[0]); sum += ex[k]; }
#pragma unroll
            for (int k = 0; k < 4; ++k) {
                ((int*)(ws + wsf::TOPI))[tok * 4 + k] = idx[k]; ((float*)(ws + wsf::TOPW))[tok * 4 + k] = ex[k] / sum;
                const int e = a.route_i ? a.route_i[tok * 4 + k] : idx[k];
                esel[tid * 4 + k] = e;
                eslot[tid * 4 + k] = __hip_atomic_fetch_add(cntl + e, 1, __ATOMIC_RELAXED, __HIP_MEMORY_SCOPE_WORKGROUP);
            }
        }
        __syncthreads();
        if (tid < 32) { const int n = cntl[tid]; basel[tid] = n > 0 ? __hip_atomic_fetch_add(cntg + tid, n, __ATOMIC_RELAXED, __HIP_MEMORY_SCOPE_AGENT) : 0; }
        __syncthreads();
        if (tid < 256) { const int e = esel[tid]; ((int*)(ws + wsf::LIST))[(size_t)e * NPAIR + basel[e] + eslot[tid]] = (blk * 64 + (tid >> 2)) * 4 + (tid & 3); }
        __syncthreads();
    }
}

struct MoeUnit { int e, m0, pn, rows; };
struct MoeSched {
    typedef MoeUnit UnitT;
    const bf16_t* A; int a_shift; const bf16_t* Wt; size_t wstride; int K; int nN;
    const int* list; const LAS int* tstart; const LAS int* cnt; int nM; int G, c, wave;
    __device__ __forceinline__ bool next(int i, MoeUnit& u) const {
        const int nwg = nM * nN, L = i * G + c; if (L >= nwg) return false;
        int wgid = L; { const int q = nwg / 8, r = nwg % 8, xcd = wgid % 8, off = wgid / 8; wgid = (xcd < r ? xcd * (q + 1) : r * (q + 1) + (xcd - r) * q) + off; }
        constexpr int WG = 4;
        const int nig = WG * nN, gid = wgid / nig, fm = gid * WG, gsz = (nM - fm) < WG ? (nM - fm) : WG;
        const int mt = fm + ((wgid % nig) % gsz); u.pn = (wgid % nig) / gsz;
        int e = 0;
        for (int k = 1; k < NE; ++k) e += (tstart[k] <= mt) ? 1 : 0;
        u.e = e; u.m0 = (mt - tstart[e]) * 256; const int left = cnt[e] - u.m0; u.rows = left < 256 ? left : 256;
        return true;
    }
    __device__ __forceinline__ const char* a_base(const MoeUnit&) const { return (const char*)A; }
    __device__ __forceinline__ const char* b_base(const MoeUnit& u) const { return (const char*)(Wt + (size_t)u.e * wstride + (size_t)u.pn * 256 * K); }
    __device__ __forceinline__ unsigned rowoff(const MoeUnit& u, int r, int C) const {
        const int rc = r < u.rows ? r : u.rows - 1;
        const int id = list[(size_t)u.e * NPAIR + u.m0 + rc] >> a_shift;
        return ((unsigned)id * (unsigned)K + (unsigned)C) * 2u;
    }
    __device__ __forceinline__ void a_offs(const MoeUnit& u, int R0, int R1, int C0, int C1, unsigned (&o)[4]) const {
        o[0] = rowoff(u, R0, C0); o[1] = rowoff(u, R1, C1); o[2] = rowoff(u, R0 + 128, C0); o[3] = rowoff(u, R1 + 128, C1);
    }
};
__device__ __forceinline__ void moe_tables(const MkArgs& a, Frame& F, LAS int*& cnt, LAS int*& tstart) {
    const int f_tid = fresh_tid(F);
    cnt = (LAS int*)(F.lds + LDS_TAB); tstart = cnt + 32;
    const int* cntg = (const int*)(a.ws + wsf::CTL) + wsf::CW_CNT;
    if (f_tid < 32) cnt[f_tid] = __hip_atomic_load(cntg + f_tid, RLX_AGENT);
    __syncthreads();
    if (f_tid == 0) { int s = 0; for (int e = 0; e < NE; ++e) { tstart[e] = s; s += (cnt[e] + 255) >> 8; } tstart[NE] = s; }
    __syncthreads();
}
struct EpiGateUp {
    bf16_t* ACT; const float* bias; const int* list;
    __device__ __forceinline__ void operator()(const f32x4 (&acc)[2][2][4][2], const MoeUnit& u, int wr, int wc, int fr, int fq) const {
        const int col0 = u.pn * 256 + wc * 32 + 8 * fq;
        f32x4 bv[2][2];
#pragma unroll
        for (int bj = 0; bj < 2; ++bj)
#pragma unroll
            for (int n = 0; n < 2; ++n) bv[bj][n] = *(const f32x4*)(bias + (size_t)u.e * 4096 + col0 + bj * 128 + 4 * n);
#pragma unroll
        for (int ai = 0; ai < 2; ++ai)
#pragma unroll
            for (int m = 0; m < 4; ++m) {
                const int r = ai * 128 + wr * 64 + m * 16 + fr;
                if (r < u.rows) {
                    const int pair = list[(size_t)u.e * NPAIR + u.m0 + r];
#pragma unroll
                    for (int bj = 0; bj < 2; ++bj) {
                        const f32x4 v0 = acc[ai][bj][m][0] + bv[bj][0], v1 = acc[ai][bj][m][1] + bv[bj][1];
                        const float gu[8] = {v0[0], v0[1], v0[2], v0[3], v1[0], v1[1], v1[2], v1[3]};
                        float o[4];
#pragma unroll
                        for (int j = 0; j < 4; ++j) {
                            const float glu = fminf(gu[2 * j], 7.0f), lin = fminf(fmaxf(gu[2 * j + 1], -7.0f), 7.0f);
                            o[j] = glu * fast_sigmoid(1.702f * glu) * (lin + 1.f);
                        }
                        *(u32x2*)(ACT + (size_t)pair * 2048 + (col0 + bj * 128) / 2) = (u32x2){pg8::cvt_pk_bf16(o[0], o[1]), pg8::cvt_pk_bf16(o[2], o[3])};
                    }
                }
            }
    }
};
struct EpiDown {
    bf16_t* YP; const float* bias; const int* list; const float* wgt;
    __device__ __forceinline__ void operator()(const f32x4 (&acc)[2][2][4][2], const MoeUnit& u, int wr, int wc, int fr, int fq) const {
        const int col0 = u.pn * 256 + wc * 32 + 8 * fq;
        f32x4 bv[2][2];
#pragma unroll
        for (int bj = 0; bj < 2; ++bj)
#pragma unroll
            for (int n = 0; n < 2; ++n) bv[bj][n] = *(const f32x4*)(bias + (size_t)u.e * 2048 + col0 + bj * 128 + 4 * n);
#pragma unroll
        for (int ai = 0; ai < 2; ++ai)
#pragma unroll
            for (int m = 0; m < 4; ++m) {
                const int r = ai * 128 + wr * 64 + m * 16 + fr;
                if (r < u.rows) {
                    const int pair = list[(size_t)u.e * NPAIR + u.m0 + r];
                    const float wv = wgt[pair];
#pragma unroll
                    for (int bj = 0; bj < 2; ++bj) {
                        const f32x4 v0 = (acc[ai][bj][m][0] + bv[bj][0]) * wv, v1 = (acc[ai][bj][m][1] + bv[bj][1]) * wv;
                        *(u32x4*)(YP + (size_t)pair * 2048 + col0 + bj * 128) =
                            (u32x4){pg8::cvt_pk_bf16(v0[0], v0[1]), pg8::cvt_pk_bf16(v0[2], v0[3]), pg8::cvt_pk_bf16(v1[0], v1[1]), pg8::cvt_pk_bf16(v1[2], v1[3])};
                    }
                }
            }
    }
};
__device__ __forceinline__ void phase9(const MkArgs& a, Frame& F) {
    const int f_tid = fresh_tid(F), f_lane = f_tid & 63, f_wave = F.wave;
    unsigned char* ws = a.ws;
    LAS int* cnt; LAS int* tstart; moe_tables(a, F, cnt, tstart);
    MoeSched S{(const bf16_t*)(ws + wsf::H2), 2, (const bf16_t*)(ws + wsf::WGU_T), (size_t)4096 * 2048, 2048, 16, (const int*)(ws + wsf::LIST), tstart, cnt, tstart[NE], F.G, F.bid, F.wave};
    EpiGateUp E{(bf16_t*)(ws + wsf::ACT), a.b_gate_up, (const int*)(ws + wsf::LIST)};
    pg8::gemm_phase<EpiGateUp, MoeSched>(F.lds, S, E);
}
__device__ __forceinline__ void phase10(const MkArgs& a, Frame& F) {
    const int f_tid = fresh_tid(F), f_lane = f_tid & 63, f_wave = F.wave;
    unsigned char* ws = a.ws;
    LAS int* cnt; LAS int* tstart; moe_tables(a, F, cnt, tstart);
    MoeSched S{(const bf16_t*)(ws + wsf::ACT), 0, (const bf16_t*)(ws + wsf::WDN_T), (size_t)2048 * 2048, 2048, 8, (const int*)(ws + wsf::LIST), tstart, cnt, tstart[NE], F.G, F.bid, F.wave};
    EpiDown E{(bf16_t*)(ws + wsf::YP), a.b_down, (const int*)(ws + wsf::LIST), a.route_w ? a.route_w : (const float*)(ws + wsf::TOPW)};
    pg8::gemm_phase<EpiDown, MoeSched>(F.lds, S, E);
}

__device__ __forceinline__ void phase11(const MkArgs& a, Frame& F) {
    const int f_tid = fresh_tid(F), f_lane = f_tid & 63, f_wave = F.wave;
    unsigned char* ws = a.ws;
    const float* mod = (const float*)(ws + wsf::MOD);
    const bf16_t* YPp = (const bf16_t*)(ws + wsf::YP);
    const float* X1p = (const float*)(ws + wsf::X1);
    const int gw = F.vcu * fp::NW + f_wave, NGW = F.G * fp::NW, lane = f_lane;
    for (int m = gw; m < NTOK; m += NGW) {
        const int b = m / S;
        float yv[32];
#pragma unroll
        for (int i = 0; i < 32; ++i) yv[i] = 0.f;
#pragma unroll
        for (int k = 0; k < 4; ++k)
#pragma unroll
            for (int j = 0; j < 4; ++j) { const u32x4 v = *(const u32x4*)(YPp + ((size_t)m * 4 + k) * 2048 + 8 * (64 * j + lane)); float f[8]; unpack8(v, f);
#pragma unroll
                for (int e = 0; e < 8; ++e) yv[8 * j + e] += f[e]; }
        float ss = 0.f;
#pragma unroll
        for (int i = 0; i < 32; ++i) ss += yv[i] * yv[i];
        const float r = rsqrtf(wave_sum_f(ss) * (1.f / D) + EPS);
#pragma unroll
        for (int j = 0; j < 4; ++j) {
            const int c0 = 8 * (64 * j + lane);
#pragma unroll
            for (int hq = 0; hq < 2; ++hq) {
                const f32x4 xv = *(const f32x4*)(X1p + (size_t)m * D + c0 + 4 * hq);
                const f32x4 gt = *(const f32x4*)(mod + b * MODW + MOD_GT2 + c0 + 4 * hq), gp = *(const f32x4*)(a.g_post_ffn + c0 + 4 * hq);
                f32x4 o;
                o.x = xv.x + gt.x * (yv[8 * j + 4 * hq + 0] * r * gp.x); o.y = xv.y + gt.y * (yv[8 * j + 4 * hq + 1] * r * gp.y);
                o.z = xv.z + gt.z * (yv[8 * j + 4 * hq + 2] * r * gp.z); o.w = xv.w + gt.w * (yv[8 * j + 4 * hq + 3] * r * gp.w);
                *(f32x4*)(a.out + (size_t)m * D + c0 + 4 * hq) = o;
            }
        }
    }
}
constexpr int N_PHASES = 12;
__global__ void __launch_bounds__(fp::NT, 2) mk_fwd(MkArgs a) {
    extern __shared__ __attribute__((aligned(16))) unsigned char lds_raw[];
    Frame F;
    F.lds = (LAS unsigned char*)lds_raw;
    F.wave = __builtin_amdgcn_readfirstlane((int)threadIdx.x >> 6);
    F.G = gridDim.x; F.bid = blockIdx.x; F.vcu = (F.G % 8 == 0) ? (F.bid % 8) * (F.G / 8) + F.bid / 8 : F.bid;
    volatile LAS unsigned* misc = (volatile LAS unsigned*)(F.lds + LDS_MISC);
    if (F.wave == 0) misc[lane_id()] = 0u;
    __syncthreads();
    XcdBarrier bar = xcd_barrier_post((unsigned*)(a.ws + wsf::CTL) + wsf::CW_BAR, misc + 8, F.wave == 0 && lane_id() == 0);
    const int lo = a.ph_lo, hi = a.ph_hi;
#define IN(k) (lo <= (k) && (k) < hi)
#define SEAM(k) do { if (IN(k) && IN((k) + 1)) xcd_barrier(bar, F.wave == 0 && lane_id() == 0); } while (0)
    if (IN(0)) { phase0(a, F); } SEAM(0);
    if (IN(1)) { phase1(a, F); } SEAM(1);
    if (IN(2)) { phase2(a, F); } SEAM(2);
#if NPH > 3
    if (IN(3)) { phase3(a, F); } SEAM(3);
#endif
#if NPH > 4
    if (IN(4)) { phase4(a, F); } SEAM(4);
#endif
#if NPH > 5
    if (IN(5)) { phase5(a, F); } SEAM(5);
#endif
#if NPH > 6
    if (IN(6)) { phase6(a, F); } SEAM(6);
#endif
#if NPH > 7
    if (IN(7)) { phase7(a, F); } SEAM(7);
#endif
#if NPH > 8
    if (IN(8)) { phase8(a, F); } SEAM(8);
#endif
#if NPH > 9
    if (IN(9)) { phase9(a, F); } SEAM(9);
#endif
#if NPH > 10
    if (IN(10)) { phase10(a, F); } SEAM(10);
#endif
#if NPH > 11
    if (IN(11)) { phase11(a, F); }
#endif
#undef IN
#undef SEAM
}

static void fill_args(MkArgs& a, void* const* d_in, void* d_out, void* d_ws) {
    a.x = (const float*)d_in[0]; a.c = (const float*)d_in[1]; a.positions = (const int*)d_in[2]; a.w_ada = (const float*)d_in[3]; a.b_ada = (const float*)d_in[4];
    a.g_pre_mix = (const float*)d_in[5]; a.g_post_mix = (const float*)d_in[6]; a.g_pre_ffn = (const float*)d_in[7]; a.g_post_ffn = (const float*)d_in[8];
    a.w_in = (const float*)d_in[9]; a.b_in = (const float*)d_in[10]; a.conv_qk = (const float*)d_in[11]; a.sinks = (const float*)d_in[12]; a.g_mlstm = (const float*)d_in[13];
    a.w_attn_proj = (const float*)d_in[14]; a.w_mlstm_proj = (const float*)d_in[15]; a.w_out = (const float*)d_in[16]; a.w_router = (const float*)d_in[17]; a.b_router = (const float*)d_in[18];
    a.w_gate_up = (const float*)d_in[19]; a.b_gate_up = (const float*)d_in[20]; a.w_down = (const float*)d_in[21]; a.b_down = (const float*)d_in[22];
    a.out = (float*)d_out; a.ws = (unsigned char*)d_ws; a.route_i = nullptr; a.route_w = nullptr; a.ph_lo = 0; a.ph_hi = 0;
}
static int mk_setup() {
    static int grid = 0;
    if (grid == 0) {
        int dev = 0, cus = 0;
        if (hipGetDevice(&dev) != hipSuccess || hipDeviceGetAttribute(&cus, hipDeviceAttributeMultiprocessorCount, dev) != hipSuccess) { grid = -1; return grid; }
        if (hipFuncSetAttribute((const void*)mk_fwd, hipFuncAttributeMaxDynamicSharedMemorySize, LDS_BYTES) != hipSuccess) { grid = -1; return grid; }
        int per_cu = 0;
        if (hipOccupancyMaxActiveBlocksPerMultiprocessor(&per_cu, (const void*)mk_fwd, fp::NT, LDS_BYTES) != hipSuccess || per_cu < 1) { (void)hipGetLastError(); }
        grid = cus;
    }
    return grid;
}

extern "C" void kernel_launch(void* const* d_in, const int* in_sizes, int n_in, void* d_out, int out_size, void* d_ws, size_t ws_size, hipStream_t stream) {
    if (n_in != 23 || ws_size < wsf::END) return;
    const int grid = mk_setup();
    if (grid <= 0) return;
    if (hipMemsetAsync((unsigned char*)d_ws + wsf::CTL, 0, 65536, stream) != hipSuccess) return;
    MkArgs a{}; fill_args(a, d_in, d_out, d_ws);
    a.ph_lo = 0; a.ph_hi = N_PHASES;
    hipLaunchKernelGGL(mk_fwd, dim3(grid), dim3(fp::NT), LDS_BYTES, stream, a);
}
```

```cpp
#include <hip/hip_runtime.h>
#include <stdint.h>
#include <math.h>
#define NPH 12
#define MOE_FP8 1
namespace cfg {
constexpr int D = 2048, NB = 2, S = 8192, NTOK = NB * S;
constexpr int HQ = 16, HKV = 2, HD = 64, QW = 1024;
constexpr int MH = 4, MDV = 256, MDK = 128, MQKW = 512, MVW = 1024, CL = 128, NC = S / CL;
constexpr int NE = 32, TOPK = 4, DFF = 2048, NPAIR = NTOK * TOPK;
constexpr int INW = 8456;
constexpr int OFF_AQ = 0, OFF_AK = 1024, OFF_AV = 1152, OFF_MQ = 1280, OFF_MK = 1792, OFF_MV = 2304, OFF_MO = 3328,
              OFF_MI = 4352, OFF_MF = 4356, OFF_GA = 4360, OFF_GM = 6408;
constexpr float EPS = 1e-6f;
constexpr int MOD_SH1 = 0, MOD_SC1 = 2048, MOD_GT1 = 4096, MOD_SH2 = 6144, MOD_SC2 = 8192, MOD_GT2 = 10240, MODW = 12288;
}
using namespace cfg;
__device__ __forceinline__ float silu_f(float x) { return x / (1.f + expf(-x)); }
__device__ __forceinline__ float sigmoid_f(float x) { return 1.f / (1.f + expf(-x)); }
__device__ __forceinline__ void rope_cs(int pos, int i, float& c, float& s) {
    const float invf[8] = {1.0f, 0.1939227432012558f, 0.03760603070259094f, 0.007292664609849453f,
                           0.0014142135623842478f, 0.00027424818836152554f, 5.3182957344688475e-05f, 1.0313385246263351e-05f};
    float f = i == 0 ? invf[0] : i == 1 ? invf[1] : i == 2 ? invf[2] : i == 3 ? invf[3] : i == 4 ? invf[4] : i == 5 ? invf[5] : i == 6 ? invf[6] : invf[7];
    float ang = (float)pos * f;
    double t = (double)ang * 0.15915494309189535;
    t -= rint(t);
    float tf = (float)t;
    s = __builtin_amdgcn_sinf(tf);
    c = __builtin_amdgcn_cosf(tf);
}
__device__ __forceinline__ float softcap_f(float z) { return 15.f * tanhf(z / 15.f); }
__device__ __forceinline__ float logsigmoid_f(float z) { return fminf(z, 0.f) - log1pf(expf(-fabsf(z))); }
#define GAS __attribute__((address_space(1)))
#define LAS __attribute__((address_space(3)))
typedef unsigned short bf16_t;
typedef short bf16x8 __attribute__((ext_vector_type(8)));
typedef short bf16x4 __attribute__((ext_vector_type(4)));
typedef float f32x4 __attribute__((ext_vector_type(4)));
typedef float f32x2 __attribute__((ext_vector_type(2)));
typedef unsigned u32x4 __attribute__((ext_vector_type(4)));
typedef unsigned u32x2 __attribute__((ext_vector_type(2)));
#define RLX_AGENT __ATOMIC_RELAXED, __HIP_MEMORY_SCOPE_AGENT
#define LDS_WAIT() asm volatile("s_waitcnt lgkmcnt(0)" ::: "memory")
#define VM_WAIT() asm volatile("s_waitcnt vmcnt(0)" ::: "memory")

__device__ __forceinline__ unsigned f2bf(float f) { unsigned u = __builtin_bit_cast(unsigned, f); return (u + 0x7fffu + ((u >> 16) & 1u)) >> 16; }
__device__ __forceinline__ unsigned pk2(float lo, float hi) { return f2bf(lo) | (f2bf(hi) << 16); }
__device__ __forceinline__ float bf2f(unsigned short h) { return __builtin_bit_cast(float, (unsigned)h << 16); }
__device__ __forceinline__ float bflo(unsigned w) { return __builtin_bit_cast(float, w << 16); }
__device__ __forceinline__ float bfhi(unsigned w) { return __builtin_bit_cast(float, w & 0xffff0000u); }
__device__ __forceinline__ unsigned pk4_fp8(float a, float b, float c, float d) {
    a = fminf(fmaxf(a, -448.f), 448.f); b = fminf(fmaxf(b, -448.f), 448.f); c = fminf(fmaxf(c, -448.f), 448.f); d = fminf(fmaxf(d, -448.f), 448.f);
    int r = __builtin_amdgcn_cvt_pk_fp8_f32(a, b, 0, false); r = __builtin_amdgcn_cvt_pk_fp8_f32(c, d, r, true); return (unsigned)r;
}
constexpr float W8SCALE = 64.f, W8INV = 1.f / 64.f;
__device__ __forceinline__ float fast_sigmoid(float x) { return __builtin_amdgcn_rcpf(1.f + __builtin_amdgcn_exp2f(-1.4426950408889634f * x)); }

namespace fp {
constexpr int NW = 8, NT = NW * 64;
constexpr int NIN = 8448;
constexpr int PB_Q = 0, PB_K = 1024, PB_V = 1152, PB_MQ = 1280, PB_MK = 1792, PB_MV = 2304, PB_MO = 3328, PB_GA = 4352, PB_GM = 6400;
constexpr float QSCALE = 0.125f * 1.4426950408889634f;
constexpr float LOG2E = 1.4426950408889634f;
}

namespace wsf {
constexpr size_t AL(size_t x) { return (x + 255) & ~(size_t)255; }
constexpr size_t CTL = 0, CTL_BYTES = 1u << 20;
constexpr size_t MODP = CTL + CTL_BYTES;
constexpr size_t MOD = AL(MODP + (size_t)16 * 2 * MODW * 4);
constexpr size_t BINP = AL(MOD + (size_t)2 * MODW * 4);
constexpr size_t CS = AL(BINP + (size_t)fp::NIN * 4);
constexpr size_t WRT = AL(CS + (size_t)NTOK * 8 * 8);
constexpr size_t WIN_T = AL(WRT + (size_t)2 * 32 * 2048 * 2);
constexpr size_t WAP_T = AL(WIN_T + (size_t)fp::NIN * 2048 * 2);
constexpr size_t WMP_T = AL(WAP_T + (size_t)2048 * 1024 * 2);
constexpr size_t WOUT_T = AL(WMP_T + (size_t)2048 * 1024 * 2);
constexpr size_t WGU_T = AL(WOUT_T + (size_t)2048 * 2048 * 2);
#if MOE_FP8
constexpr size_t WDN_T = WGU_T;
constexpr size_t GATES = WGU_T;
#else
constexpr size_t WDN_T = AL(WGU_T + (size_t)32 * 4096 * 2048 * 2);
constexpr size_t GATES = AL(WDN_T + (size_t)32 * 2048 * 2048 * 2);
#endif
constexpr size_t BCUM = AL(GATES + (size_t)NTOK * 8 * 4);
constexpr size_t LOGI = AL(BCUM + (size_t)8 * S * 4);
constexpr size_t GSUM = AL(LOGI + (size_t)8 * S * 4);
constexpr size_t MLOC = AL(GSUM + 512 * 4);
constexpr size_t MPREV = AL(MLOC + 512 * 4);
constexpr size_t DN = AL(MPREV + 512 * 4);
constexpr size_t NPREV = AL(DN + (size_t)512 * 128 * 4);
constexpr size_t DCT = AL(NPREV + (size_t)512 * 128 * 4);
constexpr size_t Y = AL(DCT + (size_t)512 * 256 * 128 * 4);
constexpr size_t X1 = AL(Y + (size_t)NTOK * 2048 * 2);
constexpr size_t H2 = AL(X1 + (size_t)NTOK * 2048 * 4);
constexpr size_t TOPI = AL(H2 + (size_t)NTOK * 2048 * 2);
constexpr size_t TOPW = AL(TOPI + (size_t)NPAIR * 4);
constexpr size_t LIST = AL(TOPW + (size_t)NPAIR * 4);
constexpr size_t PROJB = AL(LIST + (size_t)NE * NPAIR * 4);
constexpr size_t ACT = PROJB;
constexpr size_t YPREG = AL(PROJB + (size_t)NTOK * fp::NIN * 2);
constexpr size_t H1 = YPREG;
constexpr size_t MG = AL(H1 + (size_t)NTOK * 2048 * 2);
constexpr size_t OAT = AL(MG + (size_t)NTOK * 2048 * 2);
constexpr size_t HM = AL(OAT + (size_t)NTOK * 1024 * 2);
constexpr size_t QC = AL(HM + (size_t)NTOK * 1024 * 2);
constexpr size_t KC = AL(QC + (size_t)NTOK * 512 * 2);
constexpr size_t CPT = AL(KC + (size_t)NTOK * 512 * 2);
constexpr size_t YP = YPREG;
constexpr size_t F8BASE = AL(CPT + (size_t)512 * 256 * 128 * 2) > AL(YP + (size_t)NPAIR * 2048 * 2) ? AL(CPT + (size_t)512 * 256 * 128 * 2) : AL(YP + (size_t)NPAIR * 2048 * 2);
constexpr size_t WGU8 = F8BASE;
constexpr size_t WDN8 = AL(WGU8 + (size_t)32 * 4096 * 2048);
constexpr size_t H2F8 = AL(WDN8 + (size_t)32 * 2048 * 2048);
constexpr size_t ACT8 = AL(H2F8 + (size_t)NTOK * 2048);
constexpr size_t END = AL(ACT8 + (size_t)NPAIR * 2048);
static_assert((size_t)NPAIR * 2048 * 2 <= (size_t)NTOK * fp::NIN * 2, "ACT fits over PROJB");
constexpr int CW_BAR = 4096;
constexpr int CW_CNT = 8192;
}

constexpr int RING_BYTES = 131072;
constexpr int LDS_TAB = RING_BYTES;
constexpr int LDS_MISC = RING_BYTES + 8192;
constexpr int LDS_BYTES = 147456;

#define XB_TMO      128
#define XB_XCNT(j)  (256  + 64 * (j))
#define XB_XSUB(j)  (1280 + 64 * (j))
#define XB_XGEN(j)  (2304 + 64 * (j))
#define XB_TOP      3328
#define XB_TOPGEN   3392
#define XCD_BAR_WORDS 3456
#define XB_SPIN_CAP (1u << 18)
__device__ __forceinline__ unsigned xb_ld(unsigned* p)              { return __hip_atomic_load(p, __ATOMIC_RELAXED, __HIP_MEMORY_SCOPE_AGENT); }
__device__ __forceinline__ unsigned xb_add(unsigned* p, unsigned v) { return __hip_atomic_fetch_add(p, v, __ATOMIC_RELAXED, __HIP_MEMORY_SCOPE_AGENT); }
__device__ __forceinline__ unsigned xb_xcc_id() { return (unsigned)__builtin_amdgcn_s_getreg((3 << 11) | 20) & 0xFu; }
#define XB_SPIN(cond, bar) do { unsigned _sp = 0; while (cond) { __builtin_amdgcn_s_sleep(1); \
    if ((++_sp & 255u) == 0u) { if (xb_ld(&(bar)[XB_TMO])) break; if (_sp > XB_SPIN_CAP) { atomicAdd(&(bar)[XB_TMO], 1u); break; } } } } while (0)
struct XcdBarrier { unsigned* bar; unsigned x; volatile LAS unsigned* st; };
__device__ __forceinline__ XcdBarrier xcd_barrier_post(unsigned* bar, volatile LAS unsigned* st, bool t0) {
    XcdBarrier b; b.bar = bar; b.x = xb_xcc_id(); b.st = st;
    if (t0) (void)xb_add(&bar[XB_XCNT(b.x)], 1u);
    return b;
}
__device__ __forceinline__ void xcd_barrier_complete(unsigned* bar, unsigned x, unsigned& nloc, unsigned& nx) {
    const unsigned G = gridDim.x * gridDim.y * gridDim.z;
    unsigned sum, cnt, mine, sp = 0u;
    for (;;) {
        sum = 0u; cnt = 0u; mine = 0u;
#pragma unroll
        for (unsigned j = 0; j < 16; ++j) { const unsigned c = xb_ld(&bar[XB_XCNT(j)]); sum += c; cnt += (c > 0u) ? 1u : 0u; mine = (j == x) ? c : mine; }
        if (sum == G) break;
        __builtin_amdgcn_s_sleep(1);
        if ((++sp & 255u) == 0u) { if (xb_ld(&bar[XB_TMO])) break; if (sp > XB_SPIN_CAP) { atomicAdd(&bar[XB_TMO], 1u); break; } }
    }
    nloc = mine > 0u ? mine : 1u; nx = cnt > 0u ? cnt : 1u;
}
__device__ __forceinline__ void xcd_barrier(const XcdBarrier& b, bool t0) {
    asm volatile("s_waitcnt vmcnt(0)" ::: "memory");
    __syncthreads();
    if (t0) {
        unsigned* bar = b.bar;
        __builtin_amdgcn_s_waitcnt(0);
        unsigned nloc = b.st[0], nx = b.st[1];
        if (nloc == 0u) { xcd_barrier_complete(bar, b.x, nloc, nx); b.st[0] = nloc; b.st[1] = nx; }
        const unsigned old = xb_add(&bar[XB_XSUB(b.x)], 1u);
        const unsigned gen = old / nloc;
        if (old + 1u == (gen + 1u) * nloc) {
            __builtin_amdgcn_fence(__ATOMIC_RELEASE, "agent");
            asm volatile("s_waitcnt vmcnt(0)" ::: "memory");
            const unsigned og = xb_add(&bar[XB_TOP], 1u);
            const unsigned tg = og / nx;
            if (og + 1u == (tg + 1u) * nx) xb_add(&bar[XB_TOPGEN], 1u);
            else XB_SPIN(xb_ld(&bar[XB_TOPGEN]) == tg, bar);
            __builtin_amdgcn_fence(__ATOMIC_ACQUIRE, "agent");
            xb_add(&bar[XB_XGEN(b.x)], 1u);
            asm volatile("s_waitcnt vmcnt(0)" ::: "memory");
        } else {
            XB_SPIN(xb_ld(&bar[XB_XGEN(b.x)]) == gen, bar);
            __builtin_amdgcn_fence(__ATOMIC_ACQUIRE, "agent");
            asm volatile("s_waitcnt vmcnt(0)" ::: "memory");
        }
    }
    __syncthreads();
}

namespace pg8 {
constexpr int BM = 256, BK = 64, HALF = 128, HTB = HALF * BK * 2, STAGE_BYTES = 8 * HTB, NXCD = 8, WGM = 8;
__host__ __device__ __forceinline__ int lds_byte(int r, int c) { const int st = (r >> 4) * 2 + (c >> 5), rr = r & 15, cc = c & 31, ob = rr * 64 + cc * 2; return st * 1024 + (ob ^ (((ob >> 9) & 1) << 5)); }
__host__ __device__ __forceinline__ void stage_rc(int b, int& R, int& C) { const int st = b / 1024, sb = b % 1024, swz = sb ^ (((sb >> 9) & 1) << 5); R = (st >> 1) * 16 + swz / 64; C = (st & 1) * 32 + (swz % 64) / 2; }
__host__ __device__ __forceinline__ int perm32(int rho) { const int n = rho >> 4, i = rho & 15; return 8 * (i >> 2) + 4 * n + (i & 3); }
typedef int v8i32_t __attribute__((ext_vector_type(8)));
template <bool F8> struct FragSel { typedef bf16x8 T; };
typedef short s16x16_t __attribute__((ext_vector_type(16)));
template <> struct FragSel<true> { typedef s16x16_t T; };
template <bool F8> __device__ __forceinline__ typename FragSel<F8>::T ld_frag(const LAS unsigned char* p) {
    if constexpr (F8) { const bf16x8 lo = *(const LAS bf16x8*)p, hi = *(const LAS bf16x8*)(p + 16); return __builtin_shufflevector(lo, hi, 0, 1, 2, 3, 4, 5, 6, 7, 8, 9, 10, 11, 12, 13, 14, 15); }
    else return *(const LAS bf16x8*)p;
}
__device__ __forceinline__ f32x4 mma_frag(bf16x8 a, bf16x8 b, f32x4 c) { return __builtin_amdgcn_mfma_f32_16x16x32_bf16(a, b, c, 0, 0, 0); }
__device__ __forceinline__ f32x4 mma_frag(s16x16_t a, s16x16_t b, f32x4 c) {
    const v8i32_t av = __builtin_bit_cast(v8i32_t, a), bv = __builtin_bit_cast(v8i32_t, b);
    asm volatile("v_mfma_scale_f32_16x16x128_f8f6f4 %0, %1, %2, %0, %3, %3 op_sel_hi:[0,0,0]" : "+v"(c) : "v"(av), "v"(bv), "v"(0x7f7f7f7f));
    return c;
}
__device__ __forceinline__ unsigned cvt_pk_bf16(float lo, float hi) { unsigned r; asm volatile("v_cvt_pk_bf16_f32 %0, %1, %2" : "=v"(r) : "v"(lo), "v"(hi)); return r; }

__device__ __forceinline__ bool static_tile(int L, int nM, int nN, int& pm, int& pn) {
    const int nwg = nM * nN; if (L >= nwg) return false;
    int wgid = L; { const int q = nwg / NXCD, r = nwg % NXCD, xcd = wgid % NXCD, off = wgid / NXCD; wgid = (xcd < r ? xcd * (q + 1) : r * (q + 1) + (xcd - r) * q) + off; }
    const int nig = WGM * nN, gid = wgid / nig, fm = gid * WGM, gsz = (nM - fm) < WGM ? (nM - fm) : WGM;
    pm = fm + ((wgid % nig) % gsz); pn = (wgid % nig) / gsz; return true;
}

typedef int v8i32 __attribute__((ext_vector_type(8)));
template <class Epi, class Sched, bool FP8 = false>
__device__ __forceinline__ void gemm_phase(LAS unsigned char* lds, const Sched& S, const Epi& E) {
    typedef typename Sched::UnitT Unit;
    const int wid = S.wave, lane = (int)__builtin_amdgcn_mbcnt_hi(~0u, __builtin_amdgcn_mbcnt_lo(~0u, 0u)), tid = (wid << 6) | lane, wr = wid >> 2, wc = wid & 3, fr = lane & 15, fq = lane >> 4;
    const int K = S.K, nt = K / BK;
    int R[2], C[2];
    unsigned voffB[2];
#pragma unroll
    for (int i = 0; i < 2; ++i) { stage_rc(tid * 16 + i * 8192, R[i], C[i]); const int Rb = (R[i] & ~31) + perm32(R[i] & 31); voffB[i] = (unsigned)(Rb * K + C[i]) * 2u; }
    const unsigned kstep = (unsigned)(BK * 2);
    const unsigned hstepB = (unsigned)HALF * (unsigned)K * 2u;
    const unsigned ldsw = (unsigned)wid * 1024u;
    const int aoff = lds_byte(wr * 64 + fr, FP8 ? fq * 16 : fq * 8), boff = lds_byte(wc * 32 + fr, FP8 ? fq * 16 : fq * 8);
#define PG8_SA(b, h) (((b) * 2 + (h)) * HTB)
#define PG8_SB(b, h) ((4 + (b) * 2 + (h)) * HTB)
    const __amdgpu_buffer_rsrc_t rA = __builtin_amdgcn_make_buffer_rsrc((void*)S.a_buf(), 0, -1, 0x00020000), rB = __builtin_amdgcn_make_buffer_rsrc((void*)S.b_buf(), 0, -1, 0x00020000);
#define PG8_STAGE2(bufoff, rs, soff, o0, o1) do { \
        __builtin_amdgcn_raw_ptr_buffer_load_lds(rs, (LAS void*)(lds + (bufoff) + ldsw), 16, (int)(o0), (int)(soff), 0, 0); \
        __builtin_amdgcn_raw_ptr_buffer_load_lds(rs, (LAS void*)(lds + (bufoff) + ldsw + 8192), 16, (int)(o1), (int)(soff), 0, 0); } while (0)
#define PG8_STAGEA(bufoff, soff, o0, o1) PG8_STAGE2(bufoff, rA, soff, o0, o1)
#define PG8_STAGEB(bufoff, soff) PG8_STAGE2(bufoff, rB, soff, voffB[0], voffB[1])
    typedef typename pg8::FragSel<FP8>::T FragT;
    constexpr int NK = FP8 ? 1 : 2;
#define PG8_LDA(dst, b, h) do { _Pragma("unroll") for (int m = 0; m < 4; ++m) _Pragma("unroll") for (int k = 0; k < NK; ++k) dst[m][k] = pg8::ld_frag<FP8>(lds + PG8_SA(b, h) + aoff + m * 2048 + k * 1024); } while (0)
#define PG8_LDB(dst, b, h) do { _Pragma("unroll") for (int n = 0; n < 2; ++n) _Pragma("unroll") for (int k = 0; k < NK; ++k) dst[n][k] = pg8::ld_frag<FP8>(lds + PG8_SB(b, h) + boff + n * 2048 + k * 1024); } while (0)
#define PG8_MMA(ai, bj, At, Bt) do { __builtin_amdgcn_s_setprio(1); if constexpr (FP8) asm volatile("s_nop 1"); _Pragma("unroll") for (int m = 0; m < 4; ++m) _Pragma("unroll") for (int n = 0; n < 2; ++n) _Pragma("unroll") for (int k = 0; k < NK; ++k) \
        acc[ai][bj][m][n] = pg8::mma_frag(Bt[n][k], At[m][k], acc[ai][bj][m][n]); __builtin_amdgcn_s_setprio(0); } while (0)
#define PG8_WAIT_V(n) asm volatile("s_waitcnt vmcnt(" #n ")" ::: "memory")
#define PG8_WAIT_L(n) asm volatile("s_waitcnt lgkmcnt(" #n ")" ::: "memory")
#define PG8_BAR __builtin_amdgcn_s_barrier()
#define PG8_SCHED __builtin_amdgcn_sched_barrier(0)
    Unit cur, nxt; int ui = 0;
    if (!S.next(0, cur)) return;
    f32x4 acc[2][2][4][2];
#pragma unroll
    for (int a = 0; a < 2; ++a)
#pragma unroll
        for (int b = 0; b < 2; ++b)
#pragma unroll
            for (int m = 0; m < 4; ++m)
#pragma unroll
                for (int n = 0; n < 2; ++n) { float z0, z1, z2, z3; asm volatile("v_mov_b32 %0, 0\n\tv_mov_b32 %1, 0\n\tv_mov_b32 %2, 0\n\tv_mov_b32 %3, 0" : "=v"(z0), "=v"(z1), "=v"(z2), "=v"(z3)); acc[a][b][m][n] = (f32x4){z0, z1, z2, z3}; }
    FragT At[4][NK], B0[2][NK], B1[2][NK];
    unsigned ca[4], na[4];
    S.a_offs(cur, R[0], R[1], C[0], C[1], ca);
    unsigned cA = (unsigned)__builtin_amdgcn_readfirstlane((int)S.a_soff(cur)), cB = (unsigned)__builtin_amdgcn_readfirstlane((int)S.b_soff(cur));
    PG8_STAGEB(PG8_SB(0, 0), cB); PG8_STAGEB(PG8_SB(0, 1), cB + hstepB); PG8_STAGEA(PG8_SA(0, 0), cA, ca[0], ca[1]); PG8_STAGEA(PG8_SA(0, 1), cA, ca[2], ca[3]);
    if (wr == 1) PG8_BAR;
    PG8_WAIT_V(2); PG8_BAR;
    PG8_STAGEB(PG8_SB(1, 0), cB + kstep); PG8_STAGEA(PG8_SA(1, 0), cA + kstep, ca[0], ca[1]); PG8_STAGEB(PG8_SB(1, 1), cB + hstepB + kstep);
    PG8_WAIT_V(6); PG8_BAR;
#define PG8_TRIP(a1, a2, b2, a3, b3, x0, x1, x2, x3) do { \
            PG8_LDB(B0, 0, 0); PG8_LDB(B1, 0, 1); PG8_SCHED; PG8_LDA(At, 0, 0); PG8_STAGEA(PG8_SA(1, 1), a1, ca[2], ca[3]); \
            PG8_WAIT_V(8); PG8_WAIT_L(0); PG8_BAR; PG8_MMA(0, 0, At, B0); PG8_MMA(0, 1, At, B1); PG8_BAR; PG8_SCHED; \
            PG8_LDA(At, 0, 1); PG8_STAGEB(PG8_SB(0, 0), b2); PG8_STAGEB(PG8_SB(0, 1), (b2) + hstepB); PG8_STAGEA(PG8_SA(0, 0), a2, x0, x1); \
            PG8_WAIT_V(8); PG8_WAIT_L(0); PG8_BAR; PG8_MMA(1, 0, At, B0); PG8_MMA(1, 1, At, B1); PG8_BAR; PG8_SCHED; \
            PG8_LDB(B0, 1, 0); PG8_LDB(B1, 1, 1); PG8_SCHED; PG8_LDA(At, 1, 0); PG8_STAGEA(PG8_SA(0, 1), a2, x2, x3); \
            PG8_WAIT_V(8); PG8_WAIT_L(0); PG8_BAR; PG8_MMA(0, 0, At, B0); PG8_MMA(0, 1, At, B1); PG8_BAR; PG8_SCHED; \
            PG8_LDA(At, 1, 1); PG8_STAGEB(PG8_SB(1, 0), b3); PG8_STAGEB(PG8_SB(1, 1), (b3) + hstepB); PG8_STAGEA(PG8_SA(1, 0), a3, x0, x1); \
            PG8_WAIT_V(8); PG8_WAIT_L(0); PG8_BAR; PG8_MMA(1, 0, At, B0); PG8_MMA(1, 1, At, B1); PG8_BAR; PG8_SCHED; } while (0)
    for (;;) {
        const bool has_next = S.next(ui + 1, nxt);
        unsigned nA = cA, nB = cB;
#pragma unroll
        for (int i = 0; i < 4; ++i) na[i] = ca[i];
        if (has_next) { nA = (unsigned)__builtin_amdgcn_readfirstlane((int)S.a_soff(nxt)); nB = (unsigned)__builtin_amdgcn_readfirstlane((int)S.b_soff(nxt)); S.a_offs(nxt, R[0], R[1], C[0], C[1], na); }
        for (int t = 0; t < nt; t += 2) {
            const bool last = (t == nt - 2);
            const unsigned a1 = cA + (unsigned)(t + 1) * kstep;
            const unsigned a2 = last ? nA : cA + (unsigned)(t + 2) * kstep, b2 = last ? nB : cB + (unsigned)(t + 2) * kstep;
            const unsigned x0 = last ? na[0] : ca[0], x1 = last ? na[1] : ca[1], x2 = last ? na[2] : ca[2], x3 = last ? na[3] : ca[3];
            PG8_TRIP(a1, a2, b2, a2 + kstep, b2 + kstep, x0, x1, x2, x3);
        }
        if (wr == 0) PG8_BAR;
        if constexpr (FP8) asm volatile("s_nop 15\n\ts_nop 15" ::: "memory");
        E(acc, cur, wr, wc, fr, fq);
        if (!has_next) break;
#pragma unroll
        for (int a = 0; a < 2; ++a)
#pragma unroll
            for (int b = 0; b < 2; ++b)
#pragma unroll
                for (int m = 0; m < 4; ++m)
#pragma unroll
                    for (int n = 0; n < 2; ++n) { float z0, z1, z2, z3; asm volatile("v_mov_b32 %0, 0\n\tv_mov_b32 %1, 0\n\tv_mov_b32 %2, 0\n\tv_mov_b32 %3, 0" : "=v"(z0), "=v"(z1), "=v"(z2), "=v"(z3)); acc[a][b][m][n] = (f32x4){z0, z1, z2, z3}; }
        cur = nxt; cA = nA; cB = nB; ++ui;
#pragma unroll
        for (int i = 0; i < 4; ++i) ca[i] = na[i];
        if (wr == 1) PG8_BAR;
    }
    PG8_WAIT_V(0);
    PG8_BAR;
#undef PG8_SA
#undef PG8_SB
#undef PG8_TRIP
#undef PG8_STAGE2
#undef PG8_STAGEA
#undef PG8_STAGEB
#undef PG8_LDA
#undef PG8_LDB
#undef PG8_MMA
#undef PG8_WAIT_V
#undef PG8_WAIT_L
#undef PG8_BAR
#undef PG8_SCHED
}
}

struct DenseUnit { int pm, pn; };
struct DenseSched {
    typedef DenseUnit UnitT;
    const bf16_t* A; const bf16_t* Bt; int lda; int K; int nM, nN, G, c, wave;
    __device__ __forceinline__ bool next(int i, DenseUnit& u) const { return pg8::static_tile(i * G + c, nM, nN, u.pm, u.pn); }
    __device__ __forceinline__ const void* a_buf() const { return A; }
    __device__ __forceinline__ const void* b_buf() const { return Bt; }
    __device__ __forceinline__ unsigned a_soff(const DenseUnit& u) const { return (unsigned)u.pm * 256u * (unsigned)lda * 2u; }
    __device__ __forceinline__ unsigned b_soff(const DenseUnit& u) const { return (unsigned)u.pn * 256u * (unsigned)K * 2u; }
    __device__ __forceinline__ void a_offs(const DenseUnit&, int R0, int R1, int C0, int C1, unsigned (&o)[4]) const {
        o[0] = (unsigned)(R0 * lda + C0) * 2u; o[1] = (unsigned)(R1 * lda + C1) * 2u; o[2] = (unsigned)((R0 + 128) * lda + C0) * 2u; o[3] = (unsigned)((R1 + 128) * lda + C1) * 2u;
    }
};
struct MkArgs {
    const float* x; const float* c; const int* positions; const float* w_ada; const float* b_ada;
    const float* g_pre_mix; const float* g_post_mix; const float* g_pre_ffn; const float* g_post_ffn;
    const float* w_in; const float* b_in; const float* conv_qk; const float* sinks; const float* g_mlstm;
    const float* w_attn_proj; const float* w_mlstm_proj; const float* w_out; const float* w_router; const float* b_router;
    const float* w_gate_up; const float* b_gate_up; const float* w_down; const float* b_down;
    float* out; unsigned char* ws;
    const int* route_i; const float* route_w;
    int ph_lo, ph_hi;
};

struct Frame {
    LAS unsigned char* lds;
    int G, bid, vcu, wave;
};
__device__ __forceinline__ int lane_id() { return (int)__builtin_amdgcn_mbcnt_hi(~0u, __builtin_amdgcn_mbcnt_lo(~0u, 0u)); }
__device__ __forceinline__ int fresh_tid(const Frame& F) { return (F.wave << 6) | lane_id(); }

__device__ __forceinline__ float wave_sum_f(float v) {
#pragma unroll
    for (int o = 1; o < 64; o <<= 1) v += __shfl_xor(v, o);
    return v;
}
__device__ __forceinline__ float wave_max_f(float v) {
#pragma unroll
    for (int o = 1; o < 64; o <<= 1) v = fmaxf(v, __shfl_xor(v, o));
    return v;
}

__device__ __forceinline__ int in_src_col(int n) {
    if (n < 1152) { const int d = n & 63; if (d < 16) return (n & ~63) + (d >> 1) + 8 * (d & 1); return n; }
    if (n < 4352) return n;
    return n + 8;
}

template <bool MAP>
__device__ __forceinline__ void p0_transpose_item(const float* __restrict__ W, int K, int N, bf16_t* WT, LAS float* scr, int kb, int nb, int lane) {
    const int k0 = 64 * kb, n0 = 32 * nb;
    const int sc = MAP ? in_src_col(n0 + (lane & 31)) : n0 + (lane & 31);
#pragma unroll 8
    for (int i = 0; i < 32; ++i) { const int kk = 2 * i + (lane >> 5); scr[kk * 33 + (lane & 31)] = W[(size_t)(k0 + kk) * N + sc]; }
    LDS_WAIT(); asm volatile("" ::: "memory");
    const int c = lane & 7;
#pragma unroll
    for (int j = 0; j < 4; ++j) { const int n = (lane >> 3) + 8 * j; const LAS float* s = scr + (8 * c) * 33 + n;
        u32x4 o; o.x = pk2(s[0 * 33], s[1 * 33]); o.y = pk2(s[2 * 33], s[3 * 33]); o.z = pk2(s[4 * 33], s[5 * 33]); o.w = pk2(s[6 * 33], s[7 * 33]);
        *(u32x4*)(WT + (size_t)(n0 + n) * K + k0 + 8 * c) = o; }
    LDS_WAIT(); asm volatile("" ::: "memory");
}

__device__ __forceinline__ void p0_transpose_item_f8(const float* __restrict__ W, int K, int N, unsigned char* WT, LAS float* scr, int kb, int nb, int lane) {
    const int k0 = 64 * kb, n0 = 32 * nb;
    const int sc = n0 + (lane & 31);
#pragma unroll 8
    for (int i = 0; i < 32; ++i) { const int kk = 2 * i + (lane >> 5); scr[kk * 33 + (lane & 31)] = W[(size_t)(k0 + kk) * N + sc]; }
    LDS_WAIT(); asm volatile("" ::: "memory");
    const int c = lane & 7;
#pragma unroll
    for (int j = 0; j < 4; ++j) { const int n = (lane >> 3) + 8 * j; const LAS float* s = scr + (8 * c) * 33 + n;
        u32x2 o; o.x = pk4_fp8(s[0 * 33] * W8SCALE, s[1 * 33] * W8SCALE, s[2 * 33] * W8SCALE, s[3 * 33] * W8SCALE); o.y = pk4_fp8(s[4 * 33] * W8SCALE, s[5 * 33] * W8SCALE, s[6 * 33] * W8SCALE, s[7 * 33] * W8SCALE);
        *(u32x2*)(WT + (size_t)(n0 + n) * K + k0 + 8 * c) = o; }
    LDS_WAIT(); asm volatile("" ::: "memory");
}

__device__ __forceinline__ void phase0(const MkArgs& a, Frame& F) {
    const int f_tid = fresh_tid(F), f_lane = f_tid & 63, f_wave = F.wave;
    unsigned char* ws = a.ws;
    LAS float* scr = (LAS float*)(F.lds + f_wave * 16384);
    const int gw = F.vcu * fp::NW + f_wave, NGW = F.G * fp::NW;
    constexpr int I_IN = 32 * (fp::NIN / 32), I_AP = 16 * 64, I_MP = 16 * 64, I_OUT = 32 * 64, I_GU = 32 * 128, I_DN = 32 * 64;
    constexpr int NITEMS = I_IN + I_AP + I_MP + I_OUT + NE * I_GU + NE * I_DN;
    for (int it = gw; it < NITEMS; it += NGW) {
        int r = it;
        if (r < I_IN) { const int nblk = fp::NIN / 32; p0_transpose_item<true>(a.w_in, 2048, INW, (bf16_t*)(ws + wsf::WIN_T), scr, r / nblk, r % nblk, f_lane); continue; } r -= I_IN;
        if (r < I_AP) { p0_transpose_item<false>(a.w_attn_proj, 1024, 2048, (bf16_t*)(ws + wsf::WAP_T), scr, r / 64, r % 64, f_lane); continue; } r -= I_AP;
        if (r < I_MP) { p0_transpose_item<false>(a.w_mlstm_proj, 1024, 2048, (bf16_t*)(ws + wsf::WMP_T), scr, r / 64, r % 64, f_lane); continue; } r -= I_MP;
        if (r < I_OUT) { p0_transpose_item<false>(a.w_out, 2048, 2048, (bf16_t*)(ws + wsf::WOUT_T), scr, r / 64, r % 64, f_lane); continue; } r -= I_OUT;
#if MOE_FP8
        if (r < NE * I_GU) { const int e = r / I_GU, q = r % I_GU; p0_transpose_item_f8(a.w_gate_up + (size_t)e * 2048 * 4096, 2048, 4096, ws + wsf::WGU8 + (size_t)e * 4096 * 2048, scr, q / 128, q % 128, f_lane); continue; } r -= NE * I_GU;
        { const int e = r / I_DN, q = r % I_DN; p0_transpose_item_f8(a.w_down + (size_t)e * 2048 * 2048, 2048, 2048, ws + wsf::WDN8 + (size_t)e * 2048 * 2048, scr, q / 64, q % 64, f_lane); }
#else
        if (r < NE * I_GU) { const int e = r / I_GU, q = r % I_GU; p0_transpose_item<false>(a.w_gate_up + (size_t)e * 2048 * 4096, 2048, 4096, (bf16_t*)(ws + wsf::WGU_T) + (size_t)e * 4096 * 2048, scr, q / 128, q % 128, f_lane); continue; } r -= NE * I_GU;
        { const int e = r / I_DN, q = r % I_DN; p0_transpose_item<false>(a.w_down + (size_t)e * 2048 * 2048, 2048, 2048, (bf16_t*)(ws + wsf::WDN_T) + (size_t)e * 2048 * 2048, scr, q / 64, q % 64, f_lane); }
#endif
    }
    {
        float* part = (float*)(ws + wsf::MODP);
        for (int it = gw; it < (MODW / 64) * 16; it += NGW) {
            const int jb = it % (MODW / 64), ks = it / (MODW / 64), j = jb * 64 + f_lane, k0 = ks * 128;
            float a0 = 0.f, a1 = 0.f;
            for (int k = k0; k < k0 + 128; ++k) { const float w = a.w_ada[(size_t)k * MODW + j]; a0 += silu_f(a.c[k]) * w; a1 += silu_f(a.c[D + k]) * w; }
            part[(size_t)(ks * 2 + 0) * MODW + j] = a0; part[(size_t)(ks * 2 + 1) * MODW + j] = a1;
        }
    }
    const int gt = F.vcu * fp::NT + f_tid, NGT = F.G * fp::NT;
    for (int i = gt; i < NTOK * 8; i += NGT) { float cs, sn; rope_cs(a.positions[i >> 3], i & 7, cs, sn); ((f32x2*)(ws + wsf::CS))[i] = (f32x2){cs, sn}; }
    for (int i = gt; i < fp::NIN; i += NGT) ((float*)(ws + wsf::BINP))[i] = a.b_in[in_src_col(i)];
    for (int i = gt; i < 32 * 2048; i += NGT) {
        const int e = i >> 11, k = i & 2047; const float w = a.w_router[k * 32 + e]; const unsigned hi = f2bf(w); const float rem = w - __builtin_bit_cast(float, hi << 16);
        ((bf16_t*)(ws + wsf::WRT))[i] = (bf16_t)hi; ((bf16_t*)(ws + wsf::WRT))[32 * 2048 + i] = (bf16_t)f2bf(rem);
    }
}

__device__ __forceinline__ void phase1(const MkArgs& a, Frame& F) {
    const int f_tid = fresh_tid(F), f_lane = f_tid & 63, f_wave = F.wave;
    unsigned char* ws = a.ws;
    const float* part = (const float*)(ws + wsf::MODP);
    float* mod = (float*)(ws + wsf::MOD);
    { const int per = (2 * MODW) / F.G;
      for (int i = f_tid; i < per; i += fp::NT) { const int idx = F.vcu * per + i, b = idx / MODW, j = idx % MODW; float s = a.b_ada[j];
#pragma unroll
          for (int p = 0; p < 16; ++p) s += part[(size_t)(p * 2 + b) * MODW + j];
          mod[idx] = s; }
      if (F.vcu == 0) for (int idx = per * F.G + f_tid; idx < 2 * MODW; idx += fp::NT) { const int b = idx / MODW, j = idx % MODW; float s = a.b_ada[j];
          for (int p = 0; p < 16; ++p) s += part[(size_t)(p * 2 + b) * MODW + j];
          mod[idx] = s; } }
    LAS float* lmod = (LAS float*)F.lds;
    LAS float* wg = (LAS float*)(F.lds + 32768);
    for (int i = f_tid; i < 2 * 4096; i += fp::NT) { const int b = i >> 12, j = i & 4095; float s = a.b_ada[j];
#pragma unroll
        for (int p = 0; p < 16; ++p) s += part[(size_t)(p * 2 + b) * MODW + j];
        lmod[i] = s; }
    for (int i = f_tid; i < 2048 * 8; i += fp::NT) wg[i] = a.w_in[(size_t)(i >> 3) * INW + OFF_MI + (i & 7)];
    __syncthreads();
    const int gw = F.vcu * fp::NW + f_wave, NGW = F.G * fp::NW;
    for (int m = gw; m < NTOK; m += NGW) {
        const int b = m / S;
        const GAS f32x4* xr = (const GAS f32x4*)(a.x + (size_t)m * D);
        float ss = 0.f;
#pragma unroll
        for (int j = 0; j < 8; ++j) { const f32x4 v = xr[64 * j + f_lane]; ss += (v.x * v.x + v.y * v.y) + (v.z * v.z + v.w * v.w); }
        const float r = rsqrtf(wave_sum_f(ss) * (1.f / D) + EPS);
        float g8[8];
#pragma unroll
        for (int e = 0; e < 8; ++e) g8[e] = 0.f;
        GAS u32x2* o8 = (GAS u32x2*)(ws + wsf::H1 + (size_t)m * D * 2);
#pragma unroll 1
        for (int j = 0; j < 8; ++j) {
            const int c0 = 4 * (64 * j + f_lane);
            const f32x4 v = xr[64 * j + f_lane];
            const f32x4 g = *(const f32x4*)(a.g_pre_mix + c0);
            const f32x4 sh = *(const LAS f32x4*)(lmod + b * 4096 + c0), sc = *(const LAS f32x4*)(lmod + b * 4096 + 2048 + c0);
            f32x4 h;
            h.x = v.x * r * g.x * (1.f + sc.x) + sh.x; h.y = v.y * r * g.y * (1.f + sc.y) + sh.y;
            h.z = v.z * r * g.z * (1.f + sc.z) + sh.z; h.w = v.w * r * g.w * (1.f + sc.w) + sh.w;
            o8[64 * j + f_lane] = (u32x2){pk2(h.x, h.y), pk2(h.z, h.w)};
#pragma unroll
            for (int q = 0; q < 4; ++q) {
                const f32x4 w0 = *(const LAS f32x4*)(wg + (c0 + q) * 8), w1 = *(const LAS f32x4*)(wg + (c0 + q) * 8 + 4);
                const float hv = h[q];
                g8[0] += hv * w0.x; g8[1] += hv * w0.y; g8[2] += hv * w0.z; g8[3] += hv * w0.w;
                g8[4] += hv * w1.x; g8[5] += hv * w1.y; g8[6] += hv * w1.z; g8[7] += hv * w1.w;
            }
        }
        float mine = 0.f;
#pragma unroll
        for (int e = 0; e < 8; ++e) { const float s = wave_sum_f(g8[e]); if (f_lane == e) mine = s; }
        if (f_lane < 8) ((float*)(ws + wsf::GATES))[(size_t)m * 8 + f_lane] = mine + a.b_in[OFF_MI + f_lane];
    }
}

struct EpiIn {
    bf16_t* O; const float* bias; const f32x2* cs;
    __device__ __forceinline__ void operator()(const f32x4 (&acc)[2][2][4][2], const DenseUnit& u, int wr, int wc, int fr, int fq) const {
        const int row0 = u.pm * 256 + wr * 64 + fr, col0 = u.pn * 256 + wc * 32 + 8 * fq;
        const int pn = u.pn;
        const bool ropelane = ((wc & 1) == 0) && fq < 2;
        const int i0 = fq * 4;
        f32x4 bv[2][2];
#pragma unroll
        for (int bj = 0; bj < 2; ++bj)
#pragma unroll
            for (int n = 0; n < 2; ++n) bv[bj][n] = *(const f32x4*)(bias + col0 + bj * 128 + 4 * n);
#pragma unroll
        for (int ai = 0; ai < 2; ++ai)
#pragma unroll
            for (int m = 0; m < 4; ++m) {
                const int row = row0 + ai * 128 + m * 16;
                bf16_t* rowp = O + (size_t)row * fp::NIN + col0;
#pragma unroll
                for (int bj = 0; bj < 2; ++bj) {
                    f32x4 v0 = acc[ai][bj][m][0] + bv[bj][0], v1 = acc[ai][bj][m][1] + bv[bj][1];
                    if (pn < 4 || (pn == 4 && bj == 0)) {
                        if (ropelane) {
                            const f32x4 ca = *(const f32x4*)(cs + (size_t)row * 8 + i0), cb = *(const f32x4*)(cs + (size_t)row * 8 + i0 + 2);
                            f32x4 r0, r1;
                            r0.x = v0.x * ca.x - v0.y * ca.y; r0.y = v0.y * ca.x + v0.x * ca.y;
                            r0.z = v0.z * ca.z - v0.w * ca.w; r0.w = v0.w * ca.z + v0.z * ca.w;
                            r1.x = v1.x * cb.x - v1.y * cb.y; r1.y = v1.y * cb.x + v1.x * cb.y;
                            r1.z = v1.z * cb.z - v1.w * cb.w; r1.w = v1.w * cb.z + v1.z * cb.w;
                            v0 = r0; v1 = r1;
                        }
                        if (pn < 4) { v0 = v0 * fp::QSCALE; v1 = v1 * fp::QSCALE; }
                    } else if (pn >= 13) {
#pragma unroll
                        for (int q = 0; q < 4; ++q) { v0[q] = fast_sigmoid(v0[q]); v1[q] = fast_sigmoid(v1[q]); }
                    }
                    u32x4 w; w.x = pg8::cvt_pk_bf16(v0[0], v0[1]); w.y = pg8::cvt_pk_bf16(v0[2], v0[3]); w.z = pg8::cvt_pk_bf16(v1[0], v1[1]); w.w = pg8::cvt_pk_bf16(v1[2], v1[3]);
                    *(u32x4*)(rowp + bj * 128) = w;
                }
            }
    }
};

__device__ __forceinline__ void phase2(const MkArgs& a, Frame& F) {
    const int f_tid = fresh_tid(F), f_lane = f_tid & 63, f_wave = F.wave;
    unsigned char* ws = a.ws;
    DenseSched S{(const bf16_t*)(ws + wsf::H1), (const bf16_t*)(ws + wsf::WIN_T), 2048, 2048, NTOK / 256, fp::NIN / 256, F.G, F.bid, F.wave};
    EpiIn E{(bf16_t*)(ws + wsf::PROJB), (const float*)(ws + wsf::BINP), (const f32x2*)(ws + wsf::CS)};
    pg8::gemm_phase<EpiIn, DenseSched>(F.lds, S, E);
}
__device__ __forceinline__ f32x4 mfma16(bf16x8 a, bf16x8 b, f32x4 c) { return __builtin_amdgcn_mfma_f32_16x16x32_bf16(a, b, c, 0, 0, 0); }
__device__ __forceinline__ float exp2_fast(float x) { return __builtin_amdgcn_exp2f(x); }

__device__ __forceinline__ void attn_unit(const MkArgs& a, Frame& F, int unit) {
    const int f_tid = fresh_tid(F), f_lane = f_tid & 63, f_wave = F.wave;
    const int b = unit >> 7, hk = (unit >> 6) & 1, n = unit & 63;
    const bf16_t* PB = (const bf16_t*)(a.ws + wsf::PROJB);
    bf16_t* OA = (bf16_t*)(a.ws + wsf::OAT);
    const size_t tok0 = (size_t)b * S + (size_t)n * 128;
    LAS bf16_t* Ks = (LAS bf16_t*)F.lds;
    LAS bf16_t* Vt = (LAS bf16_t*)(F.lds + 36864);
    LAS bf16_t* Pw = (LAS bf16_t*)(F.lds + 36864 + 35840 + f_wave * 5376);
#pragma unroll
    for (int i = 0; i < 4; ++i) {
        const int q = f_tid + 512 * i, row = q >> 3, ch = q & 7;
        u32x4 kv = (u32x4){0u, 0u, 0u, 0u}, vv = kv;
        if (n > 0 || row >= 128) {
            const bf16_t* src = PB + (tok0 - 128 + row) * fp::NIN + hk * 64 + ch * 8;
            kv = *(const u32x4*)(src + fp::PB_K); vv = *(const u32x4*)(src + fp::PB_V);
        }
        *(LAS u32x4*)(Ks + row * 72 + ch * 8) = kv;
        LAS bf16_t* vd = Vt + (ch * 8) * 280 + row;
        vd[0 * 280] = (bf16_t)(vv.x & 0xffffu); vd[1 * 280] = (bf16_t)(vv.x >> 16); vd[2 * 280] = (bf16_t)(vv.y & 0xffffu); vd[3 * 280] = (bf16_t)(vv.y >> 16);
        vd[4 * 280] = (bf16_t)(vv.z & 0xffffu); vd[5 * 280] = (bf16_t)(vv.z >> 16); vd[6 * 280] = (bf16_t)(vv.w & 0xffffu); vd[7 * 280] = (bf16_t)(vv.w >> 16);
    }
    for (int i = f_tid; i < 64 * 24; i += fp::NT) Vt[(i / 24) * 280 + 256 + (i % 24)] = (bf16_t)0;
    __syncthreads();
    const int c16 = f_lane & 15, grp = f_lane >> 4, h = hk * 8 + f_wave;
    const float sink2 = a.sinks[h] * fp::LOG2E;
#pragma unroll 1
    for (int tt = 0; tt < 8; ++tt) {
        const size_t qtok = tok0 + tt * 16 + c16;
        bf16x8 qf[2];
#pragma unroll
        for (int ks = 0; ks < 2; ++ks) qf[ks] = *(const bf16x8*)(PB + qtok * fp::NIN + fp::PB_Q + h * 64 + ks * 32 + grp * 8);
        f32x4 sacc[9];
#pragma unroll
        for (int jq = 0; jq < 9; ++jq) {
            sacc[jq] = (f32x4){0.f, 0.f, 0.f, 0.f};
#pragma unroll
            for (int ks = 0; ks < 2; ++ks) { const bf16x8 kf = *(const LAS bf16x8*)(Ks + (16 * (tt + jq) + c16) * 72 + ks * 32 + grp * 8); sacc[jq] = mfma16(kf, qf[ks], sacc[jq]); }
        }
        float mx = sink2;
#pragma unroll
        for (int jq = 0; jq < 9; ++jq)
#pragma unroll
            for (int r = 0; r < 4; ++r) {
                const int diff = 128 + c16 - 16 * jq - 4 * grp - r, jrel = 16 * (tt + jq) + 4 * grp + r;
                const bool ok = diff >= 0 && diff < 128 && (n > 0 || jrel >= 128);
                sacc[jq][r] = ok ? sacc[jq][r] : -INFINITY;
                mx = fmaxf(mx, sacc[jq][r]);
            }
        mx = fmaxf(mx, __shfl_xor(mx, 16)); mx = fmaxf(mx, __shfl_xor(mx, 32));
        float ls = 0.f;
#pragma unroll
        for (int jq = 0; jq < 9; ++jq) {
            float p[4];
#pragma unroll
            for (int r = 0; r < 4; ++r) { p[r] = exp2_fast(sacc[jq][r] - mx); ls += p[r]; }
            *(LAS u32x2*)(Pw + c16 * 168 + 16 * jq + 4 * grp) = (u32x2){pk2(p[0], p[1]), pk2(p[2], p[3])};
        }
        *(LAS u32x2*)(Pw + c16 * 168 + 144 + 4 * grp) = (u32x2){0u, 0u};
        ls += __shfl_xor(ls, 16); ls += __shfl_xor(ls, 32);
        ls += exp2_fast(sink2 - mx);
        const float inv = 1.f / ls;
        LDS_WAIT();
        f32x4 oacc[4];
#pragma unroll
        for (int dt = 0; dt < 4; ++dt) oacc[dt] = (f32x4){0.f, 0.f, 0.f, 0.f};
#pragma unroll
        for (int k2 = 0; k2 < 5; ++k2) {
            const bf16x8 pb = *(const LAS bf16x8*)(Pw + c16 * 168 + 32 * k2 + 8 * grp);
#pragma unroll
            for (int dt = 0; dt < 4; ++dt) { const bf16x8 va = *(const LAS bf16x8*)(Vt + (16 * dt + c16) * 280 + 16 * tt + 32 * k2 + 8 * grp); oacc[dt] = mfma16(va, pb, oacc[dt]); }
        }
#pragma unroll
        for (int dt = 0; dt < 4; ++dt)
            *(u32x2*)(OA + qtok * 1024 + h * 64 + 16 * dt + 4 * grp) = (u32x2){pk2(oacc[dt][0] * inv, oacc[dt][1] * inv), pk2(oacc[dt][2] * inv, oacc[dt][3] * inv)};
        LDS_WAIT();
    }
    __syncthreads();
}

__device__ __forceinline__ void unpack8(const u32x4 v, float (&f)[8]) {
    f[0] = bflo(v.x); f[1] = bfhi(v.x); f[2] = bflo(v.y); f[3] = bfhi(v.y); f[4] = bflo(v.z); f[5] = bfhi(v.z); f[6] = bflo(v.w); f[7] = bfhi(v.w);
}
__device__ __forceinline__ void stage_vt(const bf16_t* PB, size_t tok0, int col0, LAS bf16_t* Vt, int tid) {
#pragma unroll
    for (int i = 0; i < 8; ++i) {
        const int q = tid + 512 * i, row = q >> 5, ch = q & 31;
        const u32x4 vv = *(const u32x4*)(PB + (tok0 + row) * fp::NIN + col0 + ch * 8);
        LAS bf16_t* vd = Vt + (ch * 8) * 136 + row;
        vd[0 * 136] = (bf16_t)(vv.x & 0xffffu); vd[1 * 136] = (bf16_t)(vv.x >> 16); vd[2 * 136] = (bf16_t)(vv.y & 0xffffu); vd[3 * 136] = (bf16_t)(vv.y >> 16);
        vd[4 * 136] = (bf16_t)(vv.z & 0xffffu); vd[5 * 136] = (bf16_t)(vv.z >> 16); vd[6 * 136] = (bf16_t)(vv.w & 0xffffu); vd[7 * 136] = (bf16_t)(vv.w >> 16);
    }
}

__device__ __forceinline__ void m1_unit(const MkArgs& a, Frame& F, int u) {
    const int f_tid = fresh_tid(F), f_lane = f_tid & 63, f_wave = F.wave;
    const int bh = u >> 6, c = u & 63, b = bh >> 2, h = bh & 3;
    const size_t tok0 = (size_t)b * S + (size_t)c * 128;
    unsigned char* ws = a.ws;
    const bf16_t* PB = (const bf16_t*)(ws + wsf::PROJB);
    LAS bf16_t* KwT = (LAS bf16_t*)F.lds;
    LAS bf16_t* Vt = (LAS bf16_t*)(F.lds + 34816);
    LAS float* gl = (LAS float*)(F.lds + 34816 + 69632);
    const float* GT = (const float*)(ws + wsf::GATES);
    const int tid = f_tid;
    float li = 0.f, lf = 0.f;
    if (tid < 128) { li = softcap_f(GT[(tok0 + tid) * 8 + h]); lf = logsigmoid_f(softcap_f(GT[(tok0 + tid) * 8 + 4 + h])); }
    float cum = lf;
#pragma unroll
    for (int o = 1; o < 64; o <<= 1) { const float t = __shfl_up(cum, o); if (f_lane >= o) cum += t; }
    if (tid == 63) gl[384] = cum;
    __syncthreads();
    if (tid >= 64 && tid < 128) cum += gl[384];
    if (tid == 127) gl[385] = cum;
    __syncthreads();
    const float g = gl[385];
    const float av = (tid < 128) ? (g - cum + li) : -INFINITY;
    const float wm = wave_max_f(av);
    if (f_lane == 0 && f_wave < 2) gl[386 + f_wave] = wm;
    __syncthreads();
    const float mloc = fmaxf(gl[386], gl[387]);
    if (tid < 128) {
        gl[256 + tid] = expf(av - mloc);
        ((float*)(ws + wsf::BCUM))[(size_t)bh * S + c * 128 + tid] = cum;
        ((float*)(ws + wsf::LOGI))[(size_t)bh * S + c * 128 + tid] = li;
    }
    if (tid == 0) { ((float*)(ws + wsf::GSUM))[u] = g; ((float*)(ws + wsf::MLOC))[u] = mloc; }
    __syncthreads();
#pragma unroll 1
    for (int i = 0; i < 8; ++i) {
        const int q = tid + 512 * i, row = q >> 5, ch = q & 31, isK = ch >= 16, cc = (ch & 15) * 8;
        const int colsrc = (isK ? fp::PB_MK : fp::PB_MQ) + h * 128 + cc, cwcol = (isK ? 512 : 0) + h * 128 + cc;
        float acc[8];
#pragma unroll
        for (int e = 0; e < 8; ++e) acc[e] = 0.f;
#pragma unroll
        for (int j = 0; j < 4; ++j) {
            const int sabs = c * 128 + row - 3 + j;
            if (sabs >= 0) {
                const u32x4 xv = *(const u32x4*)(PB + (tok0 + row - 3 + j) * fp::NIN + colsrc);
                float xf[8]; unpack8(xv, xf);
                const f32x4 w0 = *(const f32x4*)(a.conv_qk + j * 1024 + cwcol), w1 = *(const f32x4*)(a.conv_qk + j * 1024 + cwcol + 4);
                acc[0] += w0.x * xf[0]; acc[1] += w0.y * xf[1]; acc[2] += w0.z * xf[2]; acc[3] += w0.w * xf[3];
                acc[4] += w1.x * xf[4]; acc[5] += w1.y * xf[5]; acc[6] += w1.z * xf[6]; acc[7] += w1.w * xf[7];
            }
        }
        const float sc = isK ? 0.08838834764831845f : 1.f;
#pragma unroll
        for (int e = 0; e < 8; ++e) acc[e] = silu_f(acc[e]) * sc;
        const u32x4 o = (u32x4){pk2(acc[0], acc[1]), pk2(acc[2], acc[3]), pk2(acc[4], acc[5]), pk2(acc[6], acc[7])};
        bf16_t* dst = (bf16_t*)(ws + (isK ? wsf::KC : wsf::QC)) + (tok0 + row) * 512 + h * 128 + cc;
        *(u32x4*)dst = o;
        if (isK) {
            const float wr = gl[256 + row];
            LAS bf16_t* kd = KwT + cc * 136 + row;
#pragma unroll
            for (int e = 0; e < 8; ++e) kd[e * 136] = (bf16_t)f2bf(acc[e] * wr);
        }
    }
    stage_vt(PB, tok0, fp::PB_MV + h * 256, Vt, tid);
    __syncthreads();
    const int c16 = f_lane & 15, grp = f_lane >> 4, w = f_wave;
    f32x4 acc[8][2];
#pragma unroll
    for (int d = 0; d < 8; ++d) { acc[d][0] = (f32x4){0.f, 0.f, 0.f, 0.f}; acc[d][1] = acc[d][0]; }
#pragma unroll
    for (int ks = 0; ks < 4; ++ks) {
        bf16x8 bfr[2];
#pragma unroll
        for (int i = 0; i < 2; ++i) bfr[i] = *(const LAS bf16x8*)(Vt + (16 * (2 * w + i) + c16) * 136 + 32 * ks + 8 * grp);
#pragma unroll
        for (int d = 0; d < 8; ++d) {
            const bf16x8 af = *(const LAS bf16x8*)(KwT + (16 * d + c16) * 136 + 32 * ks + 8 * grp);
            acc[d][0] = mfma16(af, bfr[0], acc[d][0]); acc[d][1] = mfma16(af, bfr[1], acc[d][1]);
        }
    }
    float* dct = (float*)(ws + wsf::DCT) + (size_t)u * 256 * 128;
#pragma unroll
    for (int d = 0; d < 8; ++d)
#pragma unroll
        for (int i = 0; i < 2; ++i) *(f32x4*)(dct + (size_t)(16 * (2 * w + i) + c16) * 128 + 16 * d + 4 * grp) = acc[d][i];
    if (tid < 128) {
        float s = 0.f;
#pragma unroll
        for (int ch = 0; ch < 16; ++ch) { const u32x4 kv = *(const LAS u32x4*)(KwT + tid * 136 + ch * 8); float kf[8]; unpack8(kv, kf);
#pragma unroll
            for (int e = 0; e < 8; ++e) s += kf[e]; }
        ((float*)(ws + wsf::DN))[(size_t)u * 128 + tid] = s;
    }
    __syncthreads();
}

__device__ __forceinline__ void phase3(const MkArgs& a, Frame& F) {
    const int f_tid = fresh_tid(F), f_lane = f_tid & 63, f_wave = F.wave;
    for (int u = F.bid; u < NB * HKV * (S / 128); u += F.G) attn_unit(a, F, u);
    for (int u = F.bid; u < NB * MH * NC; u += F.G) m1_unit(a, F, u);
}

__device__ __forceinline__ void phase4(const MkArgs& a, Frame& F) {
    const int f_tid = fresh_tid(F), f_lane = f_tid & 63, f_wave = F.wave;
    unsigned char* ws = a.ws;
    LAS float* dec = (LAS float*)F.lds;
    LAS float* scl = dec + 512;
    if (f_tid < 8) {
        const int bh = f_tid; float m = 0.f;
        for (int c = 0; c < NC; ++c) {
            const float g = ((const float*)(ws + wsf::GSUM))[bh * NC + c], ml = ((const float*)(ws + wsf::MLOC))[bh * NC + c];
            if (F.bid == 0) ((float*)(ws + wsf::MPREV))[bh * NC + c] = m;
            const float mn = fmaxf(g + m, ml);
            dec[bh * 64 + c] = expf(g + m - mn); scl[bh * 64 + c] = expf(ml - mn); m = mn;
        }
    }
    __syncthreads();
    const int gt = F.vcu * fp::NT + f_tid, NGT = F.G * fp::NT;
    for (int it = gt; it < 8 * 16384; it += NGT) {
        const int bh = it >> 14, idx = it & 16383;
        const float* dct = (const float*)(ws + wsf::DCT) + (size_t)bh * 64 * 32768 + (size_t)idx * 2;
        bf16_t* cpt = (bf16_t*)(ws + wsf::CPT) + (size_t)bh * 64 * 32768 + (size_t)idx * 2;
        float C0 = 0.f, C1 = 0.f;
#pragma unroll 8
        for (int c = 0; c < NC; ++c) {
            const f32x2 d = *(const f32x2*)(dct + (size_t)c * 32768);
            *(unsigned*)(cpt + (size_t)c * 32768) = pk2(C0, C1);
            const float de = dec[bh * 64 + c], sc = scl[bh * 64 + c];
            C0 = de * C0 + sc * d.x; C1 = de * C1 + sc * d.y;
        }
    }
    for (int it = gt; it < 8 * 128; it += NGT) {
        const int bh = it >> 7, dk = it & 127; float nv = 0.f;
#pragma unroll 4
        for (int c = 0; c < NC; ++c) {
            const size_t id = (size_t)bh * NC + c;
            ((float*)(ws + wsf::NPREV))[id * 128 + dk] = nv;
            nv = dec[bh * 64 + c] * nv + scl[bh * 64 + c] * ((const float*)(ws + wsf::DN))[id * 128 + dk];
        }
    }
}

__device__ __forceinline__ void m3_unit(const MkArgs& a, Frame& F, int u) {
    const int f_tid = fresh_tid(F), f_lane = f_tid & 63, f_wave = F.wave;
    const int bh = u >> 6, c = u & 63, b = bh >> 2, h = bh & 3;
    const size_t tok0 = (size_t)b * S + (size_t)c * 128;
    unsigned char* ws = a.ws;
    const bf16_t* PB = (const bf16_t*)(ws + wsf::PROJB);
    const bf16_t* QCp = (const bf16_t*)(ws + wsf::QC);
    const bf16_t* KCp = (const bf16_t*)(ws + wsf::KC);
    LAS bf16_t* KP = (LAS bf16_t*)F.lds;
    LAS bf16_t* Vt = (LAS bf16_t*)(F.lds + 34816);
    LAS float* fl = (LAS float*)(F.lds + 104448);
    LAS float* f_us = fl, *f_M = fl + 128, *f_iw = fl + 256, *f_rd = fl + 384, *f_qn = fl + 512, *f_np = fl + 640, *f_en = fl + 768, *f_ssq = fl + 1024, *f_misc = fl + 896;
    const int tid = f_tid;
#pragma unroll
    for (int i = 0; i < 4; ++i) { const int q = tid + 512 * i, row = q >> 4, ch = q & 15;
        *(LAS u32x4*)(KP + row * 136 + ch * 8) = *(const u32x4*)(KCp + (tok0 + row) * 512 + h * 128 + ch * 8); }
    stage_vt(PB, tok0, fp::PB_MV + h * 256, Vt, tid);
    const float mp = ((const float*)(ws + wsf::MPREV))[u];
    float bt = 0.f, us = -INFINITY;
    if (tid < 128) { bt = ((const float*)(ws + wsf::BCUM))[(size_t)bh * S + c * 128 + tid]; us = ((const float*)(ws + wsf::LOGI))[(size_t)bh * S + c * 128 + tid] - bt;
        f_np[tid] = ((const float*)(ws + wsf::NPREV))[(size_t)u * 128 + tid]; }
    float pm = us;
#pragma unroll
    for (int o = 1; o < 64; o <<= 1) { const float t = __shfl_up(pm, o); if (f_lane >= o) pm = fmaxf(pm, t); }
    if (tid == 63) f_misc[0] = pm;
    __syncthreads();
    if (tid >= 64 && tid < 128) pm = fmaxf(pm, f_misc[0]);
    if (tid < 128) {
        const float Mt = fmaxf(mp, pm);
        f_us[tid] = us; f_M[tid] = Mt; f_iw[tid] = expf(mp - Mt); f_en[tid] = expf(-(bt + Mt));
        float s = 0.f;
#pragma unroll 4
        for (int ch = 0; ch < 16; ++ch) { const u32x4 qv = *(const u32x4*)(QCp + (tok0 + tid) * 512 + h * 128 + ch * 8); float qf[8]; unpack8(qv, qf);
#pragma unroll
            for (int e = 0; e < 8; ++e) s += qf[e] * f_np[ch * 8 + e]; }
        f_qn[tid] = s;
    }
    __syncthreads();
    const int c16 = f_lane & 15, grp = f_lane >> 4, w = f_wave;
    u32x2 pp[8]; float rs = 0.f;
    {
        bf16x8 qf[4];
#pragma unroll
        for (int ks = 0; ks < 4; ++ks) qf[ks] = *(const bf16x8*)(QCp + (tok0 + 16 * w + c16) * 512 + h * 128 + 32 * ks + 8 * grp);
        const float Mt = f_M[16 * w + c16];
        const int t = 16 * w + c16;
#pragma unroll
        for (int st = 0; st < 8; ++st) {
            pp[st] = (u32x2){0u, 0u};
            if (st <= w) {
                f32x4 acc = (f32x4){0.f, 0.f, 0.f, 0.f};
#pragma unroll
                for (int ks = 0; ks < 4; ++ks) { const bf16x8 kf = *(const LAS bf16x8*)(KP + (16 * st + c16) * 136 + 32 * ks + 8 * grp); acc = mfma16(kf, qf[ks], acc); }
                float p[4];
#pragma unroll
                for (int r = 0; r < 4; ++r) { const int s = 16 * st + 4 * grp + r; p[r] = (s <= t) ? acc[r] * expf(f_us[s] - Mt) : 0.f; rs += p[r]; }
                pp[st] = (u32x2){pk2(p[0], p[1]), pk2(p[2], p[3])};
            }
        }
        rs += __shfl_xor(rs, 16); rs += __shfl_xor(rs, 32);
        if (grp == 0) { const float den = rs + f_iw[t] * f_qn[t]; f_rd[t] = 1.f / fmaxf(fabsf(den), f_en[t]); }
    }
    __syncthreads();
#pragma unroll
    for (int st = 0; st < 8; ++st) *(LAS u32x2*)(KP + (16 * w + c16) * 136 + 16 * st + 4 * grp) = pp[st];
    __syncthreads();
    bf16x8 vf[2][4], cf[2][4];
    const bf16_t* cpt = (const bf16_t*)(ws + wsf::CPT) + (size_t)u * 256 * 128;
#pragma unroll
    for (int i = 0; i < 2; ++i)
#pragma unroll
        for (int ks = 0; ks < 4; ++ks) {
            vf[i][ks] = *(const LAS bf16x8*)(Vt + (16 * (2 * w + i) + c16) * 136 + 32 * ks + 8 * grp);
            cf[i][ks] = *(const bf16x8*)(cpt + (size_t)(16 * (2 * w + i) + c16) * 128 + 32 * ks + 8 * grp);
        }
    bf16_t* HMp = (bf16_t*)(ws + wsf::HM);
#pragma unroll 1
    for (int tt = 0; tt < 8; ++tt) {
        bf16x8 pf[4], qf[4];
#pragma unroll
        for (int ks = 0; ks < 4; ++ks) { pf[ks] = *(const LAS bf16x8*)(KP + (16 * tt + c16) * 136 + 32 * ks + 8 * grp);
            qf[ks] = *(const bf16x8*)(QCp + (tok0 + 16 * tt + c16) * 512 + h * 128 + 32 * ks + 8 * grp); }
        const int t = 16 * tt + c16; const float iw = f_iw[t], rd = f_rd[t];
        float ss = 0.f;
#pragma unroll
        for (int i = 0; i < 2; ++i) {
            f32x4 a1 = (f32x4){0.f, 0.f, 0.f, 0.f}, a2 = a1;
#pragma unroll
            for (int ks = 0; ks < 4; ++ks) { a1 = mfma16(vf[i][ks], pf[ks], a1); a2 = mfma16(cf[i][ks], qf[ks], a2); }
            const f32x4 hv = (a1 + a2 * iw) * rd;
            ss += (hv[0] * hv[0] + hv[1] * hv[1]) + (hv[2] * hv[2] + hv[3] * hv[3]);
            *(u32x2*)(HMp + (tok0 + t) * 1024 + h * 256 + 16 * (2 * w + i) + 4 * grp) = (u32x2){pk2(hv[0], hv[1]), pk2(hv[2], hv[3])};
        }
        ss += __shfl_xor(ss, 16); ss += __shfl_xor(ss, 32);
        if (grp == 0) f_ssq[t * 8 + w] = ss;
    }
    __syncthreads();
#pragma unroll 1
    for (int tt = 0; tt < 8; ++tt) {
        const int t = 16 * tt + c16;
        const f32x4 s0 = *(const LAS f32x4*)(f_ssq + t * 8), s1 = *(const LAS f32x4*)(f_ssq + t * 8 + 4);
        const float rn = rsqrtf(((s0.x + s0.y) + (s0.z + s0.w) + (s1.x + s1.y) + (s1.z + s1.w)) * (1.f / 256.f) + EPS);
#pragma unroll
        for (int i = 0; i < 2; ++i) {
            const int dv0 = 16 * (2 * w + i) + 4 * grp;
            const f32x4 g4 = *(const f32x4*)(a.g_mlstm + h * 256 + dv0);
            const u32x2 mo = *(const u32x2*)(PB + (tok0 + t) * fp::NIN + fp::PB_MO + h * 256 + dv0);
            u32x2* hp = (u32x2*)(HMp + (tok0 + t) * 1024 + h * 256 + dv0);
            const u32x2 hr = *hp;
            const float o0 = bflo(hr.x) * rn * g4.x * bflo(mo.x), o1 = bfhi(hr.x) * rn * g4.y * bfhi(mo.x);
            const float o2 = bflo(hr.y) * rn * g4.z * bflo(mo.y), o3 = bfhi(hr.y) * rn * g4.w * bfhi(mo.y);
            *hp = (u32x2){pk2(o0, o1), pk2(o2, o3)};
        }
    }
    __syncthreads();
}
__device__ __forceinline__ void phase5(const MkArgs& a, Frame& F) {
    const int f_tid = fresh_tid(F), f_lane = f_tid & 63, f_wave = F.wave;
    for (int u = F.bid; u < NB * MH * NC; u += F.G) m3_unit(a, F, u);
}
struct ProjUnit { int pm, pn, which; };
struct ProjSched {
    typedef ProjUnit UnitT;
    const bf16_t* A0; const bf16_t* A1; const bf16_t* B0; const bf16_t* B1; int K; int nM, nN, G, c, wave;
    __device__ __forceinline__ bool next(int i, ProjUnit& u) const { u.which = i & 1; return pg8::static_tile((i >> 1) * G + c, nM, nN, u.pm, u.pn); }
    __device__ __forceinline__ const void* a_buf() const { return A0; }
    __device__ __forceinline__ const void* b_buf() const { return B0; }
    __device__ __forceinline__ unsigned a_soff(const ProjUnit& u) const { return (unsigned)u.pm * 256u * (unsigned)K * 2u + (u.which ? (unsigned)((const char*)A1 - (const char*)A0) : 0u); }
    __device__ __forceinline__ unsigned b_soff(const ProjUnit& u) const { return (unsigned)u.pn * 256u * (unsigned)K * 2u + (u.which ? (unsigned)((const char*)B1 - (const char*)B0) : 0u); }
    __device__ __forceinline__ void a_offs(const ProjUnit&, int R0, int R1, int C0, int C1, unsigned (&o)[4]) const {
        o[0] = (unsigned)(R0 * K + C0) * 2u; o[1] = (unsigned)(R1 * K + C1) * 2u; o[2] = (unsigned)((R0 + 128) * K + C0) * 2u; o[3] = (unsigned)((R1 + 128) * K + C1) * 2u;
    }
};
struct EpiMerge {
    bf16_t* MG; const bf16_t* PB;
    __device__ __forceinline__ void operator()(const f32x4 (&acc)[2][2][4][2], const ProjUnit& u, int wr, int wc, int fr, int fq) const {
        const int row0 = u.pm * 256 + wr * 64 + fr, col0 = u.pn * 256 + wc * 32 + 8 * fq;
        const int gcol = (u.which ? fp::PB_GM : fp::PB_GA) + col0;
#pragma unroll
        for (int ai = 0; ai < 2; ++ai)
#pragma unroll
            for (int m = 0; m < 4; ++m) {
                const size_t row = (size_t)(row0 + ai * 128 + m * 16);
#pragma unroll
                for (int bj = 0; bj < 2; ++bj) {
                    const u32x4 gv = *(const u32x4*)(PB + row * fp::NIN + gcol + bj * 128);
                    float g[8]; unpack8(gv, g);
                    const f32x4 v0 = acc[ai][bj][m][0], v1 = acc[ai][bj][m][1];
                    float o[8] = {g[0] * v0[0], g[1] * v0[1], g[2] * v0[2], g[3] * v0[3], g[4] * v1[0], g[5] * v1[1], g[6] * v1[2], g[7] * v1[3]};
                    u32x4* dst = (u32x4*)(MG + row * 2048 + col0 + bj * 128);
                    if (u.which) { const u32x4 pv = *dst; float p[8]; unpack8(pv, p);
#pragma unroll
                        for (int e = 0; e < 8; ++e) o[e] += p[e]; }
                    *dst = (u32x4){pg8::cvt_pk_bf16(o[0], o[1]), pg8::cvt_pk_bf16(o[2], o[3]), pg8::cvt_pk_bf16(o[4], o[5]), pg8::cvt_pk_bf16(o[6], o[7])};
                }
            }
    }
};
__device__ __forceinline__ void phase6(const MkArgs& a, Frame& F) {
    const int f_tid = fresh_tid(F), f_lane = f_tid & 63, f_wave = F.wave;
    unsigned char* ws = a.ws;
    ProjSched S{(const bf16_t*)(ws + wsf::OAT), (const bf16_t*)(ws + wsf::HM), (const bf16_t*)(ws + wsf::WAP_T), (const bf16_t*)(ws + wsf::WMP_T), 1024, NTOK / 256, 2048 / 256, F.G, F.bid, F.wave};
    EpiMerge E{(bf16_t*)(ws + wsf::MG), (const bf16_t*)(ws + wsf::PROJB)};
    pg8::gemm_phase<EpiMerge, ProjSched>(F.lds, S, E);
}
struct EpiPlain {
    bf16_t* O; int ldc;
    __device__ __forceinline__ void operator()(const f32x4 (&acc)[2][2][4][2], const DenseUnit& u, int wr, int wc, int fr, int fq) const {
        const int row0 = u.pm * 256 + wr * 64 + fr, col0 = u.pn * 256 + wc * 32 + 8 * fq;
#pragma unroll
        for (int ai = 0; ai < 2; ++ai)
#pragma unroll
            for (int m = 0; m < 4; ++m)
#pragma unroll
                for (int bj = 0; bj < 2; ++bj) {
                    const f32x4 v0 = acc[ai][bj][m][0], v1 = acc[ai][bj][m][1];
                    *(u32x4*)(O + (size_t)(row0 + ai * 128 + m * 16) * ldc + col0 + bj * 128) =
                        (u32x4){pg8::cvt_pk_bf16(v0[0], v0[1]), pg8::cvt_pk_bf16(v0[2], v0[3]), pg8::cvt_pk_bf16(v1[0], v1[1]), pg8::cvt_pk_bf16(v1[2], v1[3])};
                }
    }
};
__device__ __forceinline__ void phase7(const MkArgs& a, Frame& F) {
    const int f_tid = fresh_tid(F), f_lane = f_tid & 63, f_wave = F.wave;
    unsigned char* ws = a.ws;
    DenseSched S{(const bf16_t*)(ws + wsf::MG), (const bf16_t*)(ws + wsf::WOUT_T), 2048, 2048, NTOK / 256, 2048 / 256, F.G, F.bid, F.wave};
    EpiPlain E{(bf16_t*)(ws + wsf::Y), 2048};
    pg8::gemm_phase<EpiPlain, DenseSched>(F.lds, S, E);
}

__device__ __forceinline__ void phase8(const MkArgs& a, Frame& F) {
    const int f_tid = fresh_tid(F), f_lane = f_tid & 63, f_wave = F.wave;
    unsigned char* ws = a.ws;
    LAS float* t_gt1 = (LAS float*)F.lds, *t_gpo = t_gt1 + 2048, *t_gpr = t_gt1 + 4096, *t_sc2 = t_gt1 + 6144, *t_sh2 = t_gt1 + 8192;
    LAS float* lgp = (LAS float*)(F.lds + 40960);
    LAS int* cntl = (LAS int*)(F.lds + 57344);
    LAS int* basel = cntl + 32;
    LAS int* esel = cntl + 64;
    LAS int* eslot = cntl + 320;
    const float* mod = (const float*)(ws + wsf::MOD);
    const bf16_t* Yp = (const bf16_t*)(ws + wsf::Y);
    bf16_t* H2p = (bf16_t*)(ws + wsf::H2);
    float* X1p = (float*)(ws + wsf::X1);
    const bf16_t* WR = (const bf16_t*)(ws + wsf::WRT);
    int* cntg = (int*)(ws + wsf::CTL) + wsf::CW_CNT;
    const int tid = f_tid, lane = f_lane, w = f_wave;
    for (int blk = F.vcu; blk < NTOK / 64; blk += F.G) {
        const int b = (blk * 64) / S;
        for (int i = tid; i < 2048; i += fp::NT) {
            t_gt1[i] = mod[b * MODW + MOD_GT1 + i]; t_gpo[i] = a.g_post_mix[i]; t_gpr[i] = a.g_pre_ffn[i];
            t_sc2[i] = mod[b * MODW + MOD_SC2 + i]; t_sh2[i] = mod[b * MODW + MOD_SH2 + i];
        }
        if (tid < 32) cntl[tid] = 0;
        __syncthreads();
#pragma unroll 1
        for (int rr = 0; rr < 8; ++rr) {
            const size_t row = (size_t)blk * 64 + w * 8 + rr;
            u32x4 yp[4]; float ss = 0.f;
#pragma unroll
            for (int j = 0; j < 4; ++j) { yp[j] = *(const u32x4*)(Yp + row * 2048 + 8 * (64 * j + lane)); float f[8]; unpack8(yp[j], f);
#pragma unroll
                for (int e = 0; e < 8; ++e) ss += f[e] * f[e]; }
            const float r1 = rsqrtf(wave_sum_f(ss) * (1.f / D) + EPS);
            ss = 0.f;
#pragma unroll
            for (int j = 0; j < 4; ++j) {
                const int c0 = 8 * (64 * j + lane);
                float f[8]; unpack8(yp[j], f);
                const f32x4 xa = *(const f32x4*)(a.x + row * D + c0), xb = *(const f32x4*)(a.x + row * D + c0 + 4);
                const float xv[8] = {xa.x, xa.y, xa.z, xa.w, xb.x, xb.y, xb.z, xb.w};
                float v[8];
#pragma unroll
                for (int e = 0; e < 8; ++e) { v[e] = xv[e] + t_gt1[c0 + e] * (f[e] * r1 * t_gpo[c0 + e]); ss += v[e] * v[e]; }
                *(f32x4*)(X1p + row * D + c0) = (f32x4){v[0], v[1], v[2], v[3]};
                *(f32x4*)(X1p + row * D + c0 + 4) = (f32x4){v[4], v[5], v[6], v[7]};
            }
            const float r2 = rsqrtf(wave_sum_f(ss) * (1.f / D) + EPS);
#pragma unroll
            for (int j = 0; j < 4; ++j) {
                const int c0 = 8 * (64 * j + lane);
                const f32x4 xa = *(const f32x4*)(X1p + row * D + c0), xb = *(const f32x4*)(X1p + row * D + c0 + 4);
                const float xv[8] = {xa.x, xa.y, xa.z, xa.w, xb.x, xb.y, xb.z, xb.w};
                float hv[8];
#pragma unroll
                for (int e = 0; e < 8; ++e) hv[e] = xv[e] * r2 * t_gpr[c0 + e] * (1.f + t_sc2[c0 + e]) + t_sh2[c0 + e];
                *(u32x4*)(H2p + row * 2048 + c0) = (u32x4){pk2(hv[0], hv[1]), pk2(hv[2], hv[3]), pk2(hv[4], hv[5]), pk2(hv[6], hv[7])};
#if MOE_FP8
                *(u32x2*)(ws + wsf::H2F8 + row * 2048 + c0) = (u32x2){pk4_fp8(hv[0], hv[1], hv[2], hv[3]), pk4_fp8(hv[4], hv[5], hv[6], hv[7])};
#endif
            }
        }
        VM_WAIT();
        __syncthreads();
        {
            const int c16 = lane & 15, grp = lane >> 4, rt = w & 3, kh = w >> 2;
            f32x4 acc[2] = {(f32x4){0.f, 0.f, 0.f, 0.f}, (f32x4){0.f, 0.f, 0.f, 0.f}};
            const bf16_t* ap = H2p + ((size_t)blk * 64 + 16 * rt + c16) * 2048 + 8 * grp;
#pragma unroll 4
            for (int ks = kh * 32; ks < kh * 32 + 32; ++ks) {
                const bf16x8 af = *(const bf16x8*)(ap + 32 * ks);
#pragma unroll
                for (int et = 0; et < 2; ++et) {
                    const bf16x8 bh = *(const bf16x8*)(WR + (size_t)(16 * et + c16) * 2048 + 32 * ks + 8 * grp);
                    const bf16x8 bl = *(const bf16x8*)(WR + (size_t)32 * 2048 + (size_t)(16 * et + c16) * 2048 + 32 * ks + 8 * grp);
                    acc[et] = mfma16(af, bh, acc[et]); acc[et] = mfma16(af, bl, acc[et]);
                }
            }
#pragma unroll
            for (int et = 0; et < 2; ++et)
#pragma unroll
                for (int r = 0; r < 4; ++r) lgp[kh * 2048 + (16 * rt + 4 * grp + r) * 32 + 16 * et + c16] = acc[et][r];
        }
        __syncthreads();
        if (tid < 64) {
            const size_t tok = (size_t)blk * 64 + tid;
            float lgv[32];
#pragma unroll
            for (int e = 0; e < 32; ++e) lgv[e] = lgp[tid * 32 + e] + lgp[2048 + tid * 32 + e] + a.b_router[e];
            int idx[4]; float val[4];
            unsigned used = 0u;
#pragma unroll
            for (int k = 0; k < 4; ++k) {
                float best = -INFINITY; int bi = 0;
#pragma unroll
                for (int e = 0; e < 32; ++e) { const bool c = !((used >> e) & 1u) && lgv[e] > best; best = c ? lgv[e] : best; bi = c ? e : bi; }
                used |= 1u << bi; idx[k] = bi; val[k] = best;
            }
            float ex[4], sum = 0.f;
#pragma unroll
            for (int k = 0; k < 4; ++k) { ex[k] = expf(val[k] - val[0]); sum += ex[k]; }
#pragma unroll
            for (int k = 0; k < 4; ++k) {
                ((int*)(ws + wsf::TOPI))[tok * 4 + k] = idx[k]; ((float*)(ws + wsf::TOPW))[tok * 4 + k] = ex[k] / sum;
                const int e = a.route_i ? a.route_i[tok * 4 + k] : idx[k];
                esel[tid * 4 + k] = e;
                eslot[tid * 4 + k] = __hip_atomic_fetch_add(cntl + e, 1, __ATOMIC_RELAXED, __HIP_MEMORY_SCOPE_WORKGROUP);
            }
        }
        __syncthreads();
        if (tid < 32) { const int n = cntl[tid]; basel[tid] = n > 0 ? __hip_atomic_fetch_add(cntg + tid, n, __ATOMIC_RELAXED, __HIP_MEMORY_SCOPE_AGENT) : 0; }
        __syncthreads();
        if (tid < 256) { const int e = esel[tid]; ((int*)(ws + wsf::LIST))[(size_t)e * NPAIR + basel[e] + eslot[tid]] = (blk * 64 + (tid >> 2)) * 4 + (tid & 3); }
        __syncthreads();
    }
}

struct MoeUnit { int e, m0, pn, rows; };
struct MoeSched {
    typedef MoeUnit UnitT;
    const bf16_t* A; int a_shift; const bf16_t* Wt; size_t wstride; int K; int nN;
    const int* list; const LAS int* tstart; const LAS int* cnt; int nM; int G, c, wave;
    __device__ __forceinline__ bool next(int i, MoeUnit& u) const {
        const int nwg = nM * nN, L = i * G + c; if (L >= nwg) return false;
        int wgid = L; { const int q = nwg / 8, r = nwg % 8, xcd = wgid % 8, off = wgid / 8; wgid = (xcd < r ? xcd * (q + 1) : r * (q + 1) + (xcd - r) * q) + off; }
        constexpr int WG = 4;
        const int nig = WG * nN, gid = wgid / nig, fm = gid * WG, gsz = (nM - fm) < WG ? (nM - fm) : WG;
        const int mt = fm + ((wgid % nig) % gsz); u.pn = (wgid % nig) / gsz;
        int e = 0;
        for (int k = 1; k < NE; ++k) e += (__builtin_amdgcn_readfirstlane(tstart[k]) <= mt) ? 1 : 0;
        u.e = e; u.m0 = (mt - __builtin_amdgcn_readfirstlane(tstart[e])) * 256; const int left = __builtin_amdgcn_readfirstlane(cnt[e]) - u.m0; u.rows = left < 256 ? left : 256;
        return true;
    }
    __device__ __forceinline__ const void* a_buf() const { return A; }
    __device__ __forceinline__ const void* b_buf() const { return Wt; }
    __device__ __forceinline__ unsigned a_soff(const MoeUnit&) const { return 0u; }
    __device__ __forceinline__ unsigned b_soff(const MoeUnit& u) const { return ((unsigned)u.e * (unsigned)wstride + (unsigned)u.pn * 256u * (unsigned)K) * 2u; }
    __device__ __forceinline__ unsigned rowoff(const MoeUnit& u, int r, int C) const {
        const int rc = r < u.rows ? r : u.rows - 1;
        const int id = list[(size_t)u.e * NPAIR + u.m0 + rc] >> a_shift;
        return ((unsigned)id * (unsigned)K + (unsigned)C) * 2u;
    }
    __device__ __forceinline__ void a_offs(const MoeUnit& u, int R0, int R1, int C0, int C1, unsigned (&o)[4]) const {
        o[0] = rowoff(u, R0, C0); o[1] = rowoff(u, R1, C1); o[2] = rowoff(u, R0 + 128, C0); o[3] = rowoff(u, R1 + 128, C1);
    }
};
__device__ __forceinline__ void moe_tables(const MkArgs& a, Frame& F, LAS int*& cnt, LAS int*& tstart) {
    const int f_tid = fresh_tid(F);
    cnt = (LAS int*)(F.lds + LDS_TAB); tstart = cnt + 32;
    const int* cntg = (const int*)(a.ws + wsf::CTL) + wsf::CW_CNT;
    if (f_tid < 32) cnt[f_tid] = __hip_atomic_load(cntg + f_tid, RLX_AGENT);
    __syncthreads();
    if (f_tid == 0) { int s = 0; for (int e = 0; e < NE; ++e) { tstart[e] = s; s += (cnt[e] + 255) >> 8; } tstart[NE] = s; }
    __syncthreads();
}
template <bool F8> struct EpiGateUpT {
    bf16_t* ACT; const float* bias; const int* list;
    __device__ __forceinline__ void operator()(const f32x4 (&acc)[2][2][4][2], const MoeUnit& u, int wr, int wc, int fr, int fq) const {
        const int col0 = u.pn * 256 + wc * 32 + 8 * fq;
        f32x4 bv[2][2];
#pragma unroll
        for (int bj = 0; bj < 2; ++bj)
#pragma unroll
            for (int n = 0; n < 2; ++n) bv[bj][n] = *(const f32x4*)(bias + (size_t)u.e * 4096 + col0 + bj * 128 + 4 * n);
#pragma unroll
        for (int ai = 0; ai < 2; ++ai)
#pragma unroll
            for (int m = 0; m < 4; ++m) {
                const int r = ai * 128 + wr * 64 + m * 16 + fr;
                if (r < u.rows) {
                    const int pair = list[(size_t)u.e * NPAIR + u.m0 + r];
#pragma unroll
                    for (int bj = 0; bj < 2; ++bj) {
                        const f32x4 v0 = acc[ai][bj][m][0] * (F8 ? W8INV : 1.f) + bv[bj][0], v1 = acc[ai][bj][m][1] * (F8 ? W8INV : 1.f) + bv[bj][1];
                        const float gu[8] = {v0[0], v0[1], v0[2], v0[3], v1[0], v1[1], v1[2], v1[3]};
                        float o[4];
#pragma unroll
                        for (int j = 0; j < 4; ++j) {
                            const float glu = fminf(gu[2 * j], 7.0f), lin = fminf(fmaxf(gu[2 * j + 1], -7.0f), 7.0f);
                            o[j] = glu * fast_sigmoid(1.702f * glu) * (lin + 1.f);
                        }
                        if constexpr (F8) *(unsigned*)((unsigned char*)ACT + (size_t)pair * 2048 + (col0 + bj * 128) / 2) = pk4_fp8(o[0], o[1], o[2], o[3]);
                        else *(u32x2*)(ACT + (size_t)pair * 2048 + (col0 + bj * 128) / 2) = (u32x2){pg8::cvt_pk_bf16(o[0], o[1]), pg8::cvt_pk_bf16(o[2], o[3])};
                    }
                }
            }
    }
};
template <bool F8> struct EpiDownT {
    bf16_t* YP; const float* bias; const int* list; const float* wgt;
    __device__ __forceinline__ void operator()(const f32x4 (&acc)[2][2][4][2], const MoeUnit& u, int wr, int wc, int fr, int fq) const {
        const int col0 = u.pn * 256 + wc * 32 + 8 * fq;
        f32x4 bv[2][2];
#pragma unroll
        for (int bj = 0; bj < 2; ++bj)
#pragma unroll
            for (int n = 0; n < 2; ++n) bv[bj][n] = *(const f32x4*)(bias + (size_t)u.e * 2048 + col0 + bj * 128 + 4 * n);
#pragma unroll
        for (int ai = 0; ai < 2; ++ai)
#pragma unroll
            for (int m = 0; m < 4; ++m) {
                const int r = ai * 128 + wr * 64 + m * 16 + fr;
                if (r < u.rows) {
                    const int pair = list[(size_t)u.e * NPAIR + u.m0 + r];
                    const float wv = wgt[pair];
#pragma unroll
                    for (int bj = 0; bj < 2; ++bj) {
                        const f32x4 v0 = (acc[ai][bj][m][0] * (F8 ? W8INV : 1.f) + bv[bj][0]) * wv, v1 = (acc[ai][bj][m][1] * (F8 ? W8INV : 1.f) + bv[bj][1]) * wv;
                        *(u32x4*)(YP + (size_t)pair * 2048 + col0 + bj * 128) =
                            (u32x4){pg8::cvt_pk_bf16(v0[0], v0[1]), pg8::cvt_pk_bf16(v0[2], v0[3]), pg8::cvt_pk_bf16(v1[0], v1[1]), pg8::cvt_pk_bf16(v1[2], v1[3])};
                    }
                }
            }
    }
};
__device__ __forceinline__ void phase9(const MkArgs& a, Frame& F) {
    unsigned char* ws = a.ws;
    LAS int* cnt; LAS int* tstart; moe_tables(a, F, cnt, tstart);
#if MOE_FP8
    MoeSched S{(const bf16_t*)(ws + wsf::H2F8), 2, (const bf16_t*)(ws + wsf::WGU8), (size_t)4096 * 1024, 1024, 16, (const int*)(ws + wsf::LIST), tstart, cnt, __builtin_amdgcn_readfirstlane(tstart[NE]), F.G, F.bid, F.wave};
    EpiGateUpT<true> E{(bf16_t*)(ws + wsf::ACT8), a.b_gate_up, (const int*)(ws + wsf::LIST)};
    pg8::gemm_phase<EpiGateUpT<true>, MoeSched, true>(F.lds, S, E);
#else
    MoeSched S{(const bf16_t*)(ws + wsf::H2), 2, (const bf16_t*)(ws + wsf::WGU_T), (size_t)4096 * 2048, 2048, 16, (const int*)(ws + wsf::LIST), tstart, cnt, __builtin_amdgcn_readfirstlane(tstart[NE]), F.G, F.bid, F.wave};
    EpiGateUpT<false> E{(bf16_t*)(ws + wsf::ACT), a.b_gate_up, (const int*)(ws + wsf::LIST)};
    pg8::gemm_phase<EpiGateUpT<false>, MoeSched, false>(F.lds, S, E);
#endif
}
__device__ __forceinline__ void phase10(const MkArgs& a, Frame& F) {
    unsigned char* ws = a.ws;
    LAS int* cnt; LAS int* tstart; moe_tables(a, F, cnt, tstart);
    const float* wgt = a.route_w ? a.route_w : (const float*)(ws + wsf::TOPW);
#if MOE_FP8
    MoeSched S{(const bf16_t*)(ws + wsf::ACT8), 0, (const bf16_t*)(ws + wsf::WDN8), (size_t)2048 * 1024, 1024, 8, (const int*)(ws + wsf::LIST), tstart, cnt, __builtin_amdgcn_readfirstlane(tstart[NE]), F.G, F.bid, F.wave};
    EpiDownT<true> E{(bf16_t*)(ws + wsf::YP), a.b_down, (const int*)(ws + wsf::LIST), wgt};
    pg8::gemm_phase<EpiDownT<true>, MoeSched, true>(F.lds, S, E);
#else
    MoeSched S{(const bf16_t*)(ws + wsf::ACT), 0, (const bf16_t*)(ws + wsf::WDN_T), (size_t)2048 * 2048, 2048, 8, (const int*)(ws + wsf::LIST), tstart, cnt, __builtin_amdgcn_readfirstlane(tstart[NE]), F.G, F.bid, F.wave};
    EpiDownT<false> E{(bf16_t*)(ws + wsf::YP), a.b_down, (const int*)(ws + wsf::LIST), wgt};
    pg8::gemm_phase<EpiDownT<false>, MoeSched, false>(F.lds, S, E);
#endif
}

__device__ __forceinline__ void phase11(const MkArgs& a, Frame& F) {
    const int f_tid = fresh_tid(F), f_lane = f_tid & 63, f_wave = F.wave;
    unsigned char* ws = a.ws;
    const float* mod = (const float*)(ws + wsf::MOD);
    const bf16_t* YPp = (const bf16_t*)(ws + wsf::YP);
    const float* X1p = (const float*)(ws + wsf::X1);
    const int gw = F.vcu * fp::NW + f_wave, NGW = F.G * fp::NW, lane = f_lane;
    for (int m = gw; m < NTOK; m += NGW) {
        const int b = m / S;
        float yv[32];
#pragma unroll
        for (int i = 0; i < 32; ++i) yv[i] = 0.f;
#pragma unroll
        for (int k = 0; k < 4; ++k)
#pragma unroll
            for (int j = 0; j < 4; ++j) { const u32x4 v = *(const u32x4*)(YPp + ((size_t)m * 4 + k) * 2048 + 8 * (64 * j + lane)); float f[8]; unpack8(v, f);
#pragma unroll
                for (int e = 0; e < 8; ++e) yv[8 * j + e] += f[e]; }
        float ss = 0.f;
#pragma unroll
        for (int i = 0; i < 32; ++i) ss += yv[i] * yv[i];
        const float r = rsqrtf(wave_sum_f(ss) * (1.f / D) + EPS);
#pragma unroll
        for (int j = 0; j < 4; ++j) {
            const int c0 = 8 * (64 * j + lane);
#pragma unroll
            for (int hq = 0; hq < 2; ++hq) {
                const f32x4 xv = *(const f32x4*)(X1p + (size_t)m * D + c0 + 4 * hq);
                const f32x4 gt = *(const f32x4*)(mod + b * MODW + MOD_GT2 + c0 + 4 * hq), gp = *(const f32x4*)(a.g_post_ffn + c0 + 4 * hq);
                f32x4 o;
                o.x = xv.x + gt.x * (yv[8 * j + 4 * hq + 0] * r * gp.x); o.y = xv.y + gt.y * (yv[8 * j + 4 * hq + 1] * r * gp.y);
                o.z = xv.z + gt.z * (yv[8 * j + 4 * hq + 2] * r * gp.z); o.w = xv.w + gt.w * (yv[8 * j + 4 * hq + 3] * r * gp.w);
                *(f32x4*)(a.out + (size_t)m * D + c0 + 4 * hq) = o;
            }
        }
    }
}
constexpr int N_PHASES = 12;
__global__ void __launch_bounds__(fp::NT, 2) mk_fwd(MkArgs a) {
    extern __shared__ __attribute__((aligned(16))) unsigned char lds_raw[];
    Frame F;
    F.lds = (LAS unsigned char*)lds_raw;
    F.wave = __builtin_amdgcn_readfirstlane((int)threadIdx.x >> 6);
    F.G = gridDim.x; F.bid = blockIdx.x; F.vcu = (F.G % 8 == 0) ? (F.bid % 8) * (F.G / 8) + F.bid / 8 : F.bid;
    volatile LAS unsigned* misc = (volatile LAS unsigned*)(F.lds + LDS_MISC);
    if (F.wave == 0) misc[lane_id()] = 0u;
    __syncthreads();
    XcdBarrier bar = xcd_barrier_post((unsigned*)(a.ws + wsf::CTL) + wsf::CW_BAR, misc + 8, F.wave == 0 && lane_id() == 0);
    const int lo = a.ph_lo, hi = a.ph_hi;
#define IN(k) (lo <= (k) && (k) < hi)
#define SEAM(k) do { if (IN(k) && IN((k) + 1)) xcd_barrier(bar, F.wave == 0 && lane_id() == 0); } while (0)
    if (IN(0)) { phase0(a, F); } SEAM(0);
    if (IN(1)) { phase1(a, F); } SEAM(1);
    if (IN(2)) { phase2(a, F); } SEAM(2);
#if NPH > 3
    if (IN(3)) { phase3(a, F); } SEAM(3);
#endif
#if NPH > 4
    if (IN(4)) { phase4(a, F); } SEAM(4);
#endif
#if NPH > 5
    if (IN(5)) { phase5(a, F); } SEAM(5);
#endif
#if NPH > 6
    if (IN(6)) { phase6(a, F); } SEAM(6);
#endif
#if NPH > 7
    if (IN(7)) { phase7(a, F); } SEAM(7);
#endif
#if NPH > 8
    if (IN(8)) { phase8(a, F); } SEAM(8);
#endif
#if NPH > 9
    if (IN(9)) { phase9(a, F); } SEAM(9);
#endif
#if NPH > 10
    if (IN(10)) { phase10(a, F); } SEAM(10);
#endif
#if NPH > 11
    if (IN(11)) { phase11(a, F); }
#endif
#undef IN
#undef SEAM
}

static void fill_args(MkArgs& a, void* const* d_in, void* d_out, void* d_ws) {
    a.x = (const float*)d_in[0]; a.c = (const float*)d_in[1]; a.positions = (const int*)d_in[2]; a.w_ada = (const float*)d_in[3]; a.b_ada = (const float*)d_in[4];
    a.g_pre_mix = (const float*)d_in[5]; a.g_post_mix = (const float*)d_in[6]; a.g_pre_ffn = (const float*)d_in[7]; a.g_post_ffn = (const float*)d_in[8];
    a.w_in = (const float*)d_in[9]; a.b_in = (const float*)d_in[10]; a.conv_qk = (const float*)d_in[11]; a.sinks = (const float*)d_in[12]; a.g_mlstm = (const float*)d_in[13];
    a.w_attn_proj = (const float*)d_in[14]; a.w_mlstm_proj = (const float*)d_in[15]; a.w_out = (const float*)d_in[16]; a.w_router = (const float*)d_in[17]; a.b_router = (const float*)d_in[18];
    a.w_gate_up = (const float*)d_in[19]; a.b_gate_up = (const float*)d_in[20]; a.w_down = (const float*)d_in[21]; a.b_down = (const float*)d_in[22];
    a.out = (float*)d_out; a.ws = (unsigned char*)d_ws; a.route_i = nullptr; a.route_w = nullptr; a.ph_lo = 0; a.ph_hi = 0;
}
static int mk_setup() {
    static int grid = 0;
    if (grid == 0) {
        int dev = 0, cus = 0;
        if (hipGetDevice(&dev) != hipSuccess || hipDeviceGetAttribute(&cus, hipDeviceAttributeMultiprocessorCount, dev) != hipSuccess) { grid = -1; return grid; }
        if (hipFuncSetAttribute((const void*)mk_fwd, hipFuncAttributeMaxDynamicSharedMemorySize, LDS_BYTES) != hipSuccess) { grid = -1; return grid; }
        int per_cu = 0;
        if (hipOccupancyMaxActiveBlocksPerMultiprocessor(&per_cu, (const void*)mk_fwd, fp::NT, LDS_BYTES) != hipSuccess || per_cu < 1) { (void)hipGetLastError(); }
        grid = cus;
    }
    return grid;
}

extern "C" void kernel_launch(void* const* d_in, const int* in_sizes, int n_in, void* d_out, int out_size, void* d_ws, size_t ws_size, hipStream_t stream) {
    if (n_in != 23 || ws_size < wsf::END) return;
    const int grid = mk_setup();
    if (grid <= 0) return;
    if (hipMemsetAsync((unsigned char*)d_ws + wsf::CTL, 0, 65536, stream) != hipSuccess) return;
    MkArgs a{}; fill_args(a, d_in, d_out, d_ws);
    a.ph_lo = 0; a.ph_hi = N_PHASES;
    hipLaunchKernelGGL(mk_fwd, dim3(grid), dim3(fp::NT), LDS_BYTES, stream, a);
}
```

```cpp
#include <hip/hip_runtime.h>
#include <stdint.h>
#include <math.h>
#define NPH 12
#define MOE_FP8 1
#define REP_MASK 0
#define CONV_WGS 80
#define DRY_PROBE 0
namespace cfg {
constexpr int D = 2048, NB = 2, S = 8192, NTOK = NB * S;
constexpr int HQ = 16, HKV = 2, HD = 64, QW = 1024;
constexpr int MH = 4, MDV = 256, MDK = 128, MQKW = 512, MVW = 1024, CL = 128, NC = S / CL;
constexpr int NE = 32, TOPK = 4, DFF = 2048, NPAIR = NTOK * TOPK;
constexpr int INW = 8456;
constexpr int OFF_AQ = 0, OFF_AK = 1024, OFF_AV = 1152, OFF_MQ = 1280, OFF_MK = 1792, OFF_MV = 2304, OFF_MO = 3328,
              OFF_MI = 4352, OFF_MF = 4356, OFF_GA = 4360, OFF_GM = 6408;
constexpr float EPS = 1e-6f;
constexpr int MOD_SH1 = 0, MOD_SC1 = 2048, MOD_GT1 = 4096, MOD_SH2 = 6144, MOD_SC2 = 8192, MOD_GT2 = 10240, MODW = 12288;
}
using namespace cfg;
__device__ __forceinline__ float silu_f(float x) { return x / (1.f + expf(-x)); }
__device__ __forceinline__ float sigmoid_f(float x) { return 1.f / (1.f + expf(-x)); }
__device__ __forceinline__ void rope_cs(int pos, int i, float& c, float& s) {
    const float invf[8] = {1.0f, 0.1939227432012558f, 0.03760603070259094f, 0.007292664609849453f,
                           0.0014142135623842478f, 0.00027424818836152554f, 5.3182957344688475e-05f, 1.0313385246263351e-05f};
    float f = i == 0 ? invf[0] : i == 1 ? invf[1] : i == 2 ? invf[2] : i == 3 ? invf[3] : i == 4 ? invf[4] : i == 5 ? invf[5] : i == 6 ? invf[6] : invf[7];
    float ang = (float)pos * f;
    double t = (double)ang * 0.15915494309189535;
    t -= rint(t);
    float tf = (float)t;
    s = __builtin_amdgcn_sinf(tf);
    c = __builtin_amdgcn_cosf(tf);
}
__device__ __forceinline__ float softcap_f(float z) { return 15.f * tanhf(z / 15.f); }
__device__ __forceinline__ float logsigmoid_f(float z) { return fminf(z, 0.f) - log1pf(expf(-fabsf(z))); }
#define GAS __attribute__((address_space(1)))
#define LAS __attribute__((address_space(3)))
typedef unsigned short bf16_t;
typedef short bf16x8 __attribute__((ext_vector_type(8)));
typedef short bf16x4 __attribute__((ext_vector_type(4)));
typedef float f32x4 __attribute__((ext_vector_type(4)));
typedef float f32x2 __attribute__((ext_vector_type(2)));
typedef unsigned u32x4 __attribute__((ext_vector_type(4)));
typedef unsigned u32x2 __attribute__((ext_vector_type(2)));
#define RLX_AGENT __ATOMIC_RELAXED, __HIP_MEMORY_SCOPE_AGENT
#define LDS_WAIT() asm volatile("s_waitcnt lgkmcnt(0)" ::: "memory")
#define VM_WAIT() asm volatile("s_waitcnt vmcnt(0)" ::: "memory")

__device__ __forceinline__ unsigned f2bf(float f) { unsigned u = __builtin_bit_cast(unsigned, f); return (u + 0x7fffu + ((u >> 16) & 1u)) >> 16; }
__device__ __forceinline__ unsigned pk2(float lo, float hi) { return f2bf(lo) | (f2bf(hi) << 16); }
__device__ __forceinline__ float bf2f(unsigned short h) { return __builtin_bit_cast(float, (unsigned)h << 16); }
__device__ __forceinline__ float bflo(unsigned w) { return __builtin_bit_cast(float, w << 16); }
__device__ __forceinline__ float bfhi(unsigned w) { return __builtin_bit_cast(float, w & 0xffff0000u); }
__device__ __forceinline__ unsigned pk4_fp8(float a, float b, float c, float d) {
    a = fminf(fmaxf(a, -448.f), 448.f); b = fminf(fmaxf(b, -448.f), 448.f); c = fminf(fmaxf(c, -448.f), 448.f); d = fminf(fmaxf(d, -448.f), 448.f);
    int r = __builtin_amdgcn_cvt_pk_fp8_f32(a, b, 0, false); r = __builtin_amdgcn_cvt_pk_fp8_f32(c, d, r, true); return (unsigned)r;
}
constexpr float W8SCALE = 64.f, W8INV = 1.f / 64.f;
__device__ __forceinline__ float fast_sigmoid(float x) { return __builtin_amdgcn_rcpf(1.f + __builtin_amdgcn_exp2f(-1.4426950408889634f * x)); }

namespace fp {
constexpr int NW = 8, NT = NW * 64;
constexpr int NIN = 8448;
constexpr int PB_Q = 0, PB_K = 1024, PB_V = 1152, PB_MQ = 1280, PB_MK = 1792, PB_MV = 2304, PB_MO = 3328, PB_GA = 4352, PB_GM = 6400;
constexpr float QSCALE = 0.125f * 1.4426950408889634f;
constexpr float LOG2E = 1.4426950408889634f;
}

namespace wsf {
constexpr size_t AL(size_t x) { return (x + 255) & ~(size_t)255; }
constexpr size_t CTL = 0, CTL_BYTES = 1u << 20;
constexpr size_t MODP = CTL + CTL_BYTES;
constexpr size_t MOD = AL(MODP + (size_t)16 * 2 * MODW * 4);
constexpr size_t BINP = AL(MOD + (size_t)2 * MODW * 4);
constexpr size_t CS = AL(BINP + (size_t)fp::NIN * 4);
constexpr size_t WRT = AL(CS + (size_t)NTOK * 8 * 8);
constexpr size_t WIN_T = AL(WRT + (size_t)2 * 32 * 2048 * 2);
constexpr size_t WAP_T = AL(WIN_T + (size_t)fp::NIN * 2048 * 2);
constexpr size_t WMP_T = AL(WAP_T + (size_t)2048 * 1024 * 2);
constexpr size_t WOUT_T = AL(WMP_T + (size_t)2048 * 1024 * 2);
constexpr size_t WGU_T = AL(WOUT_T + (size_t)2048 * 2048 * 2);
#if MOE_FP8
constexpr size_t WDN_T = WGU_T;
constexpr size_t GATES = WGU_T;
#else
constexpr size_t WDN_T = AL(WGU_T + (size_t)32 * 4096 * 2048 * 2);
constexpr size_t GATES = AL(WDN_T + (size_t)32 * 2048 * 2048 * 2);
#endif
constexpr size_t BCUM = AL(GATES + (size_t)NTOK * 8 * 4);
constexpr size_t LOGI = AL(BCUM + (size_t)8 * S * 4);
constexpr size_t GSUM = AL(LOGI + (size_t)8 * S * 4);
constexpr size_t MLOC = AL(GSUM + 512 * 4);
constexpr size_t MPREV = AL(MLOC + 512 * 4);
constexpr size_t DN = AL(MPREV + 512 * 4);
constexpr size_t NPREV = AL(DN + (size_t)512 * 128 * 4);
constexpr size_t DCT = AL(NPREV + (size_t)512 * 128 * 4);
constexpr size_t Y = AL(DCT + (size_t)512 * 256 * 128 * 4);
constexpr size_t X1 = AL(Y + (size_t)NTOK * 2048 * 2);
constexpr size_t H2 = AL(X1 + (size_t)NTOK * 2048 * 4);
constexpr size_t TOPI = AL(H2 + (size_t)NTOK * 2048 * 2);
constexpr size_t TOPW = AL(TOPI + (size_t)NPAIR * 4);
constexpr size_t LIST = AL(TOPW + (size_t)NPAIR * 4);
constexpr size_t PROJB = AL(LIST + (size_t)NE * NPAIR * 4);
constexpr size_t ACT = PROJB;
constexpr size_t YPREG = AL(PROJB + (size_t)NTOK * fp::NIN * 2);
constexpr size_t H1 = YPREG;
constexpr size_t MG = AL(H1 + (size_t)NTOK * 2048 * 2);
constexpr size_t OAT = AL(MG + (size_t)NTOK * 2048 * 2);
constexpr size_t HM = AL(OAT + (size_t)NTOK * 1024 * 2);
constexpr size_t QC = AL(HM + (size_t)NTOK * 1024 * 2);
constexpr size_t KC = AL(QC + (size_t)NTOK * 512 * 2);
constexpr size_t CPT = AL(KC + (size_t)NTOK * 512 * 2);
constexpr size_t YP = YPREG;
constexpr size_t F8BASE = AL(CPT + (size_t)512 * 256 * 128 * 2) > AL(YP + (size_t)NPAIR * 2048 * 2) ? AL(CPT + (size_t)512 * 256 * 128 * 2) : AL(YP + (size_t)NPAIR * 2048 * 2);
constexpr size_t WGU8 = F8BASE;
constexpr size_t WDN8 = AL(WGU8 + (size_t)32 * 4096 * 2048);
constexpr size_t H2F8 = AL(WDN8 + (size_t)32 * 2048 * 2048);
constexpr size_t ACT8 = AL(H2F8 + (size_t)NTOK * 2048);
constexpr size_t END = AL(ACT8 + (size_t)NPAIR * 2048);
static_assert((size_t)NPAIR * 2048 * 2 <= (size_t)NTOK * fp::NIN * 2, "ACT fits over PROJB");
constexpr int CW_BAR = 4096;
constexpr int CW_CNT = 8192;
}

constexpr int RING_BYTES = 131072;
constexpr int LDS_TAB = RING_BYTES;
constexpr int LDS_MISC = RING_BYTES + 8192;
constexpr int LDS_BYTES = 147456;

#define XB_TMO      128
#define XB_XCNT(j)  (256  + 64 * (j))
#define XB_XSUB(j)  (1280 + 64 * (j))
#define XB_XGEN(j)  (2304 + 64 * (j))
#define XB_TOP      3328
#define XB_TOPGEN   3392
#define XCD_BAR_WORDS 3456
#define XB_SPIN_CAP (1u << 18)
__device__ __forceinline__ unsigned xb_ld(unsigned* p)              { return __hip_atomic_load(p, __ATOMIC_RELAXED, __HIP_MEMORY_SCOPE_AGENT); }
__device__ __forceinline__ unsigned xb_add(unsigned* p, unsigned v) { return __hip_atomic_fetch_add(p, v, __ATOMIC_RELAXED, __HIP_MEMORY_SCOPE_AGENT); }
__device__ __forceinline__ unsigned xb_xcc_id() { return (unsigned)__builtin_amdgcn_s_getreg((3 << 11) | 20) & 0xFu; }
#define XB_SPIN(cond, bar) do { unsigned _sp = 0; while (cond) { __builtin_amdgcn_s_sleep(1); \
    if ((++_sp & 255u) == 0u) { if (xb_ld(&(bar)[XB_TMO])) break; if (_sp > XB_SPIN_CAP) { atomicAdd(&(bar)[XB_TMO], 1u); break; } } } } while (0)
struct XcdBarrier { unsigned* bar; unsigned x; volatile LAS unsigned* st; };
__device__ __forceinline__ XcdBarrier xcd_barrier_post(unsigned* bar, volatile LAS unsigned* st, bool t0) {
    XcdBarrier b; b.bar = bar; b.x = xb_xcc_id(); b.st = st;
    if (t0) (void)xb_add(&bar[XB_XCNT(b.x)], 1u);
    return b;
}
__device__ __forceinline__ void xcd_barrier_complete(unsigned* bar, unsigned x, unsigned& nloc, unsigned& nx) {
    const unsigned G = gridDim.x * gridDim.y * gridDim.z;
    unsigned sum, cnt, mine, sp = 0u;
    for (;;) {
        sum = 0u; cnt = 0u; mine = 0u;
#pragma unroll
        for (unsigned j = 0; j < 16; ++j) { const unsigned c = xb_ld(&bar[XB_XCNT(j)]); sum += c; cnt += (c > 0u) ? 1u : 0u; mine = (j == x) ? c : mine; }
        if (sum == G) break;
        __builtin_amdgcn_s_sleep(1);
        if ((++sp & 255u) == 0u) { if (xb_ld(&bar[XB_TMO])) break; if (sp > XB_SPIN_CAP) { atomicAdd(&bar[XB_TMO], 1u); break; } }
    }
    nloc = mine > 0u ? mine : 1u; nx = cnt > 0u ? cnt : 1u;
}
__device__ __forceinline__ void xcd_barrier(const XcdBarrier& b, bool t0) {
    asm volatile("s_waitcnt vmcnt(0)" ::: "memory");
    __syncthreads();
    if (t0) {
        unsigned* bar = b.bar;
        __builtin_amdgcn_s_waitcnt(0);
        unsigned nloc = b.st[0], nx = b.st[1];
        if (nloc == 0u) { xcd_barrier_complete(bar, b.x, nloc, nx); b.st[0] = nloc; b.st[1] = nx; }
        const unsigned old = xb_add(&bar[XB_XSUB(b.x)], 1u);
        const unsigned gen = old / nloc;
        if (old + 1u == (gen + 1u) * nloc) {
            __builtin_amdgcn_fence(__ATOMIC_RELEASE, "agent");
            asm volatile("s_waitcnt vmcnt(0)" ::: "memory");
            const unsigned og = xb_add(&bar[XB_TOP], 1u);
            const unsigned tg = og / nx;
            if (og + 1u == (tg + 1u) * nx) xb_add(&bar[XB_TOPGEN], 1u);
            else XB_SPIN(xb_ld(&bar[XB_TOPGEN]) == tg, bar);
            __builtin_amdgcn_fence(__ATOMIC_ACQUIRE, "agent");
            xb_add(&bar[XB_XGEN(b.x)], 1u);
            asm volatile("s_waitcnt vmcnt(0)" ::: "memory");
        } else {
            XB_SPIN(xb_ld(&bar[XB_XGEN(b.x)]) == gen, bar);
            __builtin_amdgcn_fence(__ATOMIC_ACQUIRE, "agent");
            asm volatile("s_waitcnt vmcnt(0)" ::: "memory");
        }
    }
    __syncthreads();
}

namespace pg8 {
constexpr int BM = 256, BK = 64, HALF = 128, HTB = HALF * BK * 2, STAGE_BYTES = 8 * HTB, NXCD = 8, WGM = 8;
__host__ __device__ __forceinline__ int lds_byte(int r, int c) { const int st = (r >> 4) * 2 + (c >> 5), rr = r & 15, cc = c & 31, ob = rr * 64 + cc * 2; return st * 1024 + (ob ^ (((ob >> 9) & 1) << 5)); }
__host__ __device__ __forceinline__ void stage_rc(int b, int& R, int& C) { const int st = b / 1024, sb = b % 1024, swz = sb ^ (((sb >> 9) & 1) << 5); R = (st >> 1) * 16 + swz / 64; C = (st & 1) * 32 + (swz % 64) / 2; }
__host__ __device__ __forceinline__ int perm32(int rho) { const int n = rho >> 4, i = rho & 15; return 8 * (i >> 2) + 4 * n + (i & 3); }
typedef int v8i32_t __attribute__((ext_vector_type(8)));
template <bool F8> struct FragSel { typedef bf16x8 T; };
typedef short s16x16_t __attribute__((ext_vector_type(16)));
template <> struct FragSel<true> { typedef s16x16_t T; };
template <bool F8> __device__ __forceinline__ typename FragSel<F8>::T ld_frag(const LAS unsigned char* p) {
    if constexpr (F8) { const bf16x8 lo = *(const LAS bf16x8*)p, hi = *(const LAS bf16x8*)(p + 16); return __builtin_shufflevector(lo, hi, 0, 1, 2, 3, 4, 5, 6, 7, 8, 9, 10, 11, 12, 13, 14, 15); }
    else return *(const LAS bf16x8*)p;
}
__device__ __forceinline__ f32x4 mma_frag(bf16x8 a, bf16x8 b, f32x4 c) { return __builtin_amdgcn_mfma_f32_16x16x32_bf16(a, b, c, 0, 0, 0); }
__device__ __forceinline__ f32x4 mma_frag(s16x16_t a, s16x16_t b, f32x4 c) {
    const v8i32_t av = __builtin_bit_cast(v8i32_t, a), bv = __builtin_bit_cast(v8i32_t, b);
    asm volatile("v_mfma_scale_f32_16x16x128_f8f6f4 %0, %1, %2, %0, %3, %3 op_sel_hi:[0,0,0]" : "+v"(c) : "v"(av), "v"(bv), "v"(0x7f7f7f7f));
    return c;
}
__device__ __forceinline__ unsigned cvt_pk_bf16(float lo, float hi) { unsigned r; asm volatile("v_cvt_pk_bf16_f32 %0, %1, %2" : "=v"(r) : "v"(lo), "v"(hi)); return r; }

__device__ __forceinline__ bool static_tile(int L, int nM, int nN, int& pm, int& pn) {
    const int nwg = nM * nN; if (L >= nwg) return false;
    int wgid = L; { const int q = nwg / NXCD, r = nwg % NXCD, xcd = wgid % NXCD, off = wgid / NXCD; wgid = (xcd < r ? xcd * (q + 1) : r * (q + 1) + (xcd - r) * q) + off; }
    const int nig = WGM * nN, gid = wgid / nig, fm = gid * WGM, gsz = (nM - fm) < WGM ? (nM - fm) : WGM;
    pm = fm + ((wgid % nig) % gsz); pn = (wgid % nig) / gsz; return true;
}

typedef int v8i32 __attribute__((ext_vector_type(8)));
template <class Epi, class Sched, bool FP8 = false>
__device__ __forceinline__ void gemm_phase(LAS unsigned char* lds, const Sched& S, const Epi& E) {
    typedef typename Sched::UnitT Unit;
    const int wid = S.wave, lane = (int)__builtin_amdgcn_mbcnt_hi(~0u, __builtin_amdgcn_mbcnt_lo(~0u, 0u)), tid = (wid << 6) | lane, wr = wid >> 2, wc = wid & 3, fr = lane & 15, fq = lane >> 4;
    const int K = S.K, nt = K / BK;
    int R[2], C[2];
    unsigned voffB[2];
#pragma unroll
    for (int i = 0; i < 2; ++i) { stage_rc(tid * 16 + i * 8192, R[i], C[i]); const int Rb = (R[i] & ~31) + perm32(R[i] & 31); voffB[i] = (unsigned)(Rb * K + C[i]) * 2u; }
    const unsigned kstep = (unsigned)(BK * 2);
    const unsigned hstepB = (unsigned)HALF * (unsigned)K * 2u;
    const unsigned ldsw = (unsigned)wid * 1024u;
    const int aoff = lds_byte(wr * 64 + fr, FP8 ? fq * 16 : fq * 8), boff = lds_byte(wc * 32 + fr, FP8 ? fq * 16 : fq * 8);
#define PG8_SA(b, h) (((b) * 2 + (h)) * HTB)
#define PG8_SB(b, h) ((4 + (b) * 2 + (h)) * HTB)
    const __amdgpu_buffer_rsrc_t rA = __builtin_amdgcn_make_buffer_rsrc((void*)S.a_buf(), 0, -1, 0x00020000), rB = __builtin_amdgcn_make_buffer_rsrc((void*)S.b_buf(), 0, -1, 0x00020000);
#define PG8_STAGE2(bufoff, rs, soff, o0, o1) do { \
        __builtin_amdgcn_raw_ptr_buffer_load_lds(rs, (LAS void*)(lds + (bufoff) + ldsw), 16, (int)(o0), (int)(soff), 0, 0); \
        __builtin_amdgcn_raw_ptr_buffer_load_lds(rs, (LAS void*)(lds + (bufoff) + ldsw + 8192), 16, (int)(o1), (int)(soff), 0, 0); } while (0)
#define PG8_STAGEA(bufoff, soff, o0, o1) PG8_STAGE2(bufoff, rA, soff, o0, o1)
#define PG8_STAGEB(bufoff, soff) PG8_STAGE2(bufoff, rB, soff, voffB[0], voffB[1])
    typedef typename pg8::FragSel<FP8>::T FragT;
    constexpr int NK = FP8 ? 1 : 2;
#define PG8_LDA(dst, b, h) do { _Pragma("unroll") for (int m = 0; m < 4; ++m) _Pragma("unroll") for (int k = 0; k < NK; ++k) dst[m][k] = pg8::ld_frag<FP8>(lds + PG8_SA(b, h) + aoff + m * 2048 + k * 1024); } while (0)
#define PG8_LDB(dst, b, h) do { _Pragma("unroll") for (int n = 0; n < 2; ++n) _Pragma("unroll") for (int k = 0; k < NK; ++k) dst[n][k] = pg8::ld_frag<FP8>(lds + PG8_SB(b, h) + boff + n * 2048 + k * 1024); } while (0)
#define PG8_MMA(ai, bj, At, Bt) do { __builtin_amdgcn_s_setprio(1); if constexpr (FP8) asm volatile("s_nop 1"); _Pragma("unroll") for (int m = 0; m < 4; ++m) _Pragma("unroll") for (int n = 0; n < 2; ++n) _Pragma("unroll") for (int k = 0; k < NK; ++k) \
        acc[ai][bj][m][n] = pg8::mma_frag(Bt[n][k], At[m][k], acc[ai][bj][m][n]); __builtin_amdgcn_s_setprio(0); } while (0)
#define PG8_WAIT_V(n) asm volatile("s_waitcnt vmcnt(" #n ")" ::: "memory")
#define PG8_WAIT_L(n) asm volatile("s_waitcnt lgkmcnt(" #n ")" ::: "memory")
#define PG8_BAR __builtin_amdgcn_s_barrier()
#define PG8_SCHED __builtin_amdgcn_sched_barrier(0)
    Unit cur, nxt; int ui = 0;
    if (!S.next(0, cur)) return;
    f32x4 acc[2][2][4][2];
#pragma unroll
    for (int a = 0; a < 2; ++a)
#pragma unroll
        for (int b = 0; b < 2; ++b)
#pragma unroll
            for (int m = 0; m < 4; ++m)
#pragma unroll
                for (int n = 0; n < 2; ++n) { float z0, z1, z2, z3; asm volatile("v_mov_b32 %0, 0\n\tv_mov_b32 %1, 0\n\tv_mov_b32 %2, 0\n\tv_mov_b32 %3, 0" : "=v"(z0), "=v"(z1), "=v"(z2), "=v"(z3)); acc[a][b][m][n] = (f32x4){z0, z1, z2, z3}; }
    FragT At[4][NK], B0[2][NK], B1[2][NK];
    unsigned ca[4], na[4];
    S.a_offs(cur, R[0], R[1], C[0], C[1], ca);
    unsigned cA = (unsigned)__builtin_amdgcn_readfirstlane((int)S.a_soff(cur)), cB = (unsigned)__builtin_amdgcn_readfirstlane((int)S.b_soff(cur));
    PG8_STAGEB(PG8_SB(0, 0), cB); PG8_STAGEB(PG8_SB(0, 1), cB + hstepB); PG8_STAGEA(PG8_SA(0, 0), cA, ca[0], ca[1]); PG8_STAGEA(PG8_SA(0, 1), cA, ca[2], ca[3]);
    if (wr == 1) PG8_BAR;
    PG8_WAIT_V(2); PG8_BAR;
    PG8_STAGEB(PG8_SB(1, 0), cB + kstep); PG8_STAGEA(PG8_SA(1, 0), cA + kstep, ca[0], ca[1]); PG8_STAGEB(PG8_SB(1, 1), cB + hstepB + kstep);
    PG8_WAIT_V(6); PG8_BAR;
#define PG8_TRIP(a1, a2, b2, a3, b3, x0, x1, x2, x3) do { \
            PG8_LDB(B0, 0, 0); PG8_LDB(B1, 0, 1); PG8_SCHED; PG8_LDA(At, 0, 0); PG8_STAGEA(PG8_SA(1, 1), a1, ca[2], ca[3]); \
            PG8_WAIT_V(8); PG8_WAIT_L(0); PG8_BAR; PG8_MMA(0, 0, At, B0); PG8_MMA(0, 1, At, B1); PG8_BAR; PG8_SCHED; \
            PG8_LDA(At, 0, 1); PG8_STAGEB(PG8_SB(0, 0), b2); PG8_STAGEB(PG8_SB(0, 1), (b2) + hstepB); PG8_STAGEA(PG8_SA(0, 0), a2, x0, x1); \
            PG8_WAIT_V(8); PG8_WAIT_L(0); PG8_BAR; PG8_MMA(1, 0, At, B0); PG8_MMA(1, 1, At, B1); PG8_BAR; PG8_SCHED; \
            PG8_LDB(B0, 1, 0); PG8_LDB(B1, 1, 1); PG8_SCHED; PG8_LDA(At, 1, 0); PG8_STAGEA(PG8_SA(0, 1), a2, x2, x3); \
            PG8_WAIT_V(8); PG8_WAIT_L(0); PG8_BAR; PG8_MMA(0, 0, At, B0); PG8_MMA(0, 1, At, B1); PG8_BAR; PG8_SCHED; \
            PG8_LDA(At, 1, 1); PG8_STAGEB(PG8_SB(1, 0), b3); PG8_STAGEB(PG8_SB(1, 1), (b3) + hstepB); PG8_STAGEA(PG8_SA(1, 0), a3, x0, x1); \
            PG8_WAIT_V(8); PG8_WAIT_L(0); PG8_BAR; PG8_MMA(1, 0, At, B0); PG8_MMA(1, 1, At, B1); PG8_BAR; PG8_SCHED; } while (0)
    for (;;) {
        const bool has_next = S.next(ui + 1, nxt);
        unsigned nA = cA, nB = cB;
#pragma unroll
        for (int i = 0; i < 4; ++i) na[i] = ca[i];
        if (has_next) { nA = (unsigned)__builtin_amdgcn_readfirstlane((int)S.a_soff(nxt)); nB = (unsigned)__builtin_amdgcn_readfirstlane((int)S.b_soff(nxt)); S.a_offs(nxt, R[0], R[1], C[0], C[1], na); }
        for (int t = 0; t < nt; t += 2) {
            const bool last = (t == nt - 2);
            const unsigned a1 = cA + (unsigned)(t + 1) * kstep;
            const unsigned a2 = last ? nA : cA + (unsigned)(t + 2) * kstep, b2 = last ? nB : cB + (unsigned)(t + 2) * kstep;
            const unsigned x0 = last ? na[0] : ca[0], x1 = last ? na[1] : ca[1], x2 = last ? na[2] : ca[2], x3 = last ? na[3] : ca[3];
            PG8_TRIP(a1, a2, b2, a2 + kstep, b2 + kstep, x0, x1, x2, x3);
        }
        if (wr == 0) PG8_BAR;
        if constexpr (FP8) asm volatile("s_nop 15\n\ts_nop 15" ::: "memory");
        E(acc, cur, wr, wc, fr, fq);
        if (!has_next) break;
#pragma unroll
        for (int a = 0; a < 2; ++a)
#pragma unroll
            for (int b = 0; b < 2; ++b)
#pragma unroll
                for (int m = 0; m < 4; ++m)
#pragma unroll
                    for (int n = 0; n < 2; ++n) { float z0, z1, z2, z3; asm volatile("v_mov_b32 %0, 0\n\tv_mov_b32 %1, 0\n\tv_mov_b32 %2, 0\n\tv_mov_b32 %3, 0" : "=v"(z0), "=v"(z1), "=v"(z2), "=v"(z3)); acc[a][b][m][n] = (f32x4){z0, z1, z2, z3}; }
        cur = nxt; cA = nA; cB = nB; ++ui;
#pragma unroll
        for (int i = 0; i < 4; ++i) ca[i] = na[i];
        if (wr == 1) PG8_BAR;
    }
    PG8_WAIT_V(0);
    PG8_BAR;
#undef PG8_SA
#undef PG8_SB
#undef PG8_TRIP
#undef PG8_STAGE2
#undef PG8_STAGEA
#undef PG8_STAGEB
#undef PG8_LDA
#undef PG8_LDB
#undef PG8_MMA
#undef PG8_WAIT_V
#undef PG8_WAIT_L
#undef PG8_BAR
#undef PG8_SCHED
}
}

struct DenseUnit { int pm, pn; };
struct DenseSched {
    typedef DenseUnit UnitT;
    const bf16_t* A; const bf16_t* Bt; int lda; int K; int nM, nN, G, c, wave;
    __device__ __forceinline__ bool next(int i, DenseUnit& u) const { return pg8::static_tile(i * G + c, nM, nN, u.pm, u.pn); }
    __device__ __forceinline__ const void* a_buf() const { return A; }
    __device__ __forceinline__ const void* b_buf() const { return Bt; }
    __device__ __forceinline__ unsigned a_soff(const DenseUnit& u) const { return (unsigned)u.pm * 256u * (unsigned)lda * 2u; }
    __device__ __forceinline__ unsigned b_soff(const DenseUnit& u) const { return (unsigned)u.pn * 256u * (unsigned)K * 2u; }
    __device__ __forceinline__ void a_offs(const DenseUnit&, int R0, int R1, int C0, int C1, unsigned (&o)[4]) const {
        o[0] = (unsigned)(R0 * lda + C0) * 2u; o[1] = (unsigned)(R1 * lda + C1) * 2u; o[2] = (unsigned)((R0 + 128) * lda + C0) * 2u; o[3] = (unsigned)((R1 + 128) * lda + C1) * 2u;
    }
};
struct MkArgs {
    const float* x; const float* c; const int* positions; const float* w_ada; const float* b_ada;
    const float* g_pre_mix; const float* g_post_mix; const float* g_pre_ffn; const float* g_post_ffn;
    const float* w_in; const float* b_in; const float* conv_qk; const float* sinks; const float* g_mlstm;
    const float* w_attn_proj; const float* w_mlstm_proj; const float* w_out; const float* w_router; const float* b_router;
    const float* w_gate_up; const float* b_gate_up; const float* w_down; const float* b_down;
    float* out; unsigned char* ws;
    const int* route_i; const float* route_w;
    int ph_lo, ph_hi;
};

struct Frame {
    LAS unsigned char* lds;
    int G, bid, vcu, wave;
};
__device__ __forceinline__ int lane_id() { return (int)__builtin_amdgcn_mbcnt_hi(~0u, __builtin_amdgcn_mbcnt_lo(~0u, 0u)); }
__device__ __forceinline__ int fresh_tid(const Frame& F) { return (F.wave << 6) | lane_id(); }

__device__ __forceinline__ float wave_sum_f(float v) {
#pragma unroll
    for (int o = 1; o < 64; o <<= 1) v += __shfl_xor(v, o);
    return v;
}
__device__ __forceinline__ float wave_max_f(float v) {
#pragma unroll
    for (int o = 1; o < 64; o <<= 1) v = fmaxf(v, __shfl_xor(v, o));
    return v;
}

__device__ __forceinline__ int in_src_col(int n) {
    if (n < 1152) { const int d = n & 63; if (d < 16) return (n & ~63) + (d >> 1) + 8 * (d & 1); return n; }
    if (n < 4352) return n;
    return n + 8;
}

template <bool MAP>
__device__ __forceinline__ void p0_transpose_item(const float* __restrict__ W, int K, int N, bf16_t* WT, LAS float* scr, int kb, int nb, int lane) {
    const int k0 = 64 * kb, n0 = 32 * nb;
    const int sc = MAP ? in_src_col(n0 + (lane & 31)) : n0 + (lane & 31);
#pragma unroll 8
    for (int i = 0; i < 32; ++i) { const int kk = 2 * i + (lane >> 5); scr[kk * 33 + (lane & 31)] = W[(size_t)(k0 + kk) * N + sc]; }
    LDS_WAIT(); asm volatile("" ::: "memory");
    const int c = lane & 7;
#pragma unroll
    for (int j = 0; j < 4; ++j) { const int n = (lane >> 3) + 8 * j; const LAS float* s = scr + (8 * c) * 33 + n;
        u32x4 o; o.x = pk2(s[0 * 33], s[1 * 33]); o.y = pk2(s[2 * 33], s[3 * 33]); o.z = pk2(s[4 * 33], s[5 * 33]); o.w = pk2(s[6 * 33], s[7 * 33]);
        *(u32x4*)(WT + (size_t)(n0 + n) * K + k0 + 8 * c) = o; }
    LDS_WAIT(); asm volatile("" ::: "memory");
}

struct ConvItem { const float* src; unsigned char* dst; };
__device__ __forceinline__ ConvItem conv_item_addr(const MkArgs& a, int it, int lane, int& N) {
    constexpr int KB = 2048 / 128, I_GU = KB * (4096 / 32), I_DN = KB * (2048 / 32);
    const float* W; unsigned char* WT; int q, NB;
    if (it < NE * I_GU) { const int e = it / I_GU; q = it % I_GU; N = 4096; NB = 128; W = a.w_gate_up + (size_t)e * 2048 * 4096; WT = a.ws + wsf::WGU8 + (size_t)e * 4096 * 2048; }
    else { const int r = it - NE * I_GU, e = r / I_DN; q = r % I_DN; N = 2048; NB = 64; W = a.w_down + (size_t)e * 2048 * 2048; WT = a.ws + wsf::WDN8 + (size_t)e * 2048 * 2048; }
    const int k0 = 128 * (q / NB), n0 = 32 * (q % NB);
    ConvItem c; c.src = W + (size_t)(k0 + (lane >> 3)) * N + n0 + (lane & 7) * 4; c.dst = WT + (size_t)(n0 + (lane >> 3)) * 2048 + k0 + 16 * (lane & 7);
    return c;
}
__device__ __forceinline__ void conv_item_load(const ConvItem& c, int N, f32x4 (&v)[16]) {
#pragma unroll
    for (int i = 0; i < 16; ++i) v[i] = __builtin_nontemporal_load((const f32x4*)(c.src + (size_t)(8 * i) * N));
}
__device__ __forceinline__ void conv_item_store(const ConvItem& c, const f32x4 (&v)[16], LAS float* scr, int lane, bool dry = false) {
    const int kr = lane >> 3, n4 = (lane & 7) * 4;
#pragma unroll
    for (int i = 0; i < 16; ++i) { const int k = 8 * i + kr, rot = 20 * (i >> 1); LAS float* row = scr + k * 33;
        row[(n4 + 0 + rot) & 31] = v[i].x; row[(n4 + 1 + rot) & 31] = v[i].y; row[(n4 + 2 + rot) & 31] = v[i].z; row[(n4 + 3 + rot) & 31] = v[i].w; }
    LDS_WAIT(); asm volatile("" ::: "memory");
    const int cblk = lane & 7;
#pragma unroll
    for (int j = 0; j < 4; ++j) {
        const int n = (lane >> 3) + 8 * j;
        const LAS float* sp = scr + (16 * cblk) * 33 + ((n + 20 * cblk) & 31);
        u32x4 o;
        o.x = pk4_fp8(sp[0 * 33] * W8SCALE, sp[1 * 33] * W8SCALE, sp[2 * 33] * W8SCALE, sp[3 * 33] * W8SCALE);
        o.y = pk4_fp8(sp[4 * 33] * W8SCALE, sp[5 * 33] * W8SCALE, sp[6 * 33] * W8SCALE, sp[7 * 33] * W8SCALE);
        o.z = pk4_fp8(sp[8 * 33] * W8SCALE, sp[9 * 33] * W8SCALE, sp[10 * 33] * W8SCALE, sp[11 * 33] * W8SCALE);
        o.w = pk4_fp8(sp[12 * 33] * W8SCALE, sp[13 * 33] * W8SCALE, sp[14 * 33] * W8SCALE, sp[15 * 33] * W8SCALE);
        if (!dry) *(u32x4*)(c.dst + (size_t)(8 * j) * 2048) = o; else asm volatile("" :: "v"(o.x), "v"(o.y), "v"(o.z), "v"(o.w));
    }
    LDS_WAIT(); asm volatile("" ::: "memory");
}
__device__ __forceinline__ void moe_convert(const MkArgs& a, Frame& F, int widx, int nw, bool dry = false) {
    const int lane = lane_id();
    LAS float* scr = (LAS float*)(F.lds + F.wave * 16896);
    constexpr int NIT = NE * ((2048 / 128) * (4096 / 32) + (2048 / 128) * (2048 / 32));
    if (widx >= NIT) return;
    f32x4 va[16], vb[16]; int Na, Nb;
    ConvItem ca = conv_item_addr(a, widx, lane, Na), cb;
    conv_item_load(ca, Na, va);
    for (int it = widx; it < NIT; it += 2 * nw) {
        const int i1 = it + nw, i2 = it + 2 * nw;
        cb = conv_item_addr(a, i1 < NIT ? i1 : NIT - 1, lane, Nb); conv_item_load(cb, Nb, vb);
        conv_item_store(ca, va, scr, lane, dry);
        if (i1 >= NIT) break;
        ca = conv_item_addr(a, i2 < NIT ? i2 : NIT - 1, lane, Na); conv_item_load(ca, Na, va);
        conv_item_store(cb, vb, scr, lane, dry);
    }
}
__device__ __forceinline__ int n_conv_wgs(int G) { return G == 256 ? CONV_WGS : 0; }

__device__ __forceinline__ void phase0(const MkArgs& a, Frame& F) {
    const int f_tid = fresh_tid(F), f_lane = f_tid & 63, f_wave = F.wave;
    unsigned char* ws = a.ws;
    LAS float* scr = (LAS float*)(F.lds + f_wave * 16384);
    const int gw = F.vcu * fp::NW + f_wave, NGW = F.G * fp::NW;
    constexpr int I_IN = 32 * (fp::NIN / 32), I_AP = 16 * 64, I_MP = 16 * 64, I_OUT = 32 * 64, I_GU = 32 * 128, I_DN = 32 * 64;
#if MOE_FP8
    constexpr int NITEMS = I_IN + I_AP + I_MP + I_OUT;
#else
    constexpr int NITEMS = I_IN + I_AP + I_MP + I_OUT + NE * I_GU + NE * I_DN;
#endif
    for (int it = gw; it < NITEMS; it += NGW) {
        int r = it;
        if (r < I_IN) { const int nblk = fp::NIN / 32; p0_transpose_item<true>(a.w_in, 2048, INW, (bf16_t*)(ws + wsf::WIN_T), scr, r / nblk, r % nblk, f_lane); continue; } r -= I_IN;
        if (r < I_AP) { p0_transpose_item<false>(a.w_attn_proj, 1024, 2048, (bf16_t*)(ws + wsf::WAP_T), scr, r / 64, r % 64, f_lane); continue; } r -= I_AP;
        if (r < I_MP) { p0_transpose_item<false>(a.w_mlstm_proj, 1024, 2048, (bf16_t*)(ws + wsf::WMP_T), scr, r / 64, r % 64, f_lane); continue; } r -= I_MP;
#if !MOE_FP8
        if (r < I_OUT) { p0_transpose_item<false>(a.w_out, 2048, 2048, (bf16_t*)(ws + wsf::WOUT_T), scr, r / 64, r % 64, f_lane); continue; } r -= I_OUT;
#endif
#if MOE_FP8
        p0_transpose_item<false>(a.w_out, 2048, 2048, (bf16_t*)(ws + wsf::WOUT_T), scr, r / 64, r % 64, f_lane);
#else
        if (r < NE * I_GU) { const int e = r / I_GU, q = r % I_GU; p0_transpose_item<false>(a.w_gate_up + (size_t)e * 2048 * 4096, 2048, 4096, (bf16_t*)(ws + wsf::WGU_T) + (size_t)e * 4096 * 2048, scr, q / 128, q % 128, f_lane); continue; } r -= NE * I_GU;
        { const int e = r / I_DN, q = r % I_DN; p0_transpose_item<false>(a.w_down + (size_t)e * 2048 * 2048, 2048, 2048, (bf16_t*)(ws + wsf::WDN_T) + (size_t)e * 2048 * 2048, scr, q / 64, q % 64, f_lane); }
#endif
    }
#if MOE_FP8
    __syncthreads();
    if (n_conv_wgs(F.G) == 0) moe_convert(a, F, gw, NGW);
#if DRY_PROBE
    moe_convert(a, F, gw, NGW, true);
#endif
#endif
    {
        float* part = (float*)(ws + wsf::MODP);
        for (int it = gw; it < (MODW / 64) * 16; it += NGW) {
            const int jb = it % (MODW / 64), ks = it / (MODW / 64), j = jb * 64 + f_lane, k0 = ks * 128;
            float a0 = 0.f, a1 = 0.f;
            for (int k = k0; k < k0 + 128; ++k) { const float w = a.w_ada[(size_t)k * MODW + j]; a0 += silu_f(a.c[k]) * w; a1 += silu_f(a.c[D + k]) * w; }
            part[(size_t)(ks * 2 + 0) * MODW + j] = a0; part[(size_t)(ks * 2 + 1) * MODW + j] = a1;
        }
    }
    const int gt = F.vcu * fp::NT + f_tid, NGT = F.G * fp::NT;
    for (int i = gt; i < NTOK * 8; i += NGT) { float cs, sn; rope_cs(a.positions[i >> 3], i & 7, cs, sn); ((f32x2*)(ws + wsf::CS))[i] = (f32x2){cs, sn}; }
    for (int i = gt; i < fp::NIN; i += NGT) ((float*)(ws + wsf::BINP))[i] = a.b_in[in_src_col(i)];
    for (int i = gt; i < 32 * 2048; i += NGT) {
        const int e = i >> 11, k = i & 2047; const float w = a.w_router[k * 32 + e]; const unsigned hi = f2bf(w); const float rem = w - __builtin_bit_cast(float, hi << 16);
        ((bf16_t*)(ws + wsf::WRT))[i] = (bf16_t)hi; ((bf16_t*)(ws + wsf::WRT))[32 * 2048 + i] = (bf16_t)f2bf(rem);
    }
}

__device__ __forceinline__ void phase1(const MkArgs& a, Frame& F) {
    const int f_tid = fresh_tid(F), f_lane = f_tid & 63, f_wave = F.wave;
    unsigned char* ws = a.ws;
    const float* part = (const float*)(ws + wsf::MODP);
    float* mod = (float*)(ws + wsf::MOD);
    { const int per = (2 * MODW) / F.G;
      for (int i = f_tid; i < per; i += fp::NT) { const int idx = F.vcu * per + i, b = idx / MODW, j = idx % MODW; float s = a.b_ada[j];
#pragma unroll
          for (int p = 0; p < 16; ++p) s += part[(size_t)(p * 2 + b) * MODW + j];
          mod[idx] = s; }
      if (F.vcu == 0) for (int idx = per * F.G + f_tid; idx < 2 * MODW; idx += fp::NT) { const int b = idx / MODW, j = idx % MODW; float s = a.b_ada[j];
          for (int p = 0; p < 16; ++p) s += part[(size_t)(p * 2 + b) * MODW + j];
          mod[idx] = s; } }
    LAS float* lmod = (LAS float*)F.lds;
    LAS float* wg = (LAS float*)(F.lds + 32768);
    for (int i = f_tid; i < 2 * 4096; i += fp::NT) { const int b = i >> 12, j = i & 4095; float s = a.b_ada[j];
#pragma unroll
        for (int p = 0; p < 16; ++p) s += part[(size_t)(p * 2 + b) * MODW + j];
        lmod[i] = s; }
    for (int i = f_tid; i < 2048 * 8; i += fp::NT) wg[i] = a.w_in[(size_t)(i >> 3) * INW + OFF_MI + (i & 7)];
    __syncthreads();
    const int gw = F.vcu * fp::NW + f_wave, NGW = F.G * fp::NW;
    for (int m = gw; m < NTOK; m += NGW) {
        const int b = m / S;
        const GAS f32x4* xr = (const GAS f32x4*)(a.x + (size_t)m * D);
        float ss = 0.f;
#pragma unroll
        for (int j = 0; j < 8; ++j) { const f32x4 v = xr[64 * j + f_lane]; ss += (v.x * v.x + v.y * v.y) + (v.z * v.z + v.w * v.w); }
        const float r = rsqrtf(wave_sum_f(ss) * (1.f / D) + EPS);
        float g8[8];
#pragma unroll
        for (int e = 0; e < 8; ++e) g8[e] = 0.f;
        GAS u32x2* o8 = (GAS u32x2*)(ws + wsf::H1 + (size_t)m * D * 2);
#pragma unroll 1
        for (int j = 0; j < 8; ++j) {
            const int c0 = 4 * (64 * j + f_lane);
            const f32x4 v = xr[64 * j + f_lane];
            const f32x4 g = *(const f32x4*)(a.g_pre_mix + c0);
            const f32x4 sh = *(const LAS f32x4*)(lmod + b * 4096 + c0), sc = *(const LAS f32x4*)(lmod + b * 4096 + 2048 + c0);
            f32x4 h;
            h.x = v.x * r * g.x * (1.f + sc.x) + sh.x; h.y = v.y * r * g.y * (1.f + sc.y) + sh.y;
            h.z = v.z * r * g.z * (1.f + sc.z) + sh.z; h.w = v.w * r * g.w * (1.f + sc.w) + sh.w;
            o8[64 * j + f_lane] = (u32x2){pk2(h.x, h.y), pk2(h.z, h.w)};
#pragma unroll
            for (int q = 0; q < 4; ++q) {
                const f32x4 w0 = *(const LAS f32x4*)(wg + (c0 + q) * 8), w1 = *(const LAS f32x4*)(wg + (c0 + q) * 8 + 4);
                const float hv = h[q];
                g8[0] += hv * w0.x; g8[1] += hv * w0.y; g8[2] += hv * w0.z; g8[3] += hv * w0.w;
                g8[4] += hv * w1.x; g8[5] += hv * w1.y; g8[6] += hv * w1.z; g8[7] += hv * w1.w;
            }
        }
        float mine = 0.f;
#pragma unroll
        for (int e = 0; e < 8; ++e) { const float s = wave_sum_f(g8[e]); if (f_lane == e) mine = s; }
        if (f_lane < 8) ((float*)(ws + wsf::GATES))[(size_t)m * 8 + f_lane] = mine + a.b_in[OFF_MI + f_lane];
    }
}

struct EpiIn {
    bf16_t* O; const float* bias; const f32x2* cs;
    __device__ __forceinline__ void operator()(const f32x4 (&acc)[2][2][4][2], const DenseUnit& u, int wr, int wc, int fr, int fq) const {
        const int row0 = u.pm * 256 + wr * 64 + fr, col0 = u.pn * 256 + wc * 32 + 8 * fq;
        const int pn = u.pn;
        const bool ropelane = ((wc & 1) == 0) && fq < 2;
        const int i0 = fq * 4;
        f32x4 bv[2][2];
#pragma unroll
        for (int bj = 0; bj < 2; ++bj)
#pragma unroll
            for (int n = 0; n < 2; ++n) bv[bj][n] = *(const f32x4*)(bias + col0 + bj * 128 + 4 * n);
#pragma unroll
        for (int ai = 0; ai < 2; ++ai)
#pragma unroll
            for (int m = 0; m < 4; ++m) {
                const int row = row0 + ai * 128 + m * 16;
                bf16_t* rowp = O + (size_t)row * fp::NIN + col0;
#pragma unroll
                for (int bj = 0; bj < 2; ++bj) {
                    f32x4 v0 = acc[ai][bj][m][0] + bv[bj][0], v1 = acc[ai][bj][m][1] + bv[bj][1];
                    if (pn < 4 || (pn == 4 && bj == 0)) {
                        if (ropelane) {
                            const f32x4 ca = *(const f32x4*)(cs + (size_t)row * 8 + i0), cb = *(const f32x4*)(cs + (size_t)row * 8 + i0 + 2);
                            f32x4 r0, r1;
                            r0.x = v0.x * ca.x - v0.y * ca.y; r0.y = v0.y * ca.x + v0.x * ca.y;
                            r0.z = v0.z * ca.z - v0.w * ca.w; r0.w = v0.w * ca.z + v0.z * ca.w;
                            r1.x = v1.x * cb.x - v1.y * cb.y; r1.y = v1.y * cb.x + v1.x * cb.y;
                            r1.z = v1.z * cb.z - v1.w * cb.w; r1.w = v1.w * cb.z + v1.z * cb.w;
                            v0 = r0; v1 = r1;
                        }
                        if (pn < 4) { v0 = v0 * fp::QSCALE; v1 = v1 * fp::QSCALE; }
                    } else if (pn >= 13) {
#pragma unroll
                        for (int q = 0; q < 4; ++q) { v0[q] = fast_sigmoid(v0[q]); v1[q] = fast_sigmoid(v1[q]); }
                    }
                    u32x4 w; w.x = pg8::cvt_pk_bf16(v0[0], v0[1]); w.y = pg8::cvt_pk_bf16(v0[2], v0[3]); w.z = pg8::cvt_pk_bf16(v1[0], v1[1]); w.w = pg8::cvt_pk_bf16(v1[2], v1[3]);
                    *(u32x4*)(rowp + bj * 128) = w;
                }
            }
    }
};

__device__ __forceinline__ void phase2(const MkArgs& a, Frame& F) {
    const int f_tid = fresh_tid(F), f_lane = f_tid & 63, f_wave = F.wave;
    unsigned char* ws = a.ws;
#if MOE_FP8
    const int ncv = n_conv_wgs(F.G), Gg = F.G - ncv;
    if (F.bid >= Gg) { moe_convert(a, F, (F.bid - Gg) * fp::NW + F.wave, ncv * fp::NW); return; }
#else
    const int Gg = F.G;
#endif
    DenseSched S{(const bf16_t*)(ws + wsf::H1), (const bf16_t*)(ws + wsf::WIN_T), 2048, 2048, NTOK / 256, fp::NIN / 256, Gg, F.bid, F.wave};
    EpiIn E{(bf16_t*)(ws + wsf::PROJB), (const float*)(ws + wsf::BINP), (const f32x2*)(ws + wsf::CS)};
    pg8::gemm_phase<EpiIn, DenseSched>(F.lds, S, E);
}
__device__ __forceinline__ f32x4 mfma16(bf16x8 a, bf16x8 b, f32x4 c) { return __builtin_amdgcn_mfma_f32_16x16x32_bf16(a, b, c, 0, 0, 0); }
__device__ __forceinline__ float exp2_fast(float x) { return __builtin_amdgcn_exp2f(x); }

__device__ __forceinline__ void attn_unit(const MkArgs& a, Frame& F, int unit) {
    const int f_tid = fresh_tid(F), f_lane = f_tid & 63, f_wave = F.wave;
    const int b = unit >> 7, hk = (unit >> 6) & 1, n = unit & 63;
    const bf16_t* PB = (const bf16_t*)(a.ws + wsf::PROJB);
    bf16_t* OA = (bf16_t*)(a.ws + wsf::OAT);
    const size_t tok0 = (size_t)b * S + (size_t)n * 128;
    LAS bf16_t* Ks = (LAS bf16_t*)F.lds;
    LAS bf16_t* Vt = (LAS bf16_t*)(F.lds + 36864);
    LAS bf16_t* Pw = (LAS bf16_t*)(F.lds + 36864 + 35840 + f_wave * 5376);
#pragma unroll
    for (int i = 0; i < 4; ++i) {
        const int q = f_tid + 512 * i, row = q >> 3, ch = q & 7;
        u32x4 kv = (u32x4){0u, 0u, 0u, 0u}, vv = kv;
        if (n > 0 || row >= 128) {
            const bf16_t* src = PB + (tok0 - 128 + row) * fp::NIN + hk * 64 + ch * 8;
            kv = *(const u32x4*)(src + fp::PB_K); vv = *(const u32x4*)(src + fp::PB_V);
        }
        *(LAS u32x4*)(Ks + row * 72 + ch * 8) = kv;
        LAS bf16_t* vd = Vt + (ch * 8) * 280 + row;
        vd[0 * 280] = (bf16_t)(vv.x & 0xffffu); vd[1 * 280] = (bf16_t)(vv.x >> 16); vd[2 * 280] = (bf16_t)(vv.y & 0xffffu); vd[3 * 280] = (bf16_t)(vv.y >> 16);
        vd[4 * 280] = (bf16_t)(vv.z & 0xffffu); vd[5 * 280] = (bf16_t)(vv.z >> 16); vd[6 * 280] = (bf16_t)(vv.w & 0xffffu); vd[7 * 280] = (bf16_t)(vv.w >> 16);
    }
    for (int i = f_tid; i < 64 * 24; i += fp::NT) Vt[(i / 24) * 280 + 256 + (i % 24)] = (bf16_t)0;
    __syncthreads();
    const int c16 = f_lane & 15, grp = f_lane >> 4, h = hk * 8 + f_wave;
    const float sink2 = a.sinks[h] * fp::LOG2E;
#pragma unroll 1
    for (int tt = 0; tt < 8; ++tt) {
        const size_t qtok = tok0 + tt * 16 + c16;
        bf16x8 qf[2];
#pragma unroll
        for (int ks = 0; ks < 2; ++ks) qf[ks] = *(const bf16x8*)(PB + qtok * fp::NIN + fp::PB_Q + h * 64 + ks * 32 + grp * 8);
        f32x4 sacc[9];
#pragma unroll
        for (int jq = 0; jq < 9; ++jq) {
            sacc[jq] = (f32x4){0.f, 0.f, 0.f, 0.f};
#pragma unroll
            for (int ks = 0; ks < 2; ++ks) { const bf16x8 kf = *(const LAS bf16x8*)(Ks + (16 * (tt + jq) + c16) * 72 + ks * 32 + grp * 8); sacc[jq] = mfma16(kf, qf[ks], sacc[jq]); }
        }
        float mx = sink2;
#pragma unroll
        for (int jq = 0; jq < 9; ++jq)
#pragma unroll
            for (int r = 0; r < 4; ++r) {
                const int diff = 128 + c16 - 16 * jq - 4 * grp - r, jrel = 16 * (tt + jq) + 4 * grp + r;
                const bool ok = diff >= 0 && diff < 128 && (n > 0 || jrel >= 128);
                sacc[jq][r] = ok ? sacc[jq][r] : -INFINITY;
                mx = fmaxf(mx, sacc[jq][r]);
            }
        mx = fmaxf(mx, __shfl_xor(mx, 16)); mx = fmaxf(mx, __shfl_xor(mx, 32));
        float ls = 0.f;
#pragma unroll
        for (int jq = 0; jq < 9; ++jq) {
            float p[4];
#pragma unroll
            for (int r = 0; r < 4; ++r) { p[r] = exp2_fast(sacc[jq][r] - mx); ls += p[r]; }
            *(LAS u32x2*)(Pw + c16 * 168 + 16 * jq + 4 * grp) = (u32x2){pk2(p[0], p[1]), pk2(p[2], p[3])};
        }
        *(LAS u32x2*)(Pw + c16 * 168 + 144 + 4 * grp) = (u32x2){0u, 0u};
        ls += __shfl_xor(ls, 16); ls += __shfl_xor(ls, 32);
        ls += exp2_fast(sink2 - mx);
        const float inv = 1.f / ls;
        LDS_WAIT();
        f32x4 oacc[4];
#pragma unroll
        for (int dt = 0; dt < 4; ++dt) oacc[dt] = (f32x4){0.f, 0.f, 0.f, 0.f};
#pragma unroll
        for (int k2 = 0; k2 < 5; ++k2) {
            const bf16x8 pb = *(const LAS bf16x8*)(Pw + c16 * 168 + 32 * k2 + 8 * grp);
#pragma unroll
            for (int dt = 0; dt < 4; ++dt) { const bf16x8 va = *(const LAS bf16x8*)(Vt + (16 * dt + c16) * 280 + 16 * tt + 32 * k2 + 8 * grp); oacc[dt] = mfma16(va, pb, oacc[dt]); }
        }
#pragma unroll
        for (int dt = 0; dt < 4; ++dt)
            *(u32x2*)(OA + qtok * 1024 + h * 64 + 16 * dt + 4 * grp) = (u32x2){pk2(oacc[dt][0] * inv, oacc[dt][1] * inv), pk2(oacc[dt][2] * inv, oacc[dt][3] * inv)};
        LDS_WAIT();
    }
    __syncthreads();
}

__device__ __forceinline__ void unpack8(const u32x4 v, float (&f)[8]) {
    f[0] = bflo(v.x); f[1] = bfhi(v.x); f[2] = bflo(v.y); f[3] = bfhi(v.y); f[4] = bflo(v.z); f[5] = bfhi(v.z); f[6] = bflo(v.w); f[7] = bfhi(v.w);
}
__device__ __forceinline__ void stage_vt(const bf16_t* PB, size_t tok0, int col0, LAS bf16_t* Vt, int tid) {
#pragma unroll
    for (int i = 0; i < 8; ++i) {
        const int q = tid + 512 * i, row = q >> 5, ch = q & 31;
        const u32x4 vv = *(const u32x4*)(PB + (tok0 + row) * fp::NIN + col0 + ch * 8);
        LAS bf16_t* vd = Vt + (ch * 8) * 136 + row;
        vd[0 * 136] = (bf16_t)(vv.x & 0xffffu); vd[1 * 136] = (bf16_t)(vv.x >> 16); vd[2 * 136] = (bf16_t)(vv.y & 0xffffu); vd[3 * 136] = (bf16_t)(vv.y >> 16);
        vd[4 * 136] = (bf16_t)(vv.z & 0xffffu); vd[5 * 136] = (bf16_t)(vv.z >> 16); vd[6 * 136] = (bf16_t)(vv.w & 0xffffu); vd[7 * 136] = (bf16_t)(vv.w >> 16);
    }
}

__device__ __forceinline__ void m1_unit(const MkArgs& a, Frame& F, int u) {
    const int f_tid = fresh_tid(F), f_lane = f_tid & 63, f_wave = F.wave;
    const int bh = u >> 6, c = u & 63, b = bh >> 2, h = bh & 3;
    const size_t tok0 = (size_t)b * S + (size_t)c * 128;
    unsigned char* ws = a.ws;
    const bf16_t* PB = (const bf16_t*)(ws + wsf::PROJB);
    LAS bf16_t* KwT = (LAS bf16_t*)F.lds;
    LAS bf16_t* Vt = (LAS bf16_t*)(F.lds + 34816);
    LAS float* gl = (LAS float*)(F.lds + 34816 + 69632);
    const float* GT = (const float*)(ws + wsf::GATES);
    const int tid = f_tid;
    float li = 0.f, lf = 0.f;
    if (tid < 128) { li = softcap_f(GT[(tok0 + tid) * 8 + h]); lf = logsigmoid_f(softcap_f(GT[(tok0 + tid) * 8 + 4 + h])); }
    float cum = lf;
#pragma unroll
    for (int o = 1; o < 64; o <<= 1) { const float t = __shfl_up(cum, o); if (f_lane >= o) cum += t; }
    if (tid == 63) gl[384] = cum;
    __syncthreads();
    if (tid >= 64 && tid < 128) cum += gl[384];
    if (tid == 127) gl[385] = cum;
    __syncthreads();
    const float g = gl[385];
    const float av = (tid < 128) ? (g - cum + li) : -INFINITY;
    const float wm = wave_max_f(av);
    if (f_lane == 0 && f_wave < 2) gl[386 + f_wave] = wm;
    __syncthreads();
    const float mloc = fmaxf(gl[386], gl[387]);
    if (tid < 128) {
        gl[256 + tid] = expf(av - mloc);
        ((float*)(ws + wsf::BCUM))[(size_t)bh * S + c * 128 + tid] = cum;
        ((float*)(ws + wsf::LOGI))[(size_t)bh * S + c * 128 + tid] = li;
    }
    if (tid == 0) { ((float*)(ws + wsf::GSUM))[u] = g; ((float*)(ws + wsf::MLOC))[u] = mloc; }
    __syncthreads();
#pragma unroll 1
    for (int i = 0; i < 8; ++i) {
        const int q = tid + 512 * i, row = q >> 5, ch = q & 31, isK = ch >= 16, cc = (ch & 15) * 8;
        const int colsrc = (isK ? fp::PB_MK : fp::PB_MQ) + h * 128 + cc, cwcol = (isK ? 512 : 0) + h * 128 + cc;
        float acc[8];
#pragma unroll
        for (int e = 0; e < 8; ++e) acc[e] = 0.f;
#pragma unroll
        for (int j = 0; j < 4; ++j) {
            const int sabs = c * 128 + row - 3 + j;
            if (sabs >= 0) {
                const u32x4 xv = *(const u32x4*)(PB + (tok0 + row - 3 + j) * fp::NIN + colsrc);
                float xf[8]; unpack8(xv, xf);
                const f32x4 w0 = *(const f32x4*)(a.conv_qk + j * 1024 + cwcol), w1 = *(const f32x4*)(a.conv_qk + j * 1024 + cwcol + 4);
                acc[0] += w0.x * xf[0]; acc[1] += w0.y * xf[1]; acc[2] += w0.z * xf[2]; acc[3] += w0.w * xf[3];
                acc[4] += w1.x * xf[4]; acc[5] += w1.y * xf[5]; acc[6] += w1.z * xf[6]; acc[7] += w1.w * xf[7];
            }
        }
        const float sc = isK ? 0.08838834764831845f : 1.f;
#pragma unroll
        for (int e = 0; e < 8; ++e) acc[e] = silu_f(acc[e]) * sc;
        const u32x4 o = (u32x4){pk2(acc[0], acc[1]), pk2(acc[2], acc[3]), pk2(acc[4], acc[5]), pk2(acc[6], acc[7])};
        bf16_t* dst = (bf16_t*)(ws + (isK ? wsf::KC : wsf::QC)) + (tok0 + row) * 512 + h * 128 + cc;
        *(u32x4*)dst = o;
        if (isK) {
            const float wr = gl[256 + row];
            LAS bf16_t* kd = KwT + cc * 136 + row;
#pragma unroll
            for (int e = 0; e < 8; ++e) kd[e * 136] = (bf16_t)f2bf(acc[e] * wr);
        }
    }
    stage_vt(PB, tok0, fp::PB_MV + h * 256, Vt, tid);
    __syncthreads();
    const int c16 = f_lane & 15, grp = f_lane >> 4, w = f_wave;
    f32x4 acc[8][2];
#pragma unroll
    for (int d = 0; d < 8; ++d) { acc[d][0] = (f32x4){0.f, 0.f, 0.f, 0.f}; acc[d][1] = acc[d][0]; }
#pragma unroll
    for (int ks = 0; ks < 4; ++ks) {
        bf16x8 bfr[2];
#pragma unroll
        for (int i = 0; i < 2; ++i) bfr[i] = *(const LAS bf16x8*)(Vt + (16 * (2 * w + i) + c16) * 136 + 32 * ks + 8 * grp);
#pragma unroll
        for (int d = 0; d < 8; ++d) {
            const bf16x8 af = *(const LAS bf16x8*)(KwT + (16 * d + c16) * 136 + 32 * ks + 8 * grp);
            acc[d][0] = mfma16(af, bfr[0], acc[d][0]); acc[d][1] = mfma16(af, bfr[1], acc[d][1]);
        }
    }
    float* dct = (float*)(ws + wsf::DCT) + (size_t)u * 256 * 128;
#pragma unroll
    for (int d = 0; d < 8; ++d)
#pragma unroll
        for (int i = 0; i < 2; ++i) *(f32x4*)(dct + (size_t)(16 * (2 * w + i) + c16) * 128 + 16 * d + 4 * grp) = acc[d][i];
    if (tid < 128) {
        float s = 0.f;
#pragma unroll
        for (int ch = 0; ch < 16; ++ch) { const u32x4 kv = *(const LAS u32x4*)(KwT + tid * 136 + ch * 8); float kf[8]; unpack8(kv, kf);
#pragma unroll
            for (int e = 0; e < 8; ++e) s += kf[e]; }
        ((float*)(ws + wsf::DN))[(size_t)u * 128 + tid] = s;
    }
    __syncthreads();
}

__device__ __forceinline__ void phase3(const MkArgs& a, Frame& F) {
    const int f_tid = fresh_tid(F), f_lane = f_tid & 63, f_wave = F.wave;
    for (int u = F.bid; u < NB * HKV * (S / 128); u += F.G) attn_unit(a, F, u);
    for (int u = F.bid; u < NB * MH * NC; u += F.G) m1_unit(a, F, u);
}

__device__ __forceinline__ void phase4(const MkArgs& a, Frame& F) {
    const int f_tid = fresh_tid(F), f_lane = f_tid & 63, f_wave = F.wave;
    unsigned char* ws = a.ws;
    LAS float* dec = (LAS float*)F.lds;
    LAS float* scl = dec + 512;
    if (f_tid < 8) {
        const int bh = f_tid; float m = 0.f;
        for (int c = 0; c < NC; ++c) {
            const float g = ((const float*)(ws + wsf::GSUM))[bh * NC + c], ml = ((const float*)(ws + wsf::MLOC))[bh * NC + c];
            if (F.bid == 0) ((float*)(ws + wsf::MPREV))[bh * NC + c] = m;
            const float mn = fmaxf(g + m, ml);
            dec[bh * 64 + c] = expf(g + m - mn); scl[bh * 64 + c] = expf(ml - mn); m = mn;
        }
    }
    __syncthreads();
    const int gt = F.vcu * fp::NT + f_tid, NGT = F.G * fp::NT;
    for (int it = gt; it < 8 * 16384; it += NGT) {
        const int bh = it >> 14, idx = it & 16383;
        const float* dct = (const float*)(ws + wsf::DCT) + (size_t)bh * 64 * 32768 + (size_t)idx * 2;
        bf16_t* cpt = (bf16_t*)(ws + wsf::CPT) + (size_t)bh * 64 * 32768 + (size_t)idx * 2;
        float C0 = 0.f, C1 = 0.f;
#pragma unroll 8
        for (int c = 0; c < NC; ++c) {
            const f32x2 d = *(const f32x2*)(dct + (size_t)c * 32768);
            *(unsigned*)(cpt + (size_t)c * 32768) = pk2(C0, C1);
            const float de = dec[bh * 64 + c], sc = scl[bh * 64 + c];
            C0 = de * C0 + sc * d.x; C1 = de * C1 + sc * d.y;
        }
    }
    for (int it = gt; it < 8 * 128; it += NGT) {
        const int bh = it >> 7, dk = it & 127; float nv = 0.f;
#pragma unroll 4
        for (int c = 0; c < NC; ++c) {
            const size_t id = (size_t)bh * NC + c;
            ((float*)(ws + wsf::NPREV))[id * 128 + dk] = nv;
            nv = dec[bh * 64 + c] * nv + scl[bh * 64 + c] * ((const float*)(ws + wsf::DN))[id * 128 + dk];
        }
    }
}

__device__ __forceinline__ void m3_unit(const MkArgs& a, Frame& F, int u) {
    const int f_tid = fresh_tid(F), f_lane = f_tid & 63, f_wave = F.wave;
    const int bh = u >> 6, c = u & 63, b = bh >> 2, h = bh & 3;
    const size_t tok0 = (size_t)b * S + (size_t)c * 128;
    unsigned char* ws = a.ws;
    const bf16_t* PB = (const bf16_t*)(ws + wsf::PROJB);
    const bf16_t* QCp = (const bf16_t*)(ws + wsf::QC);
    const bf16_t* KCp = (const bf16_t*)(ws + wsf::KC);
    LAS bf16_t* KP = (LAS bf16_t*)F.lds;
    LAS bf16_t* Vt = (LAS bf16_t*)(F.lds + 34816);
    LAS float* fl = (LAS float*)(F.lds + 104448);
    LAS float* f_us = fl, *f_M = fl + 128, *f_iw = fl + 256, *f_rd = fl + 384, *f_qn = fl + 512, *f_np = fl + 640, *f_en = fl + 768, *f_ssq = fl + 1024, *f_misc = fl + 896;
    const int tid = f_tid;
#pragma unroll
    for (int i = 0; i < 4; ++i) { const int q = tid + 512 * i, row = q >> 4, ch = q & 15;
        *(LAS u32x4*)(KP + row * 136 + ch * 8) = *(const u32x4*)(KCp + (tok0 + row) * 512 + h * 128 + ch * 8); }
    stage_vt(PB, tok0, fp::PB_MV + h * 256, Vt, tid);
    const float mp = ((const float*)(ws + wsf::MPREV))[u];
    float bt = 0.f, us = -INFINITY;
    if (tid < 128) { bt = ((const float*)(ws + wsf::BCUM))[(size_t)bh * S + c * 128 + tid]; us = ((const float*)(ws + wsf::LOGI))[(size_t)bh * S + c * 128 + tid] - bt;
        f_np[tid] = ((const float*)(ws + wsf::NPREV))[(size_t)u * 128 + tid]; }
    float pm = us;
#pragma unroll
    for (int o = 1; o < 64; o <<= 1) { const float t = __shfl_up(pm, o); if (f_lane >= o) pm = fmaxf(pm, t); }
    if (tid == 63) f_misc[0] = pm;
    __syncthreads();
    if (tid >= 64 && tid < 128) pm = fmaxf(pm, f_misc[0]);
    if (tid < 128) {
        const float Mt = fmaxf(mp, pm);
        f_us[tid] = us; f_M[tid] = Mt; f_iw[tid] = expf(mp - Mt); f_en[tid] = expf(-(bt + Mt));
        float s = 0.f;
#pragma unroll 4
        for (int ch = 0; ch < 16; ++ch) { const u32x4 qv = *(const u32x4*)(QCp + (tok0 + tid) * 512 + h * 128 + ch * 8); float qf[8]; unpack8(qv, qf);
#pragma unroll
            for (int e = 0; e < 8; ++e) s += qf[e] * f_np[ch * 8 + e]; }
        f_qn[tid] = s;
    }
    __syncthreads();
    const int c16 = f_lane & 15, grp = f_lane >> 4, w = f_wave;
    u32x2 pp[8]; float rs = 0.f;
    {
        bf16x8 qf[4];
#pragma unroll
        for (int ks = 0; ks < 4; ++ks) qf[ks] = *(const bf16x8*)(QCp + (tok0 + 16 * w + c16) * 512 + h * 128 + 32 * ks + 8 * grp);
        const float Mt = f_M[16 * w + c16];
        const int t = 16 * w + c16;
#pragma unroll
        for (int st = 0; st < 8; ++st) {
            pp[st] = (u32x2){0u, 0u};
            if (st <= w) {
                f32x4 acc = (f32x4){0.f, 0.f, 0.f, 0.f};
#pragma unroll
                for (int ks = 0; ks < 4; ++ks) { const bf16x8 kf = *(const LAS bf16x8*)(KP + (16 * st + c16) * 136 + 32 * ks + 8 * grp); acc = mfma16(kf, qf[ks], acc); }
                float p[4];
#pragma unroll
                for (int r = 0; r < 4; ++r) { const int s = 16 * st + 4 * grp + r; p[r] = (s <= t) ? acc[r] * expf(f_us[s] - Mt) : 0.f; rs += p[r]; }
                pp[st] = (u32x2){pk2(p[0], p[1]), pk2(p[2], p[3])};
            }
        }
        rs += __shfl_xor(rs, 16); rs += __shfl_xor(rs, 32);
        if (grp == 0) { const float den = rs + f_iw[t] * f_qn[t]; f_rd[t] = 1.f / fmaxf(fabsf(den), f_en[t]); }
    }
    __syncthreads();
#pragma unroll
    for (int st = 0; st < 8; ++st) *(LAS u32x2*)(KP + (16 * w + c16) * 136 + 16 * st + 4 * grp) = pp[st];
    __syncthreads();
    bf16x8 vf[2][4], cf[2][4];
    const bf16_t* cpt = (const bf16_t*)(ws + wsf::CPT) + (size_t)u * 256 * 128;
#pragma unroll
    for (int i = 0; i < 2; ++i)
#pragma unroll
        for (int ks = 0; ks < 4; ++ks) {
            vf[i][ks] = *(const LAS bf16x8*)(Vt + (16 * (2 * w + i) + c16) * 136 + 32 * ks + 8 * grp);
            cf[i][ks] = *(const bf16x8*)(cpt + (size_t)(16 * (2 * w + i) + c16) * 128 + 32 * ks + 8 * grp);
        }
    bf16_t* HMp = (bf16_t*)(ws + wsf::HM);
#pragma unroll 1
    for (int tt = 0; tt < 8; ++tt) {
        bf16x8 pf[4], qf[4];
#pragma unroll
        for (int ks = 0; ks < 4; ++ks) { pf[ks] = *(const LAS bf16x8*)(KP + (16 * tt + c16) * 136 + 32 * ks + 8 * grp);
            qf[ks] = *(const bf16x8*)(QCp + (tok0 + 16 * tt + c16) * 512 + h * 128 + 32 * ks + 8 * grp); }
        const int t = 16 * tt + c16; const float iw = f_iw[t], rd = f_rd[t];
        float ss = 0.f;
#pragma unroll
        for (int i = 0; i < 2; ++i) {
            f32x4 a1 = (f32x4){0.f, 0.f, 0.f, 0.f}, a2 = a1;
#pragma unroll
            for (int ks = 0; ks < 4; ++ks) { a1 = mfma16(vf[i][ks], pf[ks], a1); a2 = mfma16(cf[i][ks], qf[ks], a2); }
            const f32x4 hv = (a1 + a2 * iw) * rd;
            ss += (hv[0] * hv[0] + hv[1] * hv[1]) + (hv[2] * hv[2] + hv[3] * hv[3]);
            *(u32x2*)(HMp + (tok0 + t) * 1024 + h * 256 + 16 * (2 * w + i) + 4 * grp) = (u32x2){pk2(hv[0], hv[1]), pk2(hv[2], hv[3])};
        }
        ss += __shfl_xor(ss, 16); ss += __shfl_xor(ss, 32);
        if (grp == 0) f_ssq[t * 8 + w] = ss;
    }
    __syncthreads();
#pragma unroll 1
    for (int tt = 0; tt < 8; ++tt) {
        const int t = 16 * tt + c16;
        const f32x4 s0 = *(const LAS f32x4*)(f_ssq + t * 8), s1 = *(const LAS f32x4*)(f_ssq + t * 8 + 4);
        const float rn = rsqrtf(((s0.x + s0.y) + (s0.z + s0.w) + (s1.x + s1.y) + (s1.z + s1.w)) * (1.f / 256.f) + EPS);
#pragma unroll
        for (int i = 0; i < 2; ++i) {
            const int dv0 = 16 * (2 * w + i) + 4 * grp;
            const f32x4 g4 = *(const f32x4*)(a.g_mlstm + h * 256 + dv0);
            const u32x2 mo = *(const u32x2*)(PB + (tok0 + t) * fp::NIN + fp::PB_MO + h * 256 + dv0);
            u32x2* hp = (u32x2*)(HMp + (tok0 + t) * 1024 + h * 256 + dv0);
            const u32x2 hr = *hp;
            const float o0 = bflo(hr.x) * rn * g4.x * bflo(mo.x), o1 = bfhi(hr.x) * rn * g4.y * bfhi(mo.x);
            const float o2 = bflo(hr.y) * rn * g4.z * bflo(mo.y), o3 = bfhi(hr.y) * rn * g4.w * bfhi(mo.y);
            *hp = (u32x2){pk2(o0, o1), pk2(o2, o3)};
        }
    }
    __syncthreads();
}
__device__ __forceinline__ void phase5(const MkArgs& a, Frame& F) {
    const int f_tid = fresh_tid(F), f_lane = f_tid & 63, f_wave = F.wave;
    for (int u = F.bid; u < NB * MH * NC; u += F.G) m3_unit(a, F, u);
}
struct ProjUnit { int pm, pn, which; };
struct ProjSched {
    typedef ProjUnit UnitT;
    const bf16_t* A0; const bf16_t* A1; const bf16_t* B0; const bf16_t* B1; int K; int nM, nN, G, c, wave;
    __device__ __forceinline__ bool next(int i, ProjUnit& u) const { u.which = i & 1; return pg8::static_tile((i >> 1) * G + c, nM, nN, u.pm, u.pn); }
    __device__ __forceinline__ const void* a_buf() const { return A0; }
    __device__ __forceinline__ const void* b_buf() const { return B0; }
    __device__ __forceinline__ unsigned a_soff(const ProjUnit& u) const { return (unsigned)u.pm * 256u * (unsigned)K * 2u + (u.which ? (unsigned)((const char*)A1 - (const char*)A0) : 0u); }
    __device__ __forceinline__ unsigned b_soff(const ProjUnit& u) const { return (unsigned)u.pn * 256u * (unsigned)K * 2u + (u.which ? (unsigned)((const char*)B1 - (const char*)B0) : 0u); }
    __device__ __forceinline__ void a_offs(const ProjUnit&, int R0, int R1, int C0, int C1, unsigned (&o)[4]) const {
        o[0] = (unsigned)(R0 * K + C0) * 2u; o[1] = (unsigned)(R1 * K + C1) * 2u; o[2] = (unsigned)((R0 + 128) * K + C0) * 2u; o[3] = (unsigned)((R1 + 128) * K + C1) * 2u;
    }
};
struct EpiMerge {
    bf16_t* MG; const bf16_t* PB;
    __device__ __forceinline__ void operator()(const f32x4 (&acc)[2][2][4][2], const ProjUnit& u, int wr, int wc, int fr, int fq) const {
        const int row0 = u.pm * 256 + wr * 64 + fr, col0 = u.pn * 256 + wc * 32 + 8 * fq;
        const int gcol = (u.which ? fp::PB_GM : fp::PB_GA) + col0;
#pragma unroll
        for (int ai = 0; ai < 2; ++ai)
#pragma unroll
            for (int m = 0; m < 4; ++m) {
                const size_t row = (size_t)(row0 + ai * 128 + m * 16);
#pragma unroll
                for (int bj = 0; bj < 2; ++bj) {
                    const u32x4 gv = *(const u32x4*)(PB + row * fp::NIN + gcol + bj * 128);
                    float g[8]; unpack8(gv, g);
                    const f32x4 v0 = acc[ai][bj][m][0], v1 = acc[ai][bj][m][1];
                    float o[8] = {g[0] * v0[0], g[1] * v0[1], g[2] * v0[2], g[3] * v0[3], g[4] * v1[0], g[5] * v1[1], g[6] * v1[2], g[7] * v1[3]};
                    u32x4* dst = (u32x4*)(MG + row * 2048 + col0 + bj * 128);
                    if (u.which) { const u32x4 pv = *dst; float p[8]; unpack8(pv, p);
#pragma unroll
                        for (int e = 0; e < 8; ++e) o[e] += p[e]; }
                    *dst = (u32x4){pg8::cvt_pk_bf16(o[0], o[1]), pg8::cvt_pk_bf16(o[2], o[3]), pg8::cvt_pk_bf16(o[4], o[5]), pg8::cvt_pk_bf16(o[6], o[7])};
                }
            }
    }
};
__device__ __forceinline__ void phase6(const MkArgs& a, Frame& F) {
    const int f_tid = fresh_tid(F), f_lane = f_tid & 63, f_wave = F.wave;
    unsigned char* ws = a.ws;
    ProjSched S{(const bf16_t*)(ws + wsf::OAT), (const bf16_t*)(ws + wsf::HM), (const bf16_t*)(ws + wsf::WAP_T), (const bf16_t*)(ws + wsf::WMP_T), 1024, NTOK / 256, 2048 / 256, F.G, F.bid, F.wave};
    EpiMerge E{(bf16_t*)(ws + wsf::MG), (const bf16_t*)(ws + wsf::PROJB)};
    pg8::gemm_phase<EpiMerge, ProjSched>(F.lds, S, E);
}
struct EpiPlain {
    bf16_t* O; int ldc;
    __device__ __forceinline__ void operator()(const f32x4 (&acc)[2][2][4][2], const DenseUnit& u, int wr, int wc, int fr, int fq) const {
        const int row0 = u.pm * 256 + wr * 64 + fr, col0 = u.pn * 256 + wc * 32 + 8 * fq;
#pragma unroll
        for (int ai = 0; ai < 2; ++ai)
#pragma unroll
            for (int m = 0; m < 4; ++m)
#pragma unroll
                for (int bj = 0; bj < 2; ++bj) {
                    const f32x4 v0 = acc[ai][bj][m][0], v1 = acc[ai][bj][m][1];
                    *(u32x4*)(O + (size_t)(row0 + ai * 128 + m * 16) * ldc + col0 + bj * 128) =
                        (u32x4){pg8::cvt_pk_bf16(v0[0], v0[1]), pg8::cvt_pk_bf16(v0[2], v0[3]), pg8::cvt_pk_bf16(v1[0], v1[1]), pg8::cvt_pk_bf16(v1[2], v1[3])};
                }
    }
};
__device__ __forceinline__ void phase7(const MkArgs& a, Frame& F) {
    const int f_tid = fresh_tid(F), f_lane = f_tid & 63, f_wave = F.wave;
    unsigned char* ws = a.ws;
    DenseSched S{(const bf16_t*)(ws + wsf::MG), (const bf16_t*)(ws + wsf::WOUT_T), 2048, 2048, NTOK / 256, 2048 / 256, F.G, F.bid, F.wave};
    EpiPlain E{(bf16_t*)(ws + wsf::Y), 2048};
    pg8::gemm_phase<EpiPlain, DenseSched>(F.lds, S, E);
}

__device__ __forceinline__ void phase8(const MkArgs& a, Frame& F) {
    const int f_tid = fresh_tid(F), f_lane = f_tid & 63, f_wave = F.wave;
    unsigned char* ws = a.ws;
    LAS float* t_gt1 = (LAS float*)F.lds, *t_gpo = t_gt1 + 2048, *t_gpr = t_gt1 + 4096, *t_sc2 = t_gt1 + 6144, *t_sh2 = t_gt1 + 8192;
    LAS float* lgp = (LAS float*)(F.lds + 40960);
    LAS int* cntl = (LAS int*)(F.lds + 57344);
    LAS int* basel = cntl + 32;
    LAS int* esel = cntl + 64;
    LAS int* eslot = cntl + 320;
    const float* mod = (const float*)(ws + wsf::MOD);
    const bf16_t* Yp = (const bf16_t*)(ws + wsf::Y);
    bf16_t* H2p = (bf16_t*)(ws + wsf::H2);
    float* X1p = (float*)(ws + wsf::X1);
    const bf16_t* WR = (const bf16_t*)(ws + wsf::WRT);
    int* cntg = (int*)(ws + wsf::CTL) + wsf::CW_CNT;
    const int tid = f_tid, lane = f_lane, w = f_wave;
    for (int blk = F.vcu; blk < NTOK / 64; blk += F.G) {
        const int b = (blk * 64) / S;
        for (int i = tid; i < 2048; i += fp::NT) {
            t_gt1[i] = mod[b * MODW + MOD_GT1 + i]; t_gpo[i] = a.g_post_mix[i]; t_gpr[i] = a.g_pre_ffn[i];
            t_sc2[i] = mod[b * MODW + MOD_SC2 + i]; t_sh2[i] = mod[b * MODW + MOD_SH2 + i];
        }
        if (tid < 32) cntl[tid] = 0;
        __syncthreads();
#pragma unroll 1
        for (int rr = 0; rr < 8; ++rr) {
            const size_t row = (size_t)blk * 64 + w * 8 + rr;
            u32x4 yp[4]; float ss = 0.f;
#pragma unroll
            for (int j = 0; j < 4; ++j) { yp[j] = *(const u32x4*)(Yp + row * 2048 + 8 * (64 * j + lane)); float f[8]; unpack8(yp[j], f);
#pragma unroll
                for (int e = 0; e < 8; ++e) ss += f[e] * f[e]; }
            const float r1 = rsqrtf(wave_sum_f(ss) * (1.f / D) + EPS);
            ss = 0.f;
#pragma unroll
            for (int j = 0; j < 4; ++j) {
                const int c0 = 8 * (64 * j + lane);
                float f[8]; unpack8(yp[j], f);
                const f32x4 xa = *(const f32x4*)(a.x + row * D + c0), xb = *(const f32x4*)(a.x + row * D + c0 + 4);
                const float xv[8] = {xa.x, xa.y, xa.z, xa.w, xb.x, xb.y, xb.z, xb.w};
                float v[8];
#pragma unroll
                for (int e = 0; e < 8; ++e) { v[e] = xv[e] + t_gt1[c0 + e] * (f[e] * r1 * t_gpo[c0 + e]); ss += v[e] * v[e]; }
                *(f32x4*)(X1p + row * D + c0) = (f32x4){v[0], v[1], v[2], v[3]};
                *(f32x4*)(X1p + row * D + c0 + 4) = (f32x4){v[4], v[5], v[6], v[7]};
            }
            const float r2 = rsqrtf(wave_sum_f(ss) * (1.f / D) + EPS);
#pragma unroll
            for (int j = 0; j < 4; ++j) {
                const int c0 = 8 * (64 * j + lane);
                const f32x4 xa = *(const f32x4*)(X1p + row * D + c0), xb = *(const f32x4*)(X1p + row * D + c0 + 4);
                const float xv[8] = {xa.x, xa.y, xa.z, xa.w, xb.x, xb.y, xb.z, xb.w};
                float hv[8];
#pragma unroll
                for (int e = 0; e < 8; ++e) hv[e] = xv[e] * r2 * t_gpr[c0 + e] * (1.f + t_sc2[c0 + e]) + t_sh2[c0 + e];
                *(u32x4*)(H2p + row * 2048 + c0) = (u32x4){pk2(hv[0], hv[1]), pk2(hv[2], hv[3]), pk2(hv[4], hv[5]), pk2(hv[6], hv[7])};
#if MOE_FP8
                *(u32x2*)(ws + wsf::H2F8 + row * 2048 + c0) = (u32x2){pk4_fp8(hv[0], hv[1], hv[2], hv[3]), pk4_fp8(hv[4], hv[5], hv[6], hv[7])};
#endif
            }
        }
        VM_WAIT();
        __syncthreads();
        {
            const int c16 = lane & 15, grp = lane >> 4, rt = w & 3, kh = w >> 2;
            f32x4 acc[2] = {(f32x4){0.f, 0.f, 0.f, 0.f}, (f32x4){0.f, 0.f, 0.f, 0.f}};
            const bf16_t* ap = H2p + ((size_t)blk * 64 + 16 * rt + c16) * 2048 + 8 * grp;
#pragma unroll 4
            for (int ks = kh * 32; ks < kh * 32 + 32; ++ks) {
                const bf16x8 af = *(const bf16x8*)(ap + 32 * ks);
#pragma unroll
                for (int et = 0; et < 2; ++et) {
                    const bf16x8 bh = *(const bf16x8*)(WR + (size_t)(16 * et + c16) * 2048 + 32 * ks + 8 * grp);
                    const bf16x8 bl = *(const bf16x8*)(WR + (size_t)32 * 2048 + (size_t)(16 * et + c16) * 2048 + 32 * ks + 8 * grp);
                    acc[et] = mfma16(af, bh, acc[et]); acc[et] = mfma16(af, bl, acc[et]);
                }
            }
#pragma unroll
            for (int et = 0; et < 2; ++et)
#pragma unroll
                for (int r = 0; r < 4; ++r) lgp[kh * 2048 + (16 * rt + 4 * grp + r) * 32 + 16 * et + c16] = acc[et][r];
        }
        __syncthreads();
        if (tid < 64) {
            const size_t tok = (size_t)blk * 64 + tid;
            float lgv[32];
#pragma unroll
            for (int e = 0; e < 32; ++e) lgv[e] = lgp[tid * 32 + e] + lgp[2048 + tid * 32 + e] + a.b_router[e];
            int idx[4]; float val[4];
            unsigned used = 0u;
#pragma unroll
            for (int k = 0; k < 4; ++k) {
                float best = -INFINITY; int bi = 0;
#pragma unroll
                for (int e = 0; e < 32; ++e) { const bool c = !((used >> e) & 1u) && lgv[e] > best; best = c ? lgv[e] : best; bi = c ? e : bi; }
                used |= 1u << bi; idx[k] = bi; val[k] = best;
            }
            float ex[4], sum = 0.f;
#pragma unroll
            for (int k = 0; k < 4; ++k) { ex[k] = expf(val[k] - val[0]); sum += ex[k]; }
#pragma unroll
            for (int k = 0; k < 4; ++k) {
                ((int*)(ws + wsf::TOPI))[tok * 4 + k] = idx[k]; ((float*)(ws + wsf::TOPW))[tok * 4 + k] = ex[k] / sum;
                const int e = a.route_i ? a.route_i[tok * 4 + k] : idx[k];
                esel[tid * 4 + k] = e;
                eslot[tid * 4 + k] = __hip_atomic_fetch_add(cntl + e, 1, __ATOMIC_RELAXED, __HIP_MEMORY_SCOPE_WORKGROUP);
            }
        }
        __syncthreads();
        if (tid < 32) { const int n = cntl[tid]; basel[tid] = n > 0 ? __hip_atomic_fetch_add(cntg + tid, n, __ATOMIC_RELAXED, __HIP_MEMORY_SCOPE_AGENT) : 0; }
        __syncthreads();
        if (tid < 256) { const int e = esel[tid]; ((int*)(ws + wsf::LIST))[(size_t)e * NPAIR + basel[e] + eslot[tid]] = (blk * 64 + (tid >> 2)) * 4 + (tid & 3); }
        __syncthreads();
    }
}

struct MoeUnit { int e, m0, pn, rows; };
struct MoeSched {
    typedef MoeUnit UnitT;
    const bf16_t* A; int a_shift; const bf16_t* Wt; size_t wstride; int K; int nN;
    const int* list; const LAS int* tstart; const LAS int* cnt; int nM; int G, c, wave;
    __device__ __forceinline__ bool next(int i, MoeUnit& u) const {
        const int nwg = nM * nN, L = i * G + c; if (L >= nwg) return false;
        int wgid = L; { const int q = nwg / 8, r = nwg % 8, xcd = wgid % 8, off = wgid / 8; wgid = (xcd < r ? xcd * (q + 1) : r * (q + 1) + (xcd - r) * q) + off; }
        constexpr int WG = 4;
        const int nig = WG * nN, gid = wgid / nig, fm = gid * WG, gsz = (nM - fm) < WG ? (nM - fm) : WG;
        const int mt = fm + ((wgid % nig) % gsz); u.pn = (wgid % nig) / gsz;
        int e = 0;
        for (int k = 1; k < NE; ++k) e += (__builtin_amdgcn_readfirstlane(tstart[k]) <= mt) ? 1 : 0;
        u.e = e; u.m0 = (mt - __builtin_amdgcn_readfirstlane(tstart[e])) * 256; const int left = __builtin_amdgcn_readfirstlane(cnt[e]) - u.m0; u.rows = left < 256 ? left : 256;
        return true;
    }
    __device__ __forceinline__ const void* a_buf() const { return A; }
    __device__ __forceinline__ const void* b_buf() const { return Wt; }
    __device__ __forceinline__ unsigned a_soff(const MoeUnit&) const { return 0u; }
    __device__ __forceinline__ unsigned b_soff(const MoeUnit& u) const { return ((unsigned)u.e * (unsigned)wstride + (unsigned)u.pn * 256u * (unsigned)K) * 2u; }
    __device__ __forceinline__ unsigned rowoff(const MoeUnit& u, int r, int C) const {
        const int rc = r < u.rows ? r : u.rows - 1;
        const int id = list[(size_t)u.e * NPAIR + u.m0 + rc] >> a_shift;
        return ((unsigned)id * (unsigned)K + (unsigned)C) * 2u;
    }
    __device__ __forceinline__ void a_offs(const MoeUnit& u, int R0, int R1, int C0, int C1, unsigned (&o)[4]) const {
        o[0] = rowoff(u, R0, C0); o[1] = rowoff(u, R1, C1); o[2] = rowoff(u, R0 + 128, C0); o[3] = rowoff(u, R1 + 128, C1);
    }
};
__device__ __forceinline__ void moe_tables(const MkArgs& a, Frame& F, LAS int*& cnt, LAS int*& tstart) {
    const int f_tid = fresh_tid(F);
    cnt = (LAS int*)(F.lds + LDS_TAB); tstart = cnt + 32;
    const int* cntg = (const int*)(a.ws + wsf::CTL) + wsf::CW_CNT;
    if (f_tid < 32) cnt[f_tid] = __hip_atomic_load(cntg + f_tid, RLX_AGENT);
    __syncthreads();
    if (f_tid == 0) { int s = 0; for (int e = 0; e < NE; ++e) { tstart[e] = s; s += (cnt[e] + 255) >> 8; } tstart[NE] = s; }
    __syncthreads();
}
template <bool F8> struct EpiGateUpT {
    bf16_t* ACT; const float* bias; const int* list;
    __device__ __forceinline__ void operator()(const f32x4 (&acc)[2][2][4][2], const MoeUnit& u, int wr, int wc, int fr, int fq) const {
        const int col0 = u.pn * 256 + wc * 32 + 8 * fq;
        f32x4 bv[2][2];
#pragma unroll
        for (int bj = 0; bj < 2; ++bj)
#pragma unroll
            for (int n = 0; n < 2; ++n) bv[bj][n] = *(const f32x4*)(bias + (size_t)u.e * 4096 + col0 + bj * 128 + 4 * n);
#pragma unroll
        for (int ai = 0; ai < 2; ++ai)
#pragma unroll
            for (int m = 0; m < 4; ++m) {
                const int r = ai * 128 + wr * 64 + m * 16 + fr;
                if (r < u.rows) {
                    const int pair = list[(size_t)u.e * NPAIR + u.m0 + r];
#pragma unroll
                    for (int bj = 0; bj < 2; ++bj) {
                        const f32x4 v0 = acc[ai][bj][m][0] * (F8 ? W8INV : 1.f) + bv[bj][0], v1 = acc[ai][bj][m][1] * (F8 ? W8INV : 1.f) + bv[bj][1];
                        const float gu[8] = {v0[0], v0[1], v0[2], v0[3], v1[0], v1[1], v1[2], v1[3]};
                        float o[4];
#pragma unroll
                        for (int j = 0; j < 4; ++j) {
                            const float glu = fminf(gu[2 * j], 7.0f), lin = fminf(fmaxf(gu[2 * j + 1], -7.0f), 7.0f);
                            o[j] = glu * fast_sigmoid(1.702f * glu) * (lin + 1.f);
                        }
                        if constexpr (F8) *(unsigned*)((unsigned char*)ACT + (size_t)pair * 2048 + (col0 + bj * 128) / 2) = pk4_fp8(o[0], o[1], o[2], o[3]);
                        else *(u32x2*)(ACT + (size_t)pair * 2048 + (col0 + bj * 128) / 2) = (u32x2){pg8::cvt_pk_bf16(o[0], o[1]), pg8::cvt_pk_bf16(o[2], o[3])};
                    }
                }
            }
    }
};
template <bool F8> struct EpiDownT {
    bf16_t* YP; const float* bias; const int* list; const float* wgt;
    __device__ __forceinline__ void operator()(const f32x4 (&acc)[2][2][4][2], const MoeUnit& u, int wr, int wc, int fr, int fq) const {
        const int col0 = u.pn * 256 + wc * 32 + 8 * fq;
        f32x4 bv[2][2];
#pragma unroll
        for (int bj = 0; bj < 2; ++bj)
#pragma unroll
            for (int n = 0; n < 2; ++n) bv[bj][n] = *(const f32x4*)(bias + (size_t)u.e * 2048 + col0 + bj * 128 + 4 * n);
#pragma unroll
        for (int ai = 0; ai < 2; ++ai)
#pragma unroll
            for (int m = 0; m < 4; ++m) {
                const int r = ai * 128 + wr * 64 + m * 16 + fr;
                if (r < u.rows) {
                    const int pair = list[(size_t)u.e * NPAIR + u.m0 + r];
                    const float wv = wgt[pair];
#pragma unroll
                    for (int bj = 0; bj < 2; ++bj) {
                        const f32x4 v0 = (acc[ai][bj][m][0] * (F8 ? W8INV : 1.f) + bv[bj][0]) * wv, v1 = (acc[ai][bj][m][1] * (F8 ? W8INV : 1.f) + bv[bj][1]) * wv;
                        *(u32x4*)(YP + (size_t)pair * 2048 + col0 + bj * 128) =
                            (u32x4){pg8::cvt_pk_bf16(v0[0], v0[1]), pg8::cvt_pk_bf16(v0[2], v0[3]), pg8::cvt_pk_bf16(v1[0], v1[1]), pg8::cvt_pk_bf16(v1[2], v1[3])};
                    }
                }
            }
    }
};
__device__ __forceinline__ void phase9(const MkArgs& a, Frame& F) {
    unsigned char* ws = a.ws;
    LAS int* cnt; LAS int* tstart; moe_tables(a, F, cnt, tstart);
#if MOE_FP8
    MoeSched S{(const bf16_t*)(ws + wsf::H2F8), 2, (const bf16_t*)(ws + wsf::WGU8), (size_t)4096 * 1024, 1024, 16, (const int*)(ws + wsf::LIST), tstart, cnt, __builtin_amdgcn_readfirstlane(tstart[NE]), F.G, F.bid, F.wave};
    EpiGateUpT<true> E{(bf16_t*)(ws + wsf::ACT8), a.b_gate_up, (const int*)(ws + wsf::LIST)};
    pg8::gemm_phase<EpiGateUpT<true>, MoeSched, true>(F.lds, S, E);
#else
    MoeSched S{(const bf16_t*)(ws + wsf::H2), 2, (const bf16_t*)(ws + wsf::WGU_T), (size_t)4096 * 2048, 2048, 16, (const int*)(ws + wsf::LIST), tstart, cnt, __builtin_amdgcn_readfirstlane(tstart[NE]), F.G, F.bid, F.wave};
    EpiGateUpT<false> E{(bf16_t*)(ws + wsf::ACT), a.b_gate_up, (const int*)(ws + wsf::LIST)};
    pg8::gemm_phase<EpiGateUpT<false>, MoeSched, false>(F.lds, S, E);
#endif
}
__device__ __forceinline__ void phase10(const MkArgs& a, Frame& F) {
    unsigned char* ws = a.ws;
    LAS int* cnt; LAS int* tstart; moe_tables(a, F, cnt, tstart);
    const float* wgt = a.route_w ? a.route_w : (const float*)(ws + wsf::TOPW);
#if MOE_FP8
    MoeSched S{(const bf16_t*)(ws + wsf::ACT8), 0, (const bf16_t*)(ws + wsf::WDN8), (size_t)2048 * 1024, 1024, 8, (const int*)(ws + wsf::LIST), tstart, cnt, __builtin_amdgcn_readfirstlane(tstart[NE]), F.G, F.bid, F.wave};
    EpiDownT<true> E{(bf16_t*)(ws + wsf::YP), a.b_down, (const int*)(ws + wsf::LIST), wgt};
    pg8::gemm_phase<EpiDownT<true>, MoeSched, true>(F.lds, S, E);
#else
    MoeSched S{(const bf16_t*)(ws + wsf::ACT), 0, (const bf16_t*)(ws + wsf::WDN_T), (size_t)2048 * 2048, 2048, 8, (const int*)(ws + wsf::LIST), tstart, cnt, __builtin_amdgcn_readfirstlane(tstart[NE]), F.G, F.bid, F.wave};
    EpiDownT<false> E{(bf16_t*)(ws + wsf::YP), a.b_down, (const int*)(ws + wsf::LIST), wgt};
    pg8::gemm_phase<EpiDownT<false>, MoeSched, false>(F.lds, S, E);
#endif
}

__device__ __forceinline__ void phase11(const MkArgs& a, Frame& F) {
    const int f_tid = fresh_tid(F), f_lane = f_tid & 63, f_wave = F.wave;
    unsigned char* ws = a.ws;
    const float* mod = (const float*)(ws + wsf::MOD);
    const bf16_t* YPp = (const bf16_t*)(ws + wsf::YP);
    const float* X1p = (const float*)(ws + wsf::X1);
    const int gw = F.vcu * fp::NW + f_wave, NGW = F.G * fp::NW, lane = f_lane;
    for (int m = gw; m < NTOK; m += NGW) {
        const int b = m / S;
        float yv[32];
#pragma unroll
        for (int i = 0; i < 32; ++i) yv[i] = 0.f;
#pragma unroll
        for (int k = 0; k < 4; ++k)
#pragma unroll
            for (int j = 0; j < 4; ++j) { const u32x4 v = *(const u32x4*)(YPp + ((size_t)m * 4 + k) * 2048 + 8 * (64 * j + lane)); float f[8]; unpack8(v, f);
#pragma unroll
                for (int e = 0; e < 8; ++e) yv[8 * j + e] += f[e]; }
        float ss = 0.f;
#pragma unroll
        for (int i = 0; i < 32; ++i) ss += yv[i] * yv[i];
        const float r = rsqrtf(wave_sum_f(ss) * (1.f / D) + EPS);
#pragma unroll
        for (int j = 0; j < 4; ++j) {
            const int c0 = 8 * (64 * j + lane);
#pragma unroll
            for (int hq = 0; hq < 2; ++hq) {
                const f32x4 xv = *(const f32x4*)(X1p + (size_t)m * D + c0 + 4 * hq);
                const f32x4 gt = *(const f32x4*)(mod + b * MODW + MOD_GT2 + c0 + 4 * hq), gp = *(const f32x4*)(a.g_post_ffn + c0 + 4 * hq);
                f32x4 o;
                o.x = xv.x + gt.x * (yv[8 * j + 4 * hq + 0] * r * gp.x); o.y = xv.y + gt.y * (yv[8 * j + 4 * hq + 1] * r * gp.y);
                o.z = xv.z + gt.z * (yv[8 * j + 4 * hq + 2] * r * gp.z); o.w = xv.w + gt.w * (yv[8 * j + 4 * hq + 3] * r * gp.w);
                *(f32x4*)(a.out + (size_t)m * D + c0 + 4 * hq) = o;
            }
        }
    }
}
constexpr int N_PHASES = 12;
#ifndef REP_MASK
#define REP_MASK 0
#endif
__global__ void __launch_bounds__(fp::NT, 2) mk_fwd(MkArgs a) {
    extern __shared__ __attribute__((aligned(16))) unsigned char lds_raw[];
    Frame F;
    F.lds = (LAS unsigned char*)lds_raw;
    F.wave = __builtin_amdgcn_readfirstlane((int)threadIdx.x >> 6);
    F.G = gridDim.x; F.bid = blockIdx.x; F.vcu = (F.G % 8 == 0) ? (F.bid % 8) * (F.G / 8) + F.bid / 8 : F.bid;
    volatile LAS unsigned* misc = (volatile LAS unsigned*)(F.lds + LDS_MISC);
    if (F.wave == 0) misc[lane_id()] = 0u;
    __syncthreads();
    XcdBarrier bar = xcd_barrier_post((unsigned*)(a.ws + wsf::CTL) + wsf::CW_BAR, misc + 8, F.wave == 0 && lane_id() == 0);
    const int lo = a.ph_lo, hi = a.ph_hi;
#define IN(k) (lo <= (k) && (k) < hi)
#define SEAM(k) do { if (IN(k) && IN((k) + 1)) xcd_barrier(bar, F.wave == 0 && lane_id() == 0); } while (0)
    if (IN(0)) { phase0(a, F); if ((REP_MASK >> 0) & 1) phase0(a, F); } SEAM(0);
    if (IN(1)) { phase1(a, F); if ((REP_MASK >> 1) & 1) phase1(a, F); } SEAM(1);
    if (IN(2)) { phase2(a, F); if ((REP_MASK >> 2) & 1) phase2(a, F); } SEAM(2);
#if NPH > 3
    if (IN(3)) { phase3(a, F); if ((REP_MASK >> 3) & 1) phase3(a, F); } SEAM(3);
#endif
#if NPH > 4
    if (IN(4)) { phase4(a, F); if ((REP_MASK >> 4) & 1) phase4(a, F); } SEAM(4);
#endif
#if NPH > 5
    if (IN(5)) { phase5(a, F); if ((REP_MASK >> 5) & 1) phase5(a, F); } SEAM(5);
#endif
#if NPH > 6
    if (IN(6)) { phase6(a, F); if ((REP_MASK >> 6) & 1) phase6(a, F); } SEAM(6);
#endif
#if NPH > 7
    if (IN(7)) { phase7(a, F); if ((REP_MASK >> 7) & 1) phase7(a, F); } SEAM(7);
#endif
#if NPH > 8
    if (IN(8)) { phase8(a, F); if ((REP_MASK >> 8) & 1) phase8(a, F); } SEAM(8);
#endif
#if NPH > 9
    if (IN(9)) { phase9(a, F); if ((REP_MASK >> 9) & 1) phase9(a, F); } SEAM(9);
#endif
#if NPH > 10
    if (IN(10)) { phase10(a, F); if ((REP_MASK >> 10) & 1) phase10(a, F); } SEAM(10);
#endif
#if NPH > 11
    if (IN(11)) { phase11(a, F); if ((REP_MASK >> 11) & 1) phase11(a, F); }
#endif
#undef IN
#undef SEAM
}

static void fill_args(MkArgs& a, void* const* d_in, void* d_out, void* d_ws) {
    a.x = (const float*)d_in[0]; a.c = (const float*)d_in[1]; a.positions = (const int*)d_in[2]; a.w_ada = (const float*)d_in[3]; a.b_ada = (const float*)d_in[4];
    a.g_pre_mix = (const float*)d_in[5]; a.g_post_mix = (const float*)d_in[6]; a.g_pre_ffn = (const float*)d_in[7]; a.g_post_ffn = (const float*)d_in[8];
    a.w_in = (const float*)d_in[9]; a.b_in = (const float*)d_in[10]; a.conv_qk = (const float*)d_in[11]; a.sinks = (const float*)d_in[12]; a.g_mlstm = (const float*)d_in[13];
    a.w_attn_proj = (const float*)d_in[14]; a.w_mlstm_proj = (const float*)d_in[15]; a.w_out = (const float*)d_in[16]; a.w_router = (const float*)d_in[17]; a.b_router = (const float*)d_in[18];
    a.w_gate_up = (const float*)d_in[19]; a.b_gate_up = (const float*)d_in[20]; a.w_down = (const float*)d_in[21]; a.b_down = (const float*)d_in[22];
    a.out = (float*)d_out; a.ws = (unsigned char*)d_ws; a.route_i = nullptr; a.route_w = nullptr; a.ph_lo = 0; a.ph_hi = 0;
}
static int mk_setup() {
    static int grid = 0;
    if (grid == 0) {
        int dev = 0, cus = 0;
        if (hipGetDevice(&dev) != hipSuccess || hipDeviceGetAttribute(&cus, hipDeviceAttributeMultiprocessorCount, dev) != hipSuccess) { grid = -1; return grid; }
        if (hipFuncSetAttribute((const void*)mk_fwd, hipFuncAttributeMaxDynamicSharedMemorySize, LDS_BYTES) != hipSuccess) { grid = -1; return grid; }
        int per_cu = 0;
        if (hipOccupancyMaxActiveBlocksPerMultiprocessor(&per_cu, (const void*)mk_fwd, fp::NT, LDS_BYTES) != hipSuccess || per_cu < 1) { (void)hipGetLastError(); }
        grid = cus;
    }
    return grid;
}

extern "C" void kernel_launch(void* const* d_in, const int* in_sizes, int n_in, void* d_out, int out_size, void* d_ws, size_t ws_size, hipStream_t stream) {
    if (n_in != 23 || ws_size < wsf::END) return;
    const int grid = mk_setup();
    if (grid <= 0) return;
    if (hipMemsetAsync((unsigned char*)d_ws + wsf::CTL, 0, 65536, stream) != hipSuccess) return;
    MkArgs a{}; fill_args(a, d_in, d_out, d_ws);
    a.ph_lo = 0; a.ph_hi = N_PHASES;
    hipLaunchKernelGGL(mk_fwd, dim3(grid), dim3(fp::NT), LDS_BYTES, stream, a);
}
```

```cpp
#include <hip/hip_runtime.h>
#include <stdint.h>
#include <math.h>
#define NPH 12
#define MOE_FP8 1
#define REP_MASK 0
#define CONV_WGS 80
#define DRY_PROBE 0
#define EPI_SKIP_PROBE 0
#define CONV_SPLIT 900
namespace cfg {
constexpr int D = 2048, NB = 2, S = 8192, NTOK = NB * S;
constexpr int HQ = 16, HKV = 2, HD = 64, QW = 1024;
constexpr int MH = 4, MDV = 256, MDK = 128, MQKW = 512, MVW = 1024, CL = 128, NC = S / CL;
constexpr int NE = 32, TOPK = 4, DFF = 2048, NPAIR = NTOK * TOPK;
constexpr int INW = 8456;
constexpr int OFF_AQ = 0, OFF_AK = 1024, OFF_AV = 1152, OFF_MQ = 1280, OFF_MK = 1792, OFF_MV = 2304, OFF_MO = 3328,
              OFF_MI = 4352, OFF_MF = 4356, OFF_GA = 4360, OFF_GM = 6408;
constexpr float EPS = 1e-6f;
constexpr int MOD_SH1 = 0, MOD_SC1 = 2048, MOD_GT1 = 4096, MOD_SH2 = 6144, MOD_SC2 = 8192, MOD_GT2 = 10240, MODW = 12288;
}
using namespace cfg;
__device__ __forceinline__ float silu_f(float x) { return x / (1.f + expf(-x)); }
__device__ __forceinline__ float sigmoid_f(float x) { return 1.f / (1.f + expf(-x)); }
__device__ __forceinline__ void rope_cs(int pos, int i, float& c, float& s) {
    const float invf[8] = {1.0f, 0.1939227432012558f, 0.03760603070259094f, 0.007292664609849453f,
                           0.0014142135623842478f, 0.00027424818836152554f, 5.3182957344688475e-05f, 1.0313385246263351e-05f};
    float f = i == 0 ? invf[0] : i == 1 ? invf[1] : i == 2 ? invf[2] : i == 3 ? invf[3] : i == 4 ? invf[4] : i == 5 ? invf[5] : i == 6 ? invf[6] : invf[7];
    float ang = (float)pos * f;
    double t = (double)ang * 0.15915494309189535;
    t -= rint(t);
    float tf = (float)t;
    s = __builtin_amdgcn_sinf(tf);
    c = __builtin_amdgcn_cosf(tf);
}
__device__ __forceinline__ float softcap_f(float z) { return 15.f * tanhf(z / 15.f); }
__device__ __forceinline__ float logsigmoid_f(float z) { return fminf(z, 0.f) - log1pf(expf(-fabsf(z))); }
#define GAS __attribute__((address_space(1)))
#define LAS __attribute__((address_space(3)))
typedef unsigned short bf16_t;
typedef short bf16x8 __attribute__((ext_vector_type(8)));
typedef short bf16x4 __attribute__((ext_vector_type(4)));
typedef float f32x4 __attribute__((ext_vector_type(4)));
typedef float f32x2 __attribute__((ext_vector_type(2)));
typedef unsigned u32x4 __attribute__((ext_vector_type(4)));
typedef unsigned u32x2 __attribute__((ext_vector_type(2)));
#define RLX_AGENT __ATOMIC_RELAXED, __HIP_MEMORY_SCOPE_AGENT
#define LDS_WAIT() asm volatile("s_waitcnt lgkmcnt(0)" ::: "memory")
#define VM_WAIT() asm volatile("s_waitcnt vmcnt(0)" ::: "memory")

__device__ __forceinline__ unsigned f2bf(float f) { unsigned u = __builtin_bit_cast(unsigned, f); return (u + 0x7fffu + ((u >> 16) & 1u)) >> 16; }
__device__ __forceinline__ unsigned pk2(float lo, float hi) { return f2bf(lo) | (f2bf(hi) << 16); }
__device__ __forceinline__ float bf2f(unsigned short h) { return __builtin_bit_cast(float, (unsigned)h << 16); }
__device__ __forceinline__ float bflo(unsigned w) { return __builtin_bit_cast(float, w << 16); }
__device__ __forceinline__ float bfhi(unsigned w) { return __builtin_bit_cast(float, w & 0xffff0000u); }
__device__ __forceinline__ unsigned pk4_fp8(float a, float b, float c, float d) {
    a = __builtin_amdgcn_fmed3f(a, -448.f, 448.f); b = __builtin_amdgcn_fmed3f(b, -448.f, 448.f); c = __builtin_amdgcn_fmed3f(c, -448.f, 448.f); d = __builtin_amdgcn_fmed3f(d, -448.f, 448.f);
    int r = __builtin_amdgcn_cvt_pk_fp8_f32(a, b, 0, false); r = __builtin_amdgcn_cvt_pk_fp8_f32(c, d, r, true); return (unsigned)r;
}
constexpr float W8SCALE = 64.f, W8INV = 1.f / 64.f;
__device__ __forceinline__ float fast_sigmoid(float x) { return __builtin_amdgcn_rcpf(1.f + __builtin_amdgcn_exp2f(-1.4426950408889634f * x)); }

namespace fp {
constexpr int NW = 8, NT = NW * 64;
constexpr int NIN = 8448;
constexpr int PB_Q = 0, PB_K = 1024, PB_V = 1152, PB_MQ = 1280, PB_MK = 1792, PB_MV = 2304, PB_MO = 3328, PB_GA = 4352, PB_GM = 6400;
constexpr float QSCALE = 0.125f * 1.4426950408889634f;
constexpr float LOG2E = 1.4426950408889634f;
}

namespace wsf {
constexpr size_t AL(size_t x) { return (x + 255) & ~(size_t)255; }
constexpr size_t CTL = 0, CTL_BYTES = 1u << 20;
constexpr size_t MODP = CTL + CTL_BYTES;
constexpr size_t MOD = AL(MODP + (size_t)16 * 2 * MODW * 4);
constexpr size_t BINP = AL(MOD + (size_t)2 * MODW * 4);
constexpr size_t CS = AL(BINP + (size_t)fp::NIN * 4);
constexpr size_t WRT = AL(CS + (size_t)NTOK * 8 * 8);
constexpr size_t WIN_T = AL(WRT + (size_t)2 * 32 * 2048 * 2);
constexpr size_t WAP_T = AL(WIN_T + (size_t)fp::NIN * 2048 * 2);
constexpr size_t WMP_T = AL(WAP_T + (size_t)2048 * 1024 * 2);
constexpr size_t WOUT_T = AL(WMP_T + (size_t)2048 * 1024 * 2);
constexpr size_t WGU_T = AL(WOUT_T + (size_t)2048 * 2048 * 2);
#if MOE_FP8
constexpr size_t WDN_T = WGU_T;
constexpr size_t GATES = WGU_T;
#else
constexpr size_t WDN_T = AL(WGU_T + (size_t)32 * 4096 * 2048 * 2);
constexpr size_t GATES = AL(WDN_T + (size_t)32 * 2048 * 2048 * 2);
#endif
constexpr size_t BCUM = AL(GATES + (size_t)NTOK * 8 * 4);
constexpr size_t LOGI = AL(BCUM + (size_t)8 * S * 4);
constexpr size_t GSUM = AL(LOGI + (size_t)8 * S * 4);
constexpr size_t MLOC = AL(GSUM + 512 * 4);
constexpr size_t MPREV = AL(MLOC + 512 * 4);
constexpr size_t DN = AL(MPREV + 512 * 4);
constexpr size_t NPREV = AL(DN + (size_t)512 * 128 * 4);
constexpr size_t DCT = AL(NPREV + (size_t)512 * 128 * 4);
constexpr size_t Y = AL(DCT + (size_t)512 * 256 * 128 * 4);
constexpr size_t X1 = AL(Y + (size_t)NTOK * 2048 * 2);
constexpr size_t H2 = AL(X1 + (size_t)NTOK * 2048 * 4);
constexpr size_t TOPI = AL(H2 + (size_t)NTOK * 2048 * 2);
constexpr size_t TOPW = AL(TOPI + (size_t)NPAIR * 4);
constexpr size_t LIST = AL(TOPW + (size_t)NPAIR * 4);
constexpr size_t PROJB = AL(LIST + (size_t)NE * NPAIR * 4);
constexpr size_t ACT = PROJB;
constexpr size_t YPREG = AL(PROJB + (size_t)NTOK * fp::NIN * 2);
constexpr size_t H1 = YPREG;
constexpr size_t MG = AL(H1 + (size_t)NTOK * 2048 * 2);
constexpr size_t OAT = AL(MG + (size_t)NTOK * 2048 * 2);
constexpr size_t HM = AL(OAT + (size_t)NTOK * 1024 * 2);
constexpr size_t QC = AL(HM + (size_t)NTOK * 1024 * 2);
constexpr size_t KC = AL(QC + (size_t)NTOK * 512 * 2);
constexpr size_t CPT = AL(KC + (size_t)NTOK * 512 * 2);
constexpr size_t YP = YPREG;
constexpr size_t F8BASE = AL(CPT + (size_t)512 * 256 * 128 * 2) > AL(YP + (size_t)NPAIR * 2048 * 2) ? AL(CPT + (size_t)512 * 256 * 128 * 2) : AL(YP + (size_t)NPAIR * 2048 * 2);
constexpr size_t WGU8 = F8BASE;
constexpr size_t WDN8 = AL(WGU8 + (size_t)32 * 4096 * 2048);
constexpr size_t H2F8 = AL(WDN8 + (size_t)32 * 2048 * 2048);
constexpr size_t ACT8 = AL(H2F8 + (size_t)NTOK * 2048);
constexpr size_t END = AL(ACT8 + (size_t)NPAIR * 2048);
static_assert((size_t)NPAIR * 2048 * 2 <= (size_t)NTOK * fp::NIN * 2, "ACT fits over PROJB");
constexpr int CW_BAR = 4096;
constexpr int CW_CNT = 8192;
}

constexpr int RING_BYTES = 131072;
constexpr int LDS_TAB = RING_BYTES;
constexpr int LDS_MISC = RING_BYTES + 8192;
constexpr int LDS_BYTES = 147456;

#define XB_TMO      128
#define XB_XCNT(j)  (256  + 64 * (j))
#define XB_XSUB(j)  (1280 + 64 * (j))
#define XB_XGEN(j)  (2304 + 64 * (j))
#define XB_TOP      3328
#define XB_TOPGEN   3392
#define XCD_BAR_WORDS 3456
#define XB_SPIN_CAP (1u << 18)
__device__ __forceinline__ unsigned xb_ld(unsigned* p)              { return __hip_atomic_load(p, __ATOMIC_RELAXED, __HIP_MEMORY_SCOPE_AGENT); }
__device__ __forceinline__ unsigned xb_add(unsigned* p, unsigned v) { return __hip_atomic_fetch_add(p, v, __ATOMIC_RELAXED, __HIP_MEMORY_SCOPE_AGENT); }
__device__ __forceinline__ unsigned xb_xcc_id() { return (unsigned)__builtin_amdgcn_s_getreg((3 << 11) | 20) & 0xFu; }
#define XB_SPIN(cond, bar) do { unsigned _sp = 0; while (cond) { __builtin_amdgcn_s_sleep(1); \
    if ((++_sp & 255u) == 0u) { if (xb_ld(&(bar)[XB_TMO])) break; if (_sp > XB_SPIN_CAP) { atomicAdd(&(bar)[XB_TMO], 1u); break; } } } } while (0)
struct XcdBarrier { unsigned* bar; unsigned x; volatile LAS unsigned* st; };
__device__ __forceinline__ XcdBarrier xcd_barrier_post(unsigned* bar, volatile LAS unsigned* st, bool t0) {
    XcdBarrier b; b.bar = bar; b.x = xb_xcc_id(); b.st = st;
    if (t0) (void)xb_add(&bar[XB_XCNT(b.x)], 1u);
    return b;
}
__device__ __forceinline__ void xcd_barrier_complete(unsigned* bar, unsigned x, unsigned& nloc, unsigned& nx) {
    const unsigned G = gridDim.x * gridDim.y * gridDim.z;
    unsigned sum, cnt, mine, sp = 0u;
    for (;;) {
        sum = 0u; cnt = 0u; mine = 0u;
#pragma unroll
        for (unsigned j = 0; j < 16; ++j) { const unsigned c = xb_ld(&bar[XB_XCNT(j)]); sum += c; cnt += (c > 0u) ? 1u : 0u; mine = (j == x) ? c : mine; }
        if (sum == G) break;
        __builtin_amdgcn_s_sleep(1);
        if ((++sp & 255u) == 0u) { if (xb_ld(&bar[XB_TMO])) break; if (sp > XB_SPIN_CAP) { atomicAdd(&bar[XB_TMO], 1u); break; } }
    }
    nloc = mine > 0u ? mine : 1u; nx = cnt > 0u ? cnt : 1u;
}
__device__ __forceinline__ void xcd_barrier(const XcdBarrier& b, bool t0) {
    asm volatile("s_waitcnt vmcnt(0)" ::: "memory");
    __syncthreads();
    if (t0) {
        unsigned* bar = b.bar;
        __builtin_amdgcn_s_waitcnt(0);
        unsigned nloc = b.st[0], nx = b.st[1];
        if (nloc == 0u) { xcd_barrier_complete(bar, b.x, nloc, nx); b.st[0] = nloc; b.st[1] = nx; }
        const unsigned old = xb_add(&bar[XB_XSUB(b.x)], 1u);
        const unsigned gen = old / nloc;
        if (old + 1u == (gen + 1u) * nloc) {
            __builtin_amdgcn_fence(__ATOMIC_RELEASE, "agent");
            asm volatile("s_waitcnt vmcnt(0)" ::: "memory");
            const unsigned og = xb_add(&bar[XB_TOP], 1u);
            const unsigned tg = og / nx;
            if (og + 1u == (tg + 1u) * nx) xb_add(&bar[XB_TOPGEN], 1u);
            else XB_SPIN(xb_ld(&bar[XB_TOPGEN]) == tg, bar);
            __builtin_amdgcn_fence(__ATOMIC_ACQUIRE, "agent");
            xb_add(&bar[XB_XGEN(b.x)], 1u);
            asm volatile("s_waitcnt vmcnt(0)" ::: "memory");
        } else {
            XB_SPIN(xb_ld(&bar[XB_XGEN(b.x)]) == gen, bar);
            __builtin_amdgcn_fence(__ATOMIC_ACQUIRE, "agent");
            asm volatile("s_waitcnt vmcnt(0)" ::: "memory");
        }
    }
    __syncthreads();
}

namespace pg8 {
constexpr int BM = 256, BK = 64, HALF = 128, HTB = HALF * BK * 2, STAGE_BYTES = 8 * HTB, NXCD = 8, WGM = 8;
__host__ __device__ __forceinline__ int lds_byte(int r, int c) { const int st = (r >> 4) * 2 + (c >> 5), rr = r & 15, cc = c & 31, ob = rr * 64 + cc * 2; return st * 1024 + (ob ^ (((ob >> 9) & 1) << 5)); }
__host__ __device__ __forceinline__ void stage_rc(int b, int& R, int& C) { const int st = b / 1024, sb = b % 1024, swz = sb ^ (((sb >> 9) & 1) << 5); R = (st >> 1) * 16 + swz / 64; C = (st & 1) * 32 + (swz % 64) / 2; }
__host__ __device__ __forceinline__ int perm32(int rho) { const int n = rho >> 4, i = rho & 15; return 8 * (i >> 2) + 4 * n + (i & 3); }
typedef int v8i32_t __attribute__((ext_vector_type(8)));
template <bool F8> struct FragSel { typedef bf16x8 T; };
typedef short s16x16_t __attribute__((ext_vector_type(16)));
template <> struct FragSel<true> { typedef s16x16_t T; };
template <bool F8> __device__ __forceinline__ typename FragSel<F8>::T ld_frag(const LAS unsigned char* p) {
    if constexpr (F8) { const bf16x8 lo = *(const LAS bf16x8*)p, hi = *(const LAS bf16x8*)(p + 16); return __builtin_shufflevector(lo, hi, 0, 1, 2, 3, 4, 5, 6, 7, 8, 9, 10, 11, 12, 13, 14, 15); }
    else return *(const LAS bf16x8*)p;
}
__device__ __forceinline__ f32x4 mma_frag(bf16x8 a, bf16x8 b, f32x4 c) { return __builtin_amdgcn_mfma_f32_16x16x32_bf16(a, b, c, 0, 0, 0); }
__device__ __forceinline__ f32x4 mma_frag(s16x16_t a, s16x16_t b, f32x4 c) {
    const v8i32_t av = __builtin_bit_cast(v8i32_t, a), bv = __builtin_bit_cast(v8i32_t, b);
    asm volatile("v_mfma_scale_f32_16x16x128_f8f6f4 %0, %1, %2, %0, %3, %3 op_sel_hi:[0,0,0]" : "+v"(c) : "v"(av), "v"(bv), "v"(0x7f7f7f7f));
    return c;
}
__device__ __forceinline__ unsigned cvt_pk_bf16(float lo, float hi) { unsigned r; asm volatile("v_cvt_pk_bf16_f32 %0, %1, %2" : "=v"(r) : "v"(lo), "v"(hi)); return r; }

__device__ __forceinline__ bool static_tile(int L, int nM, int nN, int& pm, int& pn) {
    const int nwg = nM * nN; if (L >= nwg) return false;
    int wgid = L; { const int q = nwg / NXCD, r = nwg % NXCD, xcd = wgid % NXCD, off = wgid / NXCD; wgid = (xcd < r ? xcd * (q + 1) : r * (q + 1) + (xcd - r) * q) + off; }
    const int nig = WGM * nN, gid = wgid / nig, fm = gid * WGM, gsz = (nM - fm) < WGM ? (nM - fm) : WGM;
    pm = fm + ((wgid % nig) % gsz); pn = (wgid % nig) / gsz; return true;
}

typedef int v8i32 __attribute__((ext_vector_type(8)));
template <class Epi, class Sched, bool FP8 = false>
__device__ __forceinline__ void gemm_phase(LAS unsigned char* lds, const Sched& S, const Epi& E) {
    typedef typename Sched::UnitT Unit;
    const int wid = S.wave, lane = (int)__builtin_amdgcn_mbcnt_hi(~0u, __builtin_amdgcn_mbcnt_lo(~0u, 0u)), tid = (wid << 6) | lane, wr = wid >> 2, wc = wid & 3, fr = lane & 15, fq = lane >> 4;
    const int K = S.K, nt = K / BK;
    int R[2], C[2];
    unsigned voffB[2];
#pragma unroll
    for (int i = 0; i < 2; ++i) { stage_rc(tid * 16 + i * 8192, R[i], C[i]); const int Rb = (R[i] & ~31) + perm32(R[i] & 31); voffB[i] = (unsigned)(Rb * K + C[i]) * 2u; }
    const unsigned kstep = (unsigned)(BK * 2);
    const unsigned hstepB = (unsigned)HALF * (unsigned)K * 2u;
    const unsigned ldsw = (unsigned)wid * 1024u;
    const int aoff = lds_byte(wr * 64 + fr, FP8 ? fq * 16 : fq * 8), boff = lds_byte(wc * 32 + fr, FP8 ? fq * 16 : fq * 8);
#define PG8_SA(b, h) (((b) * 2 + (h)) * HTB)
#define PG8_SB(b, h) ((4 + (b) * 2 + (h)) * HTB)
    const __amdgpu_buffer_rsrc_t rA = __builtin_amdgcn_make_buffer_rsrc((void*)S.a_buf(), 0, -1, 0x00020000), rB = __builtin_amdgcn_make_buffer_rsrc((void*)S.b_buf(), 0, -1, 0x00020000);
#define PG8_STAGE2(bufoff, rs, soff, o0, o1) do { \
        __builtin_amdgcn_raw_ptr_buffer_load_lds(rs, (LAS void*)(lds + (bufoff) + ldsw), 16, (int)(o0), (int)(soff), 0, 0); \
        __builtin_amdgcn_raw_ptr_buffer_load_lds(rs, (LAS void*)(lds + (bufoff) + ldsw + 8192), 16, (int)(o1), (int)(soff), 0, 0); } while (0)
#define PG8_STAGEA(bufoff, soff, o0, o1) PG8_STAGE2(bufoff, rA, soff, o0, o1)
#define PG8_STAGEB(bufoff, soff) PG8_STAGE2(bufoff, rB, soff, voffB[0], voffB[1])
    typedef typename pg8::FragSel<FP8>::T FragT;
    constexpr int NK = FP8 ? 1 : 2;
#define PG8_LDA(dst, b, h) do { _Pragma("unroll") for (int m = 0; m < 4; ++m) _Pragma("unroll") for (int k = 0; k < NK; ++k) dst[m][k] = pg8::ld_frag<FP8>(lds + PG8_SA(b, h) + aoff + m * 2048 + k * 1024); } while (0)
#define PG8_LDB(dst, b, h) do { _Pragma("unroll") for (int n = 0; n < 2; ++n) _Pragma("unroll") for (int k = 0; k < NK; ++k) dst[n][k] = pg8::ld_frag<FP8>(lds + PG8_SB(b, h) + boff + n * 2048 + k * 1024); } while (0)
#define PG8_MMA(ai, bj, At, Bt) do { __builtin_amdgcn_s_setprio(1); if constexpr (FP8) asm volatile("s_nop 1"); _Pragma("unroll") for (int m = 0; m < 4; ++m) _Pragma("unroll") for (int n = 0; n < 2; ++n) _Pragma("unroll") for (int k = 0; k < NK; ++k) \
        acc[ai][bj][m][n] = pg8::mma_frag(Bt[n][k], At[m][k], acc[ai][bj][m][n]); __builtin_amdgcn_s_setprio(0); } while (0)
#define PG8_WAIT_V(n) asm volatile("s_waitcnt vmcnt(" #n ")" ::: "memory")
#define PG8_WAIT_L(n) asm volatile("s_waitcnt lgkmcnt(" #n ")" ::: "memory")
#define PG8_BAR __builtin_amdgcn_s_barrier()
#define PG8_SCHED __builtin_amdgcn_sched_barrier(0)
    Unit cur, nxt; int ui = 0;
    if (!S.next(0, cur)) return;
    f32x4 acc[2][2][4][2];
#pragma unroll
    for (int a = 0; a < 2; ++a)
#pragma unroll
        for (int b = 0; b < 2; ++b)
#pragma unroll
            for (int m = 0; m < 4; ++m)
#pragma unroll
                for (int n = 0; n < 2; ++n) { float z0, z1, z2, z3; asm volatile("v_mov_b32 %0, 0\n\tv_mov_b32 %1, 0\n\tv_mov_b32 %2, 0\n\tv_mov_b32 %3, 0" : "=v"(z0), "=v"(z1), "=v"(z2), "=v"(z3)); acc[a][b][m][n] = (f32x4){z0, z1, z2, z3}; }
    FragT At[4][NK], B0[2][NK], B1[2][NK];
    unsigned ca[4], na[4];
    S.a_offs(cur, R[0], R[1], C[0], C[1], ca);
    unsigned cA = (unsigned)__builtin_amdgcn_readfirstlane((int)S.a_soff(cur)), cB = (unsigned)__builtin_amdgcn_readfirstlane((int)S.b_soff(cur));
    PG8_STAGEB(PG8_SB(0, 0), cB); PG8_STAGEB(PG8_SB(0, 1), cB + hstepB); PG8_STAGEA(PG8_SA(0, 0), cA, ca[0], ca[1]); PG8_STAGEA(PG8_SA(0, 1), cA, ca[2], ca[3]);
    if (wr == 1) PG8_BAR;
    PG8_WAIT_V(2); PG8_BAR;
    PG8_STAGEB(PG8_SB(1, 0), cB + kstep); PG8_STAGEA(PG8_SA(1, 0), cA + kstep, ca[0], ca[1]); PG8_STAGEB(PG8_SB(1, 1), cB + hstepB + kstep);
    PG8_WAIT_V(6); PG8_BAR;
#define PG8_TRIP(a1, a2, b2, a3, b3, x0, x1, x2, x3) do { \
            PG8_LDB(B0, 0, 0); PG8_LDB(B1, 0, 1); PG8_SCHED; PG8_LDA(At, 0, 0); PG8_STAGEA(PG8_SA(1, 1), a1, ca[2], ca[3]); \
            PG8_WAIT_V(8); PG8_WAIT_L(0); PG8_BAR; PG8_MMA(0, 0, At, B0); PG8_MMA(0, 1, At, B1); PG8_BAR; PG8_SCHED; \
            PG8_LDA(At, 0, 1); PG8_STAGEB(PG8_SB(0, 0), b2); PG8_STAGEB(PG8_SB(0, 1), (b2) + hstepB); PG8_STAGEA(PG8_SA(0, 0), a2, x0, x1); \
            PG8_WAIT_V(8); PG8_WAIT_L(0); PG8_BAR; PG8_MMA(1, 0, At, B0); PG8_MMA(1, 1, At, B1); PG8_BAR; PG8_SCHED; \
            PG8_LDB(B0, 1, 0); PG8_LDB(B1, 1, 1); PG8_SCHED; PG8_LDA(At, 1, 0); PG8_STAGEA(PG8_SA(0, 1), a2, x2, x3); \
            PG8_WAIT_V(8); PG8_WAIT_L(0); PG8_BAR; PG8_MMA(0, 0, At, B0); PG8_MMA(0, 1, At, B1); PG8_BAR; PG8_SCHED; \
            PG8_LDA(At, 1, 1); PG8_STAGEB(PG8_SB(1, 0), b3); PG8_STAGEB(PG8_SB(1, 1), (b3) + hstepB); PG8_STAGEA(PG8_SA(1, 0), a3, x0, x1); \
            PG8_WAIT_V(8); PG8_WAIT_L(0); PG8_BAR; PG8_MMA(1, 0, At, B0); PG8_MMA(1, 1, At, B1); PG8_BAR; PG8_SCHED; } while (0)
    for (;;) {
        const bool has_next = S.next(ui + 1, nxt);
        unsigned nA = cA, nB = cB;
#pragma unroll
        for (int i = 0; i < 4; ++i) na[i] = ca[i];
        if (has_next) { nA = (unsigned)__builtin_amdgcn_readfirstlane((int)S.a_soff(nxt)); nB = (unsigned)__builtin_amdgcn_readfirstlane((int)S.b_soff(nxt)); S.a_offs(nxt, R[0], R[1], C[0], C[1], na); }
        for (int t = 0; t < nt; t += 2) {
            const bool last = (t == nt - 2);
            const unsigned a1 = cA + (unsigned)(t + 1) * kstep;
            const unsigned a2 = last ? nA : cA + (unsigned)(t + 2) * kstep, b2 = last ? nB : cB + (unsigned)(t + 2) * kstep;
            const unsigned x0 = last ? na[0] : ca[0], x1 = last ? na[1] : ca[1], x2 = last ? na[2] : ca[2], x3 = last ? na[3] : ca[3];
            PG8_TRIP(a1, a2, b2, a2 + kstep, b2 + kstep, x0, x1, x2, x3);
        }
        if (wr == 0) PG8_BAR;
        if constexpr (FP8) asm volatile("s_nop 15\n\ts_nop 15" ::: "memory");
        E(acc, cur, wr, wc, fr, fq);
        if (!has_next) break;
#pragma unroll
        for (int a = 0; a < 2; ++a)
#pragma unroll
            for (int b = 0; b < 2; ++b)
#pragma unroll
                for (int m = 0; m < 4; ++m)
#pragma unroll
                    for (int n = 0; n < 2; ++n) { float z0, z1, z2, z3; asm volatile("v_mov_b32 %0, 0\n\tv_mov_b32 %1, 0\n\tv_mov_b32 %2, 0\n\tv_mov_b32 %3, 0" : "=v"(z0), "=v"(z1), "=v"(z2), "=v"(z3)); acc[a][b][m][n] = (f32x4){z0, z1, z2, z3}; }
        cur = nxt; cA = nA; cB = nB; ++ui;
#pragma unroll
        for (int i = 0; i < 4; ++i) ca[i] = na[i];
        if (wr == 1) PG8_BAR;
    }
    PG8_WAIT_V(0);
    PG8_BAR;
#undef PG8_SA
#undef PG8_SB
#undef PG8_TRIP
#undef PG8_STAGE2
#undef PG8_STAGEA
#undef PG8_STAGEB
#undef PG8_LDA
#undef PG8_LDB
#undef PG8_MMA
#undef PG8_WAIT_V
#undef PG8_WAIT_L
#undef PG8_BAR
#undef PG8_SCHED
}
}

struct DenseUnit { int pm, pn; };
struct DenseSched {
    typedef DenseUnit UnitT;
    const bf16_t* A; const bf16_t* Bt; int lda; int K; int nM, nN, G, c, wave;
    __device__ __forceinline__ bool next(int i, DenseUnit& u) const { return pg8::static_tile(i * G + c, nM, nN, u.pm, u.pn); }
    __device__ __forceinline__ const void* a_buf() const { return A; }
    __device__ __forceinline__ const void* b_buf() const { return Bt; }
    __device__ __forceinline__ unsigned a_soff(const DenseUnit& u) const { return (unsigned)u.pm * 256u * (unsigned)lda * 2u; }
    __device__ __forceinline__ unsigned b_soff(const DenseUnit& u) const { return (unsigned)u.pn * 256u * (unsigned)K * 2u; }
    __device__ __forceinline__ void a_offs(const DenseUnit&, int R0, int R1, int C0, int C1, unsigned (&o)[4]) const {
        o[0] = (unsigned)(R0 * lda + C0) * 2u; o[1] = (unsigned)(R1 * lda + C1) * 2u; o[2] = (unsigned)((R0 + 128) * lda + C0) * 2u; o[3] = (unsigned)((R1 + 128) * lda + C1) * 2u;
    }
};
struct MkArgs {
    const float* x; const float* c; const int* positions; const float* w_ada; const float* b_ada;
    const float* g_pre_mix; const float* g_post_mix; const float* g_pre_ffn; const float* g_post_ffn;
    const float* w_in; const float* b_in; const float* conv_qk; const float* sinks; const float* g_mlstm;
    const float* w_attn_proj; const float* w_mlstm_proj; const float* w_out; const float* w_router; const float* b_router;
    const float* w_gate_up; const float* b_gate_up; const float* w_down; const float* b_down;
    float* out; unsigned char* ws;
    const int* route_i; const float* route_w;
    int ph_lo, ph_hi;
};

struct Frame {
    LAS unsigned char* lds;
    int G, bid, vcu, wave;
};
__device__ __forceinline__ int lane_id() { return (int)__builtin_amdgcn_mbcnt_hi(~0u, __builtin_amdgcn_mbcnt_lo(~0u, 0u)); }
__device__ __forceinline__ int fresh_tid(const Frame& F) { return (F.wave << 6) | lane_id(); }

__device__ __forceinline__ float wave_sum_f(float v) {
#pragma unroll
    for (int o = 1; o < 64; o <<= 1) v += __shfl_xor(v, o);
    return v;
}
__device__ __forceinline__ float wave_max_f(float v) {
#pragma unroll
    for (int o = 1; o < 64; o <<= 1) v = fmaxf(v, __shfl_xor(v, o));
    return v;
}

__device__ __forceinline__ int in_src_col(int n) {
    if (n < 1152) { const int d = n & 63; if (d < 16) return (n & ~63) + (d >> 1) + 8 * (d & 1); return n; }
    if (n < 4352) return n;
    return n + 8;
}

template <bool MAP>
__device__ __forceinline__ void p0_transpose_item(const float* __restrict__ W, int K, int N, bf16_t* WT, LAS float* scr, int kb, int nb, int lane) {
    const int k0 = 64 * kb, n0 = 32 * nb;
    const int sc = MAP ? in_src_col(n0 + (lane & 31)) : n0 + (lane & 31);
#pragma unroll 8
    for (int i = 0; i < 32; ++i) { const int kk = 2 * i + (lane >> 5); scr[kk * 33 + (lane & 31)] = W[(size_t)(k0 + kk) * N + sc]; }
    LDS_WAIT(); asm volatile("" ::: "memory");
    const int c = lane & 7;
#pragma unroll
    for (int j = 0; j < 4; ++j) { const int n = (lane >> 3) + 8 * j; const LAS float* s = scr + (8 * c) * 33 + n;
        u32x4 o; o.x = pk2(s[0 * 33], s[1 * 33]); o.y = pk2(s[2 * 33], s[3 * 33]); o.z = pk2(s[4 * 33], s[5 * 33]); o.w = pk2(s[6 * 33], s[7 * 33]);
        *(u32x4*)(WT + (size_t)(n0 + n) * K + k0 + 8 * c) = o; }
    LDS_WAIT(); asm volatile("" ::: "memory");
}

struct ConvItem { const float* src; unsigned char* dst; };
__device__ __forceinline__ ConvItem conv_item_addr(const MkArgs& a, int it, int lane, int& N) {
    constexpr int KB = 2048 / 128, I_GU = KB * (4096 / 32), I_DN = KB * (2048 / 32);
    const float* W; unsigned char* WT; int q, NB;
    if (it < NE * I_GU) { const int e = it / I_GU; q = it % I_GU; N = 4096; NB = 128; W = a.w_gate_up + (size_t)e * 2048 * 4096; WT = a.ws + wsf::WGU8 + (size_t)e * 4096 * 2048; }
    else { const int r = it - NE * I_GU, e = r / I_DN; q = r % I_DN; N = 2048; NB = 64; W = a.w_down + (size_t)e * 2048 * 2048; WT = a.ws + wsf::WDN8 + (size_t)e * 2048 * 2048; }
    const int k0 = 128 * (q / NB), n0 = 32 * (q % NB);
    ConvItem c; c.src = W + (size_t)(k0 + (lane >> 3)) * N + n0 + (lane & 7) * 4; c.dst = WT + (size_t)(n0 + (lane >> 3)) * 2048 + k0 + 16 * (lane & 7);
    return c;
}
__device__ __forceinline__ void conv_item_load(const ConvItem& c, int N, f32x4 (&v)[16]) {
#pragma unroll
    for (int i = 0; i < 16; ++i) v[i] = __builtin_nontemporal_load((const f32x4*)(c.src + (size_t)(8 * i) * N));
}
__device__ __forceinline__ void conv_item_store(const ConvItem& c, const f32x4 (&v)[16], LAS float* scr, int lane, bool dry = false) {
    const int kr = lane >> 3, n4 = (lane & 7) * 4;
#pragma unroll
    for (int i = 0; i < 16; ++i) { const int k = 8 * i + kr, rot = 20 * (i >> 1); LAS float* row = scr + k * 33;
        row[(n4 + 0 + rot) & 31] = v[i].x; row[(n4 + 1 + rot) & 31] = v[i].y; row[(n4 + 2 + rot) & 31] = v[i].z; row[(n4 + 3 + rot) & 31] = v[i].w; }
    LDS_WAIT(); asm volatile("" ::: "memory");
    const int cblk = lane & 7;
#pragma unroll
    for (int j = 0; j < 4; ++j) {
        const int n = (lane >> 3) + 8 * j;
        const LAS float* sp = scr + (16 * cblk) * 33 + ((n + 20 * cblk) & 31);
        u32x4 o;
        o.x = pk4_fp8(sp[0 * 33] * W8SCALE, sp[1 * 33] * W8SCALE, sp[2 * 33] * W8SCALE, sp[3 * 33] * W8SCALE);
        o.y = pk4_fp8(sp[4 * 33] * W8SCALE, sp[5 * 33] * W8SCALE, sp[6 * 33] * W8SCALE, sp[7 * 33] * W8SCALE);
        o.z = pk4_fp8(sp[8 * 33] * W8SCALE, sp[9 * 33] * W8SCALE, sp[10 * 33] * W8SCALE, sp[11 * 33] * W8SCALE);
        o.w = pk4_fp8(sp[12 * 33] * W8SCALE, sp[13 * 33] * W8SCALE, sp[14 * 33] * W8SCALE, sp[15 * 33] * W8SCALE);
        if (!dry) *(u32x4*)(c.dst + (size_t)(8 * j) * 2048) = o; else asm volatile("" :: "v"(o.x), "v"(o.y), "v"(o.z), "v"(o.w));
    }
    LDS_WAIT(); asm volatile("" ::: "memory");
}
__device__ __forceinline__ void moe_convert(const MkArgs& a, Frame& F, int widx, int nw, bool dry = false, int it0 = 0, int it1 = -1) {
    const int lane = lane_id();
    LAS float* scr = (LAS float*)(F.lds + F.wave * 16896);
    constexpr int NIT_ALL = NE * ((2048 / 128) * (4096 / 32) + (2048 / 128) * (2048 / 32));
    const int NIT = it1 < 0 ? NIT_ALL : it1;
    widx += it0;
    if (widx >= NIT) return;
    f32x4 va[16], vb[16]; int Na, Nb;
    ConvItem ca = conv_item_addr(a, widx, lane, Na), cb;
    conv_item_load(ca, Na, va);
    for (int it = widx; it < NIT; it += 2 * nw) {
        const int i1 = it + nw, i2 = it + 2 * nw;
        cb = conv_item_addr(a, i1 < NIT ? i1 : NIT - 1, lane, Nb); conv_item_load(cb, Nb, vb);
        conv_item_store(ca, va, scr, lane, dry);
        if (i1 >= NIT) break;
        ca = conv_item_addr(a, i2 < NIT ? i2 : NIT - 1, lane, Na); conv_item_load(ca, Na, va);
        conv_item_store(cb, vb, scr, lane, dry);
    }
}
__device__ __forceinline__ int n_conv_wgs(int G) { return G == 256 ? CONV_WGS : 0; }

struct TrItem { const float* src; bf16_t* dst; int N, perm; };
__device__ __forceinline__ TrItem tr_item_addr(const MkArgs& a, int it, int lane) {
    constexpr int I_IN = 32 * (fp::NIN / 32), I_AP = 16 * 64, I_MP = 16 * 64;
    const float* W; bf16_t* WT; int K, N, nblk, r = it, perm = 0, shift = 0;
    unsigned char* ws = a.ws;
    if (r < I_IN) { W = a.w_in; WT = (bf16_t*)(ws + wsf::WIN_T); K = 2048; N = INW; nblk = fp::NIN / 32; }
    else if ((r -= I_IN) < I_AP) { W = a.w_attn_proj; WT = (bf16_t*)(ws + wsf::WAP_T); K = 1024; N = 2048; nblk = 64; }
    else if ((r -= I_AP) < I_MP) { W = a.w_mlstm_proj; WT = (bf16_t*)(ws + wsf::WMP_T); K = 1024; N = 2048; nblk = 64; }
    else { r -= I_MP; W = a.w_out; WT = (bf16_t*)(ws + wsf::WOUT_T); K = 2048; N = 2048; nblk = 64; }
    const int kb = r / nblk, nb = r % nblk, k0 = 64 * kb, n0 = 32 * nb;
    if (it < I_IN) { perm = (n0 < 1152 && (n0 & 32) == 0) ? 1 : 0; shift = n0 >= 4352 ? 8 : 0; }
    TrItem t; t.src = W + (size_t)(k0 + (lane >> 3)) * N + n0 + shift + (lane & 7) * 4; t.dst = WT + (size_t)(n0 + (lane >> 3)) * K + k0 + 8 * (lane & 7); t.N = N; t.perm = perm | (K << 1);
    return t;
}
__device__ __forceinline__ void tr_item_load(const TrItem& t, f32x4 (&v)[8]) {
#pragma unroll
    for (int i = 0; i < 8; ++i) v[i] = *(const f32x4*)(t.src + (size_t)(8 * i) * t.N);
}
__device__ __forceinline__ void tr_item_store(const TrItem& t, const f32x4 (&v)[8], LAS float* scr, int lane) {
    const int kr = lane >> 3, n4 = (lane & 7) * 4, K = t.perm >> 1;
#pragma unroll
    for (int i = 0; i < 8; ++i) { const int k = 8 * i + kr, rot = 4 * (i >> 2); LAS float* row = scr + k * 33 + ((n4 + rot) & 31);
        row[0] = v[i].x; row[1] = v[i].y; row[2] = v[i].z; row[3] = v[i].w; }
    LDS_WAIT(); asm volatile("" ::: "memory");
    const int cb = lane & 7;
#pragma unroll
    for (int j = 0; j < 4; ++j) {
        const int n = (lane >> 3) + 8 * j;
        int c = n; if ((t.perm & 1) && n < 16) c = (n >> 1) + 8 * (n & 1);
        const LAS float* sp = scr + (8 * cb) * 33 + ((c + 4 * (cb >> 2)) & 31);
        u32x4 o; o.x = pk2(sp[0 * 33], sp[1 * 33]); o.y = pk2(sp[2 * 33], sp[3 * 33]); o.z = pk2(sp[4 * 33], sp[5 * 33]); o.w = pk2(sp[6 * 33], sp[7 * 33]);
        *(u32x4*)(t.dst + (size_t)(8 * j) * K) = o;
    }
    LDS_WAIT(); asm volatile("" ::: "memory");
}

__device__ __forceinline__ void phase0(const MkArgs& a, Frame& F) {
    const int f_tid = fresh_tid(F), f_lane = f_tid & 63, f_wave = F.wave;
    unsigned char* ws = a.ws;
    const int gw = F.vcu * fp::NW + f_wave, NGW = F.G * fp::NW;
    {
        LAS float* scr = (LAS float*)(F.lds + f_wave * 8448);
        constexpr int NITEMS = 32 * (fp::NIN / 32) + 16 * 64 + 16 * 64 + 32 * 64;
        if (gw < NITEMS) {
            f32x4 va[8], vb[8];
            TrItem ta = tr_item_addr(a, gw, f_lane), tb;
            tr_item_load(ta, va);
            for (int it = gw; it < NITEMS; it += 2 * NGW) {
                const int i1 = it + NGW, i2 = it + 2 * NGW;
                tb = tr_item_addr(a, i1 < NITEMS ? i1 : NITEMS - 1, f_lane); tr_item_load(tb, vb);
                tr_item_store(ta, va, scr, f_lane);
                if (i1 >= NITEMS) break;
                ta = tr_item_addr(a, i2 < NITEMS ? i2 : NITEMS - 1, f_lane); tr_item_load(ta, va);
                tr_item_store(tb, vb, scr, f_lane);
            }
        }
    }
#if MOE_FP8
    __syncthreads();
    if (n_conv_wgs(F.G) == 0) moe_convert(a, F, gw, NGW);
#if DRY_PROBE
    moe_convert(a, F, gw, NGW, true);
#endif
#endif
    __syncthreads();
    for (int cblk = F.vcu; cblk < MODW / 64; cblk += F.G) {
        LAS float* sc = (LAS float*)F.lds;
        LAS float* red = sc + 4096;
        for (int i = f_tid; i < 2 * D; i += fp::NT) sc[i] = silu_f(a.c[i]);
        __syncthreads();
        const float* wp = a.w_ada + (size_t)(f_wave * 256) * MODW + cblk * 64 + f_lane;
        float a0 = 0.f, a1 = 0.f;
#pragma unroll 32
        for (int k = 0; k < 256; ++k) { const float w = wp[(size_t)k * MODW]; a0 += w * sc[f_wave * 256 + k]; a1 += w * sc[2048 + f_wave * 256 + k]; }
        red[(f_wave * 2 + 0) * 64 + f_lane] = a0; red[(f_wave * 2 + 1) * 64 + f_lane] = a1;
        __syncthreads();
        if (f_tid < 128) { const int b = f_tid >> 6, j = f_tid & 63; float sum = a.b_ada[cblk * 64 + j];
#pragma unroll
          for (int w8 = 0; w8 < 8; ++w8) sum += red[(w8 * 2 + b) * 64 + j];
          ((float*)(ws + wsf::MOD))[b * MODW + cblk * 64 + j] = sum; }
        __syncthreads();
    }
    const int gt = F.vcu * fp::NT + f_tid, NGT = F.G * fp::NT;
    for (int i = gt; i < NTOK * 8; i += NGT) { float cs, sn; rope_cs(a.positions[i >> 3], i & 7, cs, sn); ((f32x2*)(ws + wsf::CS))[i] = (f32x2){cs, sn}; }
    for (int i = gt; i < fp::NIN; i += NGT) ((float*)(ws + wsf::BINP))[i] = a.b_in[in_src_col(i)];
    for (int i = gt; i < 32 * 2048; i += NGT) {
        const int e = i >> 11, k = i & 2047; const float w = a.w_router[k * 32 + e]; const unsigned hi = f2bf(w); const float rem = w - __builtin_bit_cast(float, hi << 16);
        ((bf16_t*)(ws + wsf::WRT))[i] = (bf16_t)hi; ((bf16_t*)(ws + wsf::WRT))[32 * 2048 + i] = (bf16_t)f2bf(rem);
    }
}

__device__ __forceinline__ void phase1(const MkArgs& a, Frame& F) {
    const int f_tid = fresh_tid(F), f_lane = f_tid & 63, f_wave = F.wave;
    unsigned char* ws = a.ws;
    const float* mod = (const float*)(ws + wsf::MOD);
    LAS float* lmod = (LAS float*)F.lds;
    LAS float* wg = (LAS float*)(F.lds + 32768);
    for (int i = f_tid; i < 2048 * 8; i += fp::NT) wg[(i & 7) * 2048 + (i >> 3)] = a.w_in[(size_t)(i >> 3) * INW + OFF_MI + (i & 7)];
    for (int blk = F.vcu; blk < NTOK / 64; blk += F.G) {
        const int b = (blk * 64) / S;
        __syncthreads();
        for (int i = f_tid; i < 4096; i += fp::NT) lmod[i] = mod[b * MODW + i];
        __syncthreads();
#pragma unroll 1
        for (int rr = 0; rr < 8; ++rr) {
            const int m = blk * 64 + f_wave * 8 + rr;
            const GAS f32x4* xr = (const GAS f32x4*)(a.x + (size_t)m * D);
            f32x4 xv[8]; float ss = 0.f;
#pragma unroll
            for (int j = 0; j < 8; ++j) { xv[j] = xr[64 * j + f_lane]; ss += (xv[j].x * xv[j].x + xv[j].y * xv[j].y) + (xv[j].z * xv[j].z + xv[j].w * xv[j].w); }
            const float r = rsqrtf(wave_sum_f(ss) * (1.f / D) + EPS);
            float g8[8];
#pragma unroll
            for (int e = 0; e < 8; ++e) g8[e] = 0.f;
            GAS u32x2* o8 = (GAS u32x2*)(ws + wsf::H1 + (size_t)m * D * 2);
#pragma unroll
            for (int j = 0; j < 8; ++j) {
                const int c0 = 4 * (64 * j + f_lane);
                const f32x4 v = xv[j];
                const f32x4 g = *(const f32x4*)(a.g_pre_mix + c0);
                const f32x4 sh = *(const LAS f32x4*)(lmod + c0), sc = *(const LAS f32x4*)(lmod + 2048 + c0);
                f32x4 h;
                h.x = v.x * r * g.x * (1.f + sc.x) + sh.x; h.y = v.y * r * g.y * (1.f + sc.y) + sh.y;
                h.z = v.z * r * g.z * (1.f + sc.z) + sh.z; h.w = v.w * r * g.w * (1.f + sc.w) + sh.w;
                o8[64 * j + f_lane] = (u32x2){pg8::cvt_pk_bf16(h.x, h.y), pg8::cvt_pk_bf16(h.z, h.w)};
#pragma unroll
                for (int e = 0; e < 8; ++e) { const f32x4 w = *(const LAS f32x4*)(wg + e * 2048 + c0); g8[e] += (h.x * w.x + h.y * w.y) + (h.z * w.z + h.w * w.w); }
            }
            float mine = 0.f;
#pragma unroll
            for (int e = 0; e < 8; ++e) { const float s8 = wave_sum_f(g8[e]); if (f_lane == e) mine = s8; }
            if (f_lane < 8) ((float*)(ws + wsf::GATES))[(size_t)m * 8 + f_lane] = mine + a.b_in[OFF_MI + f_lane];
        }
    }
}

struct EpiIn {
    bf16_t* O; const float* bias; const f32x2* cs;
    __device__ __forceinline__ void operator()(const f32x4 (&acc)[2][2][4][2], const DenseUnit& u, int wr, int wc, int fr, int fq) const {
        const int row0 = u.pm * 256 + wr * 64 + fr, col0 = u.pn * 256 + wc * 32 + 8 * fq;
        const int pn = u.pn;
        const bool ropelane = ((wc & 1) == 0) && fq < 2;
        const int i0 = fq * 4;
        f32x4 bv[2][2];
#pragma unroll
        for (int bj = 0; bj < 2; ++bj)
#pragma unroll
            for (int n = 0; n < 2; ++n) bv[bj][n] = *(const f32x4*)(bias + col0 + bj * 128 + 4 * n);
#pragma unroll
        for (int ai = 0; ai < 2; ++ai)
#pragma unroll
            for (int m = 0; m < 4; ++m) {
                const int row = row0 + ai * 128 + m * 16;
                bf16_t* rowp = O + (size_t)row * fp::NIN + col0;
#pragma unroll
                for (int bj = 0; bj < 2; ++bj) {
                    f32x4 v0 = acc[ai][bj][m][0] + bv[bj][0], v1 = acc[ai][bj][m][1] + bv[bj][1];
                    if (pn < 4 || (pn == 4 && bj == 0)) {
                        if (ropelane) {
                            const f32x4 ca = *(const f32x4*)(cs + (size_t)row * 8 + i0), cb = *(const f32x4*)(cs + (size_t)row * 8 + i0 + 2);
                            f32x4 r0, r1;
                            r0.x = v0.x * ca.x - v0.y * ca.y; r0.y = v0.y * ca.x + v0.x * ca.y;
                            r0.z = v0.z * ca.z - v0.w * ca.w; r0.w = v0.w * ca.z + v0.z * ca.w;
                            r1.x = v1.x * cb.x - v1.y * cb.y; r1.y = v1.y * cb.x + v1.x * cb.y;
                            r1.z = v1.z * cb.z - v1.w * cb.w; r1.w = v1.w * cb.z + v1.z * cb.w;
                            v0 = r0; v1 = r1;
                        }
                        if (pn < 4) { v0 = v0 * fp::QSCALE; v1 = v1 * fp::QSCALE; }
                    } else if (pn >= 13) {
#pragma unroll
                        for (int q = 0; q < 4; ++q) { v0[q] = fast_sigmoid(v0[q]); v1[q] = fast_sigmoid(v1[q]); }
                    }
                    u32x4 w; w.x = pg8::cvt_pk_bf16(v0[0], v0[1]); w.y = pg8::cvt_pk_bf16(v0[2], v0[3]); w.z = pg8::cvt_pk_bf16(v1[0], v1[1]); w.w = pg8::cvt_pk_bf16(v1[2], v1[3]);
                    *(u32x4*)(rowp + bj * 128) = w;
                }
            }
    }
};

__device__ __forceinline__ void phase2(const MkArgs& a, Frame& F) {
    const int f_tid = fresh_tid(F), f_lane = f_tid & 63, f_wave = F.wave;
    unsigned char* ws = a.ws;
#if MOE_FP8
    const int ncv = n_conv_wgs(F.G), Gg = F.G - ncv;
    constexpr int NIT_ALL = NE * ((2048 / 128) * (4096 / 32) + (2048 / 128) * (2048 / 32));
    const int nsplit = ncv > 0 ? (int)((long)NIT_ALL * CONV_SPLIT / 1024) : NIT_ALL;
    if (F.bid >= Gg) { moe_convert(a, F, (F.bid - Gg) * fp::NW + F.wave, ncv * fp::NW, false, 0, nsplit);
#if DRY_PROBE == 2
        moe_convert(a, F, (F.bid - Gg) * fp::NW + F.wave, ncv * fp::NW, true);
#endif
        return; }
#else
    const int Gg = F.G;
#endif
    DenseSched S{(const bf16_t*)(ws + wsf::H1), (const bf16_t*)(ws + wsf::WIN_T), 2048, 2048, NTOK / 256, fp::NIN / 256, Gg, F.bid, F.wave};
    EpiIn E{(bf16_t*)(ws + wsf::PROJB), (const float*)(ws + wsf::BINP), (const f32x2*)(ws + wsf::CS)};
    pg8::gemm_phase<EpiIn, DenseSched>(F.lds, S, E);
#if MOE_FP8
    if (ncv > 0 && nsplit < NIT_ALL) { __syncthreads(); moe_convert(a, F, F.bid * fp::NW + F.wave, Gg * fp::NW, false, nsplit, NIT_ALL); }
#endif
}
__device__ __forceinline__ f32x4 mfma16(bf16x8 a, bf16x8 b, f32x4 c) { return __builtin_amdgcn_mfma_f32_16x16x32_bf16(a, b, c, 0, 0, 0); }
__device__ __forceinline__ float exp2_fast(float x) { return __builtin_amdgcn_exp2f(x); }
typedef short v4i16_t __attribute__((ext_vector_type(4)));
__device__ __forceinline__ bf16x8 tr_frag(const LAS bf16_t* base, int stride, int lane) {
    const LAS bf16_t* p = base + (8 * (lane >> 4) + ((lane & 15) >> 2)) * stride + 4 * (lane & 3);
    const v4i16_t lo = __builtin_amdgcn_ds_read_tr16_b64_v4i16((LAS v4i16_t*)p), hi = __builtin_amdgcn_ds_read_tr16_b64_v4i16((LAS v4i16_t*)(p + 4 * stride));
    return __builtin_shufflevector(lo, hi, 0, 1, 2, 3, 4, 5, 6, 7);
}

__device__ __forceinline__ void attn_unit(const MkArgs& a, Frame& F, int unit) {
    const int f_tid = fresh_tid(F), f_lane = f_tid & 63, f_wave = F.wave;
    const int b = unit >> 7, hk = (unit >> 6) & 1, n = unit & 63;
    const bf16_t* PB = (const bf16_t*)(a.ws + wsf::PROJB);
    bf16_t* OA = (bf16_t*)(a.ws + wsf::OAT);
    const size_t tok0 = (size_t)b * S + (size_t)n * 128;
    LAS bf16_t* Ks = (LAS bf16_t*)F.lds;
    LAS bf16_t* Vs = (LAS bf16_t*)(F.lds + 36864);
    LAS bf16_t* Pw = (LAS bf16_t*)(F.lds + 36864 + 39168 + f_wave * 5376);
#pragma unroll
    for (int i = 0; i < 4; ++i) {
        const int q = f_tid + 512 * i, row = q >> 3, ch = q & 7;
        u32x4 kv = (u32x4){0u, 0u, 0u, 0u}, vv = kv;
        if (n > 0 || row >= 128) {
            const bf16_t* src = PB + (tok0 - 128 + row) * fp::NIN + hk * 64 + ch * 8;
            kv = *(const u32x4*)(src + fp::PB_K); vv = *(const u32x4*)(src + fp::PB_V);
        }
        *(LAS u32x4*)(Ks + row * 72 + ch * 8) = kv;
        *(LAS u32x4*)(Vs + row * 72 + ch * 8) = vv;
    }
    if (f_tid < 128) *(LAS u32x4*)(Vs + (256 + (f_tid >> 3)) * 72 + (f_tid & 7) * 8) = (u32x4){0u, 0u, 0u, 0u};
    __syncthreads();
    const int c16 = f_lane & 15, grp = f_lane >> 4, h = hk * 8 + f_wave;
    const float sink2 = a.sinks[h] * fp::LOG2E;
    bf16x8 qn[2];
#pragma unroll
    for (int ks = 0; ks < 2; ++ks) qn[ks] = *(const bf16x8*)(PB + (tok0 + c16) * fp::NIN + fp::PB_Q + h * 64 + ks * 32 + grp * 8);
#pragma unroll 1
    for (int tt = 0; tt < 8; ++tt) {
        const size_t qtok = tok0 + tt * 16 + c16;
        bf16x8 qf[2];
        { const size_t ntok = tok0 + (tt < 7 ? tt + 1 : 7) * 16 + c16;
#pragma unroll
          for (int ks = 0; ks < 2; ++ks) { qf[ks] = qn[ks]; qn[ks] = *(const bf16x8*)(PB + ntok * fp::NIN + fp::PB_Q + h * 64 + ks * 32 + grp * 8); } }
        f32x4 sacc[9];
#pragma unroll
        for (int jq = 0; jq < 9; ++jq) {
            sacc[jq] = (f32x4){0.f, 0.f, 0.f, 0.f};
#pragma unroll
            for (int ks = 0; ks < 2; ++ks) { const bf16x8 kf = *(const LAS bf16x8*)(Ks + (16 * (tt + jq) + c16) * 72 + ks * 32 + grp * 8); sacc[jq] = mfma16(kf, qf[ks], sacc[jq]); }
        }
        float mx = sink2;
#pragma unroll
        for (int jq = 0; jq < 9; ++jq)
#pragma unroll
            for (int r = 0; r < 4; ++r) {
                const int diff = 128 + c16 - 16 * jq - 4 * grp - r, jrel = 16 * (tt + jq) + 4 * grp + r;
                const bool ok = diff >= 0 && diff < 128 && (n > 0 || jrel >= 128);
                sacc[jq][r] = ok ? sacc[jq][r] : -INFINITY;
                mx = fmaxf(mx, sacc[jq][r]);
            }
        mx = fmaxf(mx, __shfl_xor(mx, 16)); mx = fmaxf(mx, __shfl_xor(mx, 32));
        float ls = 0.f;
#pragma unroll
        for (int jq = 0; jq < 9; ++jq) {
            float p[4];
#pragma unroll
            for (int r = 0; r < 4; ++r) { p[r] = exp2_fast(sacc[jq][r] - mx); ls += p[r]; }
            *(LAS u32x2*)(Pw + c16 * 168 + 16 * jq + 4 * grp) = (u32x2){pk2(p[0], p[1]), pk2(p[2], p[3])};
        }
        *(LAS u32x2*)(Pw + c16 * 168 + 144 + 4 * grp) = (u32x2){0u, 0u};
        ls += __shfl_xor(ls, 16); ls += __shfl_xor(ls, 32);
        ls += exp2_fast(sink2 - mx);
        const float inv = 1.f / ls;
        LDS_WAIT();
        f32x4 oacc[4];
#pragma unroll
        for (int dt = 0; dt < 4; ++dt) oacc[dt] = (f32x4){0.f, 0.f, 0.f, 0.f};
#pragma unroll
        for (int k2 = 0; k2 < 5; ++k2) {
            const bf16x8 pb = *(const LAS bf16x8*)(Pw + c16 * 168 + 32 * k2 + 8 * grp);
#pragma unroll
            for (int dt = 0; dt < 4; ++dt) { const bf16x8 va = tr_frag(Vs + (16 * tt + 32 * k2) * 72 + 16 * dt, 72, f_lane); oacc[dt] = mfma16(va, pb, oacc[dt]); }
        }
#pragma unroll
        for (int dt = 0; dt < 4; ++dt)
            *(u32x2*)(OA + qtok * 1024 + h * 64 + 16 * dt + 4 * grp) = (u32x2){pk2(oacc[dt][0] * inv, oacc[dt][1] * inv), pk2(oacc[dt][2] * inv, oacc[dt][3] * inv)};
        LDS_WAIT();
    }
    __syncthreads();
}

__device__ __forceinline__ void unpack8(const u32x4 v, float (&f)[8]) {
    f[0] = bflo(v.x); f[1] = bfhi(v.x); f[2] = bflo(v.y); f[3] = bfhi(v.y); f[4] = bflo(v.z); f[5] = bfhi(v.z); f[6] = bflo(v.w); f[7] = bfhi(v.w);
}
__device__ __forceinline__ void stage_vt(const bf16_t* PB, size_t tok0, int col0, LAS bf16_t* Vs, int tid) {
#pragma unroll
    for (int i = 0; i < 8; ++i) {
        const int q = tid + 512 * i, row = q >> 5, ch = q & 31;
        *(LAS u32x4*)(Vs + row * 272 + ch * 8) = *(const u32x4*)(PB + (tok0 + row) * fp::NIN + col0 + ch * 8);
    }
}

__device__ __forceinline__ void m1_unit(const MkArgs& a, Frame& F, int u) {
    const int f_tid = fresh_tid(F), f_lane = f_tid & 63, f_wave = F.wave;
    const int bh = u >> 6, c = u & 63, b = bh >> 2, h = bh & 3;
    const size_t tok0 = (size_t)b * S + (size_t)c * 128;
    unsigned char* ws = a.ws;
    const bf16_t* PB = (const bf16_t*)(ws + wsf::PROJB);
    LAS bf16_t* Kw = (LAS bf16_t*)F.lds;
    LAS bf16_t* Vt = (LAS bf16_t*)(F.lds + 34816);
    LAS float* gl = (LAS float*)(F.lds + 34816 + 69632);
    const float* GT = (const float*)(ws + wsf::GATES);
    const int tid = f_tid;
    float li = 0.f, lf = 0.f;
    if (tid < 128) { li = softcap_f(GT[(tok0 + tid) * 8 + h]); lf = logsigmoid_f(softcap_f(GT[(tok0 + tid) * 8 + 4 + h])); }
    float cum = lf;
#pragma unroll
    for (int o = 1; o < 64; o <<= 1) { const float t = __shfl_up(cum, o); if (f_lane >= o) cum += t; }
    if (tid == 63) gl[384] = cum;
    __syncthreads();
    if (tid >= 64 && tid < 128) cum += gl[384];
    if (tid == 127) gl[385] = cum;
    __syncthreads();
    const float g = gl[385];
    const float av = (tid < 128) ? (g - cum + li) : -INFINITY;
    const float wm = wave_max_f(av);
    if (f_lane == 0 && f_wave < 2) gl[386 + f_wave] = wm;
    __syncthreads();
    const float mloc = fmaxf(gl[386], gl[387]);
    if (tid < 128) {
        gl[256 + tid] = expf(av - mloc);
        ((float*)(ws + wsf::BCUM))[(size_t)bh * S + c * 128 + tid] = cum;
        ((float*)(ws + wsf::LOGI))[(size_t)bh * S + c * 128 + tid] = li;
    }
    if (tid == 0) { ((float*)(ws + wsf::GSUM))[u] = g; ((float*)(ws + wsf::MLOC))[u] = mloc; }
    __syncthreads();
#pragma unroll 2
    for (int i = 0; i < 8; ++i) {
        const int q = tid + 512 * i, row = q >> 5, ch = q & 31, isK = ch >= 16, cc = (ch & 15) * 8;
        const int colsrc = (isK ? fp::PB_MK : fp::PB_MQ) + h * 128 + cc, cwcol = (isK ? 512 : 0) + h * 128 + cc;
        float acc[8];
#pragma unroll
        for (int e = 0; e < 8; ++e) acc[e] = 0.f;
#pragma unroll
        for (int j = 0; j < 4; ++j) {
            const int sabs = c * 128 + row - 3 + j;
            const u32x4 xv = *(const u32x4*)(PB + (tok0 + row - (sabs >= 0 ? 3 - j : 0)) * fp::NIN + colsrc);
            float xf[8]; unpack8(xv, xf);
            const float z = sabs >= 0 ? 1.f : 0.f;
            const f32x4 w0 = *(const f32x4*)(a.conv_qk + j * 1024 + cwcol) * z, w1 = *(const f32x4*)(a.conv_qk + j * 1024 + cwcol + 4) * z;
            acc[0] += w0.x * xf[0]; acc[1] += w0.y * xf[1]; acc[2] += w0.z * xf[2]; acc[3] += w0.w * xf[3];
            acc[4] += w1.x * xf[4]; acc[5] += w1.y * xf[5]; acc[6] += w1.z * xf[6]; acc[7] += w1.w * xf[7];
        }
        const float sc = isK ? 0.08838834764831845f : 1.f;
#pragma unroll
        for (int e = 0; e < 8; ++e) acc[e] = silu_f(acc[e]) * sc;
        const u32x4 o = (u32x4){pk2(acc[0], acc[1]), pk2(acc[2], acc[3]), pk2(acc[4], acc[5]), pk2(acc[6], acc[7])};
        bf16_t* dst = (bf16_t*)(ws + (isK ? wsf::KC : wsf::QC)) + (tok0 + row) * 512 + h * 128 + cc;
        *(u32x4*)dst = o;
        if (isK) {
            const float wr = gl[256 + row];
            *(LAS u32x4*)(Kw + row * 136 + cc) = (u32x4){pk2(acc[0] * wr, acc[1] * wr), pk2(acc[2] * wr, acc[3] * wr), pk2(acc[4] * wr, acc[5] * wr), pk2(acc[6] * wr, acc[7] * wr)};
        }
    }
    stage_vt(PB, tok0, fp::PB_MV + h * 256, Vt, tid);
    __syncthreads();
    const int c16 = f_lane & 15, grp = f_lane >> 4, w = f_wave;
    f32x4 acc[8][2];
#pragma unroll
    for (int d = 0; d < 8; ++d) { acc[d][0] = (f32x4){0.f, 0.f, 0.f, 0.f}; acc[d][1] = acc[d][0]; }
#pragma unroll
    for (int ks = 0; ks < 4; ++ks) {
        bf16x8 bfr[2];
#pragma unroll
        for (int i = 0; i < 2; ++i) bfr[i] = tr_frag(Vt + (32 * ks) * 272 + 16 * (2 * w + i), 272, f_lane);
#pragma unroll
        for (int d = 0; d < 8; ++d) {
            const bf16x8 af = tr_frag(Kw + (32 * ks) * 136 + 16 * d, 136, f_lane);
            acc[d][0] = mfma16(af, bfr[0], acc[d][0]); acc[d][1] = mfma16(af, bfr[1], acc[d][1]);
        }
    }
    float* dct = (float*)(ws + wsf::DCT) + (size_t)u * 256 * 128;
#pragma unroll
    for (int d = 0; d < 8; ++d)
#pragma unroll
        for (int i = 0; i < 2; ++i) *(f32x4*)(dct + (size_t)(16 * (2 * w + i) + c16) * 128 + 16 * d + 4 * grp) = acc[d][i];
    if (tid < 128) {
        float s = 0.f;
#pragma unroll 16
        for (int r = 0; r < 128; ++r) s += bf2f(Kw[r * 136 + tid]);
        ((float*)(ws + wsf::DN))[(size_t)u * 128 + tid] = s;
    }
    __syncthreads();
}

__device__ __forceinline__ void phase3(const MkArgs& a, Frame& F) {
    const int f_tid = fresh_tid(F), f_lane = f_tid & 63, f_wave = F.wave;
    for (int u = F.bid; u < NB * HKV * (S / 128); u += F.G) attn_unit(a, F, u);
    for (int u = F.bid; u < NB * MH * NC; u += F.G) m1_unit(a, F, u);
}

__device__ __forceinline__ void phase4(const MkArgs& a, Frame& F) {
    const int f_tid = fresh_tid(F), f_lane = f_tid & 63, f_wave = F.wave;
    unsigned char* ws = a.ws;
    LAS float* dec = (LAS float*)F.lds;
    LAS float* scl = dec + 512;
    LAS float* gl = scl + 512;
    gl[f_tid] = ((const float*)(ws + wsf::GSUM))[f_tid]; gl[512 + f_tid] = ((const float*)(ws + wsf::MLOC))[f_tid];
    __syncthreads();
    if (f_tid < 8) {
        const int bh = f_tid; float m = 0.f;
        for (int c = 0; c < NC; ++c) {
            const float g = gl[bh * NC + c], ml = gl[512 + bh * NC + c];
            if (F.bid == 0) ((float*)(ws + wsf::MPREV))[bh * NC + c] = m;
            const float mn = fmaxf(g + m, ml);
            dec[bh * 64 + c] = expf(g + m - mn); scl[bh * 64 + c] = expf(ml - mn); m = mn;
        }
    }
    __syncthreads();
    const int gt = F.vcu * fp::NT + f_tid, NGT = F.G * fp::NT;
    for (int it = gt; it < 8 * 16384; it += NGT) {
        const int bh = it >> 14, idx = it & 16383;
        const float* dct = (const float*)(ws + wsf::DCT) + (size_t)bh * 64 * 32768 + (size_t)idx * 2;
        bf16_t* cpt = (bf16_t*)(ws + wsf::CPT) + (size_t)bh * 64 * 32768 + (size_t)idx * 2;
        float C0 = 0.f, C1 = 0.f;
#pragma unroll 8
        for (int c = 0; c < NC; ++c) {
            const f32x2 d = *(const f32x2*)(dct + (size_t)c * 32768);
            *(unsigned*)(cpt + (size_t)c * 32768) = pk2(C0, C1);
            const float de = dec[bh * 64 + c], sc = scl[bh * 64 + c];
            C0 = de * C0 + sc * d.x; C1 = de * C1 + sc * d.y;
        }
    }
    for (int it = gt; it < 8 * 128; it += NGT) {
        const int bh = it >> 7, dk = it & 127; float nv = 0.f;
        const float* dnp = (const float*)(ws + wsf::DN) + (size_t)bh * NC * 128 + dk;
        float* npp = (float*)(ws + wsf::NPREV) + (size_t)bh * NC * 128 + dk;
#pragma unroll
        for (int h = 0; h < 2; ++h) {
            float d[32];
#pragma unroll
            for (int c = 0; c < 32; ++c) d[c] = dnp[(size_t)(32 * h + c) * 128];
#pragma unroll
            for (int c = 0; c < 32; ++c) { npp[(size_t)(32 * h + c) * 128] = nv; nv = dec[bh * 64 + 32 * h + c] * nv + scl[bh * 64 + 32 * h + c] * d[c]; }
        }
    }
}

__device__ __forceinline__ void m3_unit(const MkArgs& a, Frame& F, int u) {
    const int f_tid = fresh_tid(F), f_lane = f_tid & 63, f_wave = F.wave;
    const int bh = u >> 6, c = u & 63, b = bh >> 2, h = bh & 3;
    const size_t tok0 = (size_t)b * S + (size_t)c * 128;
    unsigned char* ws = a.ws;
    const bf16_t* PB = (const bf16_t*)(ws + wsf::PROJB);
    const bf16_t* QCp = (const bf16_t*)(ws + wsf::QC);
    const bf16_t* KCp = (const bf16_t*)(ws + wsf::KC);
    LAS bf16_t* KP = (LAS bf16_t*)F.lds;
    LAS bf16_t* Vt = (LAS bf16_t*)(F.lds + 34816);
    LAS float* fl = (LAS float*)(F.lds + 104448);
    LAS float* f_us = fl, *f_M = fl + 128, *f_iw = fl + 256, *f_rd = fl + 384, *f_qn = fl + 512, *f_np = fl + 640, *f_en = fl + 768, *f_ssq = fl + 1024, *f_misc = fl + 896;
    const int tid = f_tid;
#pragma unroll
    for (int i = 0; i < 4; ++i) { const int q = tid + 512 * i, row = q >> 4, ch = q & 15;
        *(LAS u32x4*)(KP + row * 136 + ch * 8) = *(const u32x4*)(KCp + (tok0 + row) * 512 + h * 128 + ch * 8); }
    stage_vt(PB, tok0, fp::PB_MV + h * 256, Vt, tid);
    const float mp = ((const float*)(ws + wsf::MPREV))[u];
    float bt = 0.f, us = -INFINITY;
    if (tid < 128) { bt = ((const float*)(ws + wsf::BCUM))[(size_t)bh * S + c * 128 + tid]; us = ((const float*)(ws + wsf::LOGI))[(size_t)bh * S + c * 128 + tid] - bt;
        f_np[tid] = ((const float*)(ws + wsf::NPREV))[(size_t)u * 128 + tid]; }
    float pm = us;
#pragma unroll
    for (int o = 1; o < 64; o <<= 1) { const float t = __shfl_up(pm, o); if (f_lane >= o) pm = fmaxf(pm, t); }
    if (tid == 63) f_misc[0] = pm;
    __syncthreads();
    if (tid >= 64 && tid < 128) pm = fmaxf(pm, f_misc[0]);
    if (tid < 128) {
        const float Mt = fmaxf(mp, pm);
        f_us[tid] = us; f_M[tid] = Mt; f_iw[tid] = expf(mp - Mt); f_en[tid] = expf(-(bt + Mt));
        float s = 0.f;
#pragma unroll 8
        for (int ch = 0; ch < 16; ++ch) { const u32x4 qv = *(const u32x4*)(QCp + (tok0 + tid) * 512 + h * 128 + ch * 8); float qf[8]; unpack8(qv, qf);
#pragma unroll
            for (int e = 0; e < 8; ++e) s += qf[e] * f_np[ch * 8 + e]; }
        f_qn[tid] = s;
    }
    __syncthreads();
    const int c16 = f_lane & 15, grp = f_lane >> 4, w = f_wave;
    u32x2 pp[8]; float rs = 0.f;
    {
        bf16x8 qf[4];
#pragma unroll
        for (int ks = 0; ks < 4; ++ks) qf[ks] = *(const bf16x8*)(QCp + (tok0 + 16 * w + c16) * 512 + h * 128 + 32 * ks + 8 * grp);
        const float Mt = f_M[16 * w + c16];
        const int t = 16 * w + c16, tq = t - 4 * grp;
        const LAS float* usb = f_us + 4 * grp;
#pragma unroll
        for (int st = 0; st < 8; ++st) {
            pp[st] = (u32x2){0u, 0u};
            if (st <= w) {
                f32x4 acc = (f32x4){0.f, 0.f, 0.f, 0.f};
#pragma unroll
                for (int ks = 0; ks < 4; ++ks) { const bf16x8 kf = *(const LAS bf16x8*)(KP + (16 * st + c16) * 136 + 32 * ks + 8 * grp); acc = mfma16(kf, qf[ks], acc); }
                float p[4];
                const f32x4 u4 = *(const LAS f32x4*)(usb + 16 * st);
#pragma unroll
                for (int r = 0; r < 4; ++r) { p[r] = (16 * st + r <= tq) ? acc[r] * expf(u4[r] - Mt) : 0.f; rs += p[r]; }
                pp[st] = (u32x2){pk2(p[0], p[1]), pk2(p[2], p[3])};
            }
        }
        rs += __shfl_xor(rs, 16); rs += __shfl_xor(rs, 32);
        if (grp == 0) { const float den = rs + f_iw[t] * f_qn[t]; f_rd[t] = 1.f / fmaxf(fabsf(den), f_en[t]); }
    }
    __syncthreads();
#pragma unroll
    for (int st = 0; st < 8; ++st) *(LAS u32x2*)(KP + (16 * w + c16) * 136 + 16 * st + 4 * grp) = pp[st];
    __syncthreads();
    bf16x8 vf[2][4], cf[2][4];
    const bf16_t* cpt = (const bf16_t*)(ws + wsf::CPT) + (size_t)u * 256 * 128;
#pragma unroll
    for (int i = 0; i < 2; ++i)
#pragma unroll
        for (int ks = 0; ks < 4; ++ks) {
            vf[i][ks] = tr_frag(Vt + (32 * ks) * 272 + 16 * (2 * w + i), 272, f_lane);
            cf[i][ks] = *(const bf16x8*)(cpt + (size_t)(16 * (2 * w + i) + c16) * 128 + 32 * ks + 8 * grp);
        }
    bf16_t* HMp = (bf16_t*)(ws + wsf::HM);
    bf16x8 qnx[4];
#pragma unroll
    for (int ks = 0; ks < 4; ++ks) qnx[ks] = *(const bf16x8*)(QCp + (tok0 + c16) * 512 + h * 128 + 32 * ks + 8 * grp);
#pragma unroll 1
    for (int tt = 0; tt < 8; ++tt) {
        bf16x8 pf[4], qf[4];
        const int tn = tt < 7 ? tt + 1 : 7;
#pragma unroll
        for (int ks = 0; ks < 4; ++ks) { pf[ks] = *(const LAS bf16x8*)(KP + (16 * tt + c16) * 136 + 32 * ks + 8 * grp);
            qf[ks] = qnx[ks]; qnx[ks] = *(const bf16x8*)(QCp + (tok0 + 16 * tn + c16) * 512 + h * 128 + 32 * ks + 8 * grp); }
        const int t = 16 * tt + c16; const float iw = f_iw[t], rd = f_rd[t];
        float ss = 0.f;
#pragma unroll
        for (int i = 0; i < 2; ++i) {
            f32x4 a1 = (f32x4){0.f, 0.f, 0.f, 0.f}, a2 = a1;
#pragma unroll
            for (int ks = 0; ks < 4; ++ks) { a1 = mfma16(vf[i][ks], pf[ks], a1); a2 = mfma16(cf[i][ks], qf[ks], a2); }
            const f32x4 hv = (a1 + a2 * iw) * rd;
            ss += (hv[0] * hv[0] + hv[1] * hv[1]) + (hv[2] * hv[2] + hv[3] * hv[3]);
            *(u32x2*)(HMp + (tok0 + t) * 1024 + h * 256 + 16 * (2 * w + i) + 4 * grp) = (u32x2){pk2(hv[0], hv[1]), pk2(hv[2], hv[3])};
        }
        ss += __shfl_xor(ss, 16); ss += __shfl_xor(ss, 32);
        if (grp == 0) f_ssq[t * 8 + w] = ss;
    }
    __syncthreads();
#pragma unroll 2
    for (int tt = 0; tt < 8; ++tt) {
        const int t = 16 * tt + c16;
        const f32x4 s0 = *(const LAS f32x4*)(f_ssq + t * 8), s1 = *(const LAS f32x4*)(f_ssq + t * 8 + 4);
        const float rn = rsqrtf(((s0.x + s0.y) + (s0.z + s0.w) + (s1.x + s1.y) + (s1.z + s1.w)) * (1.f / 256.f) + EPS);
#pragma unroll
        for (int i = 0; i < 2; ++i) {
            const int dv0 = 16 * (2 * w + i) + 4 * grp;
            const f32x4 g4 = *(const f32x4*)(a.g_mlstm + h * 256 + dv0);
            const u32x2 mo = *(const u32x2*)(PB + (tok0 + t) * fp::NIN + fp::PB_MO + h * 256 + dv0);
            u32x2* hp = (u32x2*)(HMp + (tok0 + t) * 1024 + h * 256 + dv0);
            const u32x2 hr = *hp;
            const float o0 = bflo(hr.x) * rn * g4.x * bflo(mo.x), o1 = bfhi(hr.x) * rn * g4.y * bfhi(mo.x);
            const float o2 = bflo(hr.y) * rn * g4.z * bflo(mo.y), o3 = bfhi(hr.y) * rn * g4.w * bfhi(mo.y);
            *hp = (u32x2){pk2(o0, o1), pk2(o2, o3)};
        }
    }
    __syncthreads();
}
__device__ __forceinline__ void phase5(const MkArgs& a, Frame& F) {
    const int f_tid = fresh_tid(F), f_lane = f_tid & 63, f_wave = F.wave;
    for (int u = F.bid; u < NB * MH * NC; u += F.G) m3_unit(a, F, u);
}
struct ProjUnit { int pm, pn, which; };
struct ProjSched {
    typedef ProjUnit UnitT;
    const bf16_t* A0; const bf16_t* A1; const bf16_t* B0; const bf16_t* B1; int K; int nM, nN, G, c, wave;
    __device__ __forceinline__ bool next(int i, ProjUnit& u) const { u.which = i & 1; return pg8::static_tile((i >> 1) * G + c, nM, nN, u.pm, u.pn); }
    __device__ __forceinline__ const void* a_buf() const { return A0; }
    __device__ __forceinline__ const void* b_buf() const { return B0; }
    __device__ __forceinline__ unsigned a_soff(const ProjUnit& u) const { return (unsigned)u.pm * 256u * (unsigned)K * 2u + (u.which ? (unsigned)((const char*)A1 - (const char*)A0) : 0u); }
    __device__ __forceinline__ unsigned b_soff(const ProjUnit& u) const { return (unsigned)u.pn * 256u * (unsigned)K * 2u + (u.which ? (unsigned)((const char*)B1 - (const char*)B0) : 0u); }
    __device__ __forceinline__ void a_offs(const ProjUnit&, int R0, int R1, int C0, int C1, unsigned (&o)[4]) const {
        o[0] = (unsigned)(R0 * K + C0) * 2u; o[1] = (unsigned)(R1 * K + C1) * 2u; o[2] = (unsigned)((R0 + 128) * K + C0) * 2u; o[3] = (unsigned)((R1 + 128) * K + C1) * 2u;
    }
};
struct EpiMerge {
    bf16_t* MG; const bf16_t* PB;
    __device__ __forceinline__ void operator()(const f32x4 (&acc)[2][2][4][2], const ProjUnit& u, int wr, int wc, int fr, int fq) const {
        const int row0 = u.pm * 256 + wr * 64 + fr, col0 = u.pn * 256 + wc * 32 + 8 * fq;
        const int gcol = (u.which ? fp::PB_GM : fp::PB_GA) + col0;
#pragma unroll
        for (int ai = 0; ai < 2; ++ai) {
            u32x4 gv[4][2], pv[4][2];
#pragma unroll
            for (int m = 0; m < 4; ++m)
#pragma unroll
                for (int bj = 0; bj < 2; ++bj) { const size_t row = (size_t)(row0 + ai * 128 + m * 16);
                    gv[m][bj] = *(const u32x4*)(PB + row * fp::NIN + gcol + bj * 128);
                    pv[m][bj] = u.which ? *(const u32x4*)(MG + row * 2048 + col0 + bj * 128) : (u32x4){0u, 0u, 0u, 0u}; }
#pragma unroll
            for (int m = 0; m < 4; ++m)
#pragma unroll
                for (int bj = 0; bj < 2; ++bj) { const size_t row = (size_t)(row0 + ai * 128 + m * 16);
                    float g[8], p[8]; unpack8(gv[m][bj], g); unpack8(pv[m][bj], p);
                    const f32x4 v0 = acc[ai][bj][m][0], v1 = acc[ai][bj][m][1];
                    const float o[8] = {p[0] + g[0] * v0[0], p[1] + g[1] * v0[1], p[2] + g[2] * v0[2], p[3] + g[3] * v0[3], p[4] + g[4] * v1[0], p[5] + g[5] * v1[1], p[6] + g[6] * v1[2], p[7] + g[7] * v1[3]};
                    *(u32x4*)(MG + row * 2048 + col0 + bj * 128) = (u32x4){pg8::cvt_pk_bf16(o[0], o[1]), pg8::cvt_pk_bf16(o[2], o[3]), pg8::cvt_pk_bf16(o[4], o[5]), pg8::cvt_pk_bf16(o[6], o[7])}; }
        }
    }
};
__device__ __forceinline__ void phase6(const MkArgs& a, Frame& F) {
    const int f_tid = fresh_tid(F), f_lane = f_tid & 63, f_wave = F.wave;
    unsigned char* ws = a.ws;
    ProjSched S{(const bf16_t*)(ws + wsf::OAT), (const bf16_t*)(ws + wsf::HM), (const bf16_t*)(ws + wsf::WAP_T), (const bf16_t*)(ws + wsf::WMP_T), 1024, NTOK / 256, 2048 / 256, F.G, F.bid, F.wave};
    EpiMerge E{(bf16_t*)(ws + wsf::MG), (const bf16_t*)(ws + wsf::PROJB)};
    pg8::gemm_phase<EpiMerge, ProjSched>(F.lds, S, E);
}
struct EpiPlain {
    bf16_t* O; int ldc;
    __device__ __forceinline__ void operator()(const f32x4 (&acc)[2][2][4][2], const DenseUnit& u, int wr, int wc, int fr, int fq) const {
        const int row0 = u.pm * 256 + wr * 64 + fr, col0 = u.pn * 256 + wc * 32 + 8 * fq;
#pragma unroll
        for (int ai = 0; ai < 2; ++ai)
#pragma unroll
            for (int m = 0; m < 4; ++m)
#pragma unroll
                for (int bj = 0; bj < 2; ++bj) {
                    const f32x4 v0 = acc[ai][bj][m][0], v1 = acc[ai][bj][m][1];
                    *(u32x4*)(O + (size_t)(row0 + ai * 128 + m * 16) * ldc + col0 + bj * 128) =
                        (u32x4){pg8::cvt_pk_bf16(v0[0], v0[1]), pg8::cvt_pk_bf16(v0[2], v0[3]), pg8::cvt_pk_bf16(v1[0], v1[1]), pg8::cvt_pk_bf16(v1[2], v1[3])};
                }
    }
};
__device__ __forceinline__ void phase7(const MkArgs& a, Frame& F) {
    const int f_tid = fresh_tid(F), f_lane = f_tid & 63, f_wave = F.wave;
    unsigned char* ws = a.ws;
    DenseSched S{(const bf16_t*)(ws + wsf::MG), (const bf16_t*)(ws + wsf::WOUT_T), 2048, 2048, NTOK / 256, 2048 / 256, F.G, F.bid, F.wave};
    EpiPlain E{(bf16_t*)(ws + wsf::Y), 2048};
    pg8::gemm_phase<EpiPlain, DenseSched>(F.lds, S, E);
}

__device__ __forceinline__ void phase8(const MkArgs& a, Frame& F) {
    const int f_tid = fresh_tid(F), f_lane = f_tid & 63, f_wave = F.wave;
    unsigned char* ws = a.ws;
    LAS float* t_gt1 = (LAS float*)F.lds, *t_gpo = t_gt1 + 2048, *t_gpr = t_gt1 + 4096, *t_sc2 = t_gt1 + 6144, *t_sh2 = t_gt1 + 8192;
    LAS float* lgp = (LAS float*)(F.lds + 40960);
    LAS int* cntl = (LAS int*)(F.lds + 57344);
    LAS int* basel = cntl + 32;
    LAS int* esel = cntl + 64;
    LAS int* eslot = cntl + 320;
    const float* mod = (const float*)(ws + wsf::MOD);
    const bf16_t* Yp = (const bf16_t*)(ws + wsf::Y);
    bf16_t* H2p = (bf16_t*)(ws + wsf::H2);
    bf16_t* X1p = (bf16_t*)(ws + wsf::X1);
    const bf16_t* WR = (const bf16_t*)(ws + wsf::WRT);
    int* cntg = (int*)(ws + wsf::CTL) + wsf::CW_CNT;
    const int tid = f_tid, lane = f_lane, w = f_wave;
    for (int blk = F.vcu; blk < NTOK / 64; blk += F.G) {
        const int b = (blk * 64) / S;
        for (int i = tid; i < 2048; i += fp::NT) {
            t_gt1[i] = mod[b * MODW + MOD_GT1 + i]; t_gpo[i] = a.g_post_mix[i]; t_gpr[i] = a.g_pre_ffn[i];
            t_sc2[i] = mod[b * MODW + MOD_SC2 + i]; t_sh2[i] = mod[b * MODW + MOD_SH2 + i];
        }
        if (tid < 32) cntl[tid] = 0;
        __syncthreads();
#pragma unroll 1
        for (int rr = 0; rr < 8; ++rr) {
            const size_t row = (size_t)blk * 64 + w * 8 + rr;
            u32x4 yp[4]; float ss = 0.f;
#pragma unroll
            for (int j = 0; j < 4; ++j) { yp[j] = *(const u32x4*)(Yp + row * 2048 + 8 * (64 * j + lane)); float f[8]; unpack8(yp[j], f);
#pragma unroll
                for (int e = 0; e < 8; ++e) ss += f[e] * f[e]; }
            const float r1 = rsqrtf(wave_sum_f(ss) * (1.f / D) + EPS);
            ss = 0.f;
#pragma unroll
            for (int j = 0; j < 4; ++j) {
                const int c0 = 8 * (64 * j + lane);
                float f[8]; unpack8(yp[j], f);
                const f32x4 xa = *(const f32x4*)(a.x + row * D + c0), xb = *(const f32x4*)(a.x + row * D + c0 + 4);
                const float xv[8] = {xa.x, xa.y, xa.z, xa.w, xb.x, xb.y, xb.z, xb.w};
                float v[8];
#pragma unroll
                for (int e = 0; e < 8; ++e) { v[e] = xv[e] + t_gt1[c0 + e] * (f[e] * r1 * t_gpo[c0 + e]); ss += v[e] * v[e]; }
                *(u32x4*)(X1p + row * D + c0) = (u32x4){pg8::cvt_pk_bf16(v[0], v[1]), pg8::cvt_pk_bf16(v[2], v[3]), pg8::cvt_pk_bf16(v[4], v[5]), pg8::cvt_pk_bf16(v[6], v[7])};
            }
            const float r2 = rsqrtf(wave_sum_f(ss) * (1.f / D) + EPS);
#pragma unroll
            for (int j = 0; j < 4; ++j) {
                const int c0 = 8 * (64 * j + lane);
                const u32x4 xr = *(const u32x4*)(X1p + row * D + c0);
                float xv[8]; unpack8(xr, xv);
                float hv[8];
#pragma unroll
                for (int e = 0; e < 8; ++e) hv[e] = xv[e] * r2 * t_gpr[c0 + e] * (1.f + t_sc2[c0 + e]) + t_sh2[c0 + e];
                *(u32x4*)(H2p + row * 2048 + c0) = (u32x4){pg8::cvt_pk_bf16(hv[0], hv[1]), pg8::cvt_pk_bf16(hv[2], hv[3]), pg8::cvt_pk_bf16(hv[4], hv[5]), pg8::cvt_pk_bf16(hv[6], hv[7])};
#if MOE_FP8
                *(u32x2*)(ws + wsf::H2F8 + row * 2048 + c0) = (u32x2){pk4_fp8(hv[0], hv[1], hv[2], hv[3]), pk4_fp8(hv[4], hv[5], hv[6], hv[7])};
#endif
            }
        }
        VM_WAIT();
        __syncthreads();
        {
            const int c16 = lane & 15, grp = lane >> 4, rt = w & 3, kh = w >> 2;
            f32x4 acc[2] = {(f32x4){0.f, 0.f, 0.f, 0.f}, (f32x4){0.f, 0.f, 0.f, 0.f}};
            int blkb = blk; asm volatile("" : "+s"(blkb));
            const bf16_t* ap = H2p + ((size_t)blkb * 64 + 16 * rt + c16) * 2048 + 8 * grp;
#pragma unroll 4
            for (int ks = kh * 32; ks < kh * 32 + 32; ++ks) {
                const bf16x8 af = *(const bf16x8*)(ap + 32 * ks);
#pragma unroll
                for (int et = 0; et < 2; ++et) {
                    const bf16x8 bh = *(const bf16x8*)(WR + (size_t)(16 * et + c16) * 2048 + 32 * ks + 8 * grp);
                    const bf16x8 bl = *(const bf16x8*)(WR + (size_t)32 * 2048 + (size_t)(16 * et + c16) * 2048 + 32 * ks + 8 * grp);
                    acc[et] = mfma16(af, bh, acc[et]); acc[et] = mfma16(af, bl, acc[et]);
                }
            }
#pragma unroll
            for (int et = 0; et < 2; ++et)
#pragma unroll
                for (int r = 0; r < 4; ++r) lgp[kh * 2048 + (16 * rt + 4 * grp + r) * 32 + 16 * et + c16] = acc[et][r];
        }
        __syncthreads();
        int blkc = blk; asm volatile("" : "+s"(blkc));
        if (tid < 64) {
            const size_t tok = (size_t)blkc * 64 + tid;
            float lgv[32];
#pragma unroll
            for (int e = 0; e < 32; ++e) lgv[e] = lgp[tid * 32 + e] + lgp[2048 + tid * 32 + e] + a.b_router[e];
            int idx[4]; float val[4];
            unsigned used = 0u;
#pragma unroll
            for (int k = 0; k < 4; ++k) {
                float best = -INFINITY; int bi = 0;
#pragma unroll
                for (int e = 0; e < 32; ++e) { const bool c = !((used >> e) & 1u) && lgv[e] > best; best = c ? lgv[e] : best; bi = c ? e : bi; }
                used |= 1u << bi; idx[k] = bi; val[k] = best;
            }
            float ex[4], sum = 0.f;
#pragma unroll
            for (int k = 0; k < 4; ++k) { ex[k] = expf(val[k] - val[0]); sum += ex[k]; }
#pragma unroll
            for (int k = 0; k < 4; ++k) {
                ((int*)(ws + wsf::TOPI))[tok * 4 + k] = idx[k]; ((float*)(ws + wsf::TOPW))[tok * 4 + k] = ex[k] / sum;
                const int e = a.route_i ? a.route_i[tok * 4 + k] : idx[k];
                esel[tid * 4 + k] = e;
                eslot[tid * 4 + k] = __hip_atomic_fetch_add(cntl + e, 1, __ATOMIC_RELAXED, __HIP_MEMORY_SCOPE_WORKGROUP);
            }
        }
        __syncthreads();
        if (tid < 32) { const int n = cntl[tid]; basel[tid] = n > 0 ? __hip_atomic_fetch_add(cntg + tid, n, __ATOMIC_RELAXED, __HIP_MEMORY_SCOPE_AGENT) : 0; }
        __syncthreads();
        if (tid < 256) { const int e = esel[tid]; ((int*)(ws + wsf::LIST))[(size_t)e * NPAIR + basel[e] + eslot[tid]] = (blkc * 64 + (tid >> 2)) * 4 + (tid & 3); }
        __syncthreads();
    }
}

struct MoeUnit { int e, m0, pn, rows; };
struct MoeSched {
    typedef MoeUnit UnitT;
    const bf16_t* A; int a_shift; const bf16_t* Wt; size_t wstride; int K; int nN;
    const int* list; const LAS int* tstart; const LAS int* cnt; int nM; int G, c, wave;
    __device__ __forceinline__ bool next(int i, MoeUnit& u) const {
        const int nwg = nM * nN, L = i * G + c; if (L >= nwg) return false;
        int wgid = L; { const int q = nwg / 8, r = nwg % 8, xcd = wgid % 8, off = wgid / 8; wgid = (xcd < r ? xcd * (q + 1) : r * (q + 1) + (xcd - r) * q) + off; }
        constexpr int WG = 4;
        const int nig = WG * nN, gid = wgid / nig, fm = gid * WG, gsz = (nM - fm) < WG ? (nM - fm) : WG;
        const int mt = fm + ((wgid % nig) % gsz); u.pn = (wgid % nig) / gsz;
        int e = 0;
        for (int k = 1; k < NE; ++k) e += (__builtin_amdgcn_readfirstlane(tstart[k]) <= mt) ? 1 : 0;
        u.e = e; u.m0 = (mt - __builtin_amdgcn_readfirstlane(tstart[e])) * 256; const int left = __builtin_amdgcn_readfirstlane(cnt[e]) - u.m0; u.rows = left < 256 ? left : 256;
        return true;
    }
    __device__ __forceinline__ const void* a_buf() const { return A; }
    __device__ __forceinline__ const void* b_buf() const { return Wt; }
    __device__ __forceinline__ unsigned a_soff(const MoeUnit&) const { return 0u; }
    __device__ __forceinline__ unsigned b_soff(const MoeUnit& u) const { return ((unsigned)u.e * (unsigned)wstride + (unsigned)u.pn * 256u * (unsigned)K) * 2u; }
    __device__ __forceinline__ unsigned rowoff(const MoeUnit& u, int r, int C) const {
        const int rc = r < u.rows ? r : u.rows - 1;
        const int id = list[(size_t)u.e * NPAIR + u.m0 + rc] >> a_shift;
        return ((unsigned)id * (unsigned)K + (unsigned)C) * 2u;
    }
    __device__ __forceinline__ void a_offs(const MoeUnit& u, int R0, int R1, int C0, int C1, unsigned (&o)[4]) const {
        o[0] = rowoff(u, R0, C0); o[1] = rowoff(u, R1, C1); o[2] = rowoff(u, R0 + 128, C0); o[3] = rowoff(u, R1 + 128, C1);
    }
};
__device__ __forceinline__ void moe_tables(const MkArgs& a, Frame& F, LAS int*& cnt, LAS int*& tstart) {
    const int f_tid = fresh_tid(F);
    cnt = (LAS int*)(F.lds + LDS_TAB); tstart = cnt + 32;
    const int* cntg = (const int*)(a.ws + wsf::CTL) + wsf::CW_CNT;
    if (f_tid < 32) cnt[f_tid] = __hip_atomic_load(cntg + f_tid, RLX_AGENT);
    __syncthreads();
    if (f_tid == 0) { int s = 0; for (int e = 0; e < NE; ++e) { tstart[e] = s; s += (cnt[e] + 255) >> 8; } tstart[NE] = s; }
    __syncthreads();
}
template <bool F8> struct EpiGateUpT {
    bf16_t* ACT; const float* bias; const int* list; bool skip;
    __device__ __forceinline__ void operator()(const f32x4 (&acc)[2][2][4][2], const MoeUnit& u, int wr, int wc, int fr, int fq) const {
        if (skip) {
#pragma unroll
            for (int ai = 0; ai < 2; ++ai)
#pragma unroll
                for (int bj = 0; bj < 2; ++bj)
#pragma unroll
                    for (int m = 0; m < 4; ++m)
#pragma unroll
                        for (int n = 0; n < 2; ++n) asm volatile("" :: "v"(acc[ai][bj][m][n]));
            return;
        }
        const int col0 = u.pn * 256 + wc * 32 + 8 * fq;
        f32x4 bv[2][2];
#pragma unroll
        for (int bj = 0; bj < 2; ++bj)
#pragma unroll
            for (int n = 0; n < 2; ++n) bv[bj][n] = *(const f32x4*)(bias + (size_t)u.e * 4096 + col0 + bj * 128 + 4 * n);
        int pr[8];
#pragma unroll
        for (int q = 0; q < 8; ++q) { const int r = (q >> 2) * 128 + wr * 64 + (q & 3) * 16 + fr; pr[q] = list[(size_t)u.e * NPAIR + u.m0 + (r < u.rows ? r : 0)]; if (r >= u.rows) pr[q] = -1; }
#pragma unroll
        for (int ai = 0; ai < 2; ++ai)
#pragma unroll
            for (int m = 0; m < 4; ++m) {
                const int pair = pr[ai * 4 + m];
                if (pair >= 0) {
#pragma unroll
                    for (int bj = 0; bj < 2; ++bj) {
                        const f32x4 v0 = acc[ai][bj][m][0] * (F8 ? W8INV : 1.f) + bv[bj][0], v1 = acc[ai][bj][m][1] * (F8 ? W8INV : 1.f) + bv[bj][1];
                        const float gu[8] = {v0[0], v0[1], v0[2], v0[3], v1[0], v1[1], v1[2], v1[3]};
                        float o[4];
#pragma unroll
                        for (int j = 0; j < 4; ++j) {
                            const float glu = fminf(gu[2 * j], 7.0f), lin = fminf(fmaxf(gu[2 * j + 1], -7.0f), 7.0f);
                            o[j] = glu * fast_sigmoid(1.702f * glu) * (lin + 1.f);
                        }
                        if constexpr (F8) *(unsigned*)((unsigned char*)ACT + (size_t)pair * 2048 + (col0 + bj * 128) / 2) = pk4_fp8(o[0], o[1], o[2], o[3]);
                        else *(u32x2*)(ACT + (size_t)pair * 2048 + (col0 + bj * 128) / 2) = (u32x2){pg8::cvt_pk_bf16(o[0], o[1]), pg8::cvt_pk_bf16(o[2], o[3])};
                    }
                }
            }
    }
};
template <bool F8> struct EpiDownT {
    bf16_t* YP; const float* bias; const int* list; const float* wgt;
    __device__ __forceinline__ void operator()(const f32x4 (&acc)[2][2][4][2], const MoeUnit& u, int wr, int wc, int fr, int fq) const {
        const int col0 = u.pn * 256 + wc * 32 + 8 * fq;
        f32x4 bv[2][2];
#pragma unroll
        for (int bj = 0; bj < 2; ++bj)
#pragma unroll
            for (int n = 0; n < 2; ++n) bv[bj][n] = *(const f32x4*)(bias + (size_t)u.e * 2048 + col0 + bj * 128 + 4 * n);
        int pr[8]; float wq[8];
#pragma unroll
        for (int q = 0; q < 8; ++q) { const int r = (q >> 2) * 128 + wr * 64 + (q & 3) * 16 + fr; pr[q] = list[(size_t)u.e * NPAIR + u.m0 + (r < u.rows ? r : 0)]; if (r >= u.rows) pr[q] = -1; }
#pragma unroll
        for (int q = 0; q < 8; ++q) wq[q] = wgt[pr[q] >= 0 ? pr[q] : 0];
#pragma unroll
        for (int ai = 0; ai < 2; ++ai)
#pragma unroll
            for (int m = 0; m < 4; ++m) {
                const int pair = pr[ai * 4 + m];
                if (pair >= 0) {
                    const float wv = wq[ai * 4 + m];
#pragma unroll
                    for (int bj = 0; bj < 2; ++bj) {
                        const f32x4 v0 = (acc[ai][bj][m][0] * (F8 ? W8INV : 1.f) + bv[bj][0]) * wv, v1 = (acc[ai][bj][m][1] * (F8 ? W8INV : 1.f) + bv[bj][1]) * wv;
                        *(u32x4*)(YP + (size_t)pair * 2048 + col0 + bj * 128) =
                            (u32x4){pg8::cvt_pk_bf16(v0[0], v0[1]), pg8::cvt_pk_bf16(v0[2], v0[3]), pg8::cvt_pk_bf16(v1[0], v1[1]), pg8::cvt_pk_bf16(v1[2], v1[3])};
                    }
                }
            }
    }
};
__device__ __forceinline__ void phase9(const MkArgs& a, Frame& F, bool skip_epi = false) {
    unsigned char* ws = a.ws;
    LAS int* cnt; LAS int* tstart; moe_tables(a, F, cnt, tstart);
#if MOE_FP8
    MoeSched S{(const bf16_t*)(ws + wsf::H2F8), 2, (const bf16_t*)(ws + wsf::WGU8), (size_t)4096 * 1024, 1024, 16, (const int*)(ws + wsf::LIST), tstart, cnt, __builtin_amdgcn_readfirstlane(tstart[NE]), F.G, F.bid, F.wave};
    EpiGateUpT<true> E{(bf16_t*)(ws + wsf::ACT8), a.b_gate_up, (const int*)(ws + wsf::LIST), skip_epi};
    pg8::gemm_phase<EpiGateUpT<true>, MoeSched, true>(F.lds, S, E);
#else
    MoeSched S{(const bf16_t*)(ws + wsf::H2), 2, (const bf16_t*)(ws + wsf::WGU_T), (size_t)4096 * 2048, 2048, 16, (const int*)(ws + wsf::LIST), tstart, cnt, __builtin_amdgcn_readfirstlane(tstart[NE]), F.G, F.bid, F.wave};
    EpiGateUpT<false> E{(bf16_t*)(ws + wsf::ACT), a.b_gate_up, (const int*)(ws + wsf::LIST), skip_epi};
    pg8::gemm_phase<EpiGateUpT<false>, MoeSched, false>(F.lds, S, E);
#endif
}
__device__ __forceinline__ void phase10(const MkArgs& a, Frame& F) {
    unsigned char* ws = a.ws;
    LAS int* cnt; LAS int* tstart; moe_tables(a, F, cnt, tstart);
    const float* wgt = a.route_w ? a.route_w : (const float*)(ws + wsf::TOPW);
#if MOE_FP8
    MoeSched S{(const bf16_t*)(ws + wsf::ACT8), 0, (const bf16_t*)(ws + wsf::WDN8), (size_t)2048 * 1024, 1024, 8, (const int*)(ws + wsf::LIST), tstart, cnt, __builtin_amdgcn_readfirstlane(tstart[NE]), F.G, F.bid, F.wave};
    EpiDownT<true> E{(bf16_t*)(ws + wsf::YP), a.b_down, (const int*)(ws + wsf::LIST), wgt};
    pg8::gemm_phase<EpiDownT<true>, MoeSched, true>(F.lds, S, E);
#else
    MoeSched S{(const bf16_t*)(ws + wsf::ACT), 0, (const bf16_t*)(ws + wsf::WDN_T), (size_t)2048 * 2048, 2048, 8, (const int*)(ws + wsf::LIST), tstart, cnt, __builtin_amdgcn_readfirstlane(tstart[NE]), F.G, F.bid, F.wave};
    EpiDownT<false> E{(bf16_t*)(ws + wsf::YP), a.b_down, (const int*)(ws + wsf::LIST), wgt};
    pg8::gemm_phase<EpiDownT<false>, MoeSched, false>(F.lds, S, E);
#endif
}

__device__ __forceinline__ void phase11(const MkArgs& a, Frame& F) {
    const int f_tid = fresh_tid(F), f_lane = f_tid & 63, f_wave = F.wave;
    unsigned char* ws = a.ws;
    const float* mod = (const float*)(ws + wsf::MOD);
    const bf16_t* YPp = (const bf16_t*)(ws + wsf::YP);
    const bf16_t* X1p = (const bf16_t*)(ws + wsf::X1);
    const int gw = F.vcu * fp::NW + f_wave, NGW = F.G * fp::NW, lane = f_lane;
    if (gw >= NTOK) return;
    u32x4 yq[16]; u32x4 xq[4];
#define P11_LOAD(m_) do { const size_t m__ = (size_t)(m_); \
        _Pragma("unroll") for (int k = 0; k < 4; ++k) _Pragma("unroll") for (int j = 0; j < 4; ++j) yq[k * 4 + j] = *(const u32x4*)(YPp + (m__ * 4 + k) * 2048 + 8 * (64 * j + lane)); \
        _Pragma("unroll") for (int j = 0; j < 4; ++j) xq[j] = *(const u32x4*)(X1p + m__ * D + 8 * (64 * j + lane)); } while (0)
    P11_LOAD(gw);
    for (int m = gw; m < NTOK; m += NGW) {
        const int b = m / S;
        float yv[32]; u32x4 xv[4];
#pragma unroll
        for (int i = 0; i < 32; ++i) yv[i] = 0.f;
#pragma unroll
        for (int k = 0; k < 4; ++k)
#pragma unroll
            for (int j = 0; j < 4; ++j) { float f[8]; unpack8(yq[k * 4 + j], f);
#pragma unroll
                for (int e = 0; e < 8; ++e) yv[8 * j + e] += f[e]; }
#pragma unroll
        for (int i = 0; i < 4; ++i) xv[i] = xq[i];
        { const int mn = m + NGW < NTOK ? m + NGW : m; P11_LOAD(mn); }
        float ss = 0.f;
#pragma unroll
        for (int i = 0; i < 32; ++i) ss += yv[i] * yv[i];
        const float r = rsqrtf(wave_sum_f(ss) * (1.f / D) + EPS);
#pragma unroll
        for (int j = 0; j < 4; ++j) {
            const int c0 = 8 * (64 * j + lane);
            float xf[8]; unpack8(xv[j], xf);
#pragma unroll
            for (int hq = 0; hq < 2; ++hq) {
                const f32x4 xr = (f32x4){xf[4 * hq], xf[4 * hq + 1], xf[4 * hq + 2], xf[4 * hq + 3]};
                const f32x4 gt = *(const f32x4*)(mod + b * MODW + MOD_GT2 + c0 + 4 * hq), gp = *(const f32x4*)(a.g_post_ffn + c0 + 4 * hq);
                f32x4 o;
                o.x = xr.x + gt.x * (yv[8 * j + 4 * hq + 0] * r * gp.x); o.y = xr.y + gt.y * (yv[8 * j + 4 * hq + 1] * r * gp.y);
                o.z = xr.z + gt.z * (yv[8 * j + 4 * hq + 2] * r * gp.z); o.w = xr.w + gt.w * (yv[8 * j + 4 * hq + 3] * r * gp.w);
                *(f32x4*)(a.out + (size_t)m * D + c0 + 4 * hq) = o;
            }
        }
    }
#undef P11_LOAD
}
constexpr int N_PHASES = 12;
#ifndef EPI_SKIP_PROBE
#define EPI_SKIP_PROBE 0
#endif
#ifndef REP_MASK
#define REP_MASK 0
#endif
__global__ void __launch_bounds__(fp::NT, 2) mk_fwd(MkArgs a) {
    extern __shared__ __attribute__((aligned(16))) unsigned char lds_raw[];
    Frame F;
    F.lds = (LAS unsigned char*)lds_raw;
    F.wave = __builtin_amdgcn_readfirstlane((int)threadIdx.x >> 6);
    F.G = gridDim.x; F.bid = blockIdx.x; F.vcu = (F.G % 8 == 0) ? (F.bid % 8) * (F.G / 8) + F.bid / 8 : F.bid;
    volatile LAS unsigned* misc = (volatile LAS unsigned*)(F.lds + LDS_MISC);
    if (F.wave == 0) misc[lane_id()] = 0u;
    __syncthreads();
    XcdBarrier bar = xcd_barrier_post((unsigned*)(a.ws + wsf::CTL) + wsf::CW_BAR, misc + 8, F.wave == 0 && lane_id() == 0);
    const int lo = a.ph_lo, hi = a.ph_hi;
#define IN(k) (lo <= (k) && (k) < hi)
#define SEAM(k) do { if (IN(k) && IN((k) + 1)) xcd_barrier(bar, F.wave == 0 && lane_id() == 0); } while (0)
    if (IN(0)) { phase0(a, F); if ((REP_MASK >> 0) & 1) phase0(a, F); } SEAM(0);
    if (IN(1)) { phase1(a, F); if ((REP_MASK >> 1) & 1) phase1(a, F); } SEAM(1);
    if (IN(2)) { phase2(a, F); if ((REP_MASK >> 2) & 1) phase2(a, F); } SEAM(2);
#if NPH > 3
    if (IN(3)) { phase3(a, F); if ((REP_MASK >> 3) & 1) phase3(a, F); } SEAM(3);
#endif
#if NPH > 4
    if (IN(4)) { phase4(a, F); if ((REP_MASK >> 4) & 1) phase4(a, F); } SEAM(4);
#endif
#if NPH > 5
    if (IN(5)) { phase5(a, F); if ((REP_MASK >> 5) & 1) phase5(a, F); } SEAM(5);
#endif
#if NPH > 6
    if (IN(6)) { phase6(a, F); if ((REP_MASK >> 6) & 1) phase6(a, F); } SEAM(6);
#endif
#if NPH > 7
    if (IN(7)) { phase7(a, F); if ((REP_MASK >> 7) & 1) phase7(a, F); } SEAM(7);
#endif
#if NPH > 8
    if (IN(8)) { phase8(a, F); if ((REP_MASK >> 8) & 1) phase8(a, F); } SEAM(8);
#endif
#if NPH > 9
    if (IN(9)) { phase9(a, F); if ((REP_MASK >> 9) & 1) phase9(a, F, EPI_SKIP_PROBE != 0); } SEAM(9);
#endif
#if NPH > 10
    if (IN(10)) { phase10(a, F); if ((REP_MASK >> 10) & 1) phase10(a, F); } SEAM(10);
#endif
#if NPH > 11
    if (IN(11)) { phase11(a, F); if ((REP_MASK >> 11) & 1) phase11(a, F); }
#endif
#undef IN
#undef SEAM
}

static void fill_args(MkArgs& a, void* const* d_in, void* d_out, void* d_ws) {
    a.x = (const float*)d_in[0]; a.c = (const float*)d_in[1]; a.positions = (const int*)d_in[2]; a.w_ada = (const float*)d_in[3]; a.b_ada = (const float*)d_in[4];
    a.g_pre_mix = (const float*)d_in[5]; a.g_post_mix = (const float*)d_in[6]; a.g_pre_ffn = (const float*)d_in[7]; a.g_post_ffn = (const float*)d_in[8];
    a.w_in = (const float*)d_in[9]; a.b_in = (const float*)d_in[10]; a.conv_qk = (const float*)d_in[11]; a.sinks = (const float*)d_in[12]; a.g_mlstm = (const float*)d_in[13];
    a.w_attn_proj = (const float*)d_in[14]; a.w_mlstm_proj = (const float*)d_in[15]; a.w_out = (const float*)d_in[16]; a.w_router = (const float*)d_in[17]; a.b_router = (const float*)d_in[18];
    a.w_gate_up = (const float*)d_in[19]; a.b_gate_up = (const float*)d_in[20]; a.w_down = (const float*)d_in[21]; a.b_down = (const float*)d_in[22];
    a.out = (float*)d_out; a.ws = (unsigned char*)d_ws; a.route_i = nullptr; a.route_w = nullptr; a.ph_lo = 0; a.ph_hi = 0;
}
static int mk_setup() {
    static int grid = 0;
    if (grid == 0) {
        int dev = 0, cus = 0;
        if (hipGetDevice(&dev) != hipSuccess || hipDeviceGetAttribute(&cus, hipDeviceAttributeMultiprocessorCount, dev) != hipSuccess) { grid = -1; return grid; }
        if (hipFuncSetAttribute((const void*)mk_fwd, hipFuncAttributeMaxDynamicSharedMemorySize, LDS_BYTES) != hipSuccess) { grid = -1; return grid; }
        int per_cu = 0;
        if (hipOccupancyMaxActiveBlocksPerMultiprocessor(&per_cu, (const void*)mk_fwd, fp::NT, LDS_BYTES) != hipSuccess || per_cu < 1) { (void)hipGetLastError(); }
        grid = cus;
    }
    return grid;
}

extern "C" void kernel_launch(void* const* d_in, const int* in_sizes, int n_in, void* d_out, int out_size, void* d_ws, size_t ws_size, hipStream_t stream) {
    if (n_in != 23 || ws_size < wsf::END) return;
    const int grid = mk_setup();
    if (grid <= 0) return;
    if (hipMemsetAsync((unsigned char*)d_ws + wsf::CTL, 0, 65536, stream) != hipSuccess) return;
    MkArgs a{}; fill_args(a, d_in, d_out, d_ws);
    a.ph_lo = 0; a.ph_hi = N_PHASES;
    hipLaunchKernelGGL(mk_fwd, dim3(grid), dim3(fp::NT), LDS_BYTES, stream, a);
}
```

```cpp
#include <hip/hip_runtime.h>
#include <stdint.h>
#include <math.h>
#define NPH 12
#define MOE_FP8 1
#define REP_MASK 0
#define CONV_WGS 80
#define DRY_PROBE 0
#define EPI_SKIP_PROBE 0
#define CONV_SPLIT 900
#define P0_PARTS 7
namespace cfg {
constexpr int D = 2048, NB = 2, S = 8192, NTOK = NB * S;
constexpr int HQ = 16, HKV = 2, HD = 64, QW = 1024;
constexpr int MH = 4, MDV = 256, MDK = 128, MQKW = 512, MVW = 1024, CL = 128, NC = S / CL;
constexpr int NE = 32, TOPK = 4, DFF = 2048, NPAIR = NTOK * TOPK;
constexpr int INW = 8456;
constexpr int OFF_AQ = 0, OFF_AK = 1024, OFF_AV = 1152, OFF_MQ = 1280, OFF_MK = 1792, OFF_MV = 2304, OFF_MO = 3328,
              OFF_MI = 4352, OFF_MF = 4356, OFF_GA = 4360, OFF_GM = 6408;
constexpr float EPS = 1e-6f;
constexpr int MOD_SH1 = 0, MOD_SC1 = 2048, MOD_GT1 = 4096, MOD_SH2 = 6144, MOD_SC2 = 8192, MOD_GT2 = 10240, MODW = 12288;
}
using namespace cfg;
__device__ __forceinline__ float silu_f(float x) { return x / (1.f + expf(-x)); }
__device__ __forceinline__ float sigmoid_f(float x) { return 1.f / (1.f + expf(-x)); }
__device__ __forceinline__ void rope_cs(int pos, int i, float& c, float& s) {
    const float invf[8] = {1.0f, 0.1939227432012558f, 0.03760603070259094f, 0.007292664609849453f,
                           0.0014142135623842478f, 0.00027424818836152554f, 5.3182957344688475e-05f, 1.0313385246263351e-05f};
    float f = i == 0 ? invf[0] : i == 1 ? invf[1] : i == 2 ? invf[2] : i == 3 ? invf[3] : i == 4 ? invf[4] : i == 5 ? invf[5] : i == 6 ? invf[6] : invf[7];
    float ang = (float)pos * f;
    double t = (double)ang * 0.15915494309189535;
    t -= rint(t);
    float tf = (float)t;
    s = __builtin_amdgcn_sinf(tf);
    c = __builtin_amdgcn_cosf(tf);
}
__device__ __forceinline__ float softcap_f(float z) { return 15.f * tanhf(z / 15.f); }
__device__ __forceinline__ float logsigmoid_f(float z) { return fminf(z, 0.f) - log1pf(expf(-fabsf(z))); }
#define GAS __attribute__((address_space(1)))
#define LAS __attribute__((address_space(3)))
typedef unsigned short bf16_t;
typedef short bf16x8 __attribute__((ext_vector_type(8)));
typedef short bf16x4 __attribute__((ext_vector_type(4)));
typedef float f32x4 __attribute__((ext_vector_type(4)));
typedef float f32x2 __attribute__((ext_vector_type(2)));
typedef unsigned u32x4 __attribute__((ext_vector_type(4)));
typedef unsigned u32x2 __attribute__((ext_vector_type(2)));
#define RLX_AGENT __ATOMIC_RELAXED, __HIP_MEMORY_SCOPE_AGENT
#define LDS_WAIT() asm volatile("s_waitcnt lgkmcnt(0)" ::: "memory")
#define VM_WAIT() asm volatile("s_waitcnt vmcnt(0)" ::: "memory")

__device__ __forceinline__ unsigned f2bf(float f) { unsigned u = __builtin_bit_cast(unsigned, f); return (u + 0x7fffu + ((u >> 16) & 1u)) >> 16; }
__device__ __forceinline__ unsigned pk2(float lo, float hi) { return f2bf(lo) | (f2bf(hi) << 16); }
__device__ __forceinline__ float bf2f(unsigned short h) { return __builtin_bit_cast(float, (unsigned)h << 16); }
__device__ __forceinline__ float bflo(unsigned w) { return __builtin_bit_cast(float, w << 16); }
__device__ __forceinline__ float bfhi(unsigned w) { return __builtin_bit_cast(float, w & 0xffff0000u); }
__device__ __forceinline__ unsigned pk4_fp8(float a, float b, float c, float d) {
    a = __builtin_amdgcn_fmed3f(a, -448.f, 448.f); b = __builtin_amdgcn_fmed3f(b, -448.f, 448.f); c = __builtin_amdgcn_fmed3f(c, -448.f, 448.f); d = __builtin_amdgcn_fmed3f(d, -448.f, 448.f);
    int r = __builtin_amdgcn_cvt_pk_fp8_f32(a, b, 0, false); r = __builtin_amdgcn_cvt_pk_fp8_f32(c, d, r, true); return (unsigned)r;
}
constexpr float YP8SCALE = 16.f;
constexpr float W8SCALE = 64.f, W8INV = 1.f / 64.f;
__device__ __forceinline__ void unpack8_fp8(const u32x2 v, float (&f)[8]) {
    const f32x2 a = __builtin_amdgcn_cvt_pk_f32_fp8((int)v.x, false), b = __builtin_amdgcn_cvt_pk_f32_fp8((int)v.x, true);
    const f32x2 c = __builtin_amdgcn_cvt_pk_f32_fp8((int)v.y, false), d = __builtin_amdgcn_cvt_pk_f32_fp8((int)v.y, true);
    f[0] = a.x; f[1] = a.y; f[2] = b.x; f[3] = b.y; f[4] = c.x; f[5] = c.y; f[6] = d.x; f[7] = d.y;
}
__device__ __forceinline__ float fast_sigmoid(float x) { return __builtin_amdgcn_rcpf(1.f + __builtin_amdgcn_exp2f(-1.4426950408889634f * x)); }

namespace fp {
constexpr int NW = 8, NT = NW * 64;
constexpr int NIN = 8448;
constexpr int PB_Q = 0, PB_K = 1024, PB_V = 1152, PB_MQ = 1280, PB_MK = 1792, PB_MV = 2304, PB_MO = 3328, PB_GA = 4352, PB_GM = 6400;
constexpr float QSCALE = 0.125f * 1.4426950408889634f;
constexpr float LOG2E = 1.4426950408889634f;
}

namespace wsf {
constexpr size_t AL(size_t x) { return (x + 255) & ~(size_t)255; }
constexpr size_t CTL = 0, CTL_BYTES = 1u << 20;
constexpr size_t MODP = CTL + CTL_BYTES;
constexpr size_t MOD = AL(MODP + (size_t)16 * 2 * MODW * 4);
constexpr size_t BINP = AL(MOD + (size_t)2 * MODW * 4);
constexpr size_t CS = AL(BINP + (size_t)fp::NIN * 4);
constexpr size_t WRT = AL(CS + (size_t)NTOK * 8 * 8);
constexpr size_t WIN_T = AL(WRT + (size_t)2 * 32 * 2048 * 2);
constexpr size_t WAP_T = AL(WIN_T + (size_t)fp::NIN * 2048 * 2);
constexpr size_t WMP_T = AL(WAP_T + (size_t)2048 * 1024 * 2);
constexpr size_t WOUT_T = AL(WMP_T + (size_t)2048 * 1024 * 2);
constexpr size_t WGU_T = AL(WOUT_T + (size_t)2048 * 2048 * 2);
#if MOE_FP8
constexpr size_t WDN_T = WGU_T;
constexpr size_t GATES = WGU_T;
#else
constexpr size_t WDN_T = AL(WGU_T + (size_t)32 * 4096 * 2048 * 2);
constexpr size_t GATES = AL(WDN_T + (size_t)32 * 2048 * 2048 * 2);
#endif
constexpr size_t BCUM = AL(GATES + (size_t)NTOK * 8 * 4);
constexpr size_t LOGI = AL(BCUM + (size_t)8 * S * 4);
constexpr size_t GSUM = AL(LOGI + (size_t)8 * S * 4);
constexpr size_t MLOC = AL(GSUM + 512 * 4);
constexpr size_t MPREV = AL(MLOC + 512 * 4);
constexpr size_t DN = AL(MPREV + 512 * 4);
constexpr size_t NPREV = AL(DN + (size_t)512 * 128 * 4);
constexpr size_t DCT = AL(NPREV + (size_t)512 * 128 * 4);
constexpr size_t Y = AL(DCT + (size_t)512 * 256 * 128 * 4);
constexpr size_t X1 = AL(Y + (size_t)NTOK * 2048 * 2);
constexpr size_t H2 = AL(X1 + (size_t)NTOK * 2048 * 4);
constexpr size_t TOPI = AL(H2 + (size_t)NTOK * 2048 * 2);
constexpr size_t TOPW = AL(TOPI + (size_t)NPAIR * 4);
constexpr size_t LIST = AL(TOPW + (size_t)NPAIR * 4);
constexpr size_t PROJB = AL(LIST + (size_t)NE * NPAIR * 4);
constexpr size_t ACT = PROJB;
constexpr size_t YPREG = AL(PROJB + (size_t)NTOK * fp::NIN * 2);
constexpr size_t H1 = YPREG;
constexpr size_t MG = AL(H1 + (size_t)NTOK * 2048 * 2);
constexpr size_t OAT = AL(MG + (size_t)NTOK * 2048 * 2);
constexpr size_t HM = AL(OAT + (size_t)NTOK * 1024 * 2);
constexpr size_t QC = AL(HM + (size_t)NTOK * 1024 * 2);
constexpr size_t KC = AL(QC + (size_t)NTOK * 512 * 2);
constexpr size_t CPT = AL(KC + (size_t)NTOK * 512 * 2);
constexpr size_t YP = YPREG;
constexpr size_t F8BASE = AL(CPT + (size_t)512 * 256 * 128 * 2) > AL(YP + (size_t)NPAIR * 2048 * 2) ? AL(CPT + (size_t)512 * 256 * 128 * 2) : AL(YP + (size_t)NPAIR * 2048 * 2);
constexpr size_t WGU8 = F8BASE;
constexpr size_t WDN8 = AL(WGU8 + (size_t)32 * 4096 * 2048);
constexpr size_t H2F8 = AL(WDN8 + (size_t)32 * 2048 * 2048);
constexpr size_t ACT8 = AL(H2F8 + (size_t)NTOK * 2048);
constexpr size_t END = AL(ACT8 + (size_t)NPAIR * 2048);
static_assert((size_t)NPAIR * 2048 * 2 <= (size_t)NTOK * fp::NIN * 2, "ACT fits over PROJB");
constexpr int CW_BAR = 4096;
constexpr int CW_CNT = 8192;
}

constexpr int RING_BYTES = 131072;
constexpr int LDS_TAB = RING_BYTES;
constexpr int LDS_MISC = RING_BYTES + 8192;
constexpr int LDS_BYTES = 147456;

#define XB_TMO      128
#define XB_XCNT(j)  (256  + 64 * (j))
#define XB_XSUB(j)  (1280 + 64 * (j))
#define XB_XGEN(j)  (2304 + 64 * (j))
#define XB_TOP      3328
#define XB_TOPGEN   3392
#define XCD_BAR_WORDS 3456
#define XB_SPIN_CAP (1u << 18)
__device__ __forceinline__ unsigned xb_ld(unsigned* p)              { return __hip_atomic_load(p, __ATOMIC_RELAXED, __HIP_MEMORY_SCOPE_AGENT); }
__device__ __forceinline__ unsigned xb_add(unsigned* p, unsigned v) { return __hip_atomic_fetch_add(p, v, __ATOMIC_RELAXED, __HIP_MEMORY_SCOPE_AGENT); }
__device__ __forceinline__ unsigned xb_xcc_id() { return (unsigned)__builtin_amdgcn_s_getreg((3 << 11) | 20) & 0xFu; }
#define XB_SPIN(cond, bar) do { unsigned _sp = 0; while (cond) { __builtin_amdgcn_s_sleep(1); \
    if ((++_sp & 255u) == 0u) { if (xb_ld(&(bar)[XB_TMO])) break; if (_sp > XB_SPIN_CAP) { atomicAdd(&(bar)[XB_TMO], 1u); break; } } } } while (0)
struct XcdBarrier { unsigned* bar; unsigned x; volatile LAS unsigned* st; };
__device__ __forceinline__ XcdBarrier xcd_barrier_post(unsigned* bar, volatile LAS unsigned* st, bool t0) {
    XcdBarrier b; b.bar = bar; b.x = xb_xcc_id(); b.st = st;
    if (t0) (void)xb_add(&bar[XB_XCNT(b.x)], 1u);
    return b;
}
__device__ __forceinline__ void xcd_barrier_complete(unsigned* bar, unsigned x, unsigned& nloc, unsigned& nx) {
    const unsigned G = gridDim.x * gridDim.y * gridDim.z;
    unsigned sum, cnt, mine, sp = 0u;
    for (;;) {
        sum = 0u; cnt = 0u; mine = 0u;
#pragma unroll
        for (unsigned j = 0; j < 16; ++j) { const unsigned c = xb_ld(&bar[XB_XCNT(j)]); sum += c; cnt += (c > 0u) ? 1u : 0u; mine = (j == x) ? c : mine; }
        if (sum == G) break;
        __builtin_amdgcn_s_sleep(1);
        if ((++sp & 255u) == 0u) { if (xb_ld(&bar[XB_TMO])) break; if (sp > XB_SPIN_CAP) { atomicAdd(&bar[XB_TMO], 1u); break; } }
    }
    nloc = mine > 0u ? mine : 1u; nx = cnt > 0u ? cnt : 1u;
}
__device__ __forceinline__ void xcd_barrier(const XcdBarrier& b, bool t0) {
    asm volatile("s_waitcnt vmcnt(0)" ::: "memory");
    __syncthreads();
    if (t0) {
        unsigned* bar = b.bar;
        __builtin_amdgcn_s_waitcnt(0);
        unsigned nloc = b.st[0], nx = b.st[1];
        if (nloc == 0u) { xcd_barrier_complete(bar, b.x, nloc, nx); b.st[0] = nloc; b.st[1] = nx; }
        const unsigned old = xb_add(&bar[XB_XSUB(b.x)], 1u);
        const unsigned gen = old / nloc;
        if (old + 1u == (gen + 1u) * nloc) {
            __builtin_amdgcn_fence(__ATOMIC_RELEASE, "agent");
            asm volatile("s_waitcnt vmcnt(0)" ::: "memory");
            const unsigned og = xb_add(&bar[XB_TOP], 1u);
            const unsigned tg = og / nx;
            if (og + 1u == (tg + 1u) * nx) xb_add(&bar[XB_TOPGEN], 1u);
            else XB_SPIN(xb_ld(&bar[XB_TOPGEN]) == tg, bar);
            __builtin_amdgcn_fence(__ATOMIC_ACQUIRE, "agent");
            xb_add(&bar[XB_XGEN(b.x)], 1u);
            asm volatile("s_waitcnt vmcnt(0)" ::: "memory");
        } else {
            XB_SPIN(xb_ld(&bar[XB_XGEN(b.x)]) == gen, bar);
            __builtin_amdgcn_fence(__ATOMIC_ACQUIRE, "agent");
            asm volatile("s_waitcnt vmcnt(0)" ::: "memory");
        }
    }
    __syncthreads();
}

namespace pg8 {
constexpr int BM = 256, BK = 64, HALF = 128, HTB = HALF * BK * 2, STAGE_BYTES = 8 * HTB, NXCD = 8, WGM = 8;
__host__ __device__ __forceinline__ int lds_byte(int r, int c) { const int st = (r >> 4) * 2 + (c >> 5), rr = r & 15, cc = c & 31, ob = rr * 64 + cc * 2; return st * 1024 + (ob ^ (((ob >> 9) & 1) << 5)); }
__host__ __device__ __forceinline__ void stage_rc(int b, int& R, int& C) { const int st = b / 1024, sb = b % 1024, swz = sb ^ (((sb >> 9) & 1) << 5); R = (st >> 1) * 16 + swz / 64; C = (st & 1) * 32 + (swz % 64) / 2; }
__host__ __device__ __forceinline__ int perm32(int rho) { const int n = rho >> 4, i = rho & 15; return 8 * (i >> 2) + 4 * n + (i & 3); }
typedef int v8i32_t __attribute__((ext_vector_type(8)));
template <bool F8> struct FragSel { typedef bf16x8 T; };
typedef short s16x16_t __attribute__((ext_vector_type(16)));
template <> struct FragSel<true> { typedef s16x16_t T; };
template <bool F8> __device__ __forceinline__ typename FragSel<F8>::T ld_frag(const LAS unsigned char* p) {
    if constexpr (F8) { const bf16x8 lo = *(const LAS bf16x8*)p, hi = *(const LAS bf16x8*)(p + 1024); return __builtin_shufflevector(lo, hi, 0, 1, 2, 3, 4, 5, 6, 7, 8, 9, 10, 11, 12, 13, 14, 15); }
    else return *(const LAS bf16x8*)p;
}
__device__ __forceinline__ f32x4 mma_frag(bf16x8 a, bf16x8 b, f32x4 c) { return __builtin_amdgcn_mfma_f32_16x16x32_bf16(a, b, c, 0, 0, 0); }
__device__ __forceinline__ f32x4 mma_frag(s16x16_t a, s16x16_t b, f32x4 c) {
    const v8i32_t av = __builtin_bit_cast(v8i32_t, a), bv = __builtin_bit_cast(v8i32_t, b);
    asm volatile("v_mfma_scale_f32_16x16x128_f8f6f4 %0, %1, %2, %0, %3, %3 op_sel_hi:[0,0,0]" : "+v"(c) : "v"(av), "v"(bv), "v"(0x7f7f7f7f));
    return c;
}
__device__ __forceinline__ unsigned cvt_pk_bf16(float lo, float hi) { unsigned r; asm volatile("v_cvt_pk_bf16_f32 %0, %1, %2" : "=v"(r) : "v"(lo), "v"(hi)); return r; }

__device__ __forceinline__ bool static_tile(int L, int nM, int nN, int& pm, int& pn) {
    const int nwg = nM * nN; if (L >= nwg) return false;
    int wgid = L; { const int q = nwg / NXCD, r = nwg % NXCD, xcd = wgid % NXCD, off = wgid / NXCD; wgid = (xcd < r ? xcd * (q + 1) : r * (q + 1) + (xcd - r) * q) + off; }
    const int nig = WGM * nN, gid = wgid / nig, fm = gid * WGM, gsz = (nM - fm) < WGM ? (nM - fm) : WGM;
    pm = fm + ((wgid % nig) % gsz); pn = (wgid % nig) / gsz; return true;
}

typedef int v8i32 __attribute__((ext_vector_type(8)));
template <class Epi, class Sched, bool FP8 = false, int PROBE = 0>
__device__ __forceinline__ void gemm_phase(LAS unsigned char* lds, const Sched& S, const Epi& E) {
    typedef typename Sched::UnitT Unit;
    const int wid = S.wave, lane = (int)__builtin_amdgcn_mbcnt_hi(~0u, __builtin_amdgcn_mbcnt_lo(~0u, 0u)), tid = (wid << 6) | lane, wr = wid >> 2, wc = wid & 3, fr = lane & 15, fq = lane >> 4;
    const int K = S.K, nt = K / BK;
    int R[2], C[2];
    unsigned voffB[2];
#pragma unroll
    for (int i = 0; i < 2; ++i) { stage_rc(tid * 16 + i * 8192, R[i], C[i]); const int Rb = (R[i] & ~31) + perm32(R[i] & 31); voffB[i] = (unsigned)(Rb * K + C[i]) * 2u; }
    const unsigned kstep = (unsigned)(BK * 2);
    const unsigned hstepB = (unsigned)HALF * (unsigned)K * 2u;
    const unsigned ldsw = (unsigned)wid * 1024u;
    const int aoff = lds_byte(wr * 64 + fr, fq * 8), boff = lds_byte(wc * 32 + fr, fq * 8);
#define PG8_SA(b, h) (((b) * 2 + (h)) * HTB)
#define PG8_SB(b, h) ((4 + (b) * 2 + (h)) * HTB)
    const __amdgpu_buffer_rsrc_t rA = __builtin_amdgcn_make_buffer_rsrc((void*)S.a_buf(), 0, -1, 0x00020000), rB = __builtin_amdgcn_make_buffer_rsrc((void*)S.b_buf(), 0, -1, 0x00020000);
#define PG8_STAGE2(bufoff, rs, soff, o0, o1) do { \
        __builtin_amdgcn_raw_ptr_buffer_load_lds(rs, (LAS void*)(lds + (bufoff) + ldsw), 16, (int)(o0), (int)(soff), 0, 0); \
        __builtin_amdgcn_raw_ptr_buffer_load_lds(rs, (LAS void*)(lds + (bufoff) + ldsw + 8192), 16, (int)(o1), (int)(soff), 0, 0); } while (0)
#define PG8_STAGEA(bufoff, soff, o0, o1) PG8_STAGE2(bufoff, rA, soff, o0, o1)
#define PG8_STAGEB(bufoff, soff) PG8_STAGE2(bufoff, rB, soff, voffB[0], voffB[1])
    typedef typename pg8::FragSel<FP8>::T FragT;
    constexpr int NK = FP8 ? 1 : 2;
#define PG8_LDA(dst, b, h) do { if constexpr (PROBE == 4) break; _Pragma("unroll") for (int m = 0; m < 4; ++m) _Pragma("unroll") for (int k = 0; k < NK; ++k) dst[m][k] = pg8::ld_frag<FP8>(lds + PG8_SA(b, h) + aoff + m * 2048 + k * 1024); } while (0)
#define PG8_LDB(dst, b, h) do { if constexpr (PROBE == 4) break; _Pragma("unroll") for (int n = 0; n < 2; ++n) _Pragma("unroll") for (int k = 0; k < NK; ++k) dst[n][k] = pg8::ld_frag<FP8>(lds + PG8_SB(b, h) + boff + n * 2048 + k * 1024); } while (0)
#define PG8_MMA(ai, bj, At, Bt) do { if constexpr (PROBE == 3) break; __builtin_amdgcn_s_setprio(1); if constexpr (FP8) asm volatile("s_nop 1"); _Pragma("unroll") for (int m = 0; m < 4; ++m) _Pragma("unroll") for (int n = 0; n < 2; ++n) _Pragma("unroll") for (int k = 0; k < NK; ++k) \
        acc[ai][bj][m][n] = pg8::mma_frag(Bt[n][k], At[m][k], acc[ai][bj][m][n]); __builtin_amdgcn_s_setprio(0); } while (0)
#define PG8_WAIT_V(n) asm volatile("s_waitcnt vmcnt(" #n ")" ::: "memory")
#define PG8_WAIT_L(n) asm volatile("s_waitcnt lgkmcnt(" #n ")" ::: "memory")
#define PG8_BAR __builtin_amdgcn_s_barrier()
#define PG8_SCHED __builtin_amdgcn_sched_barrier(0)
    Unit cur, nxt; int ui = 0;
    if (!S.next(0, cur)) return;
    f32x4 acc[2][2][4][2];
#pragma unroll
    for (int a = 0; a < 2; ++a)
#pragma unroll
        for (int b = 0; b < 2; ++b)
#pragma unroll
            for (int m = 0; m < 4; ++m)
#pragma unroll
                for (int n = 0; n < 2; ++n) { float z0, z1, z2, z3; asm volatile("v_mov_b32 %0, 0\n\tv_mov_b32 %1, 0\n\tv_mov_b32 %2, 0\n\tv_mov_b32 %3, 0" : "=v"(z0), "=v"(z1), "=v"(z2), "=v"(z3)); acc[a][b][m][n] = (f32x4){z0, z1, z2, z3}; }
    FragT At[4][NK], B0[2][NK], B1[2][NK];
    if constexpr (PROBE == 4) { _Pragma("unroll") for (int m = 0; m < 4; ++m) _Pragma("unroll") for (int k = 0; k < NK; ++k) At[m][k] = FragT{}; _Pragma("unroll") for (int n = 0; n < 2; ++n) _Pragma("unroll") for (int k = 0; k < NK; ++k) { B0[n][k] = FragT{}; B1[n][k] = FragT{}; } }
    unsigned ca[4], na[4];
    S.a_offs(cur, R[0], R[1], C[0], C[1], ca);
    unsigned cA = (unsigned)__builtin_amdgcn_readfirstlane((int)S.a_soff(cur)), cB = (unsigned)__builtin_amdgcn_readfirstlane((int)S.b_soff(cur));
    PG8_STAGEB(PG8_SB(0, 0), cB); PG8_STAGEB(PG8_SB(0, 1), cB + hstepB); PG8_STAGEA(PG8_SA(0, 0), cA, ca[0], ca[1]); PG8_STAGEA(PG8_SA(0, 1), cA, ca[2], ca[3]);
    if (wr == 1) PG8_BAR;
    PG8_WAIT_V(2); PG8_BAR;
    PG8_STAGEB(PG8_SB(1, 0), cB + kstep); PG8_STAGEA(PG8_SA(1, 0), cA + kstep, ca[0], ca[1]); PG8_STAGEB(PG8_SB(1, 1), cB + hstepB + kstep);
    PG8_WAIT_V(6); PG8_BAR;
#define PG8_TRIP(a1, a2, b2, a3, b3, x0, x1, x2, x3) do { \
            PG8_LDB(B0, 0, 0); PG8_LDB(B1, 0, 1); PG8_SCHED; PG8_LDA(At, 0, 0); PG8_STAGEA(PG8_SA(1, 1), a1, ca[2], ca[3]); \
            PG8_WAIT_V(8); PG8_WAIT_L(0); PG8_BAR; PG8_MMA(0, 0, At, B0); PG8_MMA(0, 1, At, B1); PG8_BAR; PG8_SCHED; \
            PG8_LDA(At, 0, 1); PG8_STAGEB(PG8_SB(0, 0), b2); PG8_STAGEB(PG8_SB(0, 1), (b2) + hstepB); PG8_STAGEA(PG8_SA(0, 0), a2, x0, x1); \
            PG8_WAIT_V(8); PG8_WAIT_L(0); PG8_BAR; if constexpr (PROBE != 1) { PG8_MMA(1, 0, At, B0); PG8_MMA(1, 1, At, B1); } PG8_BAR; PG8_SCHED; \
            PG8_LDB(B0, 1, 0); PG8_LDB(B1, 1, 1); PG8_SCHED; PG8_LDA(At, 1, 0); PG8_STAGEA(PG8_SA(0, 1), a2, x2, x3); \
            PG8_WAIT_V(8); PG8_WAIT_L(0); PG8_BAR; PG8_MMA(0, 0, At, B0); PG8_MMA(0, 1, At, B1); PG8_BAR; PG8_SCHED; \
            PG8_LDA(At, 1, 1); PG8_STAGEB(PG8_SB(1, 0), b3); PG8_STAGEB(PG8_SB(1, 1), (b3) + hstepB); PG8_STAGEA(PG8_SA(1, 0), a3, x0, x1); \
            PG8_WAIT_V(8); PG8_WAIT_L(0); PG8_BAR; if constexpr (PROBE != 1) { PG8_MMA(1, 0, At, B0); PG8_MMA(1, 1, At, B1); } PG8_BAR; PG8_SCHED; } while (0)
    for (;;) {
        const bool has_next = S.next(ui + 1, nxt);
        unsigned nA = cA, nB = cB;
#pragma unroll
        for (int i = 0; i < 4; ++i) na[i] = ca[i];
        if (has_next) { nA = (unsigned)__builtin_amdgcn_readfirstlane((int)S.a_soff(nxt)); nB = (unsigned)__builtin_amdgcn_readfirstlane((int)S.b_soff(nxt)); S.a_offs(nxt, R[0], R[1], C[0], C[1], na); }
        for (int t = 0; t < nt; t += 2) {
            const bool last = (t == nt - 2);
            const unsigned a1 = cA + (unsigned)(t + 1) * kstep;
            const unsigned a2 = last ? nA : cA + (unsigned)(t + 2) * kstep, b2 = last ? nB : cB + (unsigned)(t + 2) * kstep;
            const unsigned x0 = last ? na[0] : ca[0], x1 = last ? na[1] : ca[1], x2 = last ? na[2] : ca[2], x3 = last ? na[3] : ca[3];
            PG8_TRIP(a1, a2, b2, a2 + kstep, b2 + kstep, x0, x1, x2, x3);
        }
        if (wr == 0) PG8_BAR;
        if constexpr (FP8) asm volatile("s_nop 15\n\ts_nop 15" ::: "memory");
        E(acc, cur, wr, wc, fr, fq);
        if (!has_next) break;
#pragma unroll
        for (int a = 0; a < 2; ++a)
#pragma unroll
            for (int b = 0; b < 2; ++b)
#pragma unroll
                for (int m = 0; m < 4; ++m)
#pragma unroll
                    for (int n = 0; n < 2; ++n) { float z0, z1, z2, z3; asm volatile("v_mov_b32 %0, 0\n\tv_mov_b32 %1, 0\n\tv_mov_b32 %2, 0\n\tv_mov_b32 %3, 0" : "=v"(z0), "=v"(z1), "=v"(z2), "=v"(z3)); acc[a][b][m][n] = (f32x4){z0, z1, z2, z3}; }
        cur = nxt; cA = nA; cB = nB; ++ui;
#pragma unroll
        for (int i = 0; i < 4; ++i) ca[i] = na[i];
        if (wr == 1) PG8_BAR;
    }
    PG8_WAIT_V(0);
    PG8_BAR;
#undef PG8_SA
#undef PG8_SB
#undef PG8_TRIP
#undef PG8_STAGE2
#undef PG8_STAGEA
#undef PG8_STAGEB
#undef PG8_LDA
#undef PG8_LDB
#undef PG8_MMA
#undef PG8_WAIT_V
#undef PG8_WAIT_L
#undef PG8_BAR
#undef PG8_SCHED
}
}

struct DenseUnit { int pm, pn; };
struct DenseSched {
    typedef DenseUnit UnitT;
    const bf16_t* A; const bf16_t* Bt; int lda; int K; int nM, nN, G, c, wave;
    __device__ __forceinline__ bool next(int i, DenseUnit& u) const { return pg8::static_tile(i * G + c, nM, nN, u.pm, u.pn); }
    __device__ __forceinline__ const void* a_buf() const { return A; }
    __device__ __forceinline__ const void* b_buf() const { return Bt; }
    __device__ __forceinline__ unsigned a_soff(const DenseUnit& u) const { return (unsigned)u.pm * 256u * (unsigned)lda * 2u; }
    __device__ __forceinline__ unsigned b_soff(const DenseUnit& u) const { return (unsigned)u.pn * 256u * (unsigned)K * 2u; }
    __device__ __forceinline__ void a_offs(const DenseUnit&, int R0, int R1, int C0, int C1, unsigned (&o)[4]) const {
        o[0] = (unsigned)(R0 * lda + C0) * 2u; o[1] = (unsigned)(R1 * lda + C1) * 2u; o[2] = (unsigned)((R0 + 128) * lda + C0) * 2u; o[3] = (unsigned)((R1 + 128) * lda + C1) * 2u;
    }
};
struct MkArgs {
    const float* x; const float* c; const int* positions; const float* w_ada; const float* b_ada;
    const float* g_pre_mix; const float* g_post_mix; const float* g_pre_ffn; const float* g_post_ffn;
    const float* w_in; const float* b_in; const float* conv_qk; const float* sinks; const float* g_mlstm;
    const float* w_attn_proj; const float* w_mlstm_proj; const float* w_out; const float* w_router; const float* b_router;
    const float* w_gate_up; const float* b_gate_up; const float* w_down; const float* b_down;
    float* out; unsigned char* ws;
    const int* route_i; const float* route_w;
    int ph_lo, ph_hi;
};

struct Frame {
    LAS unsigned char* lds;
    int G, bid, vcu, wave;
};
__device__ __forceinline__ int lane_id() { return (int)__builtin_amdgcn_mbcnt_hi(~0u, __builtin_amdgcn_mbcnt_lo(~0u, 0u)); }
__device__ __forceinline__ int fresh_tid(const Frame& F) { return (F.wave << 6) | lane_id(); }

__device__ __forceinline__ float wave_sum_f(float v) {
#pragma unroll
    for (int o = 1; o < 64; o <<= 1) v += __shfl_xor(v, o);
    return v;
}
__device__ __forceinline__ float wave_max_f(float v) {
#pragma unroll
    for (int o = 1; o < 64; o <<= 1) v = fmaxf(v, __shfl_xor(v, o));
    return v;
}

__device__ __forceinline__ int in_src_col(int n) {
    if (n < 1152) { const int d = n & 63; if (d < 16) return (n & ~63) + (d >> 1) + 8 * (d & 1); return n; }
    if (n < 4352) return n;
    return n + 8;
}

template <bool MAP>
__device__ __forceinline__ void p0_transpose_item(const float* __restrict__ W, int K, int N, bf16_t* WT, LAS float* scr, int kb, int nb, int lane) {
    const int k0 = 64 * kb, n0 = 32 * nb;
    const int sc = MAP ? in_src_col(n0 + (lane & 31)) : n0 + (lane & 31);
#pragma unroll 8
    for (int i = 0; i < 32; ++i) { const int kk = 2 * i + (lane >> 5); scr[kk * 33 + (lane & 31)] = W[(size_t)(k0 + kk) * N + sc]; }
    LDS_WAIT(); asm volatile("" ::: "memory");
    const int c = lane & 7;
#pragma unroll
    for (int j = 0; j < 4; ++j) { const int n = (lane >> 3) + 8 * j; const LAS float* s = scr + (8 * c) * 33 + n;
        u32x4 o; o.x = pk2(s[0 * 33], s[1 * 33]); o.y = pk2(s[2 * 33], s[3 * 33]); o.z = pk2(s[4 * 33], s[5 * 33]); o.w = pk2(s[6 * 33], s[7 * 33]);
        *(u32x4*)(WT + (size_t)(n0 + n) * K + k0 + 8 * c) = o; }
    LDS_WAIT(); asm volatile("" ::: "memory");
}

struct ConvItem { const float* src; unsigned char* dst; };
__device__ __forceinline__ ConvItem conv_item_addr(const MkArgs& a, int it, int lane, int& N) {
    constexpr int KB = 2048 / 128, I_GU = KB * (4096 / 32), I_DN = KB * (2048 / 32);
    const float* W; unsigned char* WT; int q, NB;
    if (it < NE * I_GU) { const int e = it / I_GU; q = it % I_GU; N = 4096; NB = 128; W = a.w_gate_up + (size_t)e * 2048 * 4096; WT = a.ws + wsf::WGU8 + (size_t)e * 4096 * 2048; }
    else { const int r = it - NE * I_GU, e = r / I_DN; q = r % I_DN; N = 2048; NB = 64; W = a.w_down + (size_t)e * 2048 * 2048; WT = a.ws + wsf::WDN8 + (size_t)e * 2048 * 2048; }
    const int k0 = 128 * (q / NB), n0 = 32 * (q % NB);
    ConvItem c; c.src = W + (size_t)(k0 + (lane >> 3)) * N + n0 + (lane & 7) * 4; c.dst = WT + (size_t)(n0 + (lane >> 3)) * 2048 + k0 + 16 * (lane & 7);
    return c;
}
__device__ __forceinline__ void conv_item_load(const ConvItem& c, int N, f32x4 (&v)[16]) {
#pragma unroll
    for (int i = 0; i < 16; ++i) v[i] = __builtin_nontemporal_load((const f32x4*)(c.src + (size_t)(8 * i) * N));
}
__device__ __forceinline__ void conv_item_store(const ConvItem& c, const f32x4 (&v)[16], LAS float* scr, int lane, bool dry = false) {
    const int kr = lane >> 3, n4 = (lane & 7) * 4;
#pragma unroll
    for (int i = 0; i < 16; ++i) { const int k = 8 * i + kr, rot = 20 * (i >> 1); LAS float* row = scr + k * 33;
        row[(n4 + 0 + rot) & 31] = v[i].x; row[(n4 + 1 + rot) & 31] = v[i].y; row[(n4 + 2 + rot) & 31] = v[i].z; row[(n4 + 3 + rot) & 31] = v[i].w; }
    LDS_WAIT(); asm volatile("" ::: "memory");
    const int cblk = lane & 7;
#pragma unroll
    for (int j = 0; j < 4; ++j) {
        const int n = (lane >> 3) + 8 * j;
        const LAS float* sp = scr + (16 * cblk) * 33 + ((n + 20 * cblk) & 31);
        u32x4 o;
        o.x = pk4_fp8(sp[0 * 33] * W8SCALE, sp[1 * 33] * W8SCALE, sp[2 * 33] * W8SCALE, sp[3 * 33] * W8SCALE);
        o.y = pk4_fp8(sp[4 * 33] * W8SCALE, sp[5 * 33] * W8SCALE, sp[6 * 33] * W8SCALE, sp[7 * 33] * W8SCALE);
        o.z = pk4_fp8(sp[8 * 33] * W8SCALE, sp[9 * 33] * W8SCALE, sp[10 * 33] * W8SCALE, sp[11 * 33] * W8SCALE);
        o.w = pk4_fp8(sp[12 * 33] * W8SCALE, sp[13 * 33] * W8SCALE, sp[14 * 33] * W8SCALE, sp[15 * 33] * W8SCALE);
        if (!dry) *(u32x4*)(c.dst + (size_t)(8 * j) * 2048) = o; else asm volatile("" :: "v"(o.x), "v"(o.y), "v"(o.z), "v"(o.w));
    }
    LDS_WAIT(); asm volatile("" ::: "memory");
}
__device__ __forceinline__ void moe_convert(const MkArgs& a, Frame& F, int widx, int nw, bool dry = false, int it0 = 0, int it1 = -1) {
    const int lane = lane_id();
    LAS float* scr = (LAS float*)(F.lds + F.wave * 16896);
    constexpr int NIT_ALL = NE * ((2048 / 128) * (4096 / 32) + (2048 / 128) * (2048 / 32));
    const int NIT = it1 < 0 ? NIT_ALL : it1;
    widx += it0;
    if (widx >= NIT) return;
    f32x4 va[16], vb[16]; int Na, Nb;
    ConvItem ca = conv_item_addr(a, widx, lane, Na), cb;
    conv_item_load(ca, Na, va);
    for (int it = widx; it < NIT; it += 2 * nw) {
        const int i1 = it + nw, i2 = it + 2 * nw;
        cb = conv_item_addr(a, i1 < NIT ? i1 : NIT - 1, lane, Nb); conv_item_load(cb, Nb, vb);
        conv_item_store(ca, va, scr, lane, dry);
        if (i1 >= NIT) break;
        ca = conv_item_addr(a, i2 < NIT ? i2 : NIT - 1, lane, Na); conv_item_load(ca, Na, va);
        conv_item_store(cb, vb, scr, lane, dry);
    }
}
__device__ __forceinline__ int n_conv_wgs(int G) { return G == 256 ? CONV_WGS : 0; }

struct TrItem { const float* src; bf16_t* dst; int N, perm; };
__device__ __forceinline__ TrItem tr_item_addr(const MkArgs& a, int it, int lane) {
    constexpr int I_IN = 32 * (fp::NIN / 32), I_AP = 16 * 64, I_MP = 16 * 64;
    const float* W; bf16_t* WT; int K, N, nblk, r = it, perm = 0, shift = 0;
    unsigned char* ws = a.ws;
    if (r < I_IN) { W = a.w_in; WT = (bf16_t*)(ws + wsf::WIN_T); K = 2048; N = INW; nblk = fp::NIN / 32; }
    else if ((r -= I_IN) < I_AP) { W = a.w_attn_proj; WT = (bf16_t*)(ws + wsf::WAP_T); K = 1024; N = 2048; nblk = 64; }
    else if ((r -= I_AP) < I_MP) { W = a.w_mlstm_proj; WT = (bf16_t*)(ws + wsf::WMP_T); K = 1024; N = 2048; nblk = 64; }
    else { r -= I_MP; W = a.w_out; WT = (bf16_t*)(ws + wsf::WOUT_T); K = 2048; N = 2048; nblk = 64; }
    const int kb = r / nblk, nb = r % nblk, k0 = 64 * kb, n0 = 32 * nb;
    if (it < I_IN) { perm = (n0 < 1152 && (n0 & 32) == 0) ? 1 : 0; shift = n0 >= 4352 ? 8 : 0; }
    TrItem t; t.src = W + (size_t)(k0 + (lane >> 3)) * N + n0 + shift + (lane & 7) * 4; t.dst = WT + (size_t)(n0 + (lane >> 3)) * K + k0 + 8 * (lane & 7); t.N = N; t.perm = perm | (K << 1);
    return t;
}
__device__ __forceinline__ void tr_item_load(const TrItem& t, f32x4 (&v)[8]) {
#pragma unroll
    for (int i = 0; i < 8; ++i) v[i] = *(const f32x4*)(t.src + (size_t)(8 * i) * t.N);
}
__device__ __forceinline__ void tr_item_store(const TrItem& t, const f32x4 (&v)[8], LAS float* scr, int lane) {
    const int kr = lane >> 3, n4 = (lane & 7) * 4, K = t.perm >> 1;
#pragma unroll
    for (int i = 0; i < 8; ++i) { const int k = 8 * i + kr, rot = 4 * (i >> 2); LAS float* row = scr + k * 33 + ((n4 + rot) & 31);
        row[0] = v[i].x; row[1] = v[i].y; row[2] = v[i].z; row[3] = v[i].w; }
    LDS_WAIT(); asm volatile("" ::: "memory");
    const int cb = lane & 7;
#pragma unroll
    for (int j = 0; j < 4; ++j) {
        const int n = (lane >> 3) + 8 * j;
        int c = n; if ((t.perm & 1) && n < 16) c = (n >> 1) + 8 * (n & 1);
        const LAS float* sp = scr + (8 * cb) * 33 + ((c + 4 * (cb >> 2)) & 31);
        u32x4 o; o.x = pk2(sp[0 * 33], sp[1 * 33]); o.y = pk2(sp[2 * 33], sp[3 * 33]); o.z = pk2(sp[4 * 33], sp[5 * 33]); o.w = pk2(sp[6 * 33], sp[7 * 33]);
        *(u32x4*)(t.dst + (size_t)(8 * j) * K) = o;
    }
    LDS_WAIT(); asm volatile("" ::: "memory");
}

__device__ __forceinline__ void ada_gemv(const MkArgs& a, Frame& F, int blk_lo, int blk_hi) {
    const int f_tid = fresh_tid(F), f_lane = f_tid & 63, f_wave = F.wave;
    LAS float* sc = (LAS float*)F.lds;
    LAS float* red = sc + 4096;
    if (blk_lo + F.vcu >= blk_hi) return;
    for (int i = f_tid; i < 2 * D; i += fp::NT) sc[i] = silu_f(a.c[i]);
    __syncthreads();
    for (int cblk = blk_lo + F.vcu; cblk < blk_hi; cblk += F.G) {
        const float* wp = a.w_ada + (size_t)(f_wave * 256) * MODW + cblk * 64 + f_lane;
        float a0 = 0.f, a1 = 0.f;
#pragma unroll 32
        for (int k = 0; k < 256; ++k) { const float w = wp[(size_t)k * MODW]; a0 += w * sc[f_wave * 256 + k]; a1 += w * sc[2048 + f_wave * 256 + k]; }
        red[(f_wave * 2 + 0) * 64 + f_lane] = a0; red[(f_wave * 2 + 1) * 64 + f_lane] = a1;
        __syncthreads();
        if (f_tid < 128) { const int b = f_tid >> 6, j = f_tid & 63; float sum = a.b_ada[cblk * 64 + j];
#pragma unroll
          for (int w8 = 0; w8 < 8; ++w8) sum += red[(w8 * 2 + b) * 64 + j];
          ((float*)(a.ws + wsf::MOD))[b * MODW + cblk * 64 + j] = sum; }
        __syncthreads();
    }
}

__device__ __forceinline__ void phase0(const MkArgs& a, Frame& F, int parts = 7) {
    const int f_tid = fresh_tid(F), f_lane = f_tid & 63, f_wave = F.wave;
    unsigned char* ws = a.ws;
    const int gw = F.vcu * fp::NW + f_wave, NGW = F.G * fp::NW;
    if (parts & 1) {
        LAS float* scr = (LAS float*)(F.lds + f_wave * 8448);
        constexpr int NITEMS = 32 * (fp::NIN / 32) + 16 * 64 + 16 * 64 + 32 * 64;
        if (gw < NITEMS) {
            f32x4 va[8], vb[8];
            TrItem ta = tr_item_addr(a, gw, f_lane), tb;
            tr_item_load(ta, va);
            for (int it = gw; it < NITEMS; it += 2 * NGW) {
                const int i1 = it + NGW, i2 = it + 2 * NGW;
                tb = tr_item_addr(a, i1 < NITEMS ? i1 : NITEMS - 1, f_lane); tr_item_load(tb, vb);
                tr_item_store(ta, va, scr, f_lane);
                if (i1 >= NITEMS) break;
                ta = tr_item_addr(a, i2 < NITEMS ? i2 : NITEMS - 1, f_lane); tr_item_load(ta, va);
                tr_item_store(tb, vb, scr, f_lane);
            }
        }
    }
#if MOE_FP8
    __syncthreads();
    if (n_conv_wgs(F.G) == 0) moe_convert(a, F, gw, NGW);
#if DRY_PROBE
    moe_convert(a, F, gw, NGW, true);
#endif
#endif
    __syncthreads();
    if (parts & 2) ada_gemv(a, F, 0, 4096 / 64);
    if (!(parts & 4)) return;
    const int gt = F.vcu * fp::NT + f_tid, NGT = F.G * fp::NT;
    for (int i = gt; i < NTOK * 8; i += NGT) { float cs, sn; rope_cs(a.positions[i >> 3], i & 7, cs, sn); ((f32x2*)(ws + wsf::CS))[i] = (f32x2){cs, sn}; }
    for (int i = gt; i < fp::NIN; i += NGT) ((float*)(ws + wsf::BINP))[i] = a.b_in[in_src_col(i)];
    for (int i = gt; i < 32 * 2048; i += NGT) {
        const int e = i >> 11, k = i & 2047; const float w = a.w_router[k * 32 + e]; const unsigned hi = f2bf(w); const float rem = w - __builtin_bit_cast(float, hi << 16);
        ((bf16_t*)(ws + wsf::WRT))[i] = (bf16_t)hi; ((bf16_t*)(ws + wsf::WRT))[32 * 2048 + i] = (bf16_t)f2bf(rem);
    }
}

__device__ __forceinline__ void phase1(const MkArgs& a, Frame& F) {
    const int f_tid = fresh_tid(F), f_lane = f_tid & 63, f_wave = F.wave;
    unsigned char* ws = a.ws;
    const float* mod = (const float*)(ws + wsf::MOD);
    LAS float* lmod = (LAS float*)F.lds;
    LAS float* wg = (LAS float*)(F.lds + 32768);
    for (int i = f_tid; i < 2048 * 8; i += fp::NT) wg[(i & 7) * 2048 + (i >> 3)] = a.w_in[(size_t)(i >> 3) * INW + OFF_MI + (i & 7)];
    for (int blk = F.vcu; blk < NTOK / 64; blk += F.G) {
        const int b = (blk * 64) / S;
        __syncthreads();
        for (int i = f_tid; i < 4096; i += fp::NT) lmod[i] = mod[b * MODW + i];
        __syncthreads();
#pragma unroll 1
        for (int rr = 0; rr < 8; ++rr) {
            const int m = blk * 64 + f_wave * 8 + rr;
            const GAS f32x4* xr = (const GAS f32x4*)(a.x + (size_t)m * D);
            f32x4 xv[8]; float ss = 0.f;
#pragma unroll
            for (int j = 0; j < 8; ++j) { xv[j] = xr[64 * j + f_lane]; ss += (xv[j].x * xv[j].x + xv[j].y * xv[j].y) + (xv[j].z * xv[j].z + xv[j].w * xv[j].w); }
            const float r = rsqrtf(wave_sum_f(ss) * (1.f / D) + EPS);
            float g8[8];
#pragma unroll
            for (int e = 0; e < 8; ++e) g8[e] = 0.f;
            GAS u32x2* o8 = (GAS u32x2*)(ws + wsf::H1 + (size_t)m * D * 2);
#pragma unroll
            for (int j = 0; j < 8; ++j) {
                const int c0 = 4 * (64 * j + f_lane);
                const f32x4 v = xv[j];
                const f32x4 g = *(const f32x4*)(a.g_pre_mix + c0);
                const f32x4 sh = *(const LAS f32x4*)(lmod + c0), sc = *(const LAS f32x4*)(lmod + 2048 + c0);
                f32x4 h;
                h.x = v.x * r * g.x * (1.f + sc.x) + sh.x; h.y = v.y * r * g.y * (1.f + sc.y) + sh.y;
                h.z = v.z * r * g.z * (1.f + sc.z) + sh.z; h.w = v.w * r * g.w * (1.f + sc.w) + sh.w;
                o8[64 * j + f_lane] = (u32x2){pg8::cvt_pk_bf16(h.x, h.y), pg8::cvt_pk_bf16(h.z, h.w)};
#pragma unroll
                for (int e = 0; e < 8; ++e) { const f32x4 w = *(const LAS f32x4*)(wg + e * 2048 + c0); g8[e] += (h.x * w.x + h.y * w.y) + (h.z * w.z + h.w * w.w); }
            }
            float mine = 0.f;
#pragma unroll
            for (int e = 0; e < 8; ++e) { const float s8 = wave_sum_f(g8[e]); if (f_lane == e) mine = s8; }
            if (f_lane < 8) ((float*)(ws + wsf::GATES))[(size_t)m * 8 + f_lane] = mine + a.b_in[OFF_MI + f_lane];
        }
    }
}

struct EpiIn {
    bf16_t* O; const float* bias; const f32x2* cs;
    __device__ __forceinline__ void operator()(const f32x4 (&acc)[2][2][4][2], const DenseUnit& u, int wr, int wc, int fr, int fq) const {
        const int row0 = u.pm * 256 + wr * 64 + fr, col0 = u.pn * 256 + wc * 32 + 8 * fq;
        const int pn = u.pn;
        const bool ropelane = ((wc & 1) == 0) && fq < 2;
        const int i0 = fq * 4;
        f32x4 bv[2][2];
#pragma unroll
        for (int bj = 0; bj < 2; ++bj)
#pragma unroll
            for (int n = 0; n < 2; ++n) bv[bj][n] = *(const f32x4*)(bias + col0 + bj * 128 + 4 * n);
#pragma unroll
        for (int ai = 0; ai < 2; ++ai)
#pragma unroll
            for (int m = 0; m < 4; ++m) {
                const int row = row0 + ai * 128 + m * 16;
                bf16_t* rowp = O + (size_t)row * fp::NIN + col0;
#pragma unroll
                for (int bj = 0; bj < 2; ++bj) {
                    f32x4 v0 = acc[ai][bj][m][0] + bv[bj][0], v1 = acc[ai][bj][m][1] + bv[bj][1];
                    if (pn < 4 || (pn == 4 && bj == 0)) {
                        if (ropelane) {
                            const f32x4 ca = *(const f32x4*)(cs + (size_t)row * 8 + i0), cb = *(const f32x4*)(cs + (size_t)row * 8 + i0 + 2);
                            f32x4 r0, r1;
                            r0.x = v0.x * ca.x - v0.y * ca.y; r0.y = v0.y * ca.x + v0.x * ca.y;
                            r0.z = v0.z * ca.z - v0.w * ca.w; r0.w = v0.w * ca.z + v0.z * ca.w;
                            r1.x = v1.x * cb.x - v1.y * cb.y; r1.y = v1.y * cb.x + v1.x * cb.y;
                            r1.z = v1.z * cb.z - v1.w * cb.w; r1.w = v1.w * cb.z + v1.z * cb.w;
                            v0 = r0; v1 = r1;
                        }
                        if (pn < 4) { v0 = v0 * fp::QSCALE; v1 = v1 * fp::QSCALE; }
                    } else if (pn >= 13) {
#pragma unroll
                        for (int q = 0; q < 4; ++q) { v0[q] = fast_sigmoid(v0[q]); v1[q] = fast_sigmoid(v1[q]); }
                    }
                    u32x4 w; w.x = pg8::cvt_pk_bf16(v0[0], v0[1]); w.y = pg8::cvt_pk_bf16(v0[2], v0[3]); w.z = pg8::cvt_pk_bf16(v1[0], v1[1]); w.w = pg8::cvt_pk_bf16(v1[2], v1[3]);
                    *(u32x4*)(rowp + bj * 128) = w;
                }
            }
    }
};

__device__ __forceinline__ void phase2(const MkArgs& a, Frame& F) {
    const int f_tid = fresh_tid(F), f_lane = f_tid & 63, f_wave = F.wave;
    unsigned char* ws = a.ws;
#if MOE_FP8
    const int ncv = n_conv_wgs(F.G), Gg = F.G - ncv;
    constexpr int NIT_ALL = NE * ((2048 / 128) * (4096 / 32) + (2048 / 128) * (2048 / 32));
    const int nsplit = ncv > 0 ? (int)((long)NIT_ALL * CONV_SPLIT / 1024) : NIT_ALL;
    if (F.bid >= Gg) { moe_convert(a, F, (F.bid - Gg) * fp::NW + F.wave, ncv * fp::NW, false, 0, nsplit);
#if DRY_PROBE == 2
        moe_convert(a, F, (F.bid - Gg) * fp::NW + F.wave, ncv * fp::NW, true);
#endif
        return; }
#else
    const int Gg = F.G;
#endif
    DenseSched S{(const bf16_t*)(ws + wsf::H1), (const bf16_t*)(ws + wsf::WIN_T), 2048, 2048, NTOK / 256, fp::NIN / 256, Gg, F.bid, F.wave};
    EpiIn E{(bf16_t*)(ws + wsf::PROJB), (const float*)(ws + wsf::BINP), (const f32x2*)(ws + wsf::CS)};
    pg8::gemm_phase<EpiIn, DenseSched>(F.lds, S, E);
#if MOE_FP8
    if (ncv > 0 && nsplit < NIT_ALL) { __syncthreads(); moe_convert(a, F, F.bid * fp::NW + F.wave, Gg * fp::NW, false, nsplit, NIT_ALL); }
#endif
}
__device__ __forceinline__ f32x4 mfma16(bf16x8 a, bf16x8 b, f32x4 c) { return __builtin_amdgcn_mfma_f32_16x16x32_bf16(a, b, c, 0, 0, 0); }
__device__ __forceinline__ float exp2_fast(float x) { return __builtin_amdgcn_exp2f(x); }
typedef short v4i16_t __attribute__((ext_vector_type(4)));
__device__ __forceinline__ bf16x8 tr_frag(const LAS bf16_t* base, int stride, int lane) {
    const LAS bf16_t* p = base + (8 * (lane >> 4) + ((lane & 15) >> 2)) * stride + 4 * (lane & 3);
    const v4i16_t lo = __builtin_amdgcn_ds_read_tr16_b64_v4i16((LAS v4i16_t*)p), hi = __builtin_amdgcn_ds_read_tr16_b64_v4i16((LAS v4i16_t*)(p + 4 * stride));
    return __builtin_shufflevector(lo, hi, 0, 1, 2, 3, 4, 5, 6, 7);
}

__device__ __forceinline__ void attn_unit(const MkArgs& a, Frame& F, int unit) {
    const int f_tid = fresh_tid(F), f_lane = f_tid & 63, f_wave = F.wave;
    const int b = unit >> 7, hk = (unit >> 6) & 1, n = unit & 63;
    const bf16_t* PB = (const bf16_t*)(a.ws + wsf::PROJB);
    bf16_t* OA = (bf16_t*)(a.ws + wsf::OAT);
    const size_t tok0 = (size_t)b * S + (size_t)n * 128;
    LAS bf16_t* Ks = (LAS bf16_t*)F.lds;
    LAS bf16_t* Vs = (LAS bf16_t*)(F.lds + 36864);
    LAS bf16_t* Pw = (LAS bf16_t*)(F.lds + 36864 + 39168 + f_wave * 5376);
#pragma unroll
    for (int i = 0; i < 4; ++i) {
        const int q = f_tid + 512 * i, row = q >> 3, ch = q & 7;
        u32x4 kv = (u32x4){0u, 0u, 0u, 0u}, vv = kv;
        if (n > 0 || row >= 128) {
            const bf16_t* src = PB + (tok0 - 128 + row) * fp::NIN + hk * 64 + ch * 8;
            kv = *(const u32x4*)(src + fp::PB_K); vv = *(const u32x4*)(src + fp::PB_V);
        }
        *(LAS u32x4*)(Ks + row * 72 + ch * 8) = kv;
        *(LAS u32x4*)(Vs + row * 72 + ch * 8) = vv;
    }
    if (f_tid < 128) *(LAS u32x4*)(Vs + (256 + (f_tid >> 3)) * 72 + (f_tid & 7) * 8) = (u32x4){0u, 0u, 0u, 0u};
    __syncthreads();
    const int c16 = f_lane & 15, grp = f_lane >> 4, h = hk * 8 + f_wave;
    const float sink2 = a.sinks[h] * fp::LOG2E;
    bf16x8 qn[2];
#pragma unroll
    for (int ks = 0; ks < 2; ++ks) qn[ks] = *(const bf16x8*)(PB + (tok0 + c16) * fp::NIN + fp::PB_Q + h * 64 + ks * 32 + grp * 8);
#pragma unroll 1
    for (int tt = 0; tt < 8; ++tt) {
        const size_t qtok = tok0 + tt * 16 + c16;
        bf16x8 qf[2];
        { const size_t ntok = tok0 + (tt < 7 ? tt + 1 : 7) * 16 + c16;
#pragma unroll
          for (int ks = 0; ks < 2; ++ks) { qf[ks] = qn[ks]; qn[ks] = *(const bf16x8*)(PB + ntok * fp::NIN + fp::PB_Q + h * 64 + ks * 32 + grp * 8); } }
        f32x4 sacc[9];
#pragma unroll
        for (int jq = 0; jq < 9; ++jq) {
            sacc[jq] = (f32x4){0.f, 0.f, 0.f, 0.f};
#pragma unroll
            for (int ks = 0; ks < 2; ++ks) { const bf16x8 kf = *(const LAS bf16x8*)(Ks + (16 * (tt + jq) + c16) * 72 + ks * 32 + grp * 8); sacc[jq] = mfma16(kf, qf[ks], sacc[jq]); }
        }
        float mx = sink2;
#pragma unroll
        for (int jq = 0; jq < 9; ++jq)
#pragma unroll
            for (int r = 0; r < 4; ++r) {
                const int diff = 128 + c16 - 16 * jq - 4 * grp - r, jrel = 16 * (tt + jq) + 4 * grp + r;
                const bool ok = diff >= 0 && diff < 128 && (n > 0 || jrel >= 128);
                sacc[jq][r] = ok ? sacc[jq][r] : -INFINITY;
                mx = fmaxf(mx, sacc[jq][r]);
            }
        mx = fmaxf(mx, __shfl_xor(mx, 16)); mx = fmaxf(mx, __shfl_xor(mx, 32));
        float ls = 0.f;
#pragma unroll
        for (int jq = 0; jq < 9; ++jq) {
            float p[4];
#pragma unroll
            for (int r = 0; r < 4; ++r) { p[r] = exp2_fast(sacc[jq][r] - mx); ls += p[r]; }
            *(LAS u32x2*)(Pw + c16 * 168 + 16 * jq + 4 * grp) = (u32x2){pk2(p[0], p[1]), pk2(p[2], p[3])};
        }
        *(LAS u32x2*)(Pw + c16 * 168 + 144 + 4 * grp) = (u32x2){0u, 0u};
        ls += __shfl_xor(ls, 16); ls += __shfl_xor(ls, 32);
        ls += exp2_fast(sink2 - mx);
        const float inv = 1.f / ls;
        LDS_WAIT();
        f32x4 oacc[4];
#pragma unroll
        for (int dt = 0; dt < 4; ++dt) oacc[dt] = (f32x4){0.f, 0.f, 0.f, 0.f};
#pragma unroll
        for (int k2 = 0; k2 < 5; ++k2) {
            const bf16x8 pb = *(const LAS bf16x8*)(Pw + c16 * 168 + 32 * k2 + 8 * grp);
#pragma unroll
            for (int dt = 0; dt < 4; ++dt) { const bf16x8 va = tr_frag(Vs + (16 * tt + 32 * k2) * 72 + 16 * dt, 72, f_lane); oacc[dt] = mfma16(va, pb, oacc[dt]); }
        }
#pragma unroll
        for (int dt = 0; dt < 4; ++dt)
            *(u32x2*)(OA + qtok * 1024 + h * 64 + 16 * dt + 4 * grp) = (u32x2){pk2(oacc[dt][0] * inv, oacc[dt][1] * inv), pk2(oacc[dt][2] * inv, oacc[dt][3] * inv)};
        LDS_WAIT();
    }
    __syncthreads();
}

__device__ __forceinline__ void unpack8(const u32x4 v, float (&f)[8]) {
    f[0] = bflo(v.x); f[1] = bfhi(v.x); f[2] = bflo(v.y); f[3] = bfhi(v.y); f[4] = bflo(v.z); f[5] = bfhi(v.z); f[6] = bflo(v.w); f[7] = bfhi(v.w);
}
__device__ __forceinline__ void stage_vt(const bf16_t* PB, size_t tok0, int col0, LAS bf16_t* Vs, int tid) {
#pragma unroll
    for (int i = 0; i < 8; ++i) {
        const int q = tid + 512 * i, row = q >> 5, ch = q & 31;
        *(LAS u32x4*)(Vs + row * 272 + ch * 8) = *(const u32x4*)(PB + (tok0 + row) * fp::NIN + col0 + ch * 8);
    }
}

__device__ __forceinline__ void m1_unit(const MkArgs& a, Frame& F, int u) {
    const int f_tid = fresh_tid(F), f_lane = f_tid & 63, f_wave = F.wave;
    const int bh = u >> 6, c = u & 63, b = bh >> 2, h = bh & 3;
    const size_t tok0 = (size_t)b * S + (size_t)c * 128;
    unsigned char* ws = a.ws;
    const bf16_t* PB = (const bf16_t*)(ws + wsf::PROJB);
    LAS bf16_t* Kw = (LAS bf16_t*)F.lds;
    LAS bf16_t* Vt = (LAS bf16_t*)(F.lds + 34816);
    LAS float* gl = (LAS float*)(F.lds + 34816 + 69632);
    const float* GT = (const float*)(ws + wsf::GATES);
    const int tid = f_tid;
    float li = 0.f, lf = 0.f;
    if (tid < 128) { li = softcap_f(GT[(tok0 + tid) * 8 + h]); lf = logsigmoid_f(softcap_f(GT[(tok0 + tid) * 8 + 4 + h])); }
    float cum = lf;
#pragma unroll
    for (int o = 1; o < 64; o <<= 1) { const float t = __shfl_up(cum, o); if (f_lane >= o) cum += t; }
    if (tid == 63) gl[384] = cum;
    __syncthreads();
    if (tid >= 64 && tid < 128) cum += gl[384];
    if (tid == 127) gl[385] = cum;
    __syncthreads();
    const float g = gl[385];
    const float av = (tid < 128) ? (g - cum + li) : -INFINITY;
    const float wm = wave_max_f(av);
    if (f_lane == 0 && f_wave < 2) gl[386 + f_wave] = wm;
    __syncthreads();
    const float mloc = fmaxf(gl[386], gl[387]);
    if (tid < 128) {
        gl[256 + tid] = expf(av - mloc);
        ((float*)(ws + wsf::BCUM))[(size_t)bh * S + c * 128 + tid] = cum;
        ((float*)(ws + wsf::LOGI))[(size_t)bh * S + c * 128 + tid] = li;
    }
    if (tid == 0) { ((float*)(ws + wsf::GSUM))[u] = g; ((float*)(ws + wsf::MLOC))[u] = mloc; }
    __syncthreads();
#pragma unroll 2
    for (int i = 0; i < 8; ++i) {
        const int q = tid + 512 * i, row = q >> 5, ch = q & 31, isK = ch >= 16, cc = (ch & 15) * 8;
        const int colsrc = (isK ? fp::PB_MK : fp::PB_MQ) + h * 128 + cc, cwcol = (isK ? 512 : 0) + h * 128 + cc;
        float acc[8];
#pragma unroll
        for (int e = 0; e < 8; ++e) acc[e] = 0.f;
#pragma unroll
        for (int j = 0; j < 4; ++j) {
            const int sabs = c * 128 + row - 3 + j;
            const u32x4 xv = *(const u32x4*)(PB + (tok0 + row - (sabs >= 0 ? 3 - j : 0)) * fp::NIN + colsrc);
            float xf[8]; unpack8(xv, xf);
            const float z = sabs >= 0 ? 1.f : 0.f;
            const f32x4 w0 = *(const f32x4*)(a.conv_qk + j * 1024 + cwcol) * z, w1 = *(const f32x4*)(a.conv_qk + j * 1024 + cwcol + 4) * z;
            acc[0] += w0.x * xf[0]; acc[1] += w0.y * xf[1]; acc[2] += w0.z * xf[2]; acc[3] += w0.w * xf[3];
            acc[4] += w1.x * xf[4]; acc[5] += w1.y * xf[5]; acc[6] += w1.z * xf[6]; acc[7] += w1.w * xf[7];
        }
        const float sc = isK ? 0.08838834764831845f : 1.f;
#pragma unroll
        for (int e = 0; e < 8; ++e) acc[e] = silu_f(acc[e]) * sc;
        const u32x4 o = (u32x4){pk2(acc[0], acc[1]), pk2(acc[2], acc[3]), pk2(acc[4], acc[5]), pk2(acc[6], acc[7])};
        bf16_t* dst = (bf16_t*)(ws + (isK ? wsf::KC : wsf::QC)) + (tok0 + row) * 512 + h * 128 + cc;
        *(u32x4*)dst = o;
        if (isK) {
            const float wr = gl[256 + row];
            *(LAS u32x4*)(Kw + row * 136 + cc) = (u32x4){pk2(acc[0] * wr, acc[1] * wr), pk2(acc[2] * wr, acc[3] * wr), pk2(acc[4] * wr, acc[5] * wr), pk2(acc[6] * wr, acc[7] * wr)};
        }
    }
    stage_vt(PB, tok0, fp::PB_MV + h * 256, Vt, tid);
    __syncthreads();
    const int c16 = f_lane & 15, grp = f_lane >> 4, w = f_wave;
    f32x4 acc[8][2];
#pragma unroll
    for (int d = 0; d < 8; ++d) { acc[d][0] = (f32x4){0.f, 0.f, 0.f, 0.f}; acc[d][1] = acc[d][0]; }
#pragma unroll
    for (int ks = 0; ks < 4; ++ks) {
        bf16x8 bfr[2];
#pragma unroll
        for (int i = 0; i < 2; ++i) bfr[i] = tr_frag(Vt + (32 * ks) * 272 + 16 * (2 * w + i), 272, f_lane);
#pragma unroll
        for (int d = 0; d < 8; ++d) {
            const bf16x8 af = tr_frag(Kw + (32 * ks) * 136 + 16 * d, 136, f_lane);
            acc[d][0] = mfma16(af, bfr[0], acc[d][0]); acc[d][1] = mfma16(af, bfr[1], acc[d][1]);
        }
    }
    float* dct = (float*)(ws + wsf::DCT) + (size_t)u * 256 * 128;
#pragma unroll
    for (int d = 0; d < 8; ++d)
#pragma unroll
        for (int i = 0; i < 2; ++i) *(f32x4*)(dct + (size_t)(16 * (2 * w + i) + c16) * 128 + 16 * d + 4 * grp) = acc[d][i];
    if (tid < 128) {
        float s = 0.f;
#pragma unroll 16
        for (int r = 0; r < 128; ++r) s += bf2f(Kw[r * 136 + tid]);
        ((float*)(ws + wsf::DN))[(size_t)u * 128 + tid] = s;
    }
    __syncthreads();
}

__device__ __forceinline__ void phase3(const MkArgs& a, Frame& F) {
    const int f_tid = fresh_tid(F), f_lane = f_tid & 63, f_wave = F.wave;
    for (int u = F.bid; u < NB * HKV * (S / 128); u += F.G) attn_unit(a, F, u);
    for (int u = F.bid; u < NB * MH * NC; u += F.G) m1_unit(a, F, u);
}

__device__ __forceinline__ void phase4(const MkArgs& a, Frame& F) {
    ada_gemv(a, F, 4096 / 64, MODW / 64);
    __syncthreads();
    const int f_tid = fresh_tid(F), f_lane = f_tid & 63, f_wave = F.wave;
    unsigned char* ws = a.ws;
    LAS float* dec = (LAS float*)F.lds;
    LAS float* scl = dec + 512;
    LAS float* gl = scl + 512;
    gl[f_tid] = ((const float*)(ws + wsf::GSUM))[f_tid]; gl[512 + f_tid] = ((const float*)(ws + wsf::MLOC))[f_tid];
    __syncthreads();
    if (f_tid < 8) {
        const int bh = f_tid; float m = 0.f;
        for (int c = 0; c < NC; ++c) {
            const float g = gl[bh * NC + c], ml = gl[512 + bh * NC + c];
            if (F.bid == 0) ((float*)(ws + wsf::MPREV))[bh * NC + c] = m;
            const float mn = fmaxf(g + m, ml);
            dec[bh * 64 + c] = expf(g + m - mn); scl[bh * 64 + c] = expf(ml - mn); m = mn;
        }
    }
    __syncthreads();
    const int gt = F.vcu * fp::NT + f_tid, NGT = F.G * fp::NT;
    for (int it = gt; it < 8 * 16384; it += NGT) {
        const int bh = it >> 14, idx = it & 16383;
        const float* dct = (const float*)(ws + wsf::DCT) + (size_t)bh * 64 * 32768 + (size_t)idx * 2;
        bf16_t* cpt = (bf16_t*)(ws + wsf::CPT) + (size_t)bh * 64 * 32768 + (size_t)idx * 2;
        float C0 = 0.f, C1 = 0.f;
#pragma unroll 8
        for (int c = 0; c < NC; ++c) {
            const f32x2 d = *(const f32x2*)(dct + (size_t)c * 32768);
            *(unsigned*)(cpt + (size_t)c * 32768) = pk2(C0, C1);
            const float de = dec[bh * 64 + c], sc = scl[bh * 64 + c];
            C0 = de * C0 + sc * d.x; C1 = de * C1 + sc * d.y;
        }
    }
    for (int it = gt; it < 8 * 128; it += NGT) {
        const int bh = it >> 7, dk = it & 127; float nv = 0.f;
        const float* dnp = (const float*)(ws + wsf::DN) + (size_t)bh * NC * 128 + dk;
        float* npp = (float*)(ws + wsf::NPREV) + (size_t)bh * NC * 128 + dk;
#pragma unroll
        for (int h = 0; h < 2; ++h) {
            float d[32];
#pragma unroll
            for (int c = 0; c < 32; ++c) d[c] = dnp[(size_t)(32 * h + c) * 128];
#pragma unroll
            for (int c = 0; c < 32; ++c) { npp[(size_t)(32 * h + c) * 128] = nv; nv = dec[bh * 64 + 32 * h + c] * nv + scl[bh * 64 + 32 * h + c] * d[c]; }
        }
    }
}

__device__ __forceinline__ void m3_unit(const MkArgs& a, Frame& F, int u) {
    const int f_tid = fresh_tid(F), f_lane = f_tid & 63, f_wave = F.wave;
    const int bh = u >> 6, c = u & 63, b = bh >> 2, h = bh & 3;
    const size_t tok0 = (size_t)b * S + (size_t)c * 128;
    unsigned char* ws = a.ws;
    const bf16_t* PB = (const bf16_t*)(ws + wsf::PROJB);
    const bf16_t* QCp = (const bf16_t*)(ws + wsf::QC);
    const bf16_t* KCp = (const bf16_t*)(ws + wsf::KC);
    LAS bf16_t* KP = (LAS bf16_t*)F.lds;
    LAS bf16_t* Vt = (LAS bf16_t*)(F.lds + 34816);
    LAS float* fl = (LAS float*)(F.lds + 104448);
    LAS float* f_us = fl, *f_M = fl + 128, *f_iw = fl + 256, *f_rd = fl + 384, *f_qn = fl + 512, *f_np = fl + 640, *f_en = fl + 768, *f_ssq = fl + 1024, *f_misc = fl + 896;
    const int tid = f_tid;
#pragma unroll
    for (int i = 0; i < 4; ++i) { const int q = tid + 512 * i, row = q >> 4, ch = q & 15;
        *(LAS u32x4*)(KP + row * 136 + ch * 8) = *(const u32x4*)(KCp + (tok0 + row) * 512 + h * 128 + ch * 8); }
    stage_vt(PB, tok0, fp::PB_MV + h * 256, Vt, tid);
    const float mp = ((const float*)(ws + wsf::MPREV))[u];
    float bt = 0.f, us = -INFINITY;
    if (tid < 128) { bt = ((const float*)(ws + wsf::BCUM))[(size_t)bh * S + c * 128 + tid]; us = ((const float*)(ws + wsf::LOGI))[(size_t)bh * S + c * 128 + tid] - bt;
        f_np[tid] = ((const float*)(ws + wsf::NPREV))[(size_t)u * 128 + tid]; }
    float pm = us;
#pragma unroll
    for (int o = 1; o < 64; o <<= 1) { const float t = __shfl_up(pm, o); if (f_lane >= o) pm = fmaxf(pm, t); }
    if (tid == 63) f_misc[0] = pm;
    __syncthreads();
    if (tid >= 64 && tid < 128) pm = fmaxf(pm, f_misc[0]);
    if (tid < 128) {
        const float Mt = fmaxf(mp, pm);
        f_us[tid] = us; f_M[tid] = Mt; f_iw[tid] = expf(mp - Mt); f_en[tid] = expf(-(bt + Mt));
        float s = 0.f;
#pragma unroll 8
        for (int ch = 0; ch < 16; ++ch) { const u32x4 qv = *(const u32x4*)(QCp + (tok0 + tid) * 512 + h * 128 + ch * 8); float qf[8]; unpack8(qv, qf);
#pragma unroll
            for (int e = 0; e < 8; ++e) s += qf[e] * f_np[ch * 8 + e]; }
        f_qn[tid] = s;
    }
    __syncthreads();
    const int c16 = f_lane & 15, grp = f_lane >> 4, w = f_wave;
    u32x2 pp[8]; float rs = 0.f;
    {
        bf16x8 qf[4];
#pragma unroll
        for (int ks = 0; ks < 4; ++ks) qf[ks] = *(const bf16x8*)(QCp + (tok0 + 16 * w + c16) * 512 + h * 128 + 32 * ks + 8 * grp);
        const float Mt = f_M[16 * w + c16];
        const int t = 16 * w + c16, tq = t - 4 * grp;
        const LAS float* usb = f_us + 4 * grp;
#pragma unroll
        for (int st = 0; st < 8; ++st) {
            pp[st] = (u32x2){0u, 0u};
            if (st <= w) {
                f32x4 acc = (f32x4){0.f, 0.f, 0.f, 0.f};
#pragma unroll
                for (int ks = 0; ks < 4; ++ks) { const bf16x8 kf = *(const LAS bf16x8*)(KP + (16 * st + c16) * 136 + 32 * ks + 8 * grp); acc = mfma16(kf, qf[ks], acc); }
                float p[4];
                const f32x4 u4 = *(const LAS f32x4*)(usb + 16 * st);
#pragma unroll
                for (int r = 0; r < 4; ++r) { p[r] = (16 * st + r <= tq) ? acc[r] * expf(u4[r] - Mt) : 0.f; rs += p[r]; }
                pp[st] = (u32x2){pk2(p[0], p[1]), pk2(p[2], p[3])};
            }
        }
        rs += __shfl_xor(rs, 16); rs += __shfl_xor(rs, 32);
        if (grp == 0) { const float den = rs + f_iw[t] * f_qn[t]; f_rd[t] = 1.f / fmaxf(fabsf(den), f_en[t]); }
    }
    __syncthreads();
#pragma unroll
    for (int st = 0; st < 8; ++st) *(LAS u32x2*)(KP + (16 * w + c16) * 136 + 16 * st + 4 * grp) = pp[st];
    __syncthreads();
    bf16x8 vf[2][4], cf[2][4];
    const bf16_t* cpt = (const bf16_t*)(ws + wsf::CPT) + (size_t)u * 256 * 128;
#pragma unroll
    for (int i = 0; i < 2; ++i)
#pragma unroll
        for (int ks = 0; ks < 4; ++ks) {
            vf[i][ks] = tr_frag(Vt + (32 * ks) * 272 + 16 * (2 * w + i), 272, f_lane);
            cf[i][ks] = *(const bf16x8*)(cpt + (size_t)(16 * (2 * w + i) + c16) * 128 + 32 * ks + 8 * grp);
        }
    bf16_t* HMp = (bf16_t*)(ws + wsf::HM);
    bf16x8 qnx[4];
#pragma unroll
    for (int ks = 0; ks < 4; ++ks) qnx[ks] = *(const bf16x8*)(QCp + (tok0 + c16) * 512 + h * 128 + 32 * ks + 8 * grp);
#pragma unroll 1
    for (int tt = 0; tt < 8; ++tt) {
        bf16x8 pf[4], qf[4];
        const int tn = tt < 7 ? tt + 1 : 7;
#pragma unroll
        for (int ks = 0; ks < 4; ++ks) { pf[ks] = *(const LAS bf16x8*)(KP + (16 * tt + c16) * 136 + 32 * ks + 8 * grp);
            qf[ks] = qnx[ks]; qnx[ks] = *(const bf16x8*)(QCp + (tok0 + 16 * tn + c16) * 512 + h * 128 + 32 * ks + 8 * grp); }
        const int t = 16 * tt + c16; const float iw = f_iw[t], rd = f_rd[t];
        float ss = 0.f;
#pragma unroll
        for (int i = 0; i < 2; ++i) {
            f32x4 a1 = (f32x4){0.f, 0.f, 0.f, 0.f}, a2 = a1;
#pragma unroll
            for (int ks = 0; ks < 4; ++ks) { a1 = mfma16(vf[i][ks], pf[ks], a1); a2 = mfma16(cf[i][ks], qf[ks], a2); }
            const f32x4 hv = (a1 + a2 * iw) * rd;
            ss += (hv[0] * hv[0] + hv[1] * hv[1]) + (hv[2] * hv[2] + hv[3] * hv[3]);
            *(u32x2*)(HMp + (tok0 + t) * 1024 + h * 256 + 16 * (2 * w + i) + 4 * grp) = (u32x2){pk2(hv[0], hv[1]), pk2(hv[2], hv[3])};
        }
        ss += __shfl_xor(ss, 16); ss += __shfl_xor(ss, 32);
        if (grp == 0) f_ssq[t * 8 + w] = ss;
    }
    __syncthreads();
#pragma unroll 2
    for (int tt = 0; tt < 8; ++tt) {
        const int t = 16 * tt + c16;
        const f32x4 s0 = *(const LAS f32x4*)(f_ssq + t * 8), s1 = *(const LAS f32x4*)(f_ssq + t * 8 + 4);
        const float rn = rsqrtf(((s0.x + s0.y) + (s0.z + s0.w) + (s1.x + s1.y) + (s1.z + s1.w)) * (1.f / 256.f) + EPS);
#pragma unroll
        for (int i = 0; i < 2; ++i) {
            const int dv0 = 16 * (2 * w + i) + 4 * grp;
            const f32x4 g4 = *(const f32x4*)(a.g_mlstm + h * 256 + dv0);
            const u32x2 mo = *(const u32x2*)(PB + (tok0 + t) * fp::NIN + fp::PB_MO + h * 256 + dv0);
            u32x2* hp = (u32x2*)(HMp + (tok0 + t) * 1024 + h * 256 + dv0);
            const u32x2 hr = *hp;
            const float o0 = bflo(hr.x) * rn * g4.x * bflo(mo.x), o1 = bfhi(hr.x) * rn * g4.y * bfhi(mo.x);
            const float o2 = bflo(hr.y) * rn * g4.z * bflo(mo.y), o3 = bfhi(hr.y) * rn * g4.w * bfhi(mo.y);
            *hp = (u32x2){pk2(o0, o1), pk2(o2, o3)};
        }
    }
    __syncthreads();
}
__device__ __forceinline__ void phase5(const MkArgs& a, Frame& F) {
    const int f_tid = fresh_tid(F), f_lane = f_tid & 63, f_wave = F.wave;
    for (int u = F.bid; u < NB * MH * NC; u += F.G) m3_unit(a, F, u);
}
struct ProjUnit { int pm, pn, which; };
struct ProjSched {
    typedef ProjUnit UnitT;
    const bf16_t* A0; const bf16_t* A1; const bf16_t* B0; const bf16_t* B1; int K; int nM, nN, G, c, wave;
    __device__ __forceinline__ bool next(int i, ProjUnit& u) const { u.which = i & 1; return pg8::static_tile((i >> 1) * G + c, nM, nN, u.pm, u.pn); }
    __device__ __forceinline__ const void* a_buf() const { return A0; }
    __device__ __forceinline__ const void* b_buf() const { return B0; }
    __device__ __forceinline__ unsigned a_soff(const ProjUnit& u) const { return (unsigned)u.pm * 256u * (unsigned)K * 2u + (u.which ? (unsigned)((const char*)A1 - (const char*)A0) : 0u); }
    __device__ __forceinline__ unsigned b_soff(const ProjUnit& u) const { return (unsigned)u.pn * 256u * (unsigned)K * 2u + (u.which ? (unsigned)((const char*)B1 - (const char*)B0) : 0u); }
    __device__ __forceinline__ void a_offs(const ProjUnit&, int R0, int R1, int C0, int C1, unsigned (&o)[4]) const {
        o[0] = (unsigned)(R0 * K + C0) * 2u; o[1] = (unsigned)(R1 * K + C1) * 2u; o[2] = (unsigned)((R0 + 128) * K + C0) * 2u; o[3] = (unsigned)((R1 + 128) * K + C1) * 2u;
    }
};
struct EpiMerge {
    bf16_t* MG; const bf16_t* PB; bool skip;
    __device__ __forceinline__ void operator()(const f32x4 (&acc)[2][2][4][2], const ProjUnit& u, int wr, int wc, int fr, int fq) const {
        if (skip) {
#pragma unroll
            for (int ai = 0; ai < 2; ++ai)
#pragma unroll
                for (int bj = 0; bj < 2; ++bj)
#pragma unroll
                    for (int m = 0; m < 4; ++m)
#pragma unroll
                        for (int n = 0; n < 2; ++n) asm volatile("" :: "v"(acc[ai][bj][m][n]));
            return;
        }
        const int row0 = u.pm * 256 + wr * 64 + fr, col0 = u.pn * 256 + wc * 32 + 8 * fq;
        const int gcol = (u.which ? fp::PB_GM : fp::PB_GA) + col0;
#pragma unroll
        for (int ai = 0; ai < 2; ++ai) {
            u32x4 gv[4][2], pv[4][2];
#pragma unroll
            for (int m = 0; m < 4; ++m)
#pragma unroll
                for (int bj = 0; bj < 2; ++bj) { const size_t row = (size_t)(row0 + ai * 128 + m * 16);
                    gv[m][bj] = *(const u32x4*)(PB + row * fp::NIN + gcol + bj * 128);
                    pv[m][bj] = u.which ? *(const u32x4*)(MG + row * 2048 + col0 + bj * 128) : (u32x4){0u, 0u, 0u, 0u}; }
#pragma unroll
            for (int m = 0; m < 4; ++m)
#pragma unroll
                for (int bj = 0; bj < 2; ++bj) { const size_t row = (size_t)(row0 + ai * 128 + m * 16);
                    float g[8], p[8]; unpack8(gv[m][bj], g); unpack8(pv[m][bj], p);
                    const f32x4 v0 = acc[ai][bj][m][0], v1 = acc[ai][bj][m][1];
                    const float o[8] = {p[0] + g[0] * v0[0], p[1] + g[1] * v0[1], p[2] + g[2] * v0[2], p[3] + g[3] * v0[3], p[4] + g[4] * v1[0], p[5] + g[5] * v1[1], p[6] + g[6] * v1[2], p[7] + g[7] * v1[3]};
                    *(u32x4*)(MG + row * 2048 + col0 + bj * 128) = (u32x4){pg8::cvt_pk_bf16(o[0], o[1]), pg8::cvt_pk_bf16(o[2], o[3]), pg8::cvt_pk_bf16(o[4], o[5]), pg8::cvt_pk_bf16(o[6], o[7])}; }
        }
    }
};
__device__ __forceinline__ void phase6(const MkArgs& a, Frame& F, bool skip_epi = false) {
    const int f_tid = fresh_tid(F), f_lane = f_tid & 63, f_wave = F.wave;
    unsigned char* ws = a.ws;
    ProjSched S{(const bf16_t*)(ws + wsf::OAT), (const bf16_t*)(ws + wsf::HM), (const bf16_t*)(ws + wsf::WAP_T), (const bf16_t*)(ws + wsf::WMP_T), 1024, NTOK / 256, 2048 / 256, F.G, F.bid, F.wave};
    EpiMerge E{(bf16_t*)(ws + wsf::MG), (const bf16_t*)(ws + wsf::PROJB), skip_epi};
    pg8::gemm_phase<EpiMerge, ProjSched>(F.lds, S, E);
}
struct EpiPlain {
    bf16_t* O; int ldc;
    __device__ __forceinline__ void operator()(const f32x4 (&acc)[2][2][4][2], const DenseUnit& u, int wr, int wc, int fr, int fq) const {
        const int row0 = u.pm * 256 + wr * 64 + fr, col0 = u.pn * 256 + wc * 32 + 8 * fq;
#pragma unroll
        for (int ai = 0; ai < 2; ++ai)
#pragma unroll
            for (int m = 0; m < 4; ++m)
#pragma unroll
                for (int bj = 0; bj < 2; ++bj) {
                    const f32x4 v0 = acc[ai][bj][m][0], v1 = acc[ai][bj][m][1];
                    *(u32x4*)(O + (size_t)(row0 + ai * 128 + m * 16) * ldc + col0 + bj * 128) =
                        (u32x4){pg8::cvt_pk_bf16(v0[0], v0[1]), pg8::cvt_pk_bf16(v0[2], v0[3]), pg8::cvt_pk_bf16(v1[0], v1[1]), pg8::cvt_pk_bf16(v1[2], v1[3])};
                }
    }
};
__device__ __forceinline__ void phase7(const MkArgs& a, Frame& F) {
    const int f_tid = fresh_tid(F), f_lane = f_tid & 63, f_wave = F.wave;
    unsigned char* ws = a.ws;
    DenseSched S{(const bf16_t*)(ws + wsf::MG), (const bf16_t*)(ws + wsf::WOUT_T), 2048, 2048, NTOK / 256, 2048 / 256, F.G, F.bid, F.wave};
    EpiPlain E{(bf16_t*)(ws + wsf::Y), 2048};
    pg8::gemm_phase<EpiPlain, DenseSched>(F.lds, S, E);
}

__device__ __forceinline__ void phase8(const MkArgs& a, Frame& F) {
    const int f_tid = fresh_tid(F), f_lane = f_tid & 63, f_wave = F.wave;
    unsigned char* ws = a.ws;
    LAS float* t_gt1 = (LAS float*)F.lds, *t_gpo = t_gt1 + 2048, *t_gpr = t_gt1 + 4096, *t_sc2 = t_gt1 + 6144, *t_sh2 = t_gt1 + 8192;
    LAS float* lgp = (LAS float*)(F.lds + 40960);
    LAS int* cntl = (LAS int*)(F.lds + 57344);
    LAS int* basel = cntl + 32;
    LAS int* esel = cntl + 64;
    LAS int* eslot = cntl + 320;
    const float* mod = (const float*)(ws + wsf::MOD);
    const bf16_t* Yp = (const bf16_t*)(ws + wsf::Y);
    bf16_t* H2p = (bf16_t*)(ws + wsf::H2);
    bf16_t* X1p = (bf16_t*)(ws + wsf::X1);
    const bf16_t* WR = (const bf16_t*)(ws + wsf::WRT);
    int* cntg = (int*)(ws + wsf::CTL) + wsf::CW_CNT;
    const int tid = f_tid, lane = f_lane, w = f_wave;
    for (int blk = F.vcu; blk < NTOK / 64; blk += F.G) {
        const int b = (blk * 64) / S;
        for (int i = tid; i < 2048; i += fp::NT) {
            t_gt1[i] = mod[b * MODW + MOD_GT1 + i]; t_gpo[i] = a.g_post_mix[i]; t_gpr[i] = a.g_pre_ffn[i];
            t_sc2[i] = mod[b * MODW + MOD_SC2 + i]; t_sh2[i] = mod[b * MODW + MOD_SH2 + i];
        }
        if (tid < 32) cntl[tid] = 0;
        __syncthreads();
#pragma unroll 1
        for (int rr = 0; rr < 8; ++rr) {
            const size_t row = (size_t)blk * 64 + w * 8 + rr;
            u32x4 yp[4]; float ss = 0.f;
#pragma unroll
            for (int j = 0; j < 4; ++j) { yp[j] = *(const u32x4*)(Yp + row * 2048 + 8 * (64 * j + lane)); float f[8]; unpack8(yp[j], f);
#pragma unroll
                for (int e = 0; e < 8; ++e) ss += f[e] * f[e]; }
            const float r1 = rsqrtf(wave_sum_f(ss) * (1.f / D) + EPS);
            ss = 0.f;
#pragma unroll
            for (int j = 0; j < 4; ++j) {
                const int c0 = 8 * (64 * j + lane);
                float f[8]; unpack8(yp[j], f);
                const f32x4 xa = *(const f32x4*)(a.x + row * D + c0), xb = *(const f32x4*)(a.x + row * D + c0 + 4);
                const float xv[8] = {xa.x, xa.y, xa.z, xa.w, xb.x, xb.y, xb.z, xb.w};
                float v[8];
#pragma unroll
                for (int e = 0; e < 8; ++e) { v[e] = xv[e] + t_gt1[c0 + e] * (f[e] * r1 * t_gpo[c0 + e]); ss += v[e] * v[e]; }
                *(u32x4*)(X1p + row * D + c0) = (u32x4){pg8::cvt_pk_bf16(v[0], v[1]), pg8::cvt_pk_bf16(v[2], v[3]), pg8::cvt_pk_bf16(v[4], v[5]), pg8::cvt_pk_bf16(v[6], v[7])};
            }
            const float r2 = rsqrtf(wave_sum_f(ss) * (1.f / D) + EPS);
#pragma unroll
            for (int j = 0; j < 4; ++j) {
                const int c0 = 8 * (64 * j + lane);
                const u32x4 xr = *(const u32x4*)(X1p + row * D + c0);
                float xv[8]; unpack8(xr, xv);
                float hv[8];
#pragma unroll
                for (int e = 0; e < 8; ++e) hv[e] = xv[e] * r2 * t_gpr[c0 + e] * (1.f + t_sc2[c0 + e]) + t_sh2[c0 + e];
                *(u32x4*)(H2p + row * 2048 + c0) = (u32x4){pg8::cvt_pk_bf16(hv[0], hv[1]), pg8::cvt_pk_bf16(hv[2], hv[3]), pg8::cvt_pk_bf16(hv[4], hv[5]), pg8::cvt_pk_bf16(hv[6], hv[7])};
#if MOE_FP8
                *(u32x2*)(ws + wsf::H2F8 + row * 2048 + c0) = (u32x2){pk4_fp8(hv[0], hv[1], hv[2], hv[3]), pk4_fp8(hv[4], hv[5], hv[6], hv[7])};
#endif
            }
        }
        VM_WAIT();
        __syncthreads();
        {
            const int c16 = lane & 15, grp = lane >> 4, rt = w & 3, kh = w >> 2;
            f32x4 acc[2] = {(f32x4){0.f, 0.f, 0.f, 0.f}, (f32x4){0.f, 0.f, 0.f, 0.f}};
            int blkb = blk; asm volatile("" : "+s"(blkb));
            const bf16_t* ap = H2p + ((size_t)blkb * 64 + 16 * rt + c16) * 2048 + 8 * grp;
#pragma unroll 4
            for (int ks = kh * 32; ks < kh * 32 + 32; ++ks) {
                const bf16x8 af = *(const bf16x8*)(ap + 32 * ks);
#pragma unroll
                for (int et = 0; et < 2; ++et) {
                    const bf16x8 bh = *(const bf16x8*)(WR + (size_t)(16 * et + c16) * 2048 + 32 * ks + 8 * grp);
                    const bf16x8 bl = *(const bf16x8*)(WR + (size_t)32 * 2048 + (size_t)(16 * et + c16) * 2048 + 32 * ks + 8 * grp);
                    acc[et] = mfma16(af, bh, acc[et]); acc[et] = mfma16(af, bl, acc[et]);
                }
            }
#pragma unroll
            for (int et = 0; et < 2; ++et)
#pragma unroll
                for (int r = 0; r < 4; ++r) lgp[kh * 2048 + (16 * rt + 4 * grp + r) * 32 + 16 * et + c16] = acc[et][r];
        }
        __syncthreads();
        int blkc = blk; asm volatile("" : "+s"(blkc));
        if (tid < 64) {
            const size_t tok = (size_t)blkc * 64 + tid;
            float lgv[32];
#pragma unroll
            for (int e = 0; e < 32; ++e) lgv[e] = lgp[tid * 32 + e] + lgp[2048 + tid * 32 + e] + a.b_router[e];
            int idx[4]; float val[4];
            unsigned used = 0u;
#pragma unroll
            for (int k = 0; k < 4; ++k) {
                float best = -INFINITY; int bi = 0;
#pragma unroll
                for (int e = 0; e < 32; ++e) { const bool c = !((used >> e) & 1u) && lgv[e] > best; best = c ? lgv[e] : best; bi = c ? e : bi; }
                used |= 1u << bi; idx[k] = bi; val[k] = best;
            }
            float ex[4], sum = 0.f;
#pragma unroll
            for (int k = 0; k < 4; ++k) { ex[k] = expf(val[k] - val[0]); sum += ex[k]; }
#pragma unroll
            for (int k = 0; k < 4; ++k) {
                ((int*)(ws + wsf::TOPI))[tok * 4 + k] = idx[k]; ((float*)(ws + wsf::TOPW))[tok * 4 + k] = ex[k] / sum;
                const int e = a.route_i ? a.route_i[tok * 4 + k] : idx[k];
                esel[tid * 4 + k] = e;
                eslot[tid * 4 + k] = __hip_atomic_fetch_add(cntl + e, 1, __ATOMIC_RELAXED, __HIP_MEMORY_SCOPE_WORKGROUP);
            }
        }
        __syncthreads();
        if (tid < 32) { const int n = cntl[tid]; basel[tid] = n > 0 ? __hip_atomic_fetch_add(cntg + tid, n, __ATOMIC_RELAXED, __HIP_MEMORY_SCOPE_AGENT) : 0; }
        __syncthreads();
        if (tid < 256) { const int e = esel[tid]; ((int*)(ws + wsf::LIST))[(size_t)e * NPAIR + basel[e] + eslot[tid]] = (blkc * 64 + (tid >> 2)) * 4 + (tid & 3); }
        __syncthreads();
    }
}

struct MoeUnit { int e, m0, pn, rows; };
struct MoeSched {
    typedef MoeUnit UnitT;
    const bf16_t* A; int a_shift; const bf16_t* Wt; size_t wstride; int K; int nN;
    const int* list; const LAS int* tstart; const LAS int* cnt; int nM; int G, c, wave;
    __device__ __forceinline__ bool next(int i, MoeUnit& u) const {
        const int nwg = nM * nN, L = i * G + c; if (L >= nwg) return false;
        int wgid = L; { const int q = nwg / 8, r = nwg % 8, xcd = wgid % 8, off = wgid / 8; wgid = (xcd < r ? xcd * (q + 1) : r * (q + 1) + (xcd - r) * q) + off; }
        constexpr int WG = 4;
        const int nig = WG * nN, gid = wgid / nig, fm = gid * WG, gsz = (nM - fm) < WG ? (nM - fm) : WG;
        const int mt = fm + ((wgid % nig) % gsz); u.pn = (wgid % nig) / gsz;
        int e = 0;
        for (int k = 1; k < NE; ++k) e += (__builtin_amdgcn_readfirstlane(tstart[k]) <= mt) ? 1 : 0;
        u.e = e; u.m0 = (mt - __builtin_amdgcn_readfirstlane(tstart[e])) * 256; const int left = __builtin_amdgcn_readfirstlane(cnt[e]) - u.m0; u.rows = left < 256 ? left : 256;
        return true;
    }
    __device__ __forceinline__ const void* a_buf() const { return A; }
    __device__ __forceinline__ const void* b_buf() const { return Wt; }
    __device__ __forceinline__ unsigned a_soff(const MoeUnit&) const { return 0u; }
    __device__ __forceinline__ unsigned b_soff(const MoeUnit& u) const { return ((unsigned)u.e * (unsigned)wstride + (unsigned)u.pn * 256u * (unsigned)K) * 2u; }
    __device__ __forceinline__ unsigned rowoff(const MoeUnit& u, int r, int C) const {
        const int rc = r < u.rows ? r : u.rows - 1;
        const int id = list[(size_t)u.e * NPAIR + u.m0 + rc] >> a_shift;
        return ((unsigned)id * (unsigned)K + (unsigned)C) * 2u;
    }
    __device__ __forceinline__ void a_offs(const MoeUnit& u, int R0, int R1, int C0, int C1, unsigned (&o)[4]) const {
        o[0] = rowoff(u, R0, C0); o[1] = rowoff(u, R1, C1); o[2] = rowoff(u, R0 + 128, C0); o[3] = rowoff(u, R1 + 128, C1);
    }
};
__device__ __forceinline__ void moe_tables(const MkArgs& a, Frame& F, LAS int*& cnt, LAS int*& tstart) {
    const int f_tid = fresh_tid(F);
    cnt = (LAS int*)(F.lds + LDS_TAB); tstart = cnt + 32;
    const int* cntg = (const int*)(a.ws + wsf::CTL) + wsf::CW_CNT;
    if (f_tid < 32) cnt[f_tid] = __hip_atomic_load(cntg + f_tid, RLX_AGENT);
    __syncthreads();
    if (f_tid == 0) { int s = 0; for (int e = 0; e < NE; ++e) { tstart[e] = s; s += (cnt[e] + 255) >> 8; } tstart[NE] = s; }
    __syncthreads();
}
template <bool F8> struct EpiGateUpT {
    bf16_t* ACT; const float* bias; const int* list; bool skip;
    __device__ __forceinline__ void operator()(const f32x4 (&acc)[2][2][4][2], const MoeUnit& u, int wr, int wc, int fr, int fq) const {
        if (skip) {
#pragma unroll
            for (int ai = 0; ai < 2; ++ai)
#pragma unroll
                for (int bj = 0; bj < 2; ++bj)
#pragma unroll
                    for (int m = 0; m < 4; ++m)
#pragma unroll
                        for (int n = 0; n < 2; ++n) asm volatile("" :: "v"(acc[ai][bj][m][n]));
            return;
        }
        const int col0 = u.pn * 256 + wc * 32 + 8 * fq;
        f32x4 bv[2][2];
#pragma unroll
        for (int bj = 0; bj < 2; ++bj)
#pragma unroll
            for (int n = 0; n < 2; ++n) bv[bj][n] = *(const f32x4*)(bias + (size_t)u.e * 4096 + col0 + bj * 128 + 4 * n);
        int pr[8];
#pragma unroll
        for (int q = 0; q < 8; ++q) { const int r = (q >> 2) * 128 + wr * 64 + (q & 3) * 16 + fr; pr[q] = list[(size_t)u.e * NPAIR + u.m0 + (r < u.rows ? r : 0)]; if (r >= u.rows) pr[q] = -1; }
#pragma unroll
        for (int ai = 0; ai < 2; ++ai)
#pragma unroll
            for (int m = 0; m < 4; ++m) {
                const int pair = pr[ai * 4 + m];
                if (pair >= 0) {
#pragma unroll
                    for (int bj = 0; bj < 2; ++bj) {
                        const f32x4 v0 = acc[ai][bj][m][0] * (F8 ? W8INV : 1.f) + bv[bj][0], v1 = acc[ai][bj][m][1] * (F8 ? W8INV : 1.f) + bv[bj][1];
                        const float gu[8] = {v0[0], v0[1], v0[2], v0[3], v1[0], v1[1], v1[2], v1[3]};
                        float o[4];
#pragma unroll
                        for (int j = 0; j < 4; ++j) {
                            const float glu = fminf(gu[2 * j], 7.0f), lin = fminf(fmaxf(gu[2 * j + 1], -7.0f), 7.0f);
                            o[j] = glu * fast_sigmoid(1.702f * glu) * (lin + 1.f);
                        }
                        if constexpr (F8) *(unsigned*)((unsigned char*)ACT + (size_t)pair * 2048 + (col0 + bj * 128) / 2) = pk4_fp8(o[0], o[1], o[2], o[3]);
                        else *(u32x2*)(ACT + (size_t)pair * 2048 + (col0 + bj * 128) / 2) = (u32x2){pg8::cvt_pk_bf16(o[0], o[1]), pg8::cvt_pk_bf16(o[2], o[3])};
                    }
                }
            }
    }
};
template <bool F8> struct EpiDownT {
    bf16_t* YP; const float* bias; const int* list; const float* wgt;
    __device__ __forceinline__ void operator()(const f32x4 (&acc)[2][2][4][2], const MoeUnit& u, int wr, int wc, int fr, int fq) const {
        const int col0 = u.pn * 256 + wc * 32 + 8 * fq;
        f32x4 bv[2][2];
#pragma unroll
        for (int bj = 0; bj < 2; ++bj)
#pragma unroll
            for (int n = 0; n < 2; ++n) bv[bj][n] = *(const f32x4*)(bias + (size_t)u.e * 2048 + col0 + bj * 128 + 4 * n);
        int pr[8]; float wq[8];
#pragma unroll
        for (int q = 0; q < 8; ++q) { const int r = (q >> 2) * 128 + wr * 64 + (q & 3) * 16 + fr; pr[q] = list[(size_t)u.e * NPAIR + u.m0 + (r < u.rows ? r : 0)]; if (r >= u.rows) pr[q] = -1; }
#pragma unroll
        for (int q = 0; q < 8; ++q) wq[q] = wgt[pr[q] >= 0 ? pr[q] : 0];
#pragma unroll
        for (int ai = 0; ai < 2; ++ai)
#pragma unroll
            for (int m = 0; m < 4; ++m) {
                const int pair = pr[ai * 4 + m];
                if (pair >= 0) {
                    const float wv = wq[ai * 4 + m];
#pragma unroll
                    for (int bj = 0; bj < 2; ++bj) {
                        const f32x4 v0 = (acc[ai][bj][m][0] * (F8 ? W8INV : 1.f) + bv[bj][0]) * wv, v1 = (acc[ai][bj][m][1] * (F8 ? W8INV : 1.f) + bv[bj][1]) * wv;
                        if constexpr (F8) *(u32x2*)((unsigned char*)YP + (size_t)pair * 2048 + col0 + bj * 128) =
                            (u32x2){pk4_fp8(v0[0] * YP8SCALE, v0[1] * YP8SCALE, v0[2] * YP8SCALE, v0[3] * YP8SCALE), pk4_fp8(v1[0] * YP8SCALE, v1[1] * YP8SCALE, v1[2] * YP8SCALE, v1[3] * YP8SCALE)};
                        else *(u32x4*)(YP + (size_t)pair * 2048 + col0 + bj * 128) =
                            (u32x4){pg8::cvt_pk_bf16(v0[0], v0[1]), pg8::cvt_pk_bf16(v0[2], v0[3]), pg8::cvt_pk_bf16(v1[0], v1[1]), pg8::cvt_pk_bf16(v1[2], v1[3])};
                    }
                }
            }
    }
};
__device__ __forceinline__ void phase9(const MkArgs& a, Frame& F, bool skip_epi = false) {
    unsigned char* ws = a.ws;
    LAS int* cnt; LAS int* tstart; moe_tables(a, F, cnt, tstart);
#if MOE_FP8
    MoeSched S{(const bf16_t*)(ws + wsf::H2F8), 2, (const bf16_t*)(ws + wsf::WGU8), (size_t)4096 * 1024, 1024, 16, (const int*)(ws + wsf::LIST), tstart, cnt, __builtin_amdgcn_readfirstlane(tstart[NE]), F.G, F.bid, F.wave};
    EpiGateUpT<true> E{(bf16_t*)(ws + wsf::ACT8), a.b_gate_up, (const int*)(ws + wsf::LIST), skip_epi};
    if (EPI_SKIP_PROBE >= 2 && skip_epi) pg8::gemm_phase<EpiGateUpT<true>, MoeSched, true, EPI_SKIP_PROBE - 1>(F.lds, S, E);
    else pg8::gemm_phase<EpiGateUpT<true>, MoeSched, true>(F.lds, S, E);
#else
    MoeSched S{(const bf16_t*)(ws + wsf::H2), 2, (const bf16_t*)(ws + wsf::WGU_T), (size_t)4096 * 2048, 2048, 16, (const int*)(ws + wsf::LIST), tstart, cnt, __builtin_amdgcn_readfirstlane(tstart[NE]), F.G, F.bid, F.wave};
    EpiGateUpT<false> E{(bf16_t*)(ws + wsf::ACT), a.b_gate_up, (const int*)(ws + wsf::LIST), skip_epi};
    pg8::gemm_phase<EpiGateUpT<false>, MoeSched, false>(F.lds, S, E);
#endif
}
__device__ __forceinline__ void phase10(const MkArgs& a, Frame& F) {
    unsigned char* ws = a.ws;
    LAS int* cnt; LAS int* tstart; moe_tables(a, F, cnt, tstart);
    const float* wgt = a.route_w ? a.route_w : (const float*)(ws + wsf::TOPW);
#if MOE_FP8
    MoeSched S{(const bf16_t*)(ws + wsf::ACT8), 0, (const bf16_t*)(ws + wsf::WDN8), (size_t)2048 * 1024, 1024, 8, (const int*)(ws + wsf::LIST), tstart, cnt, __builtin_amdgcn_readfirstlane(tstart[NE]), F.G, F.bid, F.wave};
    EpiDownT<true> E{(bf16_t*)(ws + wsf::YP), a.b_down, (const int*)(ws + wsf::LIST), wgt};
    pg8::gemm_phase<EpiDownT<true>, MoeSched, true>(F.lds, S, E);
#else
    MoeSched S{(const bf16_t*)(ws + wsf::ACT), 0, (const bf16_t*)(ws + wsf::WDN_T), (size_t)2048 * 2048, 2048, 8, (const int*)(ws + wsf::LIST), tstart, cnt, __builtin_amdgcn_readfirstlane(tstart[NE]), F.G, F.bid, F.wave};
    EpiDownT<false> E{(bf16_t*)(ws + wsf::YP), a.b_down, (const int*)(ws + wsf::LIST), wgt};
    pg8::gemm_phase<EpiDownT<false>, MoeSched, false>(F.lds, S, E);
#endif
}

__device__ __forceinline__ void phase11(const MkArgs& a, Frame& F) {
    const int f_tid = fresh_tid(F), f_lane = f_tid & 63, f_wave = F.wave;
    unsigned char* ws = a.ws;
    const float* mod = (const float*)(ws + wsf::MOD);
    const bf16_t* YPp = (const bf16_t*)(ws + wsf::YP);
    const bf16_t* X1p = (const bf16_t*)(ws + wsf::X1);
    const int gw = F.vcu * fp::NW + f_wave, NGW = F.G * fp::NW, lane = f_lane;
    if (gw >= NTOK) return;
#if MOE_FP8
    u32x2 yq[16];
#else
    u32x4 yq[16];
#endif
    u32x4 xq[4];
#if MOE_FP8
#define P11_YLOAD(prow, j) (*(const u32x2*)((const unsigned char*)YPp + (prow) * 2048 + 8 * (64 * (j) + lane)))
#else
#define P11_YLOAD(prow, j) (*(const u32x4*)(YPp + (prow) * 2048 + 8 * (64 * (j) + lane)))
#endif
#define P11_LOAD(m_) do { const size_t m__ = (size_t)(m_); \
        _Pragma("unroll") for (int k = 0; k < 4; ++k) _Pragma("unroll") for (int j = 0; j < 4; ++j) yq[k * 4 + j] = P11_YLOAD((m__ * 4 + k), j); \
        _Pragma("unroll") for (int j = 0; j < 4; ++j) xq[j] = *(const u32x4*)(X1p + m__ * D + 8 * (64 * j + lane)); } while (0)
    P11_LOAD(gw);
    for (int m = gw; m < NTOK; m += NGW) {
        const int b = m / S;
        float yv[32]; u32x4 xv[4];
#pragma unroll
        for (int i = 0; i < 32; ++i) yv[i] = 0.f;
#pragma unroll
        for (int k = 0; k < 4; ++k)
#pragma unroll
            for (int j = 0; j < 4; ++j) { float f[8];
#if MOE_FP8
                unpack8_fp8(yq[k * 4 + j], f);
#else
                unpack8(yq[k * 4 + j], f);
#endif
#pragma unroll
                for (int e = 0; e < 8; ++e) yv[8 * j + e] += f[e]; }
#pragma unroll
        for (int i = 0; i < 4; ++i) xv[i] = xq[i];
        { const int mn = m + NGW < NTOK ? m + NGW : m; P11_LOAD(mn); }
        float ss = 0.f;
#pragma unroll
        for (int i = 0; i < 32; ++i) { if (MOE_FP8) yv[i] *= (1.f / YP8SCALE); ss += yv[i] * yv[i]; }
        const float r = rsqrtf(wave_sum_f(ss) * (1.f / D) + EPS);
#pragma unroll
        for (int j = 0; j < 4; ++j) {
            const int c0 = 8 * (64 * j + lane);
            float xf[8]; unpack8(xv[j], xf);
#pragma unroll
            for (int hq = 0; hq < 2; ++hq) {
                const f32x4 xr = (f32x4){xf[4 * hq], xf[4 * hq + 1], xf[4 * hq + 2], xf[4 * hq + 3]};
                const f32x4 gt = *(const f32x4*)(mod + b * MODW + MOD_GT2 + c0 + 4 * hq), gp = *(const f32x4*)(a.g_post_ffn + c0 + 4 * hq);
                f32x4 o;
                o.x = xr.x + gt.x * (yv[8 * j + 4 * hq + 0] * r * gp.x); o.y = xr.y + gt.y * (yv[8 * j + 4 * hq + 1] * r * gp.y);
                o.z = xr.z + gt.z * (yv[8 * j + 4 * hq + 2] * r * gp.z); o.w = xr.w + gt.w * (yv[8 * j + 4 * hq + 3] * r * gp.w);
                *(f32x4*)(a.out + (size_t)m * D + c0 + 4 * hq) = o;
            }
        }
    }
#undef P11_LOAD
#undef P11_YLOAD
}
constexpr int N_PHASES = 12;
#ifndef P0_PARTS
#define P0_PARTS 7
#endif
#ifndef EPI_SKIP_PROBE
#define EPI_SKIP_PROBE 0
#endif
#ifndef REP_MASK
#define REP_MASK 0
#endif
__global__ void __launch_bounds__(fp::NT, 2) mk_fwd(MkArgs a) {
    extern __shared__ __attribute__((aligned(16))) unsigned char lds_raw[];
    Frame F;
    F.lds = (LAS unsigned char*)lds_raw;
    F.wave = __builtin_amdgcn_readfirstlane((int)threadIdx.x >> 6);
    F.G = gridDim.x; F.bid = blockIdx.x; F.vcu = (F.G % 8 == 0) ? (F.bid % 8) * (F.G / 8) + F.bid / 8 : F.bid;
    volatile LAS unsigned* misc = (volatile LAS unsigned*)(F.lds + LDS_MISC);
    if (F.wave == 0) misc[lane_id()] = 0u;
    __syncthreads();
    XcdBarrier bar = xcd_barrier_post((unsigned*)(a.ws + wsf::CTL) + wsf::CW_BAR, misc + 8, F.wave == 0 && lane_id() == 0);
    const int lo = a.ph_lo, hi = a.ph_hi;
#define IN(k) (lo <= (k) && (k) < hi)
#define SEAM(k) do { if (IN(k) && IN((k) + 1)) xcd_barrier(bar, F.wave == 0 && lane_id() == 0); } while (0)
    if (IN(0)) { phase0(a, F); if ((REP_MASK >> 0) & 1) phase0(a, F, P0_PARTS); } SEAM(0);
    if (IN(1)) { phase1(a, F); if ((REP_MASK >> 1) & 1) phase1(a, F); } SEAM(1);
    if (IN(2)) { phase2(a, F); if ((REP_MASK >> 2) & 1) phase2(a, F); } SEAM(2);
#if NPH > 3
    if (IN(3)) { phase3(a, F); if ((REP_MASK >> 3) & 1) phase3(a, F); } SEAM(3);
#endif
#if NPH > 4
    if (IN(4)) { phase4(a, F); if ((REP_MASK >> 4) & 1) phase4(a, F); } SEAM(4);
#endif
#if NPH > 5
    if (IN(5)) { phase5(a, F); if ((REP_MASK >> 5) & 1) phase5(a, F); } SEAM(5);
#endif
#if NPH > 6
    if (IN(6)) { phase6(a, F); if ((REP_MASK >> 6) & 1) phase6(a, F, EPI_SKIP_PROBE != 0); } SEAM(6);
#endif
#if NPH > 7
    if (IN(7)) { phase7(a, F); if ((REP_MASK >> 7) & 1) phase7(a, F); } SEAM(7);
#endif
#if NPH > 8
    if (IN(8)) { phase8(a, F); if ((REP_MASK >> 8) & 1) phase8(a, F); } SEAM(8);
#endif
#if NPH > 9
    if (IN(9)) { phase9(a, F); if ((REP_MASK >> 9) & 1) phase9(a, F, EPI_SKIP_PROBE != 0); } SEAM(9);
#endif
#if NPH > 10
    if (IN(10)) { phase10(a, F); if ((REP_MASK >> 10) & 1) phase10(a, F); } SEAM(10);
#endif
#if NPH > 11
    if (IN(11)) { phase11(a, F); if ((REP_MASK >> 11) & 1) phase11(a, F); }
#endif
#undef IN
#undef SEAM
}

static void fill_args(MkArgs& a, void* const* d_in, void* d_out, void* d_ws) {
    a.x = (const float*)d_in[0]; a.c = (const float*)d_in[1]; a.positions = (const int*)d_in[2]; a.w_ada = (const float*)d_in[3]; a.b_ada = (const float*)d_in[4];
    a.g_pre_mix = (const float*)d_in[5]; a.g_post_mix = (const float*)d_in[6]; a.g_pre_ffn = (const float*)d_in[7]; a.g_post_ffn = (const float*)d_in[8];
    a.w_in = (const float*)d_in[9]; a.b_in = (const float*)d_in[10]; a.conv_qk = (const float*)d_in[11]; a.sinks = (const float*)d_in[12]; a.g_mlstm = (const float*)d_in[13];
    a.w_attn_proj = (const float*)d_in[14]; a.w_mlstm_proj = (const float*)d_in[15]; a.w_out = (const float*)d_in[16]; a.w_router = (const float*)d_in[17]; a.b_router = (const float*)d_in[18];
    a.w_gate_up = (const float*)d_in[19]; a.b_gate_up = (const float*)d_in[20]; a.w_down = (const float*)d_in[21]; a.b_down = (const float*)d_in[22];
    a.out = (float*)d_out; a.ws = (unsigned char*)d_ws; a.route_i = nullptr; a.route_w = nullptr; a.ph_lo = 0; a.ph_hi = 0;
}
static int mk_setup() {
    static int grid = 0;
    if (grid == 0) {
        int dev = 0, cus = 0;
        if (hipGetDevice(&dev) != hipSuccess || hipDeviceGetAttribute(&cus, hipDeviceAttributeMultiprocessorCount, dev) != hipSuccess) { grid = -1; return grid; }
        if (hipFuncSetAttribute((const void*)mk_fwd, hipFuncAttributeMaxDynamicSharedMemorySize, LDS_BYTES) != hipSuccess) { grid = -1; return grid; }
        int per_cu = 0;
        if (hipOccupancyMaxActiveBlocksPerMultiprocessor(&per_cu, (const void*)mk_fwd, fp::NT, LDS_BYTES) != hipSuccess || per_cu < 1) { (void)hipGetLastError(); }
        grid = cus;
    }
    return grid;
}

extern "C" void kernel_launch(void* const* d_in, const int* in_sizes, int n_in, void* d_out, int out_size, void* d_ws, size_t ws_size, hipStream_t stream) {
    if (n_in != 23 || ws_size < wsf::END) return;
    const int grid = mk_setup();
    if (grid <= 0) return;
    if (hipMemsetAsync((unsigned char*)d_ws + wsf::CTL, 0, 65536, stream) != hipSuccess) return;
    MkArgs a{}; fill_args(a, d_in, d_out, d_ws);
    a.ph_lo = 0; a.ph_hi = N_PHASES;
    hipLaunchKernelGGL(mk_fwd, dim3(grid), dim3(fp::NT), LDS_BYTES, stream, a);
}
```

```cpp
#include <hip/hip_runtime.h>
#include <stdint.h>
#include <math.h>
#define NPH 12
#define MOE_FP8 1
#define REP_MASK 0
#define CONV_WGS 80
#define DRY_PROBE 0
#define EPI_SKIP_PROBE 0
#define CONV_SPLIT 900
#define P0_PARTS 7
#define LDS_LAYOUT 0
namespace cfg {
constexpr int D = 2048, NB = 2, S = 8192, NTOK = NB * S;
constexpr int HQ = 16, HKV = 2, HD = 64, QW = 1024;
constexpr int MH = 4, MDV = 256, MDK = 128, MQKW = 512, MVW = 1024, CL = 128, NC = S / CL;
constexpr int NE = 32, TOPK = 4, DFF = 2048, NPAIR = NTOK * TOPK;
constexpr int INW = 8456;
constexpr int OFF_AQ = 0, OFF_AK = 1024, OFF_AV = 1152, OFF_MQ = 1280, OFF_MK = 1792, OFF_MV = 2304, OFF_MO = 3328,
              OFF_MI = 4352, OFF_MF = 4356, OFF_GA = 4360, OFF_GM = 6408;
constexpr float EPS = 1e-6f;
constexpr int MOD_SH1 = 0, MOD_SC1 = 2048, MOD_GT1 = 4096, MOD_SH2 = 6144, MOD_SC2 = 8192, MOD_GT2 = 10240, MODW = 12288;
}
using namespace cfg;
__device__ __forceinline__ float silu_f(float x) { return x / (1.f + expf(-x)); }
__device__ __forceinline__ float sigmoid_f(float x) { return 1.f / (1.f + expf(-x)); }
__device__ __forceinline__ void rope_cs(int pos, int i, float& c, float& s) {
    const float invf[8] = {1.0f, 0.1939227432012558f, 0.03760603070259094f, 0.007292664609849453f,
                           0.0014142135623842478f, 0.00027424818836152554f, 5.3182957344688475e-05f, 1.0313385246263351e-05f};
    float f = i == 0 ? invf[0] : i == 1 ? invf[1] : i == 2 ? invf[2] : i == 3 ? invf[3] : i == 4 ? invf[4] : i == 5 ? invf[5] : i == 6 ? invf[6] : invf[7];
    float ang = (float)pos * f;
    double t = (double)ang * 0.15915494309189535;
    t -= rint(t);
    float tf = (float)t;
    s = __builtin_amdgcn_sinf(tf);
    c = __builtin_amdgcn_cosf(tf);
}
__device__ __forceinline__ float softcap_f(float z) { return 15.f * tanhf(z / 15.f); }
__device__ __forceinline__ float logsigmoid_f(float z) { return fminf(z, 0.f) - log1pf(expf(-fabsf(z))); }
#ifndef MOE_FP8
#define MOE_FP8 1
#endif
#ifndef CONV_WGS
#define CONV_WGS 80
#endif
#ifndef CONV_SPLIT
#define CONV_SPLIT 900
#endif
#ifndef LDS_LAYOUT
#define LDS_LAYOUT 0
#endif
#ifndef DRY_PROBE
#define DRY_PROBE 0
#endif
#ifndef EPI_SKIP_PROBE
#define EPI_SKIP_PROBE 0
#endif
#ifndef P0_PARTS
#define P0_PARTS 7
#endif
#ifndef REP_MASK
#define REP_MASK 0
#endif
#define GAS __attribute__((address_space(1)))
#define LAS __attribute__((address_space(3)))
typedef unsigned short bf16_t;
typedef short bf16x8 __attribute__((ext_vector_type(8)));
typedef short bf16x4 __attribute__((ext_vector_type(4)));
typedef float f32x4 __attribute__((ext_vector_type(4)));
typedef float f32x2 __attribute__((ext_vector_type(2)));
typedef unsigned u32x4 __attribute__((ext_vector_type(4)));
typedef unsigned u32x2 __attribute__((ext_vector_type(2)));
#define RLX_AGENT __ATOMIC_RELAXED, __HIP_MEMORY_SCOPE_AGENT
#define LDS_WAIT() asm volatile("s_waitcnt lgkmcnt(0)" ::: "memory")
#define VM_WAIT() asm volatile("s_waitcnt vmcnt(0)" ::: "memory")

__device__ __forceinline__ unsigned f2bf(float f) { unsigned u = __builtin_bit_cast(unsigned, f); return (u + 0x7fffu + ((u >> 16) & 1u)) >> 16; }
__device__ __forceinline__ unsigned pk2(float lo, float hi) { return f2bf(lo) | (f2bf(hi) << 16); }
__device__ __forceinline__ float bf2f(unsigned short h) { return __builtin_bit_cast(float, (unsigned)h << 16); }
__device__ __forceinline__ float bflo(unsigned w) { return __builtin_bit_cast(float, w << 16); }
__device__ __forceinline__ float bfhi(unsigned w) { return __builtin_bit_cast(float, w & 0xffff0000u); }
__device__ __forceinline__ unsigned pk4_fp8(float a, float b, float c, float d) {
    a = __builtin_amdgcn_fmed3f(a, -448.f, 448.f); b = __builtin_amdgcn_fmed3f(b, -448.f, 448.f); c = __builtin_amdgcn_fmed3f(c, -448.f, 448.f); d = __builtin_amdgcn_fmed3f(d, -448.f, 448.f);
    int r = __builtin_amdgcn_cvt_pk_fp8_f32(a, b, 0, false); r = __builtin_amdgcn_cvt_pk_fp8_f32(c, d, r, true); return (unsigned)r;
}
__device__ __forceinline__ unsigned pk4_fp8_nc(float a, float b, float c, float d) { int r = __builtin_amdgcn_cvt_pk_fp8_f32(a, b, 0, false); r = __builtin_amdgcn_cvt_pk_fp8_f32(c, d, r, true); return (unsigned)r; }
constexpr float YP8SCALE = 16.f;
constexpr float W8SCALE = 64.f, W8INV = 1.f / 64.f;
__device__ __forceinline__ void unpack8_fp8(const u32x2 v, float (&f)[8]) {
    const f32x2 a = __builtin_amdgcn_cvt_pk_f32_fp8((int)v.x, false), b = __builtin_amdgcn_cvt_pk_f32_fp8((int)v.x, true);
    const f32x2 c = __builtin_amdgcn_cvt_pk_f32_fp8((int)v.y, false), d = __builtin_amdgcn_cvt_pk_f32_fp8((int)v.y, true);
    f[0] = a.x; f[1] = a.y; f[2] = b.x; f[3] = b.y; f[4] = c.x; f[5] = c.y; f[6] = d.x; f[7] = d.y;
}
__device__ __forceinline__ float fast_sigmoid(float x) { return __builtin_amdgcn_rcpf(1.f + __builtin_amdgcn_exp2f(-1.4426950408889634f * x)); }

namespace fp {
constexpr int NW = 8, NT = NW * 64;
constexpr int NIN = 8448;
constexpr int PB_Q = 0, PB_K = 1024, PB_V = 1152, PB_MQ = 1280, PB_MK = 1792, PB_MV = 2304, PB_MO = 3328, PB_GA = 4352, PB_GM = 6400;
constexpr float QSCALE = 0.125f * 1.4426950408889634f;
constexpr float LOG2E = 1.4426950408889634f;
}

namespace wsf {
constexpr size_t AL(size_t x) { return (x + 255) & ~(size_t)255; }
constexpr size_t CTL = 0, CTL_BYTES = 1u << 20;
constexpr size_t MODP = CTL + CTL_BYTES;
constexpr size_t MOD = AL(MODP + (size_t)16 * 2 * MODW * 4);
constexpr size_t BINP = AL(MOD + (size_t)2 * MODW * 4);
constexpr size_t CS = AL(BINP + (size_t)fp::NIN * 4);
constexpr size_t WRT = AL(CS + (size_t)NTOK * 8 * 8);
constexpr size_t WIN_T = AL(WRT + (size_t)2 * 32 * 2048 * 2);
constexpr size_t WAP_T = AL(WIN_T + (size_t)fp::NIN * 2048 * 2);
constexpr size_t WMP_T = AL(WAP_T + (size_t)2048 * 1024 * 2);
constexpr size_t WOUT_T = AL(WMP_T + (size_t)2048 * 1024 * 2);
constexpr size_t WGU_T = AL(WOUT_T + (size_t)2048 * 2048 * 2);
#if MOE_FP8
constexpr size_t WDN_T = WGU_T;
constexpr size_t GATES = WGU_T;
#else
constexpr size_t WDN_T = AL(WGU_T + (size_t)32 * 4096 * 2048 * 2);
constexpr size_t GATES = AL(WDN_T + (size_t)32 * 2048 * 2048 * 2);
#endif
constexpr size_t BCUM = AL(GATES + (size_t)NTOK * 8 * 4);
constexpr size_t LOGI = AL(BCUM + (size_t)8 * S * 4);
constexpr size_t GSUM = AL(LOGI + (size_t)8 * S * 4);
constexpr size_t MLOC = AL(GSUM + 512 * 4);
constexpr size_t MPREV = AL(MLOC + 512 * 4);
constexpr size_t DN = AL(MPREV + 512 * 4);
constexpr size_t NPREV = AL(DN + (size_t)512 * 128 * 4);
constexpr size_t DCT = AL(NPREV + (size_t)512 * 128 * 4);
constexpr size_t Y = AL(DCT + (size_t)512 * 256 * 128 * 4);
constexpr size_t X1 = AL(Y + (size_t)NTOK * 2048 * 2);
constexpr size_t H2 = AL(X1 + (size_t)NTOK * 2048 * 4);
constexpr size_t TOPI = AL(H2 + (size_t)NTOK * 2048 * 2);
constexpr size_t TOPW = AL(TOPI + (size_t)NPAIR * 4);
constexpr size_t LIST = AL(TOPW + (size_t)NPAIR * 4);
constexpr size_t PROJB = AL(LIST + (size_t)NE * NPAIR * 4);
constexpr size_t ACT = PROJB;
constexpr size_t YPREG = AL(PROJB + (size_t)NTOK * fp::NIN * 2);
constexpr size_t H1 = YPREG;
constexpr size_t MG = AL(H1 + (size_t)NTOK * 2048 * 2);
constexpr size_t OAT = AL(MG + (size_t)NTOK * 2048 * 2);
constexpr size_t HM = AL(OAT + (size_t)NTOK * 1024 * 2);
constexpr size_t QC = AL(HM + (size_t)NTOK * 1024 * 2);
constexpr size_t KC = AL(QC + (size_t)NTOK * 512 * 2);
constexpr size_t CPT = AL(KC + (size_t)NTOK * 512 * 2);
constexpr size_t YP = YPREG;
constexpr size_t F8BASE = AL(CPT + (size_t)512 * 256 * 128 * 2) > AL(YP + (size_t)NPAIR * 2048 * 2) ? AL(CPT + (size_t)512 * 256 * 128 * 2) : AL(YP + (size_t)NPAIR * 2048 * 2);
constexpr size_t WGU8 = F8BASE;
constexpr size_t WDN8 = AL(WGU8 + (size_t)32 * 4096 * 2048);
constexpr size_t H2F8 = AL(WDN8 + (size_t)32 * 2048 * 2048);
constexpr size_t ACT8 = AL(H2F8 + (size_t)NTOK * 2048);
constexpr size_t END = AL(ACT8 + (size_t)NPAIR * 2048);
static_assert((size_t)NPAIR * 2048 * 2 <= (size_t)NTOK * fp::NIN * 2, "ACT fits over PROJB");
constexpr int CW_BAR = 4096;
constexpr int CW_CNT = 8192;
}

constexpr int RING_BYTES = 131072;
constexpr int LDS_TAB = RING_BYTES;
constexpr int LDS_MISC = RING_BYTES + 8192;
constexpr int LDS_BYTES = 147456;

#define XB_TMO      128
#define XB_XCNT(j)  (256  + 64 * (j))
#define XB_XSUB(j)  (1280 + 64 * (j))
#define XB_XGEN(j)  (2304 + 64 * (j))
#define XB_TOP      3328
#define XB_TOPGEN   3392
#define XCD_BAR_WORDS 3456
#define XB_SPIN_CAP (1u << 18)
__device__ __forceinline__ unsigned xb_ld(unsigned* p)              { return __hip_atomic_load(p, __ATOMIC_RELAXED, __HIP_MEMORY_SCOPE_AGENT); }
__device__ __forceinline__ unsigned xb_add(unsigned* p, unsigned v) { return __hip_atomic_fetch_add(p, v, __ATOMIC_RELAXED, __HIP_MEMORY_SCOPE_AGENT); }
__device__ __forceinline__ unsigned xb_xcc_id() { return (unsigned)__builtin_amdgcn_s_getreg((3 << 11) | 20) & 0xFu; }
#define XB_SPIN(cond, bar) do { unsigned _sp = 0; while (cond) { __builtin_amdgcn_s_sleep(1); \
    if ((++_sp & 255u) == 0u) { if (xb_ld(&(bar)[XB_TMO])) break; if (_sp > XB_SPIN_CAP) { atomicAdd(&(bar)[XB_TMO], 1u); break; } } } } while (0)
struct XcdBarrier { unsigned* bar; unsigned x; volatile LAS unsigned* st; };
__device__ __forceinline__ XcdBarrier xcd_barrier_post(unsigned* bar, volatile LAS unsigned* st, bool t0) {
    XcdBarrier b; b.bar = bar; b.x = xb_xcc_id(); b.st = st;
    if (t0) (void)xb_add(&bar[XB_XCNT(b.x)], 1u);
    return b;
}
__device__ __forceinline__ void xcd_barrier_complete(unsigned* bar, unsigned x, unsigned& nloc, unsigned& nx) {
    const unsigned G = gridDim.x * gridDim.y * gridDim.z;
    unsigned sum, cnt, mine, sp = 0u;
    for (;;) {
        sum = 0u; cnt = 0u; mine = 0u;
#pragma unroll
        for (unsigned j = 0; j < 16; ++j) { const unsigned c = xb_ld(&bar[XB_XCNT(j)]); sum += c; cnt += (c > 0u) ? 1u : 0u; mine = (j == x) ? c : mine; }
        if (sum == G) break;
        __builtin_amdgcn_s_sleep(1);
        if ((++sp & 255u) == 0u) { if (xb_ld(&bar[XB_TMO])) break; if (sp > XB_SPIN_CAP) { atomicAdd(&bar[XB_TMO], 1u); break; } }
    }
    nloc = mine > 0u ? mine : 1u; nx = cnt > 0u ? cnt : 1u;
}
__device__ __forceinline__ void xcd_barrier(const XcdBarrier& b, bool t0) {
    asm volatile("s_waitcnt vmcnt(0)" ::: "memory");
    __syncthreads();
    if (t0) {
        unsigned* bar = b.bar;
        __builtin_amdgcn_s_waitcnt(0);
        unsigned nloc = b.st[0], nx = b.st[1];
        if (nloc == 0u) { xcd_barrier_complete(bar, b.x, nloc, nx); b.st[0] = nloc; b.st[1] = nx; }
        const unsigned old = xb_add(&bar[XB_XSUB(b.x)], 1u);
        const unsigned gen = old / nloc;
        if (old + 1u == (gen + 1u) * nloc) {
            __builtin_amdgcn_fence(__ATOMIC_RELEASE, "agent");
            asm volatile("s_waitcnt vmcnt(0)" ::: "memory");
            const unsigned og = xb_add(&bar[XB_TOP], 1u);
            const unsigned tg = og / nx;
            if (og + 1u == (tg + 1u) * nx) xb_add(&bar[XB_TOPGEN], 1u);
            else XB_SPIN(xb_ld(&bar[XB_TOPGEN]) == tg, bar);
            __builtin_amdgcn_fence(__ATOMIC_ACQUIRE, "agent");
            xb_add(&bar[XB_XGEN(b.x)], 1u);
            asm volatile("s_waitcnt vmcnt(0)" ::: "memory");
        } else {
            XB_SPIN(xb_ld(&bar[XB_XGEN(b.x)]) == gen, bar);
            __builtin_amdgcn_fence(__ATOMIC_ACQUIRE, "agent");
            asm volatile("s_waitcnt vmcnt(0)" ::: "memory");
        }
    }
    __syncthreads();
}

namespace pg8 {
constexpr int BM = 256, BK = 64, HALF = 128, HTB = HALF * BK * 2, STAGE_BYTES = 8 * HTB, NXCD = 8, WGM = 8;
#if LDS_LAYOUT == 2
__host__ __device__ __forceinline__ int lds_byte(int r, int c) { const int st = (r >> 4) * 2 + (c >> 5), rr = r & 15, cc = c & 31; return st * 1024 + rr * 64 + ((((cc >> 3) ^ (rr >> 2)) & 3) << 4) + (cc & 7) * 2; }
__host__ __device__ __forceinline__ void stage_rc(int b, int& R, int& C) { const int st = b / 1024, sb = b % 1024, rr = sb / 64, pc = (sb % 64) / 16; R = (st >> 1) * 16 + rr; C = (st & 1) * 32 + (((pc ^ (rr >> 2)) & 3) << 3) + (sb % 16) / 2; }
#elif LDS_LAYOUT == 1
__host__ __device__ __forceinline__ int lds_byte(int r, int c) { const int st = (r >> 4) * 2 + (c >> 5), rr = r & 15, cc = c & 31; return st * 1024 + (cc >> 3) * 256 + rr * 16 + (cc & 7) * 2; }
__host__ __device__ __forceinline__ void stage_rc(int b, int& R, int& C) { const int st = b / 1024, sb = b % 1024; R = (st >> 1) * 16 + (sb % 256) / 16; C = (st & 1) * 32 + (sb / 256) * 8 + (sb % 16) / 2; }
#else
__host__ __device__ __forceinline__ int lds_byte(int r, int c) { const int st = (r >> 4) * 2 + (c >> 5), rr = r & 15, cc = c & 31, ob = rr * 64 + cc * 2; return st * 1024 + (ob ^ (((ob >> 9) & 1) << 5)); }
__host__ __device__ __forceinline__ void stage_rc(int b, int& R, int& C) { const int st = b / 1024, sb = b % 1024, swz = sb ^ (((sb >> 9) & 1) << 5); R = (st >> 1) * 16 + swz / 64; C = (st & 1) * 32 + (swz % 64) / 2; }
#endif
__host__ __device__ __forceinline__ int perm32(int rho) { const int n = rho >> 4, i = rho & 15; return 8 * (i >> 2) + 4 * n + (i & 3); }
typedef int v8i32_t __attribute__((ext_vector_type(8)));
template <bool F8> struct FragSel { typedef bf16x8 T; };
typedef short s16x16_t __attribute__((ext_vector_type(16)));
template <> struct FragSel<true> { typedef s16x16_t T; };
template <bool F8> __device__ __forceinline__ typename FragSel<F8>::T ld_frag(const LAS unsigned char* p) {
    if constexpr (F8) { const bf16x8 lo = *(const LAS bf16x8*)p, hi = *(const LAS bf16x8*)(p + 1024); return __builtin_shufflevector(lo, hi, 0, 1, 2, 3, 4, 5, 6, 7, 8, 9, 10, 11, 12, 13, 14, 15); }
    else return *(const LAS bf16x8*)p;
}
__device__ __forceinline__ f32x4 mma_frag(bf16x8 a, bf16x8 b, f32x4 c) { return __builtin_amdgcn_mfma_f32_16x16x32_bf16(a, b, c, 0, 0, 0); }
__device__ __forceinline__ f32x4 mma_frag(s16x16_t a, s16x16_t b, f32x4 c) {
    const v8i32_t av = __builtin_bit_cast(v8i32_t, a), bv = __builtin_bit_cast(v8i32_t, b);
    asm volatile("v_mfma_scale_f32_16x16x128_f8f6f4 %0, %1, %2, %0, %3, %3 op_sel_hi:[0,0,0]" : "+v"(c) : "v"(av), "v"(bv), "v"(0x7f7f7f7f));
    return c;
}
__device__ __forceinline__ unsigned cvt_pk_bf16(float lo, float hi) { unsigned r; asm volatile("v_cvt_pk_bf16_f32 %0, %1, %2" : "=v"(r) : "v"(lo), "v"(hi)); return r; }

__device__ __forceinline__ bool static_tile(int L, int nM, int nN, int& pm, int& pn) {
    const int nwg = nM * nN; if (L >= nwg) return false;
    int wgid = L; { const int q = nwg / NXCD, r = nwg % NXCD, xcd = wgid % NXCD, off = wgid / NXCD; wgid = (xcd < r ? xcd * (q + 1) : r * (q + 1) + (xcd - r) * q) + off; }
    const int nig = WGM * nN, gid = wgid / nig, fm = gid * WGM, gsz = (nM - fm) < WGM ? (nM - fm) : WGM;
    pm = fm + ((wgid % nig) % gsz); pn = (wgid % nig) / gsz; return true;
}

typedef int v8i32 __attribute__((ext_vector_type(8)));
template <class Epi, class Sched, bool FP8 = false, int PROBE = 0>
__device__ __forceinline__ void gemm_phase(LAS unsigned char* lds, const Sched& S, const Epi& E) {
    typedef typename Sched::UnitT Unit;
    const int wid = S.wave, lane = (int)__builtin_amdgcn_mbcnt_hi(~0u, __builtin_amdgcn_mbcnt_lo(~0u, 0u)), tid = (wid << 6) | lane, wr = wid >> 2, wc = wid & 3, fr = lane & 15, fq = lane >> 4;
    const int K = S.K, nt = K / BK;
    int R[2], C[2];
    unsigned voffB[2];
#pragma unroll
    for (int i = 0; i < 2; ++i) { stage_rc(tid * 16 + i * 8192, R[i], C[i]); const int Rb = (R[i] & ~31) + perm32(R[i] & 31); voffB[i] = (unsigned)(Rb * K + C[i]) * 2u; }
    const unsigned kstep = (unsigned)(BK * 2);
    const unsigned hstepB = (unsigned)HALF * (unsigned)K * 2u;
    const unsigned ldsw = (unsigned)wid * 1024u;
    const int aoff = lds_byte(wr * 64 + fr, fq * 8), boff = lds_byte(wc * 32 + fr, fq * 8);
#define PG8_SA(b, h) (((b) * 2 + (h)) * HTB)
#define PG8_SB(b, h) ((4 + (b) * 2 + (h)) * HTB)
    const __amdgpu_buffer_rsrc_t rA = __builtin_amdgcn_make_buffer_rsrc((void*)S.a_buf(), 0, -1, 0x00020000), rB = __builtin_amdgcn_make_buffer_rsrc((void*)S.b_buf(), 0, -1, 0x00020000);
#define PG8_STAGE2(bufoff, rs, soff, o0, o1) do { \
        __builtin_amdgcn_raw_ptr_buffer_load_lds(rs, (LAS void*)(lds + (bufoff) + ldsw), 16, (int)(o0), (int)(soff), 0, 0); \
        __builtin_amdgcn_raw_ptr_buffer_load_lds(rs, (LAS void*)(lds + (bufoff) + ldsw + 8192), 16, (int)(o1), (int)(soff), 0, 0); } while (0)
#define PG8_STAGEA(bufoff, soff, o0, o1) PG8_STAGE2(bufoff, rA, soff, o0, o1)
#define PG8_STAGEB(bufoff, soff) PG8_STAGE2(bufoff, rB, soff, voffB[0], voffB[1])
    typedef typename pg8::FragSel<FP8>::T FragT;
    constexpr int NK = FP8 ? 1 : 2;
#define PG8_LDA(dst, b, h) do { if constexpr (PROBE == 4) break; _Pragma("unroll") for (int m = 0; m < 4; ++m) _Pragma("unroll") for (int k = 0; k < NK; ++k) dst[m][k] = pg8::ld_frag<FP8>(lds + PG8_SA(b, h) + aoff + m * 2048 + k * 1024); } while (0)
#define PG8_LDB(dst, b, h) do { if constexpr (PROBE == 4) break; _Pragma("unroll") for (int n = 0; n < 2; ++n) _Pragma("unroll") for (int k = 0; k < NK; ++k) dst[n][k] = pg8::ld_frag<FP8>(lds + PG8_SB(b, h) + boff + n * 2048 + k * 1024); } while (0)
#define PG8_MMA(ai, bj, At, Bt) do { if constexpr (PROBE == 3) break; __builtin_amdgcn_s_setprio(1); if constexpr (FP8) asm volatile("s_nop 1"); _Pragma("unroll") for (int m = 0; m < 4; ++m) _Pragma("unroll") for (int n = 0; n < 2; ++n) _Pragma("unroll") for (int k = 0; k < NK; ++k) \
        acc[ai][bj][m][n] = pg8::mma_frag(Bt[n][k], At[m][k], acc[ai][bj][m][n]); __builtin_amdgcn_s_setprio(0); } while (0)
#define PG8_WAIT_V(n) asm volatile("s_waitcnt vmcnt(" #n ")" ::: "memory")
#define PG8_WAIT_L(n) asm volatile("s_waitcnt lgkmcnt(" #n ")" ::: "memory")
#define PG8_BAR __builtin_amdgcn_s_barrier()
#define PG8_SCHED __builtin_amdgcn_sched_barrier(0)
    Unit cur, nxt; int ui = 0;
    if (!S.next(0, cur)) return;
    f32x4 acc[2][2][4][2];
#pragma unroll
    for (int a = 0; a < 2; ++a)
#pragma unroll
        for (int b = 0; b < 2; ++b)
#pragma unroll
            for (int m = 0; m < 4; ++m)
#pragma unroll
                for (int n = 0; n < 2; ++n) { float z0, z1, z2, z3; asm volatile("v_mov_b32 %0, 0\n\tv_mov_b32 %1, 0\n\tv_mov_b32 %2, 0\n\tv_mov_b32 %3, 0" : "=v"(z0), "=v"(z1), "=v"(z2), "=v"(z3)); acc[a][b][m][n] = (f32x4){z0, z1, z2, z3}; }
    FragT At[4][NK], B0[2][NK], B1[2][NK];
    if constexpr (PROBE == 4) { _Pragma("unroll") for (int m = 0; m < 4; ++m) _Pragma("unroll") for (int k = 0; k < NK; ++k) At[m][k] = FragT{}; _Pragma("unroll") for (int n = 0; n < 2; ++n) _Pragma("unroll") for (int k = 0; k < NK; ++k) { B0[n][k] = FragT{}; B1[n][k] = FragT{}; } }
    unsigned ca[4], na[4];
    S.a_offs(cur, R[0], R[1], C[0], C[1], ca);
    unsigned cA = (unsigned)__builtin_amdgcn_readfirstlane((int)S.a_soff(cur)), cB = (unsigned)__builtin_amdgcn_readfirstlane((int)S.b_soff(cur));
    PG8_STAGEB(PG8_SB(0, 0), cB); PG8_STAGEB(PG8_SB(0, 1), cB + hstepB); PG8_STAGEA(PG8_SA(0, 0), cA, ca[0], ca[1]); PG8_STAGEA(PG8_SA(0, 1), cA, ca[2], ca[3]);
    if (wr == 1) PG8_BAR;
    PG8_WAIT_V(2); PG8_BAR;
    PG8_STAGEB(PG8_SB(1, 0), cB + kstep); PG8_STAGEA(PG8_SA(1, 0), cA + kstep, ca[0], ca[1]); PG8_STAGEB(PG8_SB(1, 1), cB + hstepB + kstep);
    PG8_WAIT_V(6); PG8_BAR;
#define PG8_TRIP(a1, a2, b2, a3, b3, x0, x1, x2, x3) do { \
            PG8_LDB(B0, 0, 0); PG8_LDB(B1, 0, 1); PG8_SCHED; PG8_LDA(At, 0, 0); PG8_STAGEA(PG8_SA(1, 1), a1, ca[2], ca[3]); \
            PG8_WAIT_V(8); PG8_WAIT_L(0); PG8_BAR; PG8_MMA(0, 0, At, B0); PG8_MMA(0, 1, At, B1); PG8_BAR; PG8_SCHED; \
            PG8_LDA(At, 0, 1); PG8_STAGEB(PG8_SB(0, 0), b2); PG8_STAGEB(PG8_SB(0, 1), (b2) + hstepB); PG8_STAGEA(PG8_SA(0, 0), a2, x0, x1); \
            PG8_WAIT_V(8); PG8_WAIT_L(0); PG8_BAR; if constexpr (PROBE != 1) { PG8_MMA(1, 0, At, B0); PG8_MMA(1, 1, At, B1); } PG8_BAR; PG8_SCHED; \
            PG8_LDB(B0, 1, 0); PG8_LDB(B1, 1, 1); PG8_SCHED; PG8_LDA(At, 1, 0); PG8_STAGEA(PG8_SA(0, 1), a2, x2, x3); \
            PG8_WAIT_V(8); PG8_WAIT_L(0); PG8_BAR; PG8_MMA(0, 0, At, B0); PG8_MMA(0, 1, At, B1); PG8_BAR; PG8_SCHED; \
            PG8_LDA(At, 1, 1); PG8_STAGEB(PG8_SB(1, 0), b3); PG8_STAGEB(PG8_SB(1, 1), (b3) + hstepB); PG8_STAGEA(PG8_SA(1, 0), a3, x0, x1); \
            PG8_WAIT_V(8); PG8_WAIT_L(0); PG8_BAR; if constexpr (PROBE != 1) { PG8_MMA(1, 0, At, B0); PG8_MMA(1, 1, At, B1); } PG8_BAR; PG8_SCHED; } while (0)
    for (;;) {
        const bool has_next = S.next(ui + 1, nxt);
        unsigned nA = cA, nB = cB;
#pragma unroll
        for (int i = 0; i < 4; ++i) na[i] = ca[i];
        if (has_next) { nA = (unsigned)__builtin_amdgcn_readfirstlane((int)S.a_soff(nxt)); nB = (unsigned)__builtin_amdgcn_readfirstlane((int)S.b_soff(nxt)); S.a_offs(nxt, R[0], R[1], C[0], C[1], na); }
        for (int t = 0; t < nt; t += 2) {
            const bool last = (t == nt - 2);
            const unsigned a1 = cA + (unsigned)(t + 1) * kstep;
            const unsigned a2 = last ? nA : cA + (unsigned)(t + 2) * kstep, b2 = last ? nB : cB + (unsigned)(t + 2) * kstep;
            const unsigned x0 = last ? na[0] : ca[0], x1 = last ? na[1] : ca[1], x2 = last ? na[2] : ca[2], x3 = last ? na[3] : ca[3];
            PG8_TRIP(a1, a2, b2, a2 + kstep, b2 + kstep, x0, x1, x2, x3);
        }
        if (wr == 0) PG8_BAR;
        if constexpr (FP8) asm volatile("s_nop 15\n\ts_nop 15" ::: "memory");
        E(acc, cur, wr, wc, fr, fq);
        if (!has_next) break;
#pragma unroll
        for (int a = 0; a < 2; ++a)
#pragma unroll
            for (int b = 0; b < 2; ++b)
#pragma unroll
                for (int m = 0; m < 4; ++m)
#pragma unroll
                    for (int n = 0; n < 2; ++n) { float z0, z1, z2, z3; asm volatile("v_mov_b32 %0, 0\n\tv_mov_b32 %1, 0\n\tv_mov_b32 %2, 0\n\tv_mov_b32 %3, 0" : "=v"(z0), "=v"(z1), "=v"(z2), "=v"(z3)); acc[a][b][m][n] = (f32x4){z0, z1, z2, z3}; }
        cur = nxt; cA = nA; cB = nB; ++ui;
#pragma unroll
        for (int i = 0; i < 4; ++i) ca[i] = na[i];
        if (wr == 1) PG8_BAR;
    }
    PG8_WAIT_V(0);
    PG8_BAR;
#undef PG8_SA
#undef PG8_SB
#undef PG8_TRIP
#undef PG8_STAGE2
#undef PG8_STAGEA
#undef PG8_STAGEB
#undef PG8_LDA
#undef PG8_LDB
#undef PG8_MMA
#undef PG8_WAIT_V
#undef PG8_WAIT_L
#undef PG8_BAR
#undef PG8_SCHED
}
}

struct DenseUnit { int pm, pn; };
struct DenseSched {
    typedef DenseUnit UnitT;
    const bf16_t* A; const bf16_t* Bt; int lda; int K; int nM, nN, G, c, wave;
    __device__ __forceinline__ bool next(int i, DenseUnit& u) const { return pg8::static_tile(i * G + c, nM, nN, u.pm, u.pn); }
    __device__ __forceinline__ const void* a_buf() const { return A; }
    __device__ __forceinline__ const void* b_buf() const { return Bt; }
    __device__ __forceinline__ unsigned a_soff(const DenseUnit& u) const { return (unsigned)u.pm * 256u * (unsigned)lda * 2u; }
    __device__ __forceinline__ unsigned b_soff(const DenseUnit& u) const { return (unsigned)u.pn * 256u * (unsigned)K * 2u; }
    __device__ __forceinline__ void a_offs(const DenseUnit&, int R0, int R1, int C0, int C1, unsigned (&o)[4]) const {
        o[0] = (unsigned)(R0 * lda + C0) * 2u; o[1] = (unsigned)(R1 * lda + C1) * 2u; o[2] = (unsigned)((R0 + 128) * lda + C0) * 2u; o[3] = (unsigned)((R1 + 128) * lda + C1) * 2u;
    }
};
struct MkArgs {
    const float* x; const float* c; const int* positions; const float* w_ada; const float* b_ada;
    const float* g_pre_mix; const float* g_post_mix; const float* g_pre_ffn; const float* g_post_ffn;
    const float* w_in; const float* b_in; const float* conv_qk; const float* sinks; const float* g_mlstm;
    const float* w_attn_proj; const float* w_mlstm_proj; const float* w_out; const float* w_router; const float* b_router;
    const float* w_gate_up; const float* b_gate_up; const float* w_down; const float* b_down;
    float* out; unsigned char* ws;
    const int* route_i; const float* route_w;
    int ph_lo, ph_hi;
};

struct Frame {
    LAS unsigned char* lds;
    int G, bid, vcu, wave;
};
__device__ __forceinline__ int lane_id() { return (int)__builtin_amdgcn_mbcnt_hi(~0u, __builtin_amdgcn_mbcnt_lo(~0u, 0u)); }
__device__ __forceinline__ int fresh_tid(const Frame& F) { return (F.wave << 6) | lane_id(); }

__device__ __forceinline__ float wave_sum_f(float v) {
#pragma unroll
    for (int o = 1; o < 64; o <<= 1) v += __shfl_xor(v, o);
    return v;
}
__device__ __forceinline__ float wave_max_f(float v) {
#pragma unroll
    for (int o = 1; o < 64; o <<= 1) v = fmaxf(v, __shfl_xor(v, o));
    return v;
}

__device__ __forceinline__ int in_src_col(int n) {
    if (n < 1152) { const int d = n & 63; if (d < 16) return (n & ~63) + (d >> 1) + 8 * (d & 1); return n; }
    if (n < 4352) return n;
    return n + 8;
}

template <bool MAP>
__device__ __forceinline__ void p0_transpose_item(const float* __restrict__ W, int K, int N, bf16_t* WT, LAS float* scr, int kb, int nb, int lane) {
    const int k0 = 64 * kb, n0 = 32 * nb;
    const int sc = MAP ? in_src_col(n0 + (lane & 31)) : n0 + (lane & 31);
#pragma unroll 8
    for (int i = 0; i < 32; ++i) { const int kk = 2 * i + (lane >> 5); scr[kk * 33 + (lane & 31)] = W[(size_t)(k0 + kk) * N + sc]; }
    LDS_WAIT(); asm volatile("" ::: "memory");
    const int c = lane & 7;
#pragma unroll
    for (int j = 0; j < 4; ++j) { const int n = (lane >> 3) + 8 * j; const LAS float* s = scr + (8 * c) * 33 + n;
        u32x4 o; o.x = pk2(s[0 * 33], s[1 * 33]); o.y = pk2(s[2 * 33], s[3 * 33]); o.z = pk2(s[4 * 33], s[5 * 33]); o.w = pk2(s[6 * 33], s[7 * 33]);
        *(u32x4*)(WT + (size_t)(n0 + n) * K + k0 + 8 * c) = o; }
    LDS_WAIT(); asm volatile("" ::: "memory");
}

struct ConvItem { const float* src; unsigned char* dst; };
__device__ __forceinline__ ConvItem conv_item_addr(const MkArgs& a, int it, int lane, int& N) {
    constexpr int KB = 2048 / 128, I_GU = KB * (4096 / 32), I_DN = KB * (2048 / 32);
    const float* W; unsigned char* WT; int q, NB;
    if (it < NE * I_GU) { const int e = it / I_GU; q = it % I_GU; N = 4096; NB = 128; W = a.w_gate_up + (size_t)e * 2048 * 4096; WT = a.ws + wsf::WGU8 + (size_t)e * 4096 * 2048; }
    else { const int r = it - NE * I_GU, e = r / I_DN; q = r % I_DN; N = 2048; NB = 64; W = a.w_down + (size_t)e * 2048 * 2048; WT = a.ws + wsf::WDN8 + (size_t)e * 2048 * 2048; }
    const int k0 = 128 * (q / NB), n0 = 32 * (q % NB);
    ConvItem c; c.src = W + (size_t)(k0 + (lane >> 3)) * N + n0 + (lane & 7) * 4; c.dst = WT + (size_t)(n0 + (lane >> 3)) * 2048 + k0 + 16 * (lane & 7);
    return c;
}
__device__ __forceinline__ void conv_item_load(const ConvItem& c, int N, f32x4 (&v)[16]) {
#pragma unroll
    for (int i = 0; i < 16; ++i) v[i] = __builtin_nontemporal_load((const f32x4*)(c.src + (size_t)(8 * i) * N));
}
__device__ __forceinline__ void conv_item_store(const ConvItem& c, const f32x4 (&v)[16], LAS float* scr, int lane, bool dry = false) {
    const int kr = lane >> 3, n4 = (lane & 7) * 4;
#pragma unroll
    for (int i = 0; i < 16; ++i) { const int k = 8 * i + kr, rot = 20 * (i >> 1); LAS float* row = scr + k * 33;
        row[(n4 + 0 + rot) & 31] = v[i].x; row[(n4 + 1 + rot) & 31] = v[i].y; row[(n4 + 2 + rot) & 31] = v[i].z; row[(n4 + 3 + rot) & 31] = v[i].w; }
    LDS_WAIT(); asm volatile("" ::: "memory");
    const int cblk = lane & 7;
#pragma unroll
    for (int j = 0; j < 4; ++j) {
        const int n = (lane >> 3) + 8 * j;
        const LAS float* sp = scr + (16 * cblk) * 33 + ((n + 20 * cblk) & 31);
        u32x4 o;
        o.x = pk4_fp8(sp[0 * 33] * W8SCALE, sp[1 * 33] * W8SCALE, sp[2 * 33] * W8SCALE, sp[3 * 33] * W8SCALE);
        o.y = pk4_fp8(sp[4 * 33] * W8SCALE, sp[5 * 33] * W8SCALE, sp[6 * 33] * W8SCALE, sp[7 * 33] * W8SCALE);
        o.z = pk4_fp8(sp[8 * 33] * W8SCALE, sp[9 * 33] * W8SCALE, sp[10 * 33] * W8SCALE, sp[11 * 33] * W8SCALE);
        o.w = pk4_fp8(sp[12 * 33] * W8SCALE, sp[13 * 33] * W8SCALE, sp[14 * 33] * W8SCALE, sp[15 * 33] * W8SCALE);
        if (!dry) *(u32x4*)(c.dst + (size_t)(8 * j) * 2048) = o; else asm volatile("" :: "v"(o.x), "v"(o.y), "v"(o.z), "v"(o.w));
    }
    LDS_WAIT(); asm volatile("" ::: "memory");
}
__device__ __forceinline__ void moe_convert(const MkArgs& a, Frame& F, int widx, int nw, bool dry = false, int it0 = 0, int it1 = -1) {
    const int lane = lane_id();
    LAS float* scr = (LAS float*)(F.lds + F.wave * 16896);
    constexpr int NIT_ALL = NE * ((2048 / 128) * (4096 / 32) + (2048 / 128) * (2048 / 32));
    const int NIT = it1 < 0 ? NIT_ALL : it1;
    widx += it0;
    if (widx >= NIT) return;
    f32x4 va[16], vb[16]; int Na, Nb;
    ConvItem ca = conv_item_addr(a, widx, lane, Na), cb;
    conv_item_load(ca, Na, va);
    for (int it = widx; it < NIT; it += 2 * nw) {
        const int i1 = it + nw, i2 = it + 2 * nw;
        cb = conv_item_addr(a, i1 < NIT ? i1 : NIT - 1, lane, Nb); conv_item_load(cb, Nb, vb);
        conv_item_store(ca, va, scr, lane, dry);
        if (i1 >= NIT) break;
        ca = conv_item_addr(a, i2 < NIT ? i2 : NIT - 1, lane, Na); conv_item_load(ca, Na, va);
        conv_item_store(cb, vb, scr, lane, dry);
    }
}
__device__ __forceinline__ int n_conv_wgs(int G) { return G == 256 ? CONV_WGS : 0; }

struct TrItem { const float* src; bf16_t* dst; int N, perm; };
__device__ __forceinline__ TrItem tr_item_addr(const MkArgs& a, int it, int lane) {
    constexpr int I_IN = 32 * (fp::NIN / 32), I_AP = 16 * 64, I_MP = 16 * 64;
    const float* W; bf16_t* WT; int K, N, nblk, r = it, perm = 0, shift = 0;
    unsigned char* ws = a.ws;
    if (r < I_IN) { W = a.w_in; WT = (bf16_t*)(ws + wsf::WIN_T); K = 2048; N = INW; nblk = fp::NIN / 32; }
    else if ((r -= I_IN) < I_AP) { W = a.w_attn_proj; WT = (bf16_t*)(ws + wsf::WAP_T); K = 1024; N = 2048; nblk = 64; }
    else if ((r -= I_AP) < I_MP) { W = a.w_mlstm_proj; WT = (bf16_t*)(ws + wsf::WMP_T); K = 1024; N = 2048; nblk = 64; }
    else { r -= I_MP; W = a.w_out; WT = (bf16_t*)(ws + wsf::WOUT_T); K = 2048; N = 2048; nblk = 64; }
    const int kb = r / nblk, nb = r % nblk, k0 = 64 * kb, n0 = 32 * nb;
    if (it < I_IN) { perm = (n0 < 1152 && (n0 & 32) == 0) ? 1 : 0; shift = n0 >= 4352 ? 8 : 0; }
    TrItem t; t.src = W + (size_t)(k0 + (lane >> 3)) * N + n0 + shift + (lane & 7) * 4; t.dst = WT + (size_t)(n0 + (lane >> 3)) * K + k0 + 8 * (lane & 7); t.N = N; t.perm = perm | (K << 1);
    return t;
}
__device__ __forceinline__ void tr_item_load(const TrItem& t, f32x4 (&v)[8]) {
#pragma unroll
    for (int i = 0; i < 8; ++i) v[i] = *(const f32x4*)(t.src + (size_t)(8 * i) * t.N);
}
__device__ __forceinline__ void tr_item_store(const TrItem& t, const f32x4 (&v)[8], LAS float* scr, int lane) {
    const int kr = lane >> 3, n4 = (lane & 7) * 4, K = t.perm >> 1;
#pragma unroll
    for (int i = 0; i < 8; ++i) { const int k = 8 * i + kr, rot = 4 * (i >> 2); LAS float* row = scr + k * 33 + ((n4 + rot) & 31);
        row[0] = v[i].x; row[1] = v[i].y; row[2] = v[i].z; row[3] = v[i].w; }
    LDS_WAIT(); asm volatile("" ::: "memory");
    const int cb = lane & 7;
#pragma unroll
    for (int j = 0; j < 4; ++j) {
        const int n = (lane >> 3) + 8 * j;
        int c = n; if ((t.perm & 1) && n < 16) c = (n >> 1) + 8 * (n & 1);
        const LAS float* sp = scr + (8 * cb) * 33 + ((c + 4 * (cb >> 2)) & 31);
        u32x4 o; o.x = pk2(sp[0 * 33], sp[1 * 33]); o.y = pk2(sp[2 * 33], sp[3 * 33]); o.z = pk2(sp[4 * 33], sp[5 * 33]); o.w = pk2(sp[6 * 33], sp[7 * 33]);
        *(u32x4*)(t.dst + (size_t)(8 * j) * K) = o;
    }
    LDS_WAIT(); asm volatile("" ::: "memory");
}

__device__ __forceinline__ void ada_gemv(const MkArgs& a, Frame& F, int blk_lo, int blk_hi) {
    const int f_tid = fresh_tid(F), f_lane = f_tid & 63, f_wave = F.wave;
    LAS float* sc = (LAS float*)F.lds;
    LAS float* red = sc + 4096;
    if (blk_lo + F.vcu >= blk_hi) return;
    for (int i = f_tid; i < 2 * D; i += fp::NT) sc[i] = silu_f(a.c[i]);
    __syncthreads();
    for (int cblk = blk_lo + F.vcu; cblk < blk_hi; cblk += F.G) {
        const float* wp = a.w_ada + (size_t)(f_wave * 256) * MODW + cblk * 64 + f_lane;
        float a0 = 0.f, a1 = 0.f;
#pragma unroll 32
        for (int k = 0; k < 256; ++k) { const float w = wp[(size_t)k * MODW]; a0 += w * sc[f_wave * 256 + k]; a1 += w * sc[2048 + f_wave * 256 + k]; }
        red[(f_wave * 2 + 0) * 64 + f_lane] = a0; red[(f_wave * 2 + 1) * 64 + f_lane] = a1;
        __syncthreads();
        if (f_tid < 128) { const int b = f_tid >> 6, j = f_tid & 63; float sum = a.b_ada[cblk * 64 + j];
#pragma unroll
          for (int w8 = 0; w8 < 8; ++w8) sum += red[(w8 * 2 + b) * 64 + j];
          ((float*)(a.ws + wsf::MOD))[b * MODW + cblk * 64 + j] = sum; }
        __syncthreads();
    }
}

__device__ __forceinline__ void phase0(const MkArgs& a, Frame& F, int parts = 7) {
    const int f_tid = fresh_tid(F), f_lane = f_tid & 63, f_wave = F.wave;
    unsigned char* ws = a.ws;
    const int gw = F.vcu * fp::NW + f_wave, NGW = F.G * fp::NW;
    if (parts & 1) {
        LAS float* scr = (LAS float*)(F.lds + f_wave * 8448);
        constexpr int NITEMS = 32 * (fp::NIN / 32) + 16 * 64 + 16 * 64 + 32 * 64;
        if (gw < NITEMS) {
            f32x4 va[8], vb[8];
            TrItem ta = tr_item_addr(a, gw, f_lane), tb;
            tr_item_load(ta, va);
            for (int it = gw; it < NITEMS; it += 2 * NGW) {
                const int i1 = it + NGW, i2 = it + 2 * NGW;
                tb = tr_item_addr(a, i1 < NITEMS ? i1 : NITEMS - 1, f_lane); tr_item_load(tb, vb);
                tr_item_store(ta, va, scr, f_lane);
                if (i1 >= NITEMS) break;
                ta = tr_item_addr(a, i2 < NITEMS ? i2 : NITEMS - 1, f_lane); tr_item_load(ta, va);
                tr_item_store(tb, vb, scr, f_lane);
            }
        }
    }
#if MOE_FP8
    __syncthreads();
    if (n_conv_wgs(F.G) == 0) moe_convert(a, F, gw, NGW);
#if DRY_PROBE
    moe_convert(a, F, gw, NGW, true);
#endif
#endif
    __syncthreads();
    if (parts & 2) ada_gemv(a, F, 0, 4096 / 64);
    if (!(parts & 4)) return;
    const int gt = F.vcu * fp::NT + f_tid, NGT = F.G * fp::NT;
    for (int i = gt; i < NTOK * 8; i += NGT) { float cs, sn; rope_cs(a.positions[i >> 3], i & 7, cs, sn); ((f32x2*)(ws + wsf::CS))[i] = (f32x2){cs, sn}; }
    for (int i = gt; i < fp::NIN; i += NGT) ((float*)(ws + wsf::BINP))[i] = a.b_in[in_src_col(i)];
    for (int i = gt; i < 32 * 2048; i += NGT) {
        const int e = i >> 11, k = i & 2047; const float w = a.w_router[k * 32 + e]; const unsigned hi = f2bf(w); const float rem = w - __builtin_bit_cast(float, hi << 16);
        ((bf16_t*)(ws + wsf::WRT))[i] = (bf16_t)hi; ((bf16_t*)(ws + wsf::WRT))[32 * 2048 + i] = (bf16_t)f2bf(rem);
    }
}

__device__ __forceinline__ void phase1(const MkArgs& a, Frame& F) {
    const int f_tid = fresh_tid(F), f_lane = f_tid & 63, f_wave = F.wave;
    unsigned char* ws = a.ws;
    const float* mod = (const float*)(ws + wsf::MOD);
    LAS float* lmod = (LAS float*)F.lds;
    LAS float* wg = (LAS float*)(F.lds + 32768);
    for (int i = f_tid; i < 2048 * 8; i += fp::NT) wg[(i & 7) * 2048 + (i >> 3)] = a.w_in[(size_t)(i >> 3) * INW + OFF_MI + (i & 7)];
    for (int blk = F.vcu; blk < NTOK / 64; blk += F.G) {
        const int b = (blk * 64) / S;
        __syncthreads();
        for (int i = f_tid; i < 4096; i += fp::NT) lmod[i] = mod[b * MODW + i];
        __syncthreads();
#pragma unroll 1
        for (int rr = 0; rr < 8; ++rr) {
            const int m = blk * 64 + f_wave * 8 + rr;
            const GAS f32x4* xr = (const GAS f32x4*)(a.x + (size_t)m * D);
            f32x4 xv[8]; float ss = 0.f;
#pragma unroll
            for (int j = 0; j < 8; ++j) { xv[j] = xr[64 * j + f_lane]; ss += (xv[j].x * xv[j].x + xv[j].y * xv[j].y) + (xv[j].z * xv[j].z + xv[j].w * xv[j].w); }
            const float r = rsqrtf(wave_sum_f(ss) * (1.f / D) + EPS);
            float g8[8];
#pragma unroll
            for (int e = 0; e < 8; ++e) g8[e] = 0.f;
            GAS u32x2* o8 = (GAS u32x2*)(ws + wsf::H1 + (size_t)m * D * 2);
#pragma unroll
            for (int j = 0; j < 8; ++j) {
                const int c0 = 4 * (64 * j + f_lane);
                const f32x4 v = xv[j];
                const f32x4 g = *(const f32x4*)(a.g_pre_mix + c0);
                const f32x4 sh = *(const LAS f32x4*)(lmod + c0), sc = *(const LAS f32x4*)(lmod + 2048 + c0);
                f32x4 h;
                h.x = v.x * r * g.x * (1.f + sc.x) + sh.x; h.y = v.y * r * g.y * (1.f + sc.y) + sh.y;
                h.z = v.z * r * g.z * (1.f + sc.z) + sh.z; h.w = v.w * r * g.w * (1.f + sc.w) + sh.w;
                o8[64 * j + f_lane] = (u32x2){pg8::cvt_pk_bf16(h.x, h.y), pg8::cvt_pk_bf16(h.z, h.w)};
#pragma unroll
                for (int e = 0; e < 8; ++e) { const f32x4 w = *(const LAS f32x4*)(wg + e * 2048 + c0); g8[e] += (h.x * w.x + h.y * w.y) + (h.z * w.z + h.w * w.w); }
            }
            float mine = 0.f;
#pragma unroll
            for (int e = 0; e < 8; ++e) { const float s8 = wave_sum_f(g8[e]); if (f_lane == e) mine = s8; }
            if (f_lane < 8) ((float*)(ws + wsf::GATES))[(size_t)m * 8 + f_lane] = mine + a.b_in[OFF_MI + f_lane];
        }
    }
}

struct EpiIn {
    bf16_t* O; const float* bias; const f32x2* cs;
    __device__ __forceinline__ void operator()(const f32x4 (&acc)[2][2][4][2], const DenseUnit& u, int wr, int wc, int fr, int fq) const {
        const int row0 = u.pm * 256 + wr * 64 + fr, col0 = u.pn * 256 + wc * 32 + 8 * fq;
        const int pn = u.pn;
        const bool ropelane = ((wc & 1) == 0) && fq < 2;
        const int i0 = fq * 4;
        f32x4 bv[2][2];
#pragma unroll
        for (int bj = 0; bj < 2; ++bj)
#pragma unroll
            for (int n = 0; n < 2; ++n) bv[bj][n] = *(const f32x4*)(bias + col0 + bj * 128 + 4 * n);
#pragma unroll
        for (int ai = 0; ai < 2; ++ai)
#pragma unroll
            for (int m = 0; m < 4; ++m) {
                const int row = row0 + ai * 128 + m * 16;
                bf16_t* rowp = O + (size_t)row * fp::NIN + col0;
#pragma unroll
                for (int bj = 0; bj < 2; ++bj) {
                    f32x4 v0 = acc[ai][bj][m][0] + bv[bj][0], v1 = acc[ai][bj][m][1] + bv[bj][1];
                    if (pn < 4 || (pn == 4 && bj == 0)) {
                        if (ropelane) {
                            const f32x4 ca = *(const f32x4*)(cs + (size_t)row * 8 + i0), cb = *(const f32x4*)(cs + (size_t)row * 8 + i0 + 2);
                            f32x4 r0, r1;
                            r0.x = v0.x * ca.x - v0.y * ca.y; r0.y = v0.y * ca.x + v0.x * ca.y;
                            r0.z = v0.z * ca.z - v0.w * ca.w; r0.w = v0.w * ca.z + v0.z * ca.w;
                            r1.x = v1.x * cb.x - v1.y * cb.y; r1.y = v1.y * cb.x + v1.x * cb.y;
                            r1.z = v1.z * cb.z - v1.w * cb.w; r1.w = v1.w * cb.z + v1.z * cb.w;
                            v0 = r0; v1 = r1;
                        }
                        if (pn < 4) { v0 = v0 * fp::QSCALE; v1 = v1 * fp::QSCALE; }
                    } else if (pn >= 13) {
#pragma unroll
                        for (int q = 0; q < 4; ++q) { v0[q] = fast_sigmoid(v0[q]); v1[q] = fast_sigmoid(v1[q]); }
                    }
                    u32x4 w; w.x = pg8::cvt_pk_bf16(v0[0], v0[1]); w.y = pg8::cvt_pk_bf16(v0[2], v0[3]); w.z = pg8::cvt_pk_bf16(v1[0], v1[1]); w.w = pg8::cvt_pk_bf16(v1[2], v1[3]);
                    *(u32x4*)(rowp + bj * 128) = w;
                }
            }
    }
};

__device__ __forceinline__ void phase2(const MkArgs& a, Frame& F) {
    const int f_tid = fresh_tid(F), f_lane = f_tid & 63, f_wave = F.wave;
    unsigned char* ws = a.ws;
#if MOE_FP8
    const int ncv = n_conv_wgs(F.G), Gg = F.G - ncv;
    constexpr int NIT_ALL = NE * ((2048 / 128) * (4096 / 32) + (2048 / 128) * (2048 / 32));
    const int nsplit = ncv > 0 ? (int)((long)NIT_ALL * CONV_SPLIT / 1024) : NIT_ALL;
    if (F.bid >= Gg) { moe_convert(a, F, (F.bid - Gg) * fp::NW + F.wave, ncv * fp::NW, false, 0, nsplit);
#if DRY_PROBE == 2
        moe_convert(a, F, (F.bid - Gg) * fp::NW + F.wave, ncv * fp::NW, true);
#endif
        return; }
#else
    const int Gg = F.G;
#endif
    DenseSched S{(const bf16_t*)(ws + wsf::H1), (const bf16_t*)(ws + wsf::WIN_T), 2048, 2048, NTOK / 256, fp::NIN / 256, Gg, F.bid, F.wave};
    EpiIn E{(bf16_t*)(ws + wsf::PROJB), (const float*)(ws + wsf::BINP), (const f32x2*)(ws + wsf::CS)};
    pg8::gemm_phase<EpiIn, DenseSched>(F.lds, S, E);
#if MOE_FP8
    if (ncv > 0 && nsplit < NIT_ALL) { __syncthreads(); moe_convert(a, F, F.bid * fp::NW + F.wave, Gg * fp::NW, false, nsplit, NIT_ALL); }
#endif
}
__device__ __forceinline__ f32x4 mfma16(bf16x8 a, bf16x8 b, f32x4 c) { return __builtin_amdgcn_mfma_f32_16x16x32_bf16(a, b, c, 0, 0, 0); }
__device__ __forceinline__ float exp2_fast(float x) { return __builtin_amdgcn_exp2f(x); }
typedef short v4i16_t __attribute__((ext_vector_type(4)));
__device__ __forceinline__ bf16x8 tr_frag(const LAS bf16_t* base, int stride, int lane) {
    const LAS bf16_t* p = base + (8 * (lane >> 4) + ((lane & 15) >> 2)) * stride + 4 * (lane & 3);
    const v4i16_t lo = __builtin_amdgcn_ds_read_tr16_b64_v4i16((LAS v4i16_t*)p), hi = __builtin_amdgcn_ds_read_tr16_b64_v4i16((LAS v4i16_t*)(p + 4 * stride));
    return __builtin_shufflevector(lo, hi, 0, 1, 2, 3, 4, 5, 6, 7);
}

__device__ __forceinline__ void attn_unit(const MkArgs& a, Frame& F, int unit) {
    const int f_tid = fresh_tid(F), f_lane = f_tid & 63, f_wave = F.wave;
    const int b = unit >> 7, hk = (unit >> 6) & 1, n = unit & 63;
    const bf16_t* PB = (const bf16_t*)(a.ws + wsf::PROJB);
    bf16_t* OA = (bf16_t*)(a.ws + wsf::OAT);
    const size_t tok0 = (size_t)b * S + (size_t)n * 128;
    LAS bf16_t* Ks = (LAS bf16_t*)F.lds;
    LAS bf16_t* Vs = (LAS bf16_t*)(F.lds + 36864);
    LAS bf16_t* Pw = (LAS bf16_t*)(F.lds + 36864 + 39168 + f_wave * 5376);
#pragma unroll
    for (int i = 0; i < 4; ++i) {
        const int q = f_tid + 512 * i, row = q >> 3, ch = q & 7;
        u32x4 kv = (u32x4){0u, 0u, 0u, 0u}, vv = kv;
        if (n > 0 || row >= 128) {
            const bf16_t* src = PB + (tok0 - 128 + row) * fp::NIN + hk * 64 + ch * 8;
            kv = *(const u32x4*)(src + fp::PB_K); vv = *(const u32x4*)(src + fp::PB_V);
        }
        *(LAS u32x4*)(Ks + row * 72 + ch * 8) = kv;
        *(LAS u32x4*)(Vs + row * 72 + ch * 8) = vv;
    }
    if (f_tid < 128) *(LAS u32x4*)(Vs + (256 + (f_tid >> 3)) * 72 + (f_tid & 7) * 8) = (u32x4){0u, 0u, 0u, 0u};
    __syncthreads();
    const int c16 = f_lane & 15, grp = f_lane >> 4, h = hk * 8 + f_wave;
    const float sink2 = a.sinks[h] * fp::LOG2E;
    bf16x8 qn[2];
#pragma unroll
    for (int ks = 0; ks < 2; ++ks) qn[ks] = *(const bf16x8*)(PB + (tok0 + c16) * fp::NIN + fp::PB_Q + h * 64 + ks * 32 + grp * 8);
#pragma unroll 1
    for (int tt = 0; tt < 8; ++tt) {
        const size_t qtok = tok0 + tt * 16 + c16;
        bf16x8 qf[2];
        { const size_t ntok = tok0 + (tt < 7 ? tt + 1 : 7) * 16 + c16;
#pragma unroll
          for (int ks = 0; ks < 2; ++ks) { qf[ks] = qn[ks]; qn[ks] = *(const bf16x8*)(PB + ntok * fp::NIN + fp::PB_Q + h * 64 + ks * 32 + grp * 8); } }
        f32x4 sacc[9];
#pragma unroll
        for (int jq = 0; jq < 9; ++jq) {
            sacc[jq] = (f32x4){0.f, 0.f, 0.f, 0.f};
#pragma unroll
            for (int ks = 0; ks < 2; ++ks) { const bf16x8 kf = *(const LAS bf16x8*)(Ks + (16 * (tt + jq) + c16) * 72 + ks * 32 + grp * 8); sacc[jq] = mfma16(kf, qf[ks], sacc[jq]); }
        }
        float mx = sink2;
#pragma unroll
        for (int jq = 0; jq < 9; ++jq)
#pragma unroll
            for (int r = 0; r < 4; ++r) {
                const int diff = 128 + c16 - 16 * jq - 4 * grp - r, jrel = 16 * (tt + jq) + 4 * grp + r;
                const bool ok = diff >= 0 && diff < 128 && (n > 0 || jrel >= 128);
                sacc[jq][r] = ok ? sacc[jq][r] : -INFINITY;
                mx = fmaxf(mx, sacc[jq][r]);
            }
        mx = fmaxf(mx, __shfl_xor(mx, 16)); mx = fmaxf(mx, __shfl_xor(mx, 32));
        float ls = 0.f;
#pragma unroll
        for (int jq = 0; jq < 9; ++jq) {
            float p[4];
#pragma unroll
            for (int r = 0; r < 4; ++r) { p[r] = exp2_fast(sacc[jq][r] - mx); ls += p[r]; }
            *(LAS u32x2*)(Pw + c16 * 168 + 16 * jq + 4 * grp) = (u32x2){pk2(p[0], p[1]), pk2(p[2], p[3])};
        }
        *(LAS u32x2*)(Pw + c16 * 168 + 144 + 4 * grp) = (u32x2){0u, 0u};
        ls += __shfl_xor(ls, 16); ls += __shfl_xor(ls, 32);
        ls += exp2_fast(sink2 - mx);
        const float inv = 1.f / ls;
        LDS_WAIT();
        f32x4 oacc[4];
#pragma unroll
        for (int dt = 0; dt < 4; ++dt) oacc[dt] = (f32x4){0.f, 0.f, 0.f, 0.f};
#pragma unroll
        for (int k2 = 0; k2 < 5; ++k2) {
            const bf16x8 pb = *(const LAS bf16x8*)(Pw + c16 * 168 + 32 * k2 + 8 * grp);
#pragma unroll
            for (int dt = 0; dt < 4; ++dt) { const bf16x8 va = tr_frag(Vs + (16 * tt + 32 * k2) * 72 + 16 * dt, 72, f_lane); oacc[dt] = mfma16(va, pb, oacc[dt]); }
        }
#pragma unroll
        for (int dt = 0; dt < 4; ++dt)
            *(u32x2*)(OA + qtok * 1024 + h * 64 + 16 * dt + 4 * grp) = (u32x2){pk2(oacc[dt][0] * inv, oacc[dt][1] * inv), pk2(oacc[dt][2] * inv, oacc[dt][3] * inv)};
        LDS_WAIT();
    }
    __syncthreads();
}

__device__ __forceinline__ void unpack8(const u32x4 v, float (&f)[8]) {
    f[0] = bflo(v.x); f[1] = bfhi(v.x); f[2] = bflo(v.y); f[3] = bfhi(v.y); f[4] = bflo(v.z); f[5] = bfhi(v.z); f[6] = bflo(v.w); f[7] = bfhi(v.w);
}
__device__ __forceinline__ void stage_vt(const bf16_t* PB, size_t tok0, int col0, LAS bf16_t* Vs, int tid) {
#pragma unroll
    for (int i = 0; i < 8; ++i) {
        const int q = tid + 512 * i, row = q >> 5, ch = q & 31;
        *(LAS u32x4*)(Vs + row * 272 + ch * 8) = *(const u32x4*)(PB + (tok0 + row) * fp::NIN + col0 + ch * 8);
    }
}

__device__ __forceinline__ void m1_unit(const MkArgs& a, Frame& F, int u) {
    const int f_tid = fresh_tid(F), f_lane = f_tid & 63, f_wave = F.wave;
    const int bh = u >> 6, c = u & 63, b = bh >> 2, h = bh & 3;
    const size_t tok0 = (size_t)b * S + (size_t)c * 128;
    unsigned char* ws = a.ws;
    const bf16_t* PB = (const bf16_t*)(ws + wsf::PROJB);
    LAS bf16_t* Kw = (LAS bf16_t*)F.lds;
    LAS bf16_t* Vt = (LAS bf16_t*)(F.lds + 34816);
    LAS float* gl = (LAS float*)(F.lds + 34816 + 69632);
    const float* GT = (const float*)(ws + wsf::GATES);
    const int tid = f_tid;
    LAS bf16_t* Raw = Vt;
    float gi = 0.f, gf = 0.f;
    if (tid < 128) { gi = GT[(tok0 + tid) * 8 + h]; gf = GT[(tok0 + tid) * 8 + 4 + h]; }
    u32x4 rawv[9];
#pragma unroll
    for (int i = 0; i < 9; ++i) {
        const int q = tid + 512 * i, row = (q >> 5) < 131 ? (q >> 5) : 130, ch = q & 31;
        const int back = (c * 128 + row - 3 >= 0) ? 3 - row : 0;
        rawv[i] = *(const u32x4*)(PB + (size_t)((long)tok0 - back) * fp::NIN + (ch < 16 ? fp::PB_MQ + h * 128 + ch * 8 : fp::PB_MK + h * 128 + (ch - 16) * 8));
    }
    u32x4 vreg[8];
#pragma unroll
    for (int i = 0; i < 8; ++i) { const int q = tid + 512 * i; vreg[i] = *(const u32x4*)(PB + (tok0 + (q >> 5)) * fp::NIN + fp::PB_MV + h * 256 + (q & 31) * 8); }
#pragma unroll
    for (int i = 0; i < 9; ++i) {
        const int q = tid + 512 * i, row = q >> 5, ch = q & 31;
        if (row < 131) *(LAS u32x4*)(Raw + row * 256 + ch * 8) = (c * 128 + row - 3 >= 0) ? rawv[i] : (u32x4){0u, 0u, 0u, 0u};
    }
    float li = 0.f, lf = 0.f;
    if (tid < 128) { li = softcap_f(gi); lf = logsigmoid_f(softcap_f(gf)); }
    float cum = lf;
#pragma unroll
    for (int o = 1; o < 64; o <<= 1) { const float t = __shfl_up(cum, o); if (f_lane >= o) cum += t; }
    if (tid == 63) gl[384] = cum;
    __syncthreads();
    if (tid >= 64 && tid < 128) cum += gl[384];
    if (tid == 127) gl[385] = cum;
    __syncthreads();
    const float g = gl[385];
    const float av = (tid < 128) ? (g - cum + li) : -INFINITY;
    const float wm = wave_max_f(av);
    if (f_lane == 0 && f_wave < 2) gl[386 + f_wave] = wm;
    __syncthreads();
    const float mloc = fmaxf(gl[386], gl[387]);
    if (tid < 128) {
        gl[256 + tid] = expf(av - mloc);
        ((float*)(ws + wsf::BCUM))[(size_t)bh * S + c * 128 + tid] = cum;
        ((float*)(ws + wsf::LOGI))[(size_t)bh * S + c * 128 + tid] = li;
    }
    if (tid == 0) { ((float*)(ws + wsf::GSUM))[u] = g; ((float*)(ws + wsf::MLOC))[u] = mloc; }
    __syncthreads();
#pragma unroll 2
    for (int i = 0; i < 8; ++i) {
        const int q = tid + 512 * i, row = q >> 5, ch = q & 31, isK = ch >= 16, cc = (ch & 15) * 8;
        const int cwcol = (isK ? 512 : 0) + h * 128 + cc;
        float acc[8];
#pragma unroll
        for (int e = 0; e < 8; ++e) acc[e] = 0.f;
#pragma unroll
        for (int j = 0; j < 4; ++j) {
            const u32x4 xv = *(const LAS u32x4*)(Raw + (row + j) * 256 + ch * 8);
            float xf[8]; unpack8(xv, xf);
            const f32x4 w0 = *(const f32x4*)(a.conv_qk + j * 1024 + cwcol), w1 = *(const f32x4*)(a.conv_qk + j * 1024 + cwcol + 4);
            acc[0] += w0.x * xf[0]; acc[1] += w0.y * xf[1]; acc[2] += w0.z * xf[2]; acc[3] += w0.w * xf[3];
            acc[4] += w1.x * xf[4]; acc[5] += w1.y * xf[5]; acc[6] += w1.z * xf[6]; acc[7] += w1.w * xf[7];
        }
        const float sc = isK ? 0.08838834764831845f : 1.f;
#pragma unroll
        for (int e = 0; e < 8; ++e) acc[e] = silu_f(acc[e]) * sc;
        const u32x4 o = (u32x4){pk2(acc[0], acc[1]), pk2(acc[2], acc[3]), pk2(acc[4], acc[5]), pk2(acc[6], acc[7])};
        bf16_t* dst = (bf16_t*)(ws + (isK ? wsf::KC : wsf::QC)) + (tok0 + row) * 512 + h * 128 + cc;
        *(u32x4*)dst = o;
        if (isK) {
            const float wr = gl[256 + row];
            *(LAS u32x4*)(Kw + row * 136 + cc) = (u32x4){pk2(acc[0] * wr, acc[1] * wr), pk2(acc[2] * wr, acc[3] * wr), pk2(acc[4] * wr, acc[5] * wr), pk2(acc[6] * wr, acc[7] * wr)};
        }
    }
    __syncthreads();
#pragma unroll
    for (int i = 0; i < 8; ++i) { const int q = tid + 512 * i; *(LAS u32x4*)(Vt + (q >> 5) * 272 + (q & 31) * 8) = vreg[i]; }
    __syncthreads();
    const int c16 = f_lane & 15, grp = f_lane >> 4, w = f_wave;
    f32x4 acc[8][2];
#pragma unroll
    for (int d = 0; d < 8; ++d) { acc[d][0] = (f32x4){0.f, 0.f, 0.f, 0.f}; acc[d][1] = acc[d][0]; }
#pragma unroll
    for (int ks = 0; ks < 4; ++ks) {
        bf16x8 bfr[2];
#pragma unroll
        for (int i = 0; i < 2; ++i) bfr[i] = tr_frag(Vt + (32 * ks) * 272 + 16 * (2 * w + i), 272, f_lane);
#pragma unroll
        for (int d = 0; d < 8; ++d) {
            const bf16x8 af = tr_frag(Kw + (32 * ks) * 136 + 16 * d, 136, f_lane);
            acc[d][0] = mfma16(af, bfr[0], acc[d][0]); acc[d][1] = mfma16(af, bfr[1], acc[d][1]);
        }
    }
    float* dct = (float*)(ws + wsf::DCT) + (size_t)u * 256 * 128;
#pragma unroll
    for (int d = 0; d < 8; ++d)
#pragma unroll
        for (int i = 0; i < 2; ++i) *(f32x4*)(dct + (size_t)(16 * (2 * w + i) + c16) * 128 + 16 * d + 4 * grp) = acc[d][i];
    if (tid < 128) {
        float s = 0.f;
#pragma unroll 16
        for (int r = 0; r < 128; ++r) s += bf2f(Kw[r * 136 + tid]);
        ((float*)(ws + wsf::DN))[(size_t)u * 128 + tid] = s;
    }
    __syncthreads();
}

__device__ __forceinline__ void phase3(const MkArgs& a, Frame& F) {
    const int f_tid = fresh_tid(F), f_lane = f_tid & 63, f_wave = F.wave;
    for (int u = F.bid; u < NB * HKV * (S / 128); u += F.G) attn_unit(a, F, u);
    for (int u = F.bid; u < NB * MH * NC; u += F.G) m1_unit(a, F, u);
}

__device__ __forceinline__ void phase4(const MkArgs& a, Frame& F) {
    ada_gemv(a, F, 4096 / 64, MODW / 64);
    __syncthreads();
    const int f_tid = fresh_tid(F), f_lane = f_tid & 63, f_wave = F.wave;
    unsigned char* ws = a.ws;
    LAS float* dec = (LAS float*)F.lds;
    LAS float* scl = dec + 512;
    LAS float* gl = scl + 512;
    gl[f_tid] = ((const float*)(ws + wsf::GSUM))[f_tid]; gl[512 + f_tid] = ((const float*)(ws + wsf::MLOC))[f_tid];
    __syncthreads();
    if (f_tid < 8) {
        const int bh = f_tid; float m = 0.f;
        for (int c = 0; c < NC; ++c) {
            const float g = gl[bh * NC + c], ml = gl[512 + bh * NC + c];
            if (F.bid == 0) ((float*)(ws + wsf::MPREV))[bh * NC + c] = m;
            const float mn = fmaxf(g + m, ml);
            dec[bh * 64 + c] = expf(g + m - mn); scl[bh * 64 + c] = expf(ml - mn); m = mn;
        }
    }
    __syncthreads();
    const int gt = F.vcu * fp::NT + f_tid, NGT = F.G * fp::NT;
    for (int it = gt; it < 8 * 16384; it += NGT) {
        const int bh = it >> 14, idx = it & 16383;
        const float* dct = (const float*)(ws + wsf::DCT) + (size_t)bh * 64 * 32768 + (size_t)idx * 2;
        bf16_t* cpt = (bf16_t*)(ws + wsf::CPT) + (size_t)bh * 64 * 32768 + (size_t)idx * 2;
        float C0 = 0.f, C1 = 0.f;
#pragma unroll 8
        for (int c = 0; c < NC; ++c) {
            const f32x2 d = *(const f32x2*)(dct + (size_t)c * 32768);
            *(unsigned*)(cpt + (size_t)c * 32768) = pk2(C0, C1);
            const float de = dec[bh * 64 + c], sc = scl[bh * 64 + c];
            C0 = de * C0 + sc * d.x; C1 = de * C1 + sc * d.y;
        }
    }
    for (int it = gt; it < 8 * 128; it += NGT) {
        const int bh = it >> 7, dk = it & 127; float nv = 0.f;
        const float* dnp = (const float*)(ws + wsf::DN) + (size_t)bh * NC * 128 + dk;
        float* npp = (float*)(ws + wsf::NPREV) + (size_t)bh * NC * 128 + dk;
#pragma unroll
        for (int h = 0; h < 2; ++h) {
            float d[32];
#pragma unroll
            for (int c = 0; c < 32; ++c) d[c] = dnp[(size_t)(32 * h + c) * 128];
#pragma unroll
            for (int c = 0; c < 32; ++c) { npp[(size_t)(32 * h + c) * 128] = nv; nv = dec[bh * 64 + 32 * h + c] * nv + scl[bh * 64 + 32 * h + c] * d[c]; }
        }
    }
}

__device__ __forceinline__ void m3_unit(const MkArgs& a, Frame& F, int u) {
    const int f_tid = fresh_tid(F), f_lane = f_tid & 63, f_wave = F.wave;
    const int bh = u >> 6, c = u & 63, b = bh >> 2, h = bh & 3;
    const size_t tok0 = (size_t)b * S + (size_t)c * 128;
    unsigned char* ws = a.ws;
    const bf16_t* PB = (const bf16_t*)(ws + wsf::PROJB);
    const bf16_t* QCp = (const bf16_t*)(ws + wsf::QC);
    const bf16_t* KCp = (const bf16_t*)(ws + wsf::KC);
    LAS bf16_t* KP = (LAS bf16_t*)F.lds;
    LAS bf16_t* Vt = (LAS bf16_t*)(F.lds + 34816);
    LAS float* fl = (LAS float*)(F.lds + 104448);
    LAS float* f_us = fl, *f_M = fl + 128, *f_iw = fl + 256, *f_rd = fl + 384, *f_qn = fl + 512, *f_np = fl + 640, *f_en = fl + 768, *f_ssq = fl + 1024, *f_misc = fl + 896;
    const int tid = f_tid;
#pragma unroll
    for (int i = 0; i < 4; ++i) { const int q = tid + 512 * i, row = q >> 4, ch = q & 15;
        *(LAS u32x4*)(KP + row * 136 + ch * 8) = *(const u32x4*)(KCp + (tok0 + row) * 512 + h * 128 + ch * 8); }
    stage_vt(PB, tok0, fp::PB_MV + h * 256, Vt, tid);
    const float mp = ((const float*)(ws + wsf::MPREV))[u];
    float bt = 0.f, us = -INFINITY;
    if (tid < 128) { bt = ((const float*)(ws + wsf::BCUM))[(size_t)bh * S + c * 128 + tid]; us = ((const float*)(ws + wsf::LOGI))[(size_t)bh * S + c * 128 + tid] - bt;
        f_np[tid] = ((const float*)(ws + wsf::NPREV))[(size_t)u * 128 + tid]; }
    float pm = us;
#pragma unroll
    for (int o = 1; o < 64; o <<= 1) { const float t = __shfl_up(pm, o); if (f_lane >= o) pm = fmaxf(pm, t); }
    if (tid == 63) f_misc[0] = pm;
    __syncthreads();
    if (tid >= 64 && tid < 128) pm = fmaxf(pm, f_misc[0]);
    if (tid < 128) {
        const float Mt = fmaxf(mp, pm);
        f_us[tid] = us; f_M[tid] = Mt; f_iw[tid] = expf(mp - Mt); f_en[tid] = expf(-(bt + Mt));
        float s = 0.f;
#pragma unroll 8
        for (int ch = 0; ch < 16; ++ch) { const u32x4 qv = *(const u32x4*)(QCp + (tok0 + tid) * 512 + h * 128 + ch * 8); float qf[8]; unpack8(qv, qf);
#pragma unroll
            for (int e = 0; e < 8; ++e) s += qf[e] * f_np[ch * 8 + e]; }
        f_qn[tid] = s;
    }
    __syncthreads();
    const int c16 = f_lane & 15, grp = f_lane >> 4, w = f_wave;
    u32x2 pp[8]; float rs = 0.f;
    {
        bf16x8 qf[4];
#pragma unroll
        for (int ks = 0; ks < 4; ++ks) qf[ks] = *(const bf16x8*)(QCp + (tok0 + 16 * w + c16) * 512 + h * 128 + 32 * ks + 8 * grp);
        const float Mt = f_M[16 * w + c16];
        const int t = 16 * w + c16, tq = t - 4 * grp;
        const LAS float* usb = f_us + 4 * grp;
#pragma unroll
        for (int st = 0; st < 8; ++st) {
            pp[st] = (u32x2){0u, 0u};
            if (st <= w) {
                f32x4 acc = (f32x4){0.f, 0.f, 0.f, 0.f};
#pragma unroll
                for (int ks = 0; ks < 4; ++ks) { const bf16x8 kf = *(const LAS bf16x8*)(KP + (16 * st + c16) * 136 + 32 * ks + 8 * grp); acc = mfma16(kf, qf[ks], acc); }
                float p[4];
                const f32x4 u4 = *(const LAS f32x4*)(usb + 16 * st);
#pragma unroll
                for (int r = 0; r < 4; ++r) { p[r] = (16 * st + r <= tq) ? acc[r] * expf(u4[r] - Mt) : 0.f; rs += p[r]; }
                pp[st] = (u32x2){pk2(p[0], p[1]), pk2(p[2], p[3])};
            }
        }
        rs += __shfl_xor(rs, 16); rs += __shfl_xor(rs, 32);
        if (grp == 0) { const float den = rs + f_iw[t] * f_qn[t]; f_rd[t] = 1.f / fmaxf(fabsf(den), f_en[t]); }
    }
    __syncthreads();
#pragma unroll
    for (int st = 0; st < 8; ++st) *(LAS u32x2*)(KP + (16 * w + c16) * 136 + 16 * st + 4 * grp) = pp[st];
    __syncthreads();
    bf16x8 vf[2][4], cf[2][4];
    const bf16_t* cpt = (const bf16_t*)(ws + wsf::CPT) + (size_t)u * 256 * 128;
#pragma unroll
    for (int i = 0; i < 2; ++i)
#pragma unroll
        for (int ks = 0; ks < 4; ++ks) {
            vf[i][ks] = tr_frag(Vt + (32 * ks) * 272 + 16 * (2 * w + i), 272, f_lane);
            cf[i][ks] = *(const bf16x8*)(cpt + (size_t)(16 * (2 * w + i) + c16) * 128 + 32 * ks + 8 * grp);
        }
    bf16_t* HMp = (bf16_t*)(ws + wsf::HM);
    bf16x8 qnx[4];
#pragma unroll
    for (int ks = 0; ks < 4; ++ks) qnx[ks] = *(const bf16x8*)(QCp + (tok0 + c16) * 512 + h * 128 + 32 * ks + 8 * grp);
#pragma unroll 1
    for (int tt = 0; tt < 8; ++tt) {
        bf16x8 pf[4], qf[4];
        const int tn = tt < 7 ? tt + 1 : 7;
#pragma unroll
        for (int ks = 0; ks < 4; ++ks) { pf[ks] = *(const LAS bf16x8*)(KP + (16 * tt + c16) * 136 + 32 * ks + 8 * grp);
            qf[ks] = qnx[ks]; qnx[ks] = *(const bf16x8*)(QCp + (tok0 + 16 * tn + c16) * 512 + h * 128 + 32 * ks + 8 * grp); }
        const int t = 16 * tt + c16; const float iw = f_iw[t], rd = f_rd[t];
        float ss = 0.f;
#pragma unroll
        for (int i = 0; i < 2; ++i) {
            f32x4 a1 = (f32x4){0.f, 0.f, 0.f, 0.f}, a2 = a1;
#pragma unroll
            for (int ks = 0; ks < 4; ++ks) { a1 = mfma16(vf[i][ks], pf[ks], a1); a2 = mfma16(cf[i][ks], qf[ks], a2); }
            const f32x4 hv = (a1 + a2 * iw) * rd;
            ss += (hv[0] * hv[0] + hv[1] * hv[1]) + (hv[2] * hv[2] + hv[3] * hv[3]);
            *(u32x2*)(HMp + (tok0 + t) * 1024 + h * 256 + 16 * (2 * w + i) + 4 * grp) = (u32x2){pk2(hv[0], hv[1]), pk2(hv[2], hv[3])};
        }
        ss += __shfl_xor(ss, 16); ss += __shfl_xor(ss, 32);
        if (grp == 0) f_ssq[t * 8 + w] = ss;
    }
    u32x2 mon[2];
#pragma unroll
    for (int i = 0; i < 2; ++i) mon[i] = *(const u32x2*)(PB + (tok0 + c16) * fp::NIN + fp::PB_MO + h * 256 + 16 * (2 * w + i) + 4 * grp);
    __syncthreads();
#pragma unroll 1
    for (int tt = 0; tt < 8; ++tt) {
        const int t = 16 * tt + c16, tn2 = 16 * (tt < 7 ? tt + 1 : 7) + c16;
        u32x2 moc[2];
#pragma unroll
        for (int i = 0; i < 2; ++i) { moc[i] = mon[i]; mon[i] = *(const u32x2*)(PB + (tok0 + tn2) * fp::NIN + fp::PB_MO + h * 256 + 16 * (2 * w + i) + 4 * grp); }
        const f32x4 s0 = *(const LAS f32x4*)(f_ssq + t * 8), s1 = *(const LAS f32x4*)(f_ssq + t * 8 + 4);
        const float rn = rsqrtf(((s0.x + s0.y) + (s0.z + s0.w) + (s1.x + s1.y) + (s1.z + s1.w)) * (1.f / 256.f) + EPS);
#pragma unroll
        for (int i = 0; i < 2; ++i) {
            const int dv0 = 16 * (2 * w + i) + 4 * grp;
            const f32x4 g4 = *(const f32x4*)(a.g_mlstm + h * 256 + dv0);
            const u32x2 mo = moc[i];
            u32x2* hp = (u32x2*)(HMp + (tok0 + t) * 1024 + h * 256 + dv0);
            const u32x2 hr = *hp;
            const float o0 = bflo(hr.x) * rn * g4.x * bflo(mo.x), o1 = bfhi(hr.x) * rn * g4.y * bfhi(mo.x);
            const float o2 = bflo(hr.y) * rn * g4.z * bflo(mo.y), o3 = bfhi(hr.y) * rn * g4.w * bfhi(mo.y);
            *hp = (u32x2){pk2(o0, o1), pk2(o2, o3)};
        }
    }
    __syncthreads();
}
__device__ __forceinline__ void phase5(const MkArgs& a, Frame& F) {
    const int f_tid = fresh_tid(F), f_lane = f_tid & 63, f_wave = F.wave;
    for (int u = F.bid; u < NB * MH * NC; u += F.G) m3_unit(a, F, u);
}
struct ProjUnit { int pm, pn, which; };
struct ProjSched {
    typedef ProjUnit UnitT;
    const bf16_t* A0; const bf16_t* A1; const bf16_t* B0; const bf16_t* B1; int K; int nM, nN, G, c, wave;
    __device__ __forceinline__ bool next(int i, ProjUnit& u) const { u.which = i & 1; return pg8::static_tile((i >> 1) * G + c, nM, nN, u.pm, u.pn); }
    __device__ __forceinline__ const void* a_buf() const { return A0; }
    __device__ __forceinline__ const void* b_buf() const { return B0; }
    __device__ __forceinline__ unsigned a_soff(const ProjUnit& u) const { return (unsigned)u.pm * 256u * (unsigned)K * 2u + (u.which ? (unsigned)((const char*)A1 - (const char*)A0) : 0u); }
    __device__ __forceinline__ unsigned b_soff(const ProjUnit& u) const { return (unsigned)u.pn * 256u * (unsigned)K * 2u + (u.which ? (unsigned)((const char*)B1 - (const char*)B0) : 0u); }
    __device__ __forceinline__ void a_offs(const ProjUnit&, int R0, int R1, int C0, int C1, unsigned (&o)[4]) const {
        o[0] = (unsigned)(R0 * K + C0) * 2u; o[1] = (unsigned)(R1 * K + C1) * 2u; o[2] = (unsigned)((R0 + 128) * K + C0) * 2u; o[3] = (unsigned)((R1 + 128) * K + C1) * 2u;
    }
};
struct EpiMerge {
    bf16_t* MG; const bf16_t* PB; bool skip;
    __device__ __forceinline__ void operator()(const f32x4 (&acc)[2][2][4][2], const ProjUnit& u, int wr, int wc, int fr, int fq) const {
        if (skip) {
#pragma unroll
            for (int ai = 0; ai < 2; ++ai)
#pragma unroll
                for (int bj = 0; bj < 2; ++bj)
#pragma unroll
                    for (int m = 0; m < 4; ++m)
#pragma unroll
                        for (int n = 0; n < 2; ++n) asm volatile("" :: "v"(acc[ai][bj][m][n]));
            return;
        }
        const int row0 = u.pm * 256 + wr * 64 + fr, col0 = u.pn * 256 + wc * 32 + 8 * fq;
        const int gcol = (u.which ? fp::PB_GM : fp::PB_GA) + col0;
#pragma unroll
        for (int ai = 0; ai < 2; ++ai) {
            u32x4 gv[4][2], pv[4][2];
#pragma unroll
            for (int m = 0; m < 4; ++m)
#pragma unroll
                for (int bj = 0; bj < 2; ++bj) { const size_t row = (size_t)(row0 + ai * 128 + m * 16);
                    gv[m][bj] = *(const u32x4*)(PB + row * fp::NIN + gcol + bj * 128);
                    pv[m][bj] = u.which ? *(const u32x4*)(MG + row * 2048 + col0 + bj * 128) : (u32x4){0u, 0u, 0u, 0u}; }
#pragma unroll
            for (int m = 0; m < 4; ++m)
#pragma unroll
                for (int bj = 0; bj < 2; ++bj) { const size_t row = (size_t)(row0 + ai * 128 + m * 16);
                    float g[8], p[8]; unpack8(gv[m][bj], g); unpack8(pv[m][bj], p);
                    const f32x4 v0 = acc[ai][bj][m][0], v1 = acc[ai][bj][m][1];
                    const float o[8] = {p[0] + g[0] * v0[0], p[1] + g[1] * v0[1], p[2] + g[2] * v0[2], p[3] + g[3] * v0[3], p[4] + g[4] * v1[0], p[5] + g[5] * v1[1], p[6] + g[6] * v1[2], p[7] + g[7] * v1[3]};
                    *(u32x4*)(MG + row * 2048 + col0 + bj * 128) = (u32x4){pg8::cvt_pk_bf16(o[0], o[1]), pg8::cvt_pk_bf16(o[2], o[3]), pg8::cvt_pk_bf16(o[4], o[5]), pg8::cvt_pk_bf16(o[6], o[7])}; }
        }
    }
};
__device__ __forceinline__ void phase6(const MkArgs& a, Frame& F, bool skip_epi = false) {
    const int f_tid = fresh_tid(F), f_lane = f_tid & 63, f_wave = F.wave;
    unsigned char* ws = a.ws;
    ProjSched S{(const bf16_t*)(ws + wsf::OAT), (const bf16_t*)(ws + wsf::HM), (const bf16_t*)(ws + wsf::WAP_T), (const bf16_t*)(ws + wsf::WMP_T), 1024, NTOK / 256, 2048 / 256, F.G, F.bid, F.wave};
    EpiMerge E{(bf16_t*)(ws + wsf::MG), (const bf16_t*)(ws + wsf::PROJB), skip_epi};
    pg8::gemm_phase<EpiMerge, ProjSched>(F.lds, S, E);
}
struct EpiPlain {
    bf16_t* O; int ldc;
    __device__ __forceinline__ void operator()(const f32x4 (&acc)[2][2][4][2], const DenseUnit& u, int wr, int wc, int fr, int fq) const {
        const int row0 = u.pm * 256 + wr * 64 + fr, col0 = u.pn * 256 + wc * 32 + 8 * fq;
#pragma unroll
        for (int ai = 0; ai < 2; ++ai)
#pragma unroll
            for (int m = 0; m < 4; ++m)
#pragma unroll
                for (int bj = 0; bj < 2; ++bj) {
                    const f32x4 v0 = acc[ai][bj][m][0], v1 = acc[ai][bj][m][1];
                    *(u32x4*)(O + (size_t)(row0 + ai * 128 + m * 16) * ldc + col0 + bj * 128) =
                        (u32x4){pg8::cvt_pk_bf16(v0[0], v0[1]), pg8::cvt_pk_bf16(v0[2], v0[3]), pg8::cvt_pk_bf16(v1[0], v1[1]), pg8::cvt_pk_bf16(v1[2], v1[3])};
                }
    }
};
__device__ __forceinline__ void phase7(const MkArgs& a, Frame& F) {
    const int f_tid = fresh_tid(F), f_lane = f_tid & 63, f_wave = F.wave;
    unsigned char* ws = a.ws;
    DenseSched S{(const bf16_t*)(ws + wsf::MG), (const bf16_t*)(ws + wsf::WOUT_T), 2048, 2048, NTOK / 256, 2048 / 256, F.G, F.bid, F.wave};
    EpiPlain E{(bf16_t*)(ws + wsf::Y), 2048};
    pg8::gemm_phase<EpiPlain, DenseSched>(F.lds, S, E);
}

__device__ __forceinline__ void phase8(const MkArgs& a, Frame& F) {
    const int f_tid = fresh_tid(F), f_lane = f_tid & 63, f_wave = F.wave;
    unsigned char* ws = a.ws;
    LAS float* t_gt1 = (LAS float*)F.lds, *t_gpo = t_gt1 + 2048, *t_gpr = t_gt1 + 4096, *t_sc2 = t_gt1 + 6144, *t_sh2 = t_gt1 + 8192;
    LAS float* lgp = (LAS float*)(F.lds + 40960);
    LAS int* cntl = (LAS int*)(F.lds + 57344);
    LAS int* basel = cntl + 32;
    LAS int* esel = cntl + 64;
    LAS int* eslot = cntl + 320;
    const float* mod = (const float*)(ws + wsf::MOD);
    const bf16_t* Yp = (const bf16_t*)(ws + wsf::Y);
    bf16_t* H2p = (bf16_t*)(ws + wsf::H2);
    bf16_t* X1p = (bf16_t*)(ws + wsf::X1);
    const bf16_t* WR = (const bf16_t*)(ws + wsf::WRT);
    int* cntg = (int*)(ws + wsf::CTL) + wsf::CW_CNT;
    const int tid = f_tid, lane = f_lane, w = f_wave;
    for (int blk = F.vcu; blk < NTOK / 64; blk += F.G) {
        const int b = (blk * 64) / S;
        for (int i = tid; i < 2048; i += fp::NT) {
            t_gt1[i] = mod[b * MODW + MOD_GT1 + i]; t_gpo[i] = a.g_post_mix[i]; t_gpr[i] = a.g_pre_ffn[i];
            t_sc2[i] = mod[b * MODW + MOD_SC2 + i]; t_sh2[i] = mod[b * MODW + MOD_SH2 + i];
        }
        if (tid < 32) cntl[tid] = 0;
        __syncthreads();
#pragma unroll 1
        for (int rr = 0; rr < 8; ++rr) {
            const size_t row = (size_t)blk * 64 + w * 8 + rr;
            u32x4 yp[4]; float ss = 0.f;
#pragma unroll
            for (int j = 0; j < 4; ++j) { yp[j] = *(const u32x4*)(Yp + row * 2048 + 8 * (64 * j + lane)); float f[8]; unpack8(yp[j], f);
#pragma unroll
                for (int e = 0; e < 8; ++e) ss += f[e] * f[e]; }
            const float r1 = rsqrtf(wave_sum_f(ss) * (1.f / D) + EPS);
            ss = 0.f;
#pragma unroll
            for (int j = 0; j < 4; ++j) {
                const int c0 = 8 * (64 * j + lane);
                float f[8]; unpack8(yp[j], f);
                const f32x4 xa = *(const f32x4*)(a.x + row * D + c0), xb = *(const f32x4*)(a.x + row * D + c0 + 4);
                const float xv[8] = {xa.x, xa.y, xa.z, xa.w, xb.x, xb.y, xb.z, xb.w};
                float v[8];
#pragma unroll
                for (int e = 0; e < 8; ++e) { v[e] = xv[e] + t_gt1[c0 + e] * (f[e] * r1 * t_gpo[c0 + e]); ss += v[e] * v[e]; }
                *(u32x4*)(X1p + row * D + c0) = (u32x4){pg8::cvt_pk_bf16(v[0], v[1]), pg8::cvt_pk_bf16(v[2], v[3]), pg8::cvt_pk_bf16(v[4], v[5]), pg8::cvt_pk_bf16(v[6], v[7])};
            }
            const float r2 = rsqrtf(wave_sum_f(ss) * (1.f / D) + EPS);
#pragma unroll
            for (int j = 0; j < 4; ++j) {
                const int c0 = 8 * (64 * j + lane);
                const u32x4 xr = *(const u32x4*)(X1p + row * D + c0);
                float xv[8]; unpack8(xr, xv);
                float hv[8];
#pragma unroll
                for (int e = 0; e < 8; ++e) hv[e] = xv[e] * r2 * t_gpr[c0 + e] * (1.f + t_sc2[c0 + e]) + t_sh2[c0 + e];
                *(u32x4*)(H2p + row * 2048 + c0) = (u32x4){pg8::cvt_pk_bf16(hv[0], hv[1]), pg8::cvt_pk_bf16(hv[2], hv[3]), pg8::cvt_pk_bf16(hv[4], hv[5]), pg8::cvt_pk_bf16(hv[6], hv[7])};
#if MOE_FP8
                *(u32x2*)(ws + wsf::H2F8 + row * 2048 + c0) = (u32x2){pk4_fp8(hv[0], hv[1], hv[2], hv[3]), pk4_fp8(hv[4], hv[5], hv[6], hv[7])};
#endif
            }
        }
        VM_WAIT();
        __syncthreads();
        {
            const int c16 = lane & 15, grp = lane >> 4, rt = w & 3, kh = w >> 2;
            f32x4 acc[2] = {(f32x4){0.f, 0.f, 0.f, 0.f}, (f32x4){0.f, 0.f, 0.f, 0.f}};
            int blkb = blk; asm volatile("" : "+s"(blkb));
            const bf16_t* ap = H2p + ((size_t)blkb * 64 + 16 * rt + c16) * 2048 + 8 * grp;
#pragma unroll 4
            for (int ks = kh * 32; ks < kh * 32 + 32; ++ks) {
                const bf16x8 af = *(const bf16x8*)(ap + 32 * ks);
#pragma unroll
                for (int et = 0; et < 2; ++et) {
                    const bf16x8 bh = *(const bf16x8*)(WR + (size_t)(16 * et + c16) * 2048 + 32 * ks + 8 * grp);
                    const bf16x8 bl = *(const bf16x8*)(WR + (size_t)32 * 2048 + (size_t)(16 * et + c16) * 2048 + 32 * ks + 8 * grp);
                    acc[et] = mfma16(af, bh, acc[et]); acc[et] = mfma16(af, bl, acc[et]);
                }
            }
#pragma unroll
            for (int et = 0; et < 2; ++et)
#pragma unroll
                for (int r = 0; r < 4; ++r) lgp[kh * 2048 + (16 * rt + 4 * grp + r) * 32 + 16 * et + c16] = acc[et][r];
        }
        __syncthreads();
        int blkc = blk; asm volatile("" : "+s"(blkc));
        if (tid < 64) {
            const size_t tok = (size_t)blkc * 64 + tid;
            float lgv[32];
#pragma unroll
            for (int e = 0; e < 32; ++e) lgv[e] = lgp[tid * 32 + e] + lgp[2048 + tid * 32 + e] + a.b_router[e];
            int idx[4]; float val[4];
            unsigned used = 0u;
#pragma unroll
            for (int k = 0; k < 4; ++k) {
                float best = -INFINITY; int bi = 0;
#pragma unroll
                for (int e = 0; e < 32; ++e) { const bool c = !((used >> e) & 1u) && lgv[e] > best; best = c ? lgv[e] : best; bi = c ? e : bi; }
                used |= 1u << bi; idx[k] = bi; val[k] = best;
            }
            float ex[4], sum = 0.f;
#pragma unroll
            for (int k = 0; k < 4; ++k) { ex[k] = expf(val[k] - val[0]); sum += ex[k]; }
#pragma unroll
            for (int k = 0; k < 4; ++k) {
                ((int*)(ws + wsf::TOPI))[tok * 4 + k] = idx[k]; ((float*)(ws + wsf::TOPW))[tok * 4 + k] = ex[k] / sum;
                const int e = a.route_i ? a.route_i[tok * 4 + k] : idx[k];
                esel[tid * 4 + k] = e;
                eslot[tid * 4 + k] = __hip_atomic_fetch_add(cntl + e, 1, __ATOMIC_RELAXED, __HIP_MEMORY_SCOPE_WORKGROUP);
            }
        }
        __syncthreads();
        if (tid < 32) { const int n = cntl[tid]; basel[tid] = n > 0 ? __hip_atomic_fetch_add(cntg + tid, n, __ATOMIC_RELAXED, __HIP_MEMORY_SCOPE_AGENT) : 0; }
        __syncthreads();
        if (tid < 256) { const int e = esel[tid]; ((int*)(ws + wsf::LIST))[(size_t)e * NPAIR + basel[e] + eslot[tid]] = (blkc * 64 + (tid >> 2)) * 4 + (tid & 3); }
        __syncthreads();
    }
}

struct MoeUnit { int e, m0, pn, rows; };
struct MoeSched {
    typedef MoeUnit UnitT;
    const bf16_t* A; int a_shift; const bf16_t* Wt; size_t wstride; int K; int nN;
    const int* list; const LAS int* tstart; const LAS int* cnt; int nM; int G, c, wave;
    __device__ __forceinline__ bool next(int i, MoeUnit& u) const {
        const int nwg = nM * nN, L = i * G + c; if (L >= nwg) return false;
        int wgid = L; { const int q = nwg / 8, r = nwg % 8, xcd = wgid % 8, off = wgid / 8; wgid = (xcd < r ? xcd * (q + 1) : r * (q + 1) + (xcd - r) * q) + off; }
        constexpr int WG = 4;
        const int nig = WG * nN, gid = wgid / nig, fm = gid * WG, gsz = (nM - fm) < WG ? (nM - fm) : WG;
        const int mt = fm + ((wgid % nig) % gsz); u.pn = (wgid % nig) / gsz;
        int e = 0;
        for (int k = 1; k < NE; ++k) e += (__builtin_amdgcn_readfirstlane(tstart[k]) <= mt) ? 1 : 0;
        u.e = e; u.m0 = (mt - __builtin_amdgcn_readfirstlane(tstart[e])) * 256; const int left = __builtin_amdgcn_readfirstlane(cnt[e]) - u.m0; u.rows = left < 256 ? left : 256;
        return true;
    }
    __device__ __forceinline__ const void* a_buf() const { return A; }
    __device__ __forceinline__ const void* b_buf() const { return Wt; }
    __device__ __forceinline__ unsigned a_soff(const MoeUnit&) const { return 0u; }
    __device__ __forceinline__ unsigned b_soff(const MoeUnit& u) const { return ((unsigned)u.e * (unsigned)wstride + (unsigned)u.pn * 256u * (unsigned)K) * 2u; }
    __device__ __forceinline__ unsigned rowoff(const MoeUnit& u, int r, int C) const {
        const int rc = r < u.rows ? r : u.rows - 1;
        const int id = list[(size_t)u.e * NPAIR + u.m0 + rc] >> a_shift;
        return ((unsigned)id * (unsigned)K + (unsigned)C) * 2u;
    }
    __device__ __forceinline__ void a_offs(const MoeUnit& u, int R0, int R1, int C0, int C1, unsigned (&o)[4]) const {
        o[0] = rowoff(u, R0, C0); o[1] = rowoff(u, R1, C1); o[2] = rowoff(u, R0 + 128, C0); o[3] = rowoff(u, R1 + 128, C1);
    }
};
__device__ __forceinline__ void moe_tables(const MkArgs& a, Frame& F, LAS int*& cnt, LAS int*& tstart) {
    const int f_tid = fresh_tid(F);
    cnt = (LAS int*)(F.lds + LDS_TAB); tstart = cnt + 32;
    const int* cntg = (const int*)(a.ws + wsf::CTL) + wsf::CW_CNT;
    if (f_tid < 32) cnt[f_tid] = __hip_atomic_load(cntg + f_tid, RLX_AGENT);
    __syncthreads();
    if (f_tid == 0) { int s = 0; for (int e = 0; e < NE; ++e) { tstart[e] = s; s += (cnt[e] + 255) >> 8; } tstart[NE] = s; }
    __syncthreads();
}
template <bool F8> struct EpiGateUpT {
    bf16_t* ACT; const float* bias; const int* list; bool skip;
    __device__ __forceinline__ void operator()(const f32x4 (&acc)[2][2][4][2], const MoeUnit& u, int wr, int wc, int fr, int fq) const {
        if (skip) {
#pragma unroll
            for (int ai = 0; ai < 2; ++ai)
#pragma unroll
                for (int bj = 0; bj < 2; ++bj)
#pragma unroll
                    for (int m = 0; m < 4; ++m)
#pragma unroll
                        for (int n = 0; n < 2; ++n) asm volatile("" :: "v"(acc[ai][bj][m][n]));
            return;
        }
        const int col0 = u.pn * 256 + wc * 32 + 8 * fq;
        f32x4 bv[2][2];
#pragma unroll
        for (int bj = 0; bj < 2; ++bj)
#pragma unroll
            for (int n = 0; n < 2; ++n) bv[bj][n] = *(const f32x4*)(bias + (size_t)u.e * 4096 + col0 + bj * 128 + 4 * n);
        int pr[8];
#pragma unroll
        for (int q = 0; q < 8; ++q) { const int r = (q >> 2) * 128 + wr * 64 + (q & 3) * 16 + fr; pr[q] = list[(size_t)u.e * NPAIR + u.m0 + (r < u.rows ? r : 0)]; if (r >= u.rows) pr[q] = -1; }
#pragma unroll
        for (int ai = 0; ai < 2; ++ai)
#pragma unroll
            for (int m = 0; m < 4; ++m) {
                const int pair = pr[ai * 4 + m];
                if (pair >= 0) {
#pragma unroll
                    for (int bj = 0; bj < 2; ++bj) {
                        const f32x4 v0 = acc[ai][bj][m][0] * (F8 ? W8INV : 1.f) + bv[bj][0], v1 = acc[ai][bj][m][1] * (F8 ? W8INV : 1.f) + bv[bj][1];
                        const float gu[8] = {v0[0], v0[1], v0[2], v0[3], v1[0], v1[1], v1[2], v1[3]};
                        float o[4];
#pragma unroll
                        for (int j = 0; j < 4; ++j) {
                            const float glu = fminf(gu[2 * j], 7.0f), lin = fminf(fmaxf(gu[2 * j + 1], -7.0f), 7.0f);
                            o[j] = glu * fast_sigmoid(1.702f * glu) * (lin + 1.f);
                        }
                        if constexpr (F8) *(unsigned*)((unsigned char*)ACT + (size_t)pair * 2048 + (col0 + bj * 128) / 2) = pk4_fp8_nc(o[0], o[1], o[2], o[3]);
                        else *(u32x2*)(ACT + (size_t)pair * 2048 + (col0 + bj * 128) / 2) = (u32x2){pg8::cvt_pk_bf16(o[0], o[1]), pg8::cvt_pk_bf16(o[2], o[3])};
                    }
                }
            }
    }
};
template <bool F8> struct EpiDownT {
    bf16_t* YP; const float* bias; const int* list; const float* wgt;
    __device__ __forceinline__ void operator()(const f32x4 (&acc)[2][2][4][2], const MoeUnit& u, int wr, int wc, int fr, int fq) const {
        const int col0 = u.pn * 256 + wc * 32 + 8 * fq;
        f32x4 bv[2][2];
#pragma unroll
        for (int bj = 0; bj < 2; ++bj)
#pragma unroll
            for (int n = 0; n < 2; ++n) bv[bj][n] = *(const f32x4*)(bias + (size_t)u.e * 2048 + col0 + bj * 128 + 4 * n);
        int pr[8]; float wq[8];
#pragma unroll
        for (int q = 0; q < 8; ++q) { const int r = (q >> 2) * 128 + wr * 64 + (q & 3) * 16 + fr; pr[q] = list[(size_t)u.e * NPAIR + u.m0 + (r < u.rows ? r : 0)]; if (r >= u.rows) pr[q] = -1; }
#pragma unroll
        for (int q = 0; q < 8; ++q) wq[q] = wgt[pr[q] >= 0 ? pr[q] : 0];
#pragma unroll
        for (int ai = 0; ai < 2; ++ai)
#pragma unroll
            for (int m = 0; m < 4; ++m) {
                const int pair = pr[ai * 4 + m];
                if (pair >= 0) {
                    const float wv = wq[ai * 4 + m];
#pragma unroll
                    for (int bj = 0; bj < 2; ++bj) {
                        const f32x4 v0 = (acc[ai][bj][m][0] * (F8 ? W8INV : 1.f) + bv[bj][0]) * wv, v1 = (acc[ai][bj][m][1] * (F8 ? W8INV : 1.f) + bv[bj][1]) * wv;
                        if constexpr (F8) *(u32x2*)((unsigned char*)YP + (size_t)pair * 2048 + col0 + bj * 128) =
                            (u32x2){pk4_fp8(v0[0] * YP8SCALE, v0[1] * YP8SCALE, v0[2] * YP8SCALE, v0[3] * YP8SCALE), pk4_fp8(v1[0] * YP8SCALE, v1[1] * YP8SCALE, v1[2] * YP8SCALE, v1[3] * YP8SCALE)};
                        else *(u32x4*)(YP + (size_t)pair * 2048 + col0 + bj * 128) =
                            (u32x4){pg8::cvt_pk_bf16(v0[0], v0[1]), pg8::cvt_pk_bf16(v0[2], v0[3]), pg8::cvt_pk_bf16(v1[0], v1[1]), pg8::cvt_pk_bf16(v1[2], v1[3])};
                    }
                }
            }
    }
};
__device__ __forceinline__ void phase9(const MkArgs& a, Frame& F, bool skip_epi = false) {
    unsigned char* ws = a.ws;
    LAS int* cnt; LAS int* tstart; moe_tables(a, F, cnt, tstart);
#if MOE_FP8
    MoeSched S{(const bf16_t*)(ws + wsf::H2F8), 2, (const bf16_t*)(ws + wsf::WGU8), (size_t)4096 * 1024, 1024, 16, (const int*)(ws + wsf::LIST), tstart, cnt, __builtin_amdgcn_readfirstlane(tstart[NE]), F.G, F.bid, F.wave};
    EpiGateUpT<true> E{(bf16_t*)(ws + wsf::ACT8), a.b_gate_up, (const int*)(ws + wsf::LIST), skip_epi};
    if (EPI_SKIP_PROBE >= 2 && skip_epi) pg8::gemm_phase<EpiGateUpT<true>, MoeSched, true, EPI_SKIP_PROBE - 1>(F.lds, S, E);
    else pg8::gemm_phase<EpiGateUpT<true>, MoeSched, true>(F.lds, S, E);
#else
    MoeSched S{(const bf16_t*)(ws + wsf::H2), 2, (const bf16_t*)(ws + wsf::WGU_T), (size_t)4096 * 2048, 2048, 16, (const int*)(ws + wsf::LIST), tstart, cnt, __builtin_amdgcn_readfirstlane(tstart[NE]), F.G, F.bid, F.wave};
    EpiGateUpT<false> E{(bf16_t*)(ws + wsf::ACT), a.b_gate_up, (const int*)(ws + wsf::LIST), skip_epi};
    pg8::gemm_phase<EpiGateUpT<false>, MoeSched, false>(F.lds, S, E);
#endif
}
__device__ __forceinline__ void phase10(const MkArgs& a, Frame& F) {
    unsigned char* ws = a.ws;
    LAS int* cnt; LAS int* tstart; moe_tables(a, F, cnt, tstart);
    const float* wgt = a.route_w ? a.route_w : (const float*)(ws + wsf::TOPW);
#if MOE_FP8
    MoeSched S{(const bf16_t*)(ws + wsf::ACT8), 0, (const bf16_t*)(ws + wsf::WDN8), (size_t)2048 * 1024, 1024, 8, (const int*)(ws + wsf::LIST), tstart, cnt, __builtin_amdgcn_readfirstlane(tstart[NE]), F.G, F.bid, F.wave};
    EpiDownT<true> E{(bf16_t*)(ws + wsf::YP), a.b_down, (const int*)(ws + wsf::LIST), wgt};
    pg8::gemm_phase<EpiDownT<true>, MoeSched, true>(F.lds, S, E);
#else
    MoeSched S{(const bf16_t*)(ws + wsf::ACT), 0, (const bf16_t*)(ws + wsf::WDN_T), (size_t)2048 * 2048, 2048, 8, (const int*)(ws + wsf::LIST), tstart, cnt, __builtin_amdgcn_readfirstlane(tstart[NE]), F.G, F.bid, F.wave};
    EpiDownT<false> E{(bf16_t*)(ws + wsf::YP), a.b_down, (const int*)(ws + wsf::LIST), wgt};
    pg8::gemm_phase<EpiDownT<false>, MoeSched, false>(F.lds, S, E);
#endif
}

__device__ __forceinline__ void phase11(const MkArgs& a, Frame& F) {
    const int f_tid = fresh_tid(F), f_lane = f_tid & 63, f_wave = F.wave;
    unsigned char* ws = a.ws;
    const float* mod = (const float*)(ws + wsf::MOD);
    const bf16_t* YPp = (const bf16_t*)(ws + wsf::YP);
    const bf16_t* X1p = (const bf16_t*)(ws + wsf::X1);
    const int gw = F.vcu * fp::NW + f_wave, NGW = F.G * fp::NW, lane = f_lane;
    if (gw >= NTOK) return;
#if MOE_FP8
    u32x2 yq[16];
#else
    u32x4 yq[16];
#endif
    u32x4 xq[4];
#if MOE_FP8
#define P11_YLOAD(prow, j) (*(const u32x2*)((const unsigned char*)YPp + (prow) * 2048 + 8 * (64 * (j) + lane)))
#else
#define P11_YLOAD(prow, j) (*(const u32x4*)(YPp + (prow) * 2048 + 8 * (64 * (j) + lane)))
#endif
#define P11_LOAD(m_) do { const size_t m__ = (size_t)(m_); \
        _Pragma("unroll") for (int k = 0; k < 4; ++k) _Pragma("unroll") for (int j = 0; j < 4; ++j) yq[k * 4 + j] = P11_YLOAD((m__ * 4 + k), j); \
        _Pragma("unroll") for (int j = 0; j < 4; ++j) xq[j] = *(const u32x4*)(X1p + m__ * D + 8 * (64 * j + lane)); } while (0)
    P11_LOAD(gw);
    for (int m = gw; m < NTOK; m += NGW) {
        const int b = m / S;
        float yv[32]; u32x4 xv[4];
#pragma unroll
        for (int i = 0; i < 32; ++i) yv[i] = 0.f;
#pragma unroll
        for (int k = 0; k < 4; ++k)
#pragma unroll
            for (int j = 0; j < 4; ++j) { float f[8];
#if MOE_FP8
                unpack8_fp8(yq[k * 4 + j], f);
#else
                unpack8(yq[k * 4 + j], f);
#endif
#pragma unroll
                for (int e = 0; e < 8; ++e) yv[8 * j + e] += f[e]; }
#pragma unroll
        for (int i = 0; i < 4; ++i) xv[i] = xq[i];
        { const int mn = m + NGW < NTOK ? m + NGW : m; P11_LOAD(mn); }
        float ss = 0.f;
#pragma unroll
        for (int i = 0; i < 32; ++i) { if (MOE_FP8) yv[i] *= (1.f / YP8SCALE); ss += yv[i] * yv[i]; }
        const float r = rsqrtf(wave_sum_f(ss) * (1.f / D) + EPS);
#pragma unroll
        for (int j = 0; j < 4; ++j) {
            const int c0 = 8 * (64 * j + lane);
            float xf[8]; unpack8(xv[j], xf);
#pragma unroll
            for (int hq = 0; hq < 2; ++hq) {
                const f32x4 xr = (f32x4){xf[4 * hq], xf[4 * hq + 1], xf[4 * hq + 2], xf[4 * hq + 3]};
                const f32x4 gt = *(const f32x4*)(mod + b * MODW + MOD_GT2 + c0 + 4 * hq), gp = *(const f32x4*)(a.g_post_ffn + c0 + 4 * hq);
                f32x4 o;
                o.x = xr.x + gt.x * (yv[8 * j + 4 * hq + 0] * r * gp.x); o.y = xr.y + gt.y * (yv[8 * j + 4 * hq + 1] * r * gp.y);
                o.z = xr.z + gt.z * (yv[8 * j + 4 * hq + 2] * r * gp.z); o.w = xr.w + gt.w * (yv[8 * j + 4 * hq + 3] * r * gp.w);
                *(f32x4*)(a.out + (size_t)m * D + c0 + 4 * hq) = o;
            }
        }
    }
#undef P11_LOAD
#undef P11_YLOAD
}
constexpr int N_PHASES = 12;
#ifndef P0_PARTS
#define P0_PARTS 7
#endif
#ifndef EPI_SKIP_PROBE
#define EPI_SKIP_PROBE 0
#endif
#ifndef REP_MASK
#define REP_MASK 0
#endif
__global__ void __launch_bounds__(fp::NT, 2) mk_fwd(MkArgs a) {
    extern __shared__ __attribute__((aligned(16))) unsigned char lds_raw[];
    Frame F;
    F.lds = (LAS unsigned char*)lds_raw;
    F.wave = __builtin_amdgcn_readfirstlane((int)threadIdx.x >> 6);
    F.G = gridDim.x; F.bid = blockIdx.x; F.vcu = (F.G % 8 == 0) ? (F.bid % 8) * (F.G / 8) + F.bid / 8 : F.bid;
    volatile LAS unsigned* misc = (volatile LAS unsigned*)(F.lds + LDS_MISC);
    if (F.wave == 0) misc[lane_id()] = 0u;
    __syncthreads();
    XcdBarrier bar = xcd_barrier_post((unsigned*)(a.ws + wsf::CTL) + wsf::CW_BAR, misc + 8, F.wave == 0 && lane_id() == 0);
    const int lo = a.ph_lo, hi = a.ph_hi;
#define IN(k) (lo <= (k) && (k) < hi)
#define SEAM(k) do { if (IN(k) && IN((k) + 1)) xcd_barrier(bar, F.wave == 0 && lane_id() == 0); } while (0)
    if (IN(0)) { phase0(a, F); if ((REP_MASK >> 0) & 1) phase0(a, F, P0_PARTS); } SEAM(0);
    if (IN(1)) { phase1(a, F); if ((REP_MASK >> 1) & 1) phase1(a, F); } SEAM(1);
    if (IN(2)) { phase2(a, F); if ((REP_MASK >> 2) & 1) phase2(a, F); } SEAM(2);
#if NPH > 3
    if (IN(3)) { phase3(a, F); if ((REP_MASK >> 3) & 1) phase3(a, F); } SEAM(3);
#endif
#if NPH > 4
    if (IN(4)) { phase4(a, F); if ((REP_MASK >> 4) & 1) phase4(a, F); } SEAM(4);
#endif
#if NPH > 5
    if (IN(5)) { phase5(a, F); if ((REP_MASK >> 5) & 1) phase5(a, F); } SEAM(5);
#endif
#if NPH > 6
    if (IN(6)) { phase6(a, F); if ((REP_MASK >> 6) & 1) phase6(a, F, EPI_SKIP_PROBE != 0); } SEAM(6);
#endif
#if NPH > 7
    if (IN(7)) { phase7(a, F); if ((REP_MASK >> 7) & 1) phase7(a, F); } SEAM(7);
#endif
#if NPH > 8
    if (IN(8)) { phase8(a, F); if ((REP_MASK >> 8) & 1) phase8(a, F); } SEAM(8);
#endif
#if NPH > 9
    if (IN(9)) { phase9(a, F); if ((REP_MASK >> 9) & 1) phase9(a, F, EPI_SKIP_PROBE != 0); } SEAM(9);
#endif
#if NPH > 10
    if (IN(10)) { phase10(a, F); if ((REP_MASK >> 10) & 1) phase10(a, F); } SEAM(10);
#endif
#if NPH > 11
    if (IN(11)) { phase11(a, F); if ((REP_MASK >> 11) & 1) phase11(a, F); }
#endif
#undef IN
#undef SEAM
}

static void fill_args(MkArgs& a, void* const* d_in, void* d_out, void* d_ws) {
    a.x = (const float*)d_in[0]; a.c = (const float*)d_in[1]; a.positions = (const int*)d_in[2]; a.w_ada = (const float*)d_in[3]; a.b_ada = (const float*)d_in[4];
    a.g_pre_mix = (const float*)d_in[5]; a.g_post_mix = (const float*)d_in[6]; a.g_pre_ffn = (const float*)d_in[7]; a.g_post_ffn = (const float*)d_in[8];
    a.w_in = (const float*)d_in[9]; a.b_in = (const float*)d_in[10]; a.conv_qk = (const float*)d_in[11]; a.sinks = (const float*)d_in[12]; a.g_mlstm = (const float*)d_in[13];
    a.w_attn_proj = (const float*)d_in[14]; a.w_mlstm_proj = (const float*)d_in[15]; a.w_out = (const float*)d_in[16]; a.w_router = (const float*)d_in[17]; a.b_router = (const float*)d_in[18];
    a.w_gate_up = (const float*)d_in[19]; a.b_gate_up = (const float*)d_in[20]; a.w_down = (const float*)d_in[21]; a.b_down = (const float*)d_in[22];
    a.out = (float*)d_out; a.ws = (unsigned char*)d_ws; a.route_i = nullptr; a.route_w = nullptr; a.ph_lo = 0; a.ph_hi = 0;
}
static int mk_setup() {
    static int grid = 0;
    if (grid == 0) {
        int dev = 0, cus = 0;
        if (hipGetDevice(&dev) != hipSuccess || hipDeviceGetAttribute(&cus, hipDeviceAttributeMultiprocessorCount, dev) != hipSuccess) { grid = -1; return grid; }
        if (hipFuncSetAttribute((const void*)mk_fwd, hipFuncAttributeMaxDynamicSharedMemorySize, LDS_BYTES) != hipSuccess) { grid = -1; return grid; }
        int per_cu = 0;
        if (hipOccupancyMaxActiveBlocksPerMultiprocessor(&per_cu, (const void*)mk_fwd, fp::NT, LDS_BYTES) != hipSuccess || per_cu < 1) { (void)hipGetLastError(); }
        grid = cus;
    }
    return grid;
}

extern "C" void kernel_launch(void* const* d_in, const int* in_sizes, int n_in, void* d_out, int out_size, void* d_ws, size_t ws_size, hipStream_t stream) {
    if (n_in != 23 || ws_size < wsf::END) return;
    const int grid = mk_setup();
    if (grid <= 0) return;
    if (hipMemsetAsync((unsigned char*)d_ws + wsf::CTL, 0, 65536, stream) != hipSuccess) return;
    MkArgs a{}; fill_args(a, d_in, d_out, d_ws);
    a.ph_lo = 0; a.ph_hi = N_PHASES;
    hipLaunchKernelGGL(mk_fwd, dim3(grid), dim3(fp::NT), LDS_BYTES, stream, a);
}
```

```cpp
#include <hip/hip_runtime.h>
#include <stdint.h>
#include <math.h>
#define NPH 12
#define MOE_FP8 1
#define REP_MASK 0
#define CONV_WGS 80
#define DRY_PROBE 0
#define EPI_SKIP_PROBE 0
#define CONV_SPLIT 900
#define P0_PARTS 7
#define LDS_LAYOUT 0
namespace cfg {
constexpr int D = 2048, NB = 2, S = 8192, NTOK = NB * S;
constexpr int HQ = 16, HKV = 2, HD = 64, QW = 1024;
constexpr int MH = 4, MDV = 256, MDK = 128, MQKW = 512, MVW = 1024, CL = 128, NC = S / CL;
constexpr int NE = 32, TOPK = 4, DFF = 2048, NPAIR = NTOK * TOPK;
constexpr int INW = 8456;
constexpr int OFF_AQ = 0, OFF_AK = 1024, OFF_AV = 1152, OFF_MQ = 1280, OFF_MK = 1792, OFF_MV = 2304, OFF_MO = 3328,
              OFF_MI = 4352, OFF_MF = 4356, OFF_GA = 4360, OFF_GM = 6408;
constexpr float EPS = 1e-6f;
constexpr int MOD_SH1 = 0, MOD_SC1 = 2048, MOD_GT1 = 4096, MOD_SH2 = 6144, MOD_SC2 = 8192, MOD_GT2 = 10240, MODW = 12288;
}
using namespace cfg;
__device__ __forceinline__ float silu_f(float x) { return x / (1.f + expf(-x)); }
__device__ __forceinline__ float sigmoid_f(float x) { return 1.f / (1.f + expf(-x)); }
__device__ __forceinline__ void rope_cs(int pos, int i, float& c, float& s) {
    const float invf[8] = {1.0f, 0.1939227432012558f, 0.03760603070259094f, 0.007292664609849453f,
                           0.0014142135623842478f, 0.00027424818836152554f, 5.3182957344688475e-05f, 1.0313385246263351e-05f};
    float f = i == 0 ? invf[0] : i == 1 ? invf[1] : i == 2 ? invf[2] : i == 3 ? invf[3] : i == 4 ? invf[4] : i == 5 ? invf[5] : i == 6 ? invf[6] : invf[7];
    float ang = (float)pos * f;
    double t = (double)ang * 0.15915494309189535;
    t -= rint(t);
    float tf = (float)t;
    s = __builtin_amdgcn_sinf(tf);
    c = __builtin_amdgcn_cosf(tf);
}
__device__ __forceinline__ float softcap_f(float z) { return 15.f * tanhf(z / 15.f); }
__device__ __forceinline__ float logsigmoid_f(float z) { return fminf(z, 0.f) - log1pf(expf(-fabsf(z))); }
#ifndef MOE_FP8
#define MOE_FP8 1
#endif
#ifndef CONV_WGS
#define CONV_WGS 80
#endif
#ifndef CONV_SPLIT
#define CONV_SPLIT 900
#endif
#ifndef LDS_LAYOUT
#define LDS_LAYOUT 0
#endif
#ifndef DRY_PROBE
#define DRY_PROBE 0
#endif
#ifndef EPI_SKIP_PROBE
#define EPI_SKIP_PROBE 0
#endif
#ifndef P0_PARTS
#define P0_PARTS 7
#endif
#ifndef REP_MASK
#define REP_MASK 0
#endif
#define GAS __attribute__((address_space(1)))
#define LAS __attribute__((address_space(3)))
typedef unsigned short bf16_t;
typedef short bf16x8 __attribute__((ext_vector_type(8)));
typedef short bf16x4 __attribute__((ext_vector_type(4)));
typedef float f32x4 __attribute__((ext_vector_type(4)));
typedef float f32x2 __attribute__((ext_vector_type(2)));
typedef unsigned u32x4 __attribute__((ext_vector_type(4)));
typedef unsigned u32x2 __attribute__((ext_vector_type(2)));
#define RLX_AGENT __ATOMIC_RELAXED, __HIP_MEMORY_SCOPE_AGENT
#define LDS_WAIT() asm volatile("s_waitcnt lgkmcnt(0)" ::: "memory")
#define VM_WAIT() asm volatile("s_waitcnt vmcnt(0)" ::: "memory")

__device__ __forceinline__ unsigned f2bf(float f) { unsigned u = __builtin_bit_cast(unsigned, f); return (u + 0x7fffu + ((u >> 16) & 1u)) >> 16; }
__device__ __forceinline__ unsigned pk2(float lo, float hi) { return f2bf(lo) | (f2bf(hi) << 16); }
__device__ __forceinline__ float bf2f(unsigned short h) { return __builtin_bit_cast(float, (unsigned)h << 16); }
__device__ __forceinline__ float bflo(unsigned w) { return __builtin_bit_cast(float, w << 16); }
__device__ __forceinline__ float bfhi(unsigned w) { return __builtin_bit_cast(float, w & 0xffff0000u); }
__device__ __forceinline__ unsigned pk4_fp8(float a, float b, float c, float d) {
    a = __builtin_amdgcn_fmed3f(a, -448.f, 448.f); b = __builtin_amdgcn_fmed3f(b, -448.f, 448.f); c = __builtin_amdgcn_fmed3f(c, -448.f, 448.f); d = __builtin_amdgcn_fmed3f(d, -448.f, 448.f);
    int r = __builtin_amdgcn_cvt_pk_fp8_f32(a, b, 0, false); r = __builtin_amdgcn_cvt_pk_fp8_f32(c, d, r, true); return (unsigned)r;
}
__device__ __forceinline__ unsigned pk4_fp8_nc(float a, float b, float c, float d) { int r = __builtin_amdgcn_cvt_pk_fp8_f32(a, b, 0, false); r = __builtin_amdgcn_cvt_pk_fp8_f32(c, d, r, true); return (unsigned)r; }
constexpr float YP8SCALE = 16.f;
constexpr float W8SCALE = 64.f, W8INV = 1.f / 64.f;
__device__ __forceinline__ void unpack8_fp8(const u32x2 v, float (&f)[8]) {
    const f32x2 a = __builtin_amdgcn_cvt_pk_f32_fp8((int)v.x, false), b = __builtin_amdgcn_cvt_pk_f32_fp8((int)v.x, true);
    const f32x2 c = __builtin_amdgcn_cvt_pk_f32_fp8((int)v.y, false), d = __builtin_amdgcn_cvt_pk_f32_fp8((int)v.y, true);
    f[0] = a.x; f[1] = a.y; f[2] = b.x; f[3] = b.y; f[4] = c.x; f[5] = c.y; f[6] = d.x; f[7] = d.y;
}
__device__ __forceinline__ float fast_sigmoid(float x) { return __builtin_amdgcn_rcpf(1.f + __builtin_amdgcn_exp2f(-1.4426950408889634f * x)); }

namespace fp {
constexpr int NW = 8, NT = NW * 64;
constexpr int NIN = 8448;
constexpr int PB_Q = 0, PB_K = 1024, PB_V = 1152, PB_MQ = 1280, PB_MK = 1792, PB_MV = 2304, PB_MO = 3328, PB_GA = 4352, PB_GM = 6400;
constexpr float QSCALE = 0.125f * 1.4426950408889634f;
constexpr float LOG2E = 1.4426950408889634f;
}

namespace wsf {
constexpr size_t AL(size_t x) { return (x + 255) & ~(size_t)255; }
constexpr size_t CTL = 0, CTL_BYTES = 1u << 20;
constexpr size_t MODP = CTL + CTL_BYTES;
constexpr size_t MOD = AL(MODP + (size_t)16 * 2 * MODW * 4);
constexpr size_t BINP = AL(MOD + (size_t)2 * MODW * 4);
constexpr size_t CS = AL(BINP + (size_t)fp::NIN * 4);
constexpr size_t WRT = AL(CS + (size_t)NTOK * 8 * 8);
constexpr size_t WIN_T = AL(WRT + (size_t)2 * 32 * 2048 * 2);
constexpr size_t WAP_T = AL(WIN_T + (size_t)fp::NIN * 2048 * 2);
constexpr size_t WMP_T = AL(WAP_T + (size_t)2048 * 1024 * 2);
constexpr size_t WOUT_T = AL(WMP_T + (size_t)2048 * 1024 * 2);
constexpr size_t WGU_T = AL(WOUT_T + (size_t)2048 * 2048 * 2);
#if MOE_FP8
constexpr size_t WDN_T = WGU_T;
constexpr size_t GATES = WGU_T;
#else
constexpr size_t WDN_T = AL(WGU_T + (size_t)32 * 4096 * 2048 * 2);
constexpr size_t GATES = AL(WDN_T + (size_t)32 * 2048 * 2048 * 2);
#endif
constexpr size_t BCUM = AL(GATES + (size_t)NTOK * 8 * 4);
constexpr size_t LOGI = AL(BCUM + (size_t)8 * S * 4);
constexpr size_t GSUM = AL(LOGI + (size_t)8 * S * 4);
constexpr size_t MLOC = AL(GSUM + 512 * 4);
constexpr size_t MPREV = AL(MLOC + 512 * 4);
constexpr size_t DN = AL(MPREV + 512 * 4);
constexpr size_t NPREV = AL(DN + (size_t)512 * 128 * 4);
constexpr size_t DCT = AL(NPREV + (size_t)512 * 128 * 4);
constexpr size_t Y = AL(DCT + (size_t)512 * 256 * 128 * 4);
constexpr size_t X1 = AL(Y + (size_t)NTOK * 2048 * 2);
constexpr size_t H2 = AL(X1 + (size_t)NTOK * 2048 * 4);
constexpr size_t TOPI = AL(H2 + (size_t)NTOK * 2048 * 2);
constexpr size_t TOPW = AL(TOPI + (size_t)NPAIR * 4);
constexpr size_t LIST = AL(TOPW + (size_t)NPAIR * 4);
constexpr size_t PROJB = AL(LIST + (size_t)NE * NPAIR * 4);
constexpr size_t ACT = PROJB;
constexpr size_t YPREG = AL(PROJB + (size_t)NTOK * fp::NIN * 2);
constexpr size_t H1 = YPREG;
constexpr size_t MG = AL(H1 + (size_t)NTOK * 2048 * 2);
constexpr size_t OAT = AL(MG + (size_t)NTOK * 2048 * 2);
constexpr size_t HM = AL(OAT + (size_t)NTOK * 1024 * 2);
constexpr size_t QC = AL(HM + (size_t)NTOK * 1024 * 2);
constexpr size_t KC = AL(QC + (size_t)NTOK * 512 * 2);
constexpr size_t CPT = AL(KC + (size_t)NTOK * 512 * 2);
constexpr size_t YP = YPREG;
constexpr size_t F8BASE = AL(CPT + (size_t)512 * 256 * 128 * 2) > AL(YP + (size_t)NPAIR * 2048 * 2) ? AL(CPT + (size_t)512 * 256 * 128 * 2) : AL(YP + (size_t)NPAIR * 2048 * 2);
constexpr size_t WGU8 = F8BASE;
constexpr size_t WDN8 = AL(WGU8 + (size_t)32 * 4096 * 2048);
constexpr size_t H2F8 = AL(WDN8 + (size_t)32 * 2048 * 2048);
constexpr size_t ACT8 = AL(H2F8 + (size_t)NTOK * 2048);
constexpr size_t END = AL(ACT8 + (size_t)NPAIR * 2048);
static_assert((size_t)NPAIR * 2048 * 2 <= (size_t)NTOK * fp::NIN * 2, "ACT fits over PROJB");
constexpr int CW_BAR = 4096;
constexpr int CW_CNT = 8192;
}

constexpr int RING_BYTES = 131072;
constexpr int LDS_TAB = RING_BYTES;
constexpr int LDS_MISC = RING_BYTES + 8192;
constexpr int LDS_BYTES = 147456;

#define XB_TMO      128
#define XB_XCNT(j)  (256  + 64 * (j))
#define XB_XSUB(j)  (1280 + 64 * (j))
#define XB_XGEN(j)  (2304 + 64 * (j))
#define XB_TOP      3328
#define XB_TOPGEN   3392
#define XCD_BAR_WORDS 3456
#define XB_SPIN_CAP (1u << 18)
__device__ __forceinline__ unsigned xb_ld(unsigned* p)              { return __hip_atomic_load(p, __ATOMIC_RELAXED, __HIP_MEMORY_SCOPE_AGENT); }
__device__ __forceinline__ unsigned xb_add(unsigned* p, unsigned v) { return __hip_atomic_fetch_add(p, v, __ATOMIC_RELAXED, __HIP_MEMORY_SCOPE_AGENT); }
__device__ __forceinline__ unsigned xb_xcc_id() { return (unsigned)__builtin_amdgcn_s_getreg((3 << 11) | 20) & 0xFu; }
#define XB_SPIN(cond, bar) do { unsigned _sp = 0; while (cond) { __builtin_amdgcn_s_sleep(1); \
    if ((++_sp & 255u) == 0u) { if (xb_ld(&(bar)[XB_TMO])) break; if (_sp > XB_SPIN_CAP) { atomicAdd(&(bar)[XB_TMO], 1u); break; } } } } while (0)
struct XcdBarrier { unsigned* bar; unsigned x; volatile LAS unsigned* st; };
__device__ __forceinline__ XcdBarrier xcd_barrier_post(unsigned* bar, volatile LAS unsigned* st, bool t0) {
    XcdBarrier b; b.bar = bar; b.x = xb_xcc_id(); b.st = st;
    if (t0) (void)xb_add(&bar[XB_XCNT(b.x)], 1u);
    return b;
}
__device__ __forceinline__ void xcd_barrier_complete(unsigned* bar, unsigned x, unsigned& nloc, unsigned& nx) {
    const unsigned G = gridDim.x * gridDim.y * gridDim.z;
    unsigned sum, cnt, mine, sp = 0u;
    for (;;) {
        sum = 0u; cnt = 0u; mine = 0u;
#pragma unroll
        for (unsigned j = 0; j < 16; ++j) { const unsigned c = xb_ld(&bar[XB_XCNT(j)]); sum += c; cnt += (c > 0u) ? 1u : 0u; mine = (j == x) ? c : mine; }
        if (sum == G) break;
        __builtin_amdgcn_s_sleep(1);
        if ((++sp & 255u) == 0u) { if (xb_ld(&bar[XB_TMO])) break; if (sp > XB_SPIN_CAP) { atomicAdd(&bar[XB_TMO], 1u); break; } }
    }
    nloc = mine > 0u ? mine : 1u; nx = cnt > 0u ? cnt : 1u;
}
__device__ __forceinline__ void xcd_barrier(const XcdBarrier& b, bool t0) {
    asm volatile("s_waitcnt vmcnt(0)" ::: "memory");
    __syncthreads();
    if (t0) {
        unsigned* bar = b.bar;
        __builtin_amdgcn_s_waitcnt(0);
        unsigned nloc = b.st[0], nx = b.st[1];
        if (nloc == 0u) { xcd_barrier_complete(bar, b.x, nloc, nx); b.st[0] = nloc; b.st[1] = nx; }
        const unsigned old = xb_add(&bar[XB_XSUB(b.x)], 1u);
        const unsigned gen = old / nloc;
        if (old + 1u == (gen + 1u) * nloc) {
            __builtin_amdgcn_fence(__ATOMIC_RELEASE, "agent");
            asm volatile("s_waitcnt vmcnt(0)" ::: "memory");
            const unsigned og = xb_add(&bar[XB_TOP], 1u);
            const unsigned tg = og / nx;
            if (og + 1u == (tg + 1u) * nx) xb_add(&bar[XB_TOPGEN], 1u);
            else XB_SPIN(xb_ld(&bar[XB_TOPGEN]) == tg, bar);
            __builtin_amdgcn_fence(__ATOMIC_ACQUIRE, "agent");
            xb_add(&bar[XB_XGEN(b.x)], 1u);
            asm volatile("s_waitcnt vmcnt(0)" ::: "memory");
        } else {
            XB_SPIN(xb_ld(&bar[XB_XGEN(b.x)]) == gen, bar);
            __builtin_amdgcn_fence(__ATOMIC_ACQUIRE, "agent");
            asm volatile("s_waitcnt vmcnt(0)" ::: "memory");
        }
    }
    __syncthreads();
}

namespace pg8 {
constexpr int BM = 256, BK = 64, HALF = 128, HTB = HALF * BK * 2, STAGE_BYTES = 8 * HTB, NXCD = 8, WGM = 8;
#if LDS_LAYOUT == 2
__host__ __device__ __forceinline__ int lds_byte(int r, int c) { const int st = (r >> 4) * 2 + (c >> 5), rr = r & 15, cc = c & 31; return st * 1024 + rr * 64 + ((((cc >> 3) ^ (rr >> 2)) & 3) << 4) + (cc & 7) * 2; }
__host__ __device__ __forceinline__ void stage_rc(int b, int& R, int& C) { const int st = b / 1024, sb = b % 1024, rr = sb / 64, pc = (sb % 64) / 16; R = (st >> 1) * 16 + rr; C = (st & 1) * 32 + (((pc ^ (rr >> 2)) & 3) << 3) + (sb % 16) / 2; }
#elif LDS_LAYOUT == 1
__host__ __device__ __forceinline__ int lds_byte(int r, int c) { const int st = (r >> 4) * 2 + (c >> 5), rr = r & 15, cc = c & 31; return st * 1024 + (cc >> 3) * 256 + rr * 16 + (cc & 7) * 2; }
__host__ __device__ __forceinline__ void stage_rc(int b, int& R, int& C) { const int st = b / 1024, sb = b % 1024; R = (st >> 1) * 16 + (sb % 256) / 16; C = (st & 1) * 32 + (sb / 256) * 8 + (sb % 16) / 2; }
#else
__host__ __device__ __forceinline__ int lds_byte(int r, int c) { const int st = (r >> 4) * 2 + (c >> 5), rr = r & 15, cc = c & 31, ob = rr * 64 + cc * 2; return st * 1024 + (ob ^ (((ob >> 9) & 1) << 5)); }
__host__ __device__ __forceinline__ void stage_rc(int b, int& R, int& C) { const int st = b / 1024, sb = b % 1024, swz = sb ^ (((sb >> 9) & 1) << 5); R = (st >> 1) * 16 + swz / 64; C = (st & 1) * 32 + (swz % 64) / 2; }
#endif
__host__ __device__ __forceinline__ int perm32(int rho) { const int n = rho >> 4, i = rho & 15; return 8 * (i >> 2) + 4 * n + (i & 3); }
typedef int v8i32_t __attribute__((ext_vector_type(8)));
template <bool F8> struct FragSel { typedef bf16x8 T; };
typedef short s16x16_t __attribute__((ext_vector_type(16)));
template <> struct FragSel<true> { typedef s16x16_t T; };
template <bool F8> __device__ __forceinline__ typename FragSel<F8>::T ld_frag(const LAS unsigned char* p) {
    if constexpr (F8) { const bf16x8 lo = *(const LAS bf16x8*)p, hi = *(const LAS bf16x8*)(p + 1024); return __builtin_shufflevector(lo, hi, 0, 1, 2, 3, 4, 5, 6, 7, 8, 9, 10, 11, 12, 13, 14, 15); }
    else return *(const LAS bf16x8*)p;
}
__device__ __forceinline__ f32x4 mma_frag(bf16x8 a, bf16x8 b, f32x4 c) { return __builtin_amdgcn_mfma_f32_16x16x32_bf16(a, b, c, 0, 0, 0); }
__device__ __forceinline__ f32x4 mma_frag(s16x16_t a, s16x16_t b, f32x4 c) {
    const v8i32_t av = __builtin_bit_cast(v8i32_t, a), bv = __builtin_bit_cast(v8i32_t, b);
    asm volatile("v_mfma_scale_f32_16x16x128_f8f6f4 %0, %1, %2, %0, %3, %3 op_sel_hi:[0,0,0]" : "+v"(c) : "v"(av), "v"(bv), "v"(0x7f7f7f7f));
    return c;
}
__device__ __forceinline__ unsigned cvt_pk_bf16(float lo, float hi) { unsigned r; asm volatile("v_cvt_pk_bf16_f32 %0, %1, %2" : "=v"(r) : "v"(lo), "v"(hi)); return r; }

__device__ __forceinline__ bool static_tile(int L, int nM, int nN, int& pm, int& pn) {
    const int nwg = nM * nN; if (L >= nwg) return false;
    int wgid = L; { const int q = nwg / NXCD, r = nwg % NXCD, xcd = wgid % NXCD, off = wgid / NXCD; wgid = (xcd < r ? xcd * (q + 1) : r * (q + 1) + (xcd - r) * q) + off; }
    const int nig = WGM * nN, gid = wgid / nig, fm = gid * WGM, gsz = (nM - fm) < WGM ? (nM - fm) : WGM;
    pm = fm + ((wgid % nig) % gsz); pn = (wgid % nig) / gsz; return true;
}

typedef int v8i32 __attribute__((ext_vector_type(8)));
template <class Epi, class Sched, bool FP8 = false, int PROBE = 0, bool MID = false>
__device__ __forceinline__ void gemm_phase(LAS unsigned char* lds, const Sched& S, const Epi& E) {
    typedef typename Sched::UnitT Unit;
    const int wid = S.wave, lane = (int)__builtin_amdgcn_mbcnt_hi(~0u, __builtin_amdgcn_mbcnt_lo(~0u, 0u)), tid = (wid << 6) | lane, wr = wid >> 2, wc = wid & 3, fr = lane & 15, fq = lane >> 4;
    const int K = S.K;
    int nt = K / BK; if constexpr (MID) nt = S.nt_total;
    int R[2], C[2];
    unsigned voffB[2];
#pragma unroll
    for (int i = 0; i < 2; ++i) { stage_rc(tid * 16 + i * 8192, R[i], C[i]); const int Rb = (R[i] & ~31) + perm32(R[i] & 31); voffB[i] = (unsigned)(Rb * K + C[i]) * 2u; }
    const unsigned kstep = (unsigned)(BK * 2);
    const unsigned hstepB = (unsigned)HALF * (unsigned)K * 2u;
    const unsigned ldsw = (unsigned)wid * 1024u;
    const int aoff = lds_byte(wr * 64 + fr, fq * 8), boff = lds_byte(wc * 32 + fr, fq * 8);
#define PG8_SA(b, h) (((b) * 2 + (h)) * HTB)
#define PG8_SB(b, h) ((4 + (b) * 2 + (h)) * HTB)
    const __amdgpu_buffer_rsrc_t rA = __builtin_amdgcn_make_buffer_rsrc((void*)S.a_buf(), 0, -1, 0x00020000), rB = __builtin_amdgcn_make_buffer_rsrc((void*)S.b_buf(), 0, -1, 0x00020000);
#define PG8_STAGE2(bufoff, rs, soff, o0, o1) do { \
        __builtin_amdgcn_raw_ptr_buffer_load_lds(rs, (LAS void*)(lds + (bufoff) + ldsw), 16, (int)(o0), (int)(soff), 0, 0); \
        __builtin_amdgcn_raw_ptr_buffer_load_lds(rs, (LAS void*)(lds + (bufoff) + ldsw + 8192), 16, (int)(o1), (int)(soff), 0, 0); } while (0)
#define PG8_STAGEA(bufoff, soff, o0, o1) PG8_STAGE2(bufoff, rA, soff, o0, o1)
#define PG8_STAGEB(bufoff, soff) PG8_STAGE2(bufoff, rB, soff, voffB[0], voffB[1])
    typedef typename pg8::FragSel<FP8>::T FragT;
    constexpr int NK = FP8 ? 1 : 2;
#define PG8_LDA(dst, b, h) do { if constexpr (PROBE == 4) break; _Pragma("unroll") for (int m = 0; m < 4; ++m) _Pragma("unroll") for (int k = 0; k < NK; ++k) dst[m][k] = pg8::ld_frag<FP8>(lds + PG8_SA(b, h) + aoff + m * 2048 + k * 1024); } while (0)
#define PG8_LDB(dst, b, h) do { if constexpr (PROBE == 4) break; _Pragma("unroll") for (int n = 0; n < 2; ++n) _Pragma("unroll") for (int k = 0; k < NK; ++k) dst[n][k] = pg8::ld_frag<FP8>(lds + PG8_SB(b, h) + boff + n * 2048 + k * 1024); } while (0)
#define PG8_MMA(ai, bj, At, Bt) do { if constexpr (PROBE == 3) break; __builtin_amdgcn_s_setprio(1); if constexpr (FP8) asm volatile("s_nop 1"); _Pragma("unroll") for (int m = 0; m < 4; ++m) _Pragma("unroll") for (int n = 0; n < 2; ++n) _Pragma("unroll") for (int k = 0; k < NK; ++k) \
        acc[ai][bj][m][n] = pg8::mma_frag(Bt[n][k], At[m][k], acc[ai][bj][m][n]); __builtin_amdgcn_s_setprio(0); } while (0)
#define PG8_WAIT_V(n) asm volatile("s_waitcnt vmcnt(" #n ")" ::: "memory")
#define PG8_WAIT_L(n) asm volatile("s_waitcnt lgkmcnt(" #n ")" ::: "memory")
#define PG8_BAR __builtin_amdgcn_s_barrier()
#define PG8_SCHED __builtin_amdgcn_sched_barrier(0)
    Unit cur, nxt; int ui = 0;
    if (!S.next(0, cur)) return;
    f32x4 acc[2][2][4][2];
#pragma unroll
    for (int a = 0; a < 2; ++a)
#pragma unroll
        for (int b = 0; b < 2; ++b)
#pragma unroll
            for (int m = 0; m < 4; ++m)
#pragma unroll
                for (int n = 0; n < 2; ++n) { float z0, z1, z2, z3; asm volatile("v_mov_b32 %0, 0\n\tv_mov_b32 %1, 0\n\tv_mov_b32 %2, 0\n\tv_mov_b32 %3, 0" : "=v"(z0), "=v"(z1), "=v"(z2), "=v"(z3)); acc[a][b][m][n] = (f32x4){z0, z1, z2, z3}; }
    FragT At[4][NK], B0[2][NK], B1[2][NK];
    if constexpr (PROBE == 4) { _Pragma("unroll") for (int m = 0; m < 4; ++m) _Pragma("unroll") for (int k = 0; k < NK; ++k) At[m][k] = FragT{}; _Pragma("unroll") for (int n = 0; n < 2; ++n) _Pragma("unroll") for (int k = 0; k < NK; ++k) { B0[n][k] = FragT{}; B1[n][k] = FragT{}; } }
    unsigned ca[4], na[4];
    S.a_offs(cur, R[0], R[1], C[0], C[1], ca);
    unsigned cA = (unsigned)__builtin_amdgcn_readfirstlane((int)S.a_soff(cur)), cB = (unsigned)__builtin_amdgcn_readfirstlane((int)S.b_soff(cur));
    PG8_STAGEB(PG8_SB(0, 0), cB); PG8_STAGEB(PG8_SB(0, 1), cB + hstepB); PG8_STAGEA(PG8_SA(0, 0), cA, ca[0], ca[1]); PG8_STAGEA(PG8_SA(0, 1), cA, ca[2], ca[3]);
    if (wr == 1) PG8_BAR;
    PG8_WAIT_V(2); PG8_BAR;
    PG8_STAGEB(PG8_SB(1, 0), cB + kstep); PG8_STAGEA(PG8_SA(1, 0), cA + kstep, ca[0], ca[1]); PG8_STAGEB(PG8_SB(1, 1), cB + hstepB + kstep);
    PG8_WAIT_V(6); PG8_BAR;
#define PG8_TRIP(a1, a2, b2, a3, b3, x0, x1, x2, x3) do { \
            PG8_LDB(B0, 0, 0); PG8_LDB(B1, 0, 1); PG8_SCHED; PG8_LDA(At, 0, 0); PG8_STAGEA(PG8_SA(1, 1), a1, ca[2], ca[3]); \
            PG8_WAIT_V(8); PG8_WAIT_L(0); PG8_BAR; PG8_MMA(0, 0, At, B0); PG8_MMA(0, 1, At, B1); PG8_BAR; PG8_SCHED; \
            PG8_LDA(At, 0, 1); PG8_STAGEB(PG8_SB(0, 0), b2); PG8_STAGEB(PG8_SB(0, 1), (b2) + hstepB); PG8_STAGEA(PG8_SA(0, 0), a2, x0, x1); \
            PG8_WAIT_V(8); PG8_WAIT_L(0); PG8_BAR; if constexpr (PROBE != 1) { PG8_MMA(1, 0, At, B0); PG8_MMA(1, 1, At, B1); } PG8_BAR; PG8_SCHED; \
            PG8_LDB(B0, 1, 0); PG8_LDB(B1, 1, 1); PG8_SCHED; PG8_LDA(At, 1, 0); PG8_STAGEA(PG8_SA(0, 1), a2, x2, x3); \
            PG8_WAIT_V(8); PG8_WAIT_L(0); PG8_BAR; PG8_MMA(0, 0, At, B0); PG8_MMA(0, 1, At, B1); PG8_BAR; PG8_SCHED; \
            PG8_LDA(At, 1, 1); PG8_STAGEB(PG8_SB(1, 0), b3); PG8_STAGEB(PG8_SB(1, 1), (b3) + hstepB); PG8_STAGEA(PG8_SA(1, 0), a3, x0, x1); \
            PG8_WAIT_V(8); PG8_WAIT_L(0); PG8_BAR; if constexpr (PROBE != 1) { PG8_MMA(1, 0, At, B0); PG8_MMA(1, 1, At, B1); } PG8_BAR; PG8_SCHED; } while (0)
    for (;;) {
        const bool has_next = S.next(ui + 1, nxt);
        unsigned nA = cA, nB = cB;
#pragma unroll
        for (int i = 0; i < 4; ++i) na[i] = ca[i];
        if (has_next) { nA = (unsigned)__builtin_amdgcn_readfirstlane((int)S.a_soff(nxt)); nB = (unsigned)__builtin_amdgcn_readfirstlane((int)S.b_soff(nxt)); S.a_offs(nxt, R[0], R[1], C[0], C[1], na); }
        for (int t = 0; t < nt; t += 2) {
            const bool last = (t == nt - 2);
            unsigned ja1 = 0u, ja2 = 0u, jb2 = 0u;
            if constexpr (MID) { if (t == S.ntf) E.mid(acc, cur, wr, wc, fr, fq); if (t >= S.ntf) ja1 = S.a_jump; if (t + 2 >= S.ntf) { ja2 = S.a_jump; jb2 = S.b_jump; } }
            const unsigned a1 = cA + (unsigned)(t + 1) * kstep + ja1;
            const unsigned a2 = last ? nA : cA + (unsigned)(t + 2) * kstep + ja2, b2 = last ? nB : cB + (unsigned)(t + 2) * kstep + jb2;
            const unsigned x0 = last ? na[0] : ca[0], x1 = last ? na[1] : ca[1], x2 = last ? na[2] : ca[2], x3 = last ? na[3] : ca[3];
            PG8_TRIP(a1, a2, b2, a2 + kstep, b2 + kstep, x0, x1, x2, x3);
        }
        if (wr == 0) PG8_BAR;
        if constexpr (FP8) asm volatile("s_nop 15\n\ts_nop 15" ::: "memory");
        E(acc, cur, wr, wc, fr, fq);
        if (!has_next) break;
#pragma unroll
        for (int a = 0; a < 2; ++a)
#pragma unroll
            for (int b = 0; b < 2; ++b)
#pragma unroll
                for (int m = 0; m < 4; ++m)
#pragma unroll
                    for (int n = 0; n < 2; ++n) { float z0, z1, z2, z3; asm volatile("v_mov_b32 %0, 0\n\tv_mov_b32 %1, 0\n\tv_mov_b32 %2, 0\n\tv_mov_b32 %3, 0" : "=v"(z0), "=v"(z1), "=v"(z2), "=v"(z3)); acc[a][b][m][n] = (f32x4){z0, z1, z2, z3}; }
        cur = nxt; cA = nA; cB = nB; ++ui;
#pragma unroll
        for (int i = 0; i < 4; ++i) ca[i] = na[i];
        if (wr == 1) PG8_BAR;
    }
    PG8_WAIT_V(0);
    PG8_BAR;
#undef PG8_SA
#undef PG8_SB
#undef PG8_TRIP
#undef PG8_STAGE2
#undef PG8_STAGEA
#undef PG8_STAGEB
#undef PG8_LDA
#undef PG8_LDB
#undef PG8_MMA
#undef PG8_WAIT_V
#undef PG8_WAIT_L
#undef PG8_BAR
#undef PG8_SCHED
}
}

struct DenseUnit { int pm, pn; };
struct DenseSched {
    typedef DenseUnit UnitT;
    const bf16_t* A; const bf16_t* Bt; int lda; int K; int nM, nN, G, c, wave;
    __device__ __forceinline__ bool next(int i, DenseUnit& u) const { return pg8::static_tile(i * G + c, nM, nN, u.pm, u.pn); }
    __device__ __forceinline__ const void* a_buf() const { return A; }
    __device__ __forceinline__ const void* b_buf() const { return Bt; }
    __device__ __forceinline__ unsigned a_soff(const DenseUnit& u) const { return (unsigned)u.pm * 256u * (unsigned)lda * 2u; }
    __device__ __forceinline__ unsigned b_soff(const DenseUnit& u) const { return (unsigned)u.pn * 256u * (unsigned)K * 2u; }
    __device__ __forceinline__ void a_offs(const DenseUnit&, int R0, int R1, int C0, int C1, unsigned (&o)[4]) const {
        o[0] = (unsigned)(R0 * lda + C0) * 2u; o[1] = (unsigned)(R1 * lda + C1) * 2u; o[2] = (unsigned)((R0 + 128) * lda + C0) * 2u; o[3] = (unsigned)((R1 + 128) * lda + C1) * 2u;
    }
};
struct MkArgs {
    const float* x; const float* c; const int* positions; const float* w_ada; const float* b_ada;
    const float* g_pre_mix; const float* g_post_mix; const float* g_pre_ffn; const float* g_post_ffn;
    const float* w_in; const float* b_in; const float* conv_qk; const float* sinks; const float* g_mlstm;
    const float* w_attn_proj; const float* w_mlstm_proj; const float* w_out; const float* w_router; const float* b_router;
    const float* w_gate_up; const float* b_gate_up; const float* w_down; const float* b_down;
    float* out; unsigned char* ws;
    const int* route_i; const float* route_w;
    int ph_lo, ph_hi;
};

struct Frame {
    LAS unsigned char* lds;
    int G, bid, vcu, wave;
};
__device__ __forceinline__ int lane_id() { return (int)__builtin_amdgcn_mbcnt_hi(~0u, __builtin_amdgcn_mbcnt_lo(~0u, 0u)); }
__device__ __forceinline__ int fresh_tid(const Frame& F) { return (F.wave << 6) | lane_id(); }

__device__ __forceinline__ float wave_sum_f(float v) {
#pragma unroll
    for (int o = 1; o < 64; o <<= 1) v += __shfl_xor(v, o);
    return v;
}
__device__ __forceinline__ float wave_max_f(float v) {
#pragma unroll
    for (int o = 1; o < 64; o <<= 1) v = fmaxf(v, __shfl_xor(v, o));
    return v;
}

__device__ __forceinline__ int in_src_col(int n) {
    if (n < 1152) { const int d = n & 63; if (d < 16) return (n & ~63) + (d >> 1) + 8 * (d & 1); return n; }
    if (n < 4352) return n;
    return n + 8;
}

template <bool MAP>
__device__ __forceinline__ void p0_transpose_item(const float* __restrict__ W, int K, int N, bf16_t* WT, LAS float* scr, int kb, int nb, int lane) {
    const int k0 = 64 * kb, n0 = 32 * nb;
    const int sc = MAP ? in_src_col(n0 + (lane & 31)) : n0 + (lane & 31);
#pragma unroll 8
    for (int i = 0; i < 32; ++i) { const int kk = 2 * i + (lane >> 5); scr[kk * 33 + (lane & 31)] = W[(size_t)(k0 + kk) * N + sc]; }
    LDS_WAIT(); asm volatile("" ::: "memory");
    const int c = lane & 7;
#pragma unroll
    for (int j = 0; j < 4; ++j) { const int n = (lane >> 3) + 8 * j; const LAS float* s = scr + (8 * c) * 33 + n;
        u32x4 o; o.x = pk2(s[0 * 33], s[1 * 33]); o.y = pk2(s[2 * 33], s[3 * 33]); o.z = pk2(s[4 * 33], s[5 * 33]); o.w = pk2(s[6 * 33], s[7 * 33]);
        *(u32x4*)(WT + (size_t)(n0 + n) * K + k0 + 8 * c) = o; }
    LDS_WAIT(); asm volatile("" ::: "memory");
}

struct ConvItem { const float* src; unsigned char* dst; };
__device__ __forceinline__ ConvItem conv_item_addr(const MkArgs& a, int it, int lane, int& N) {
    constexpr int KB = 2048 / 128, I_GU = KB * (4096 / 32), I_DN = KB * (2048 / 32);
    const float* W; unsigned char* WT; int q, NB;
    if (it < NE * I_GU) { const int e = it / I_GU; q = it % I_GU; N = 4096; NB = 128; W = a.w_gate_up + (size_t)e * 2048 * 4096; WT = a.ws + wsf::WGU8 + (size_t)e * 4096 * 2048; }
    else { const int r = it - NE * I_GU, e = r / I_DN; q = r % I_DN; N = 2048; NB = 64; W = a.w_down + (size_t)e * 2048 * 2048; WT = a.ws + wsf::WDN8 + (size_t)e * 2048 * 2048; }
    const int k0 = 128 * (q / NB), n0 = 32 * (q % NB);
    ConvItem c; c.src = W + (size_t)(k0 + (lane >> 3)) * N + n0 + (lane & 7) * 4; c.dst = WT + (size_t)(n0 + (lane >> 3)) * 2048 + k0 + 16 * (lane & 7);
    return c;
}
__device__ __forceinline__ void conv_item_load(const ConvItem& c, int N, f32x4 (&v)[16]) {
#pragma unroll
    for (int i = 0; i < 16; ++i) v[i] = __builtin_nontemporal_load((const f32x4*)(c.src + (size_t)(8 * i) * N));
}
__device__ __forceinline__ void conv_item_store(const ConvItem& c, const f32x4 (&v)[16], LAS float* scr, int lane, bool dry = false) {
    const int kr = lane >> 3, n4 = (lane & 7) * 4;
#pragma unroll
    for (int i = 0; i < 16; ++i) { const int k = 8 * i + kr, rot = 20 * (i >> 1); LAS float* row = scr + k * 33;
        row[(n4 + 0 + rot) & 31] = v[i].x; row[(n4 + 1 + rot) & 31] = v[i].y; row[(n4 + 2 + rot) & 31] = v[i].z; row[(n4 + 3 + rot) & 31] = v[i].w; }
    LDS_WAIT(); asm volatile("" ::: "memory");
    const int cblk = lane & 7;
#pragma unroll
    for (int j = 0; j < 4; ++j) {
        const int n = (lane >> 3) + 8 * j;
        const LAS float* sp = scr + (16 * cblk) * 33 + ((n + 20 * cblk) & 31);
        u32x4 o;
        o.x = pk4_fp8(sp[0 * 33] * W8SCALE, sp[1 * 33] * W8SCALE, sp[2 * 33] * W8SCALE, sp[3 * 33] * W8SCALE);
        o.y = pk4_fp8(sp[4 * 33] * W8SCALE, sp[5 * 33] * W8SCALE, sp[6 * 33] * W8SCALE, sp[7 * 33] * W8SCALE);
        o.z = pk4_fp8(sp[8 * 33] * W8SCALE, sp[9 * 33] * W8SCALE, sp[10 * 33] * W8SCALE, sp[11 * 33] * W8SCALE);
        o.w = pk4_fp8(sp[12 * 33] * W8SCALE, sp[13 * 33] * W8SCALE, sp[14 * 33] * W8SCALE, sp[15 * 33] * W8SCALE);
        if (!dry) *(u32x4*)(c.dst + (size_t)(8 * j) * 2048) = o; else asm volatile("" :: "v"(o.x), "v"(o.y), "v"(o.z), "v"(o.w));
    }
    LDS_WAIT(); asm volatile("" ::: "memory");
}
__device__ __forceinline__ void moe_convert(const MkArgs& a, Frame& F, int widx, int nw, bool dry = false, int it0 = 0, int it1 = -1) {
    const int lane = lane_id();
    LAS float* scr = (LAS float*)(F.lds + F.wave * 16896);
    constexpr int NIT_ALL = NE * ((2048 / 128) * (4096 / 32) + (2048 / 128) * (2048 / 32));
    const int NIT = it1 < 0 ? NIT_ALL : it1;
    widx += it0;
    if (widx >= NIT) return;
    f32x4 va[16], vb[16]; int Na, Nb;
    ConvItem ca = conv_item_addr(a, widx, lane, Na), cb;
    conv_item_load(ca, Na, va);
    for (int it = widx; it < NIT; it += 2 * nw) {
        const int i1 = it + nw, i2 = it + 2 * nw;
        cb = conv_item_addr(a, i1 < NIT ? i1 : NIT - 1, lane, Nb); conv_item_load(cb, Nb, vb);
        conv_item_store(ca, va, scr, lane, dry);
        if (i1 >= NIT) break;
        ca = conv_item_addr(a, i2 < NIT ? i2 : NIT - 1, lane, Na); conv_item_load(ca, Na, va);
        conv_item_store(cb, vb, scr, lane, dry);
    }
}
__device__ __forceinline__ int n_conv_wgs(int G) { return G == 256 ? CONV_WGS : 0; }

struct TrItem { const float* src; bf16_t* dst; int N, perm; };
__device__ __forceinline__ TrItem tr_item_addr(const MkArgs& a, int it, int lane) {
    constexpr int I_IN = 32 * (fp::NIN / 32), I_AP = 16 * 64, I_MP = 16 * 64;
    const float* W; bf16_t* WT; int K, N, nblk, r = it, perm = 0, shift = 0;
    unsigned char* ws = a.ws;
    if (r < I_IN) { W = a.w_in; WT = (bf16_t*)(ws + wsf::WIN_T); K = 2048; N = INW; nblk = fp::NIN / 32; }
    else if ((r -= I_IN) < I_AP) { W = a.w_attn_proj; WT = (bf16_t*)(ws + wsf::WAP_T); K = 1024; N = 2048; nblk = 64; }
    else if ((r -= I_AP) < I_MP) { W = a.w_mlstm_proj; WT = (bf16_t*)(ws + wsf::WMP_T); K = 1024; N = 2048; nblk = 64; }
    else { r -= I_MP; W = a.w_out; WT = (bf16_t*)(ws + wsf::WOUT_T); K = 2048; N = 2048; nblk = 64; }
    const int kb = r / nblk, nb = r % nblk, k0 = 64 * kb, n0 = 32 * nb;
    if (it < I_IN) { perm = (n0 < 1152 && (n0 & 32) == 0) ? 1 : 0; shift = n0 >= 4352 ? 8 : 0; }
    TrItem t; t.src = W + (size_t)(k0 + (lane >> 3)) * N + n0 + shift + (lane & 7) * 4; t.dst = WT + (size_t)(n0 + (lane >> 3)) * K + k0 + 8 * (lane & 7); t.N = N; t.perm = perm | (K << 1);
    return t;
}
__device__ __forceinline__ void tr_item_load(const TrItem& t, f32x4 (&v)[8]) {
#pragma unroll
    for (int i = 0; i < 8; ++i) v[i] = *(const f32x4*)(t.src + (size_t)(8 * i) * t.N);
}
__device__ __forceinline__ void tr_item_store(const TrItem& t, const f32x4 (&v)[8], LAS float* scr, int lane) {
    const int kr = lane >> 3, n4 = (lane & 7) * 4, K = t.perm >> 1;
#pragma unroll
    for (int i = 0; i < 8; ++i) { const int k = 8 * i + kr, rot = 4 * (i >> 2); LAS float* row = scr + k * 33 + ((n4 + rot) & 31);
        row[0] = v[i].x; row[1] = v[i].y; row[2] = v[i].z; row[3] = v[i].w; }
    LDS_WAIT(); asm volatile("" ::: "memory");
    const int cb = lane & 7;
#pragma unroll
    for (int j = 0; j < 4; ++j) {
        const int n = (lane >> 3) + 8 * j;
        int c = n; if ((t.perm & 1) && n < 16) c = (n >> 1) + 8 * (n & 1);
        const LAS float* sp = scr + (8 * cb) * 33 + ((c + 4 * (cb >> 2)) & 31);
        u32x4 o; o.x = pk2(sp[0 * 33], sp[1 * 33]); o.y = pk2(sp[2 * 33], sp[3 * 33]); o.z = pk2(sp[4 * 33], sp[5 * 33]); o.w = pk2(sp[6 * 33], sp[7 * 33]);
        *(u32x4*)(t.dst + (size_t)(8 * j) * K) = o;
    }
    LDS_WAIT(); asm volatile("" ::: "memory");
}

__device__ __forceinline__ void ada_gemv(const MkArgs& a, Frame& F, int blk_lo, int blk_hi) {
    const int f_tid = fresh_tid(F), f_lane = f_tid & 63, f_wave = F.wave;
    LAS float* sc = (LAS float*)F.lds;
    LAS float* red = sc + 4096;
    if (blk_lo + F.vcu >= blk_hi) return;
    for (int i = f_tid; i < 2 * D; i += fp::NT) sc[i] = silu_f(a.c[i]);
    __syncthreads();
    for (int cblk = blk_lo + F.vcu; cblk < blk_hi; cblk += F.G) {
        const float* wp = a.w_ada + (size_t)(f_wave * 256) * MODW + cblk * 64 + f_lane;
        float a0 = 0.f, a1 = 0.f;
#pragma unroll 32
        for (int k = 0; k < 256; ++k) { const float w = wp[(size_t)k * MODW]; a0 += w * sc[f_wave * 256 + k]; a1 += w * sc[2048 + f_wave * 256 + k]; }
        red[(f_wave * 2 + 0) * 64 + f_lane] = a0; red[(f_wave * 2 + 1) * 64 + f_lane] = a1;
        __syncthreads();
        if (f_tid < 128) { const int b = f_tid >> 6, j = f_tid & 63; float sum = a.b_ada[cblk * 64 + j];
#pragma unroll
          for (int w8 = 0; w8 < 8; ++w8) sum += red[(w8 * 2 + b) * 64 + j];
          ((float*)(a.ws + wsf::MOD))[b * MODW + cblk * 64 + j] = sum; }
        __syncthreads();
    }
}

__device__ __forceinline__ void phase0(const MkArgs& a, Frame& F, int parts = 7) {
    const int f_tid = fresh_tid(F), f_lane = f_tid & 63, f_wave = F.wave;
    unsigned char* ws = a.ws;
    const int gw = F.vcu * fp::NW + f_wave, NGW = F.G * fp::NW;
    if (parts & 1) {
        LAS float* scr = (LAS float*)(F.lds + f_wave * 8448);
        constexpr int NITEMS = 32 * (fp::NIN / 32) + 16 * 64 + 16 * 64 + 32 * 64;
        if (gw < NITEMS) {
            f32x4 va[8], vb[8];
            TrItem ta = tr_item_addr(a, gw, f_lane), tb;
            tr_item_load(ta, va);
            for (int it = gw; it < NITEMS; it += 2 * NGW) {
                const int i1 = it + NGW, i2 = it + 2 * NGW;
                tb = tr_item_addr(a, i1 < NITEMS ? i1 : NITEMS - 1, f_lane); tr_item_load(tb, vb);
                tr_item_store(ta, va, scr, f_lane);
                if (i1 >= NITEMS) break;
                ta = tr_item_addr(a, i2 < NITEMS ? i2 : NITEMS - 1, f_lane); tr_item_load(ta, va);
                tr_item_store(tb, vb, scr, f_lane);
            }
        }
    }
#if MOE_FP8
    __syncthreads();
    if (n_conv_wgs(F.G) == 0) moe_convert(a, F, gw, NGW);
#if DRY_PROBE
    moe_convert(a, F, gw, NGW, true);
#endif
#endif
    __syncthreads();
    if (parts & 2) ada_gemv(a, F, 0, 4096 / 64);
    if (!(parts & 4)) return;
    const int gt = F.vcu * fp::NT + f_tid, NGT = F.G * fp::NT;
    for (int i = gt; i < NTOK * 8; i += NGT) { float cs, sn; rope_cs(a.positions[i >> 3], i & 7, cs, sn); ((f32x2*)(ws + wsf::CS))[i] = (f32x2){cs, sn}; }
    for (int i = gt; i < fp::NIN; i += NGT) ((float*)(ws + wsf::BINP))[i] = a.b_in[in_src_col(i)];
    for (int i = gt; i < 32 * 2048; i += NGT) {
        const int e = i >> 11, k = i & 2047; const float w = a.w_router[k * 32 + e]; const unsigned hi = f2bf(w); const float rem = w - __builtin_bit_cast(float, hi << 16);
        ((bf16_t*)(ws + wsf::WRT))[i] = (bf16_t)hi; ((bf16_t*)(ws + wsf::WRT))[32 * 2048 + i] = (bf16_t)f2bf(rem);
    }
}

__device__ __forceinline__ void phase1(const MkArgs& a, Frame& F) {
    const int f_tid = fresh_tid(F), f_lane = f_tid & 63, f_wave = F.wave;
    unsigned char* ws = a.ws;
    const float* mod = (const float*)(ws + wsf::MOD);
    LAS float* lmod = (LAS float*)F.lds;
    LAS float* wg = (LAS float*)(F.lds + 32768);
    for (int i = f_tid; i < 2048 * 8; i += fp::NT) wg[(i & 7) * 2048 + (i >> 3)] = a.w_in[(size_t)(i >> 3) * INW + OFF_MI + (i & 7)];
    for (int blk = F.vcu; blk < NTOK / 64; blk += F.G) {
        const int b = (blk * 64) / S;
        __syncthreads();
        for (int i = f_tid; i < 4096; i += fp::NT) lmod[i] = mod[b * MODW + i];
        __syncthreads();
#pragma unroll 1
        for (int rr = 0; rr < 8; ++rr) {
            const int m = blk * 64 + f_wave * 8 + rr;
            const GAS f32x4* xr = (const GAS f32x4*)(a.x + (size_t)m * D);
            f32x4 xv[8]; float ss = 0.f;
#pragma unroll
            for (int j = 0; j < 8; ++j) { xv[j] = xr[64 * j + f_lane]; ss += (xv[j].x * xv[j].x + xv[j].y * xv[j].y) + (xv[j].z * xv[j].z + xv[j].w * xv[j].w); }
            const float r = rsqrtf(wave_sum_f(ss) * (1.f / D) + EPS);
            float g8[8];
#pragma unroll
            for (int e = 0; e < 8; ++e) g8[e] = 0.f;
            GAS u32x2* o8 = (GAS u32x2*)(ws + wsf::H1 + (size_t)m * D * 2);
#pragma unroll
            for (int j = 0; j < 8; ++j) {
                const int c0 = 4 * (64 * j + f_lane);
                const f32x4 v = xv[j];
                const f32x4 g = *(const f32x4*)(a.g_pre_mix + c0);
                const f32x4 sh = *(const LAS f32x4*)(lmod + c0), sc = *(const LAS f32x4*)(lmod + 2048 + c0);
                f32x4 h;
                h.x = v.x * r * g.x * (1.f + sc.x) + sh.x; h.y = v.y * r * g.y * (1.f + sc.y) + sh.y;
                h.z = v.z * r * g.z * (1.f + sc.z) + sh.z; h.w = v.w * r * g.w * (1.f + sc.w) + sh.w;
                o8[64 * j + f_lane] = (u32x2){pg8::cvt_pk_bf16(h.x, h.y), pg8::cvt_pk_bf16(h.z, h.w)};
#pragma unroll
                for (int e = 0; e < 8; ++e) { const f32x4 w = *(const LAS f32x4*)(wg + e * 2048 + c0); g8[e] += (h.x * w.x + h.y * w.y) + (h.z * w.z + h.w * w.w); }
            }
            float mine = 0.f;
#pragma unroll
            for (int e = 0; e < 8; ++e) { const float s8 = wave_sum_f(g8[e]); if (f_lane == e) mine = s8; }
            if (f_lane < 8) ((float*)(ws + wsf::GATES))[(size_t)m * 8 + f_lane] = mine + a.b_in[OFF_MI + f_lane];
        }
    }
}

struct EpiIn {
    bf16_t* O; const float* bias; const f32x2* cs;
    __device__ __forceinline__ void operator()(const f32x4 (&acc)[2][2][4][2], const DenseUnit& u, int wr, int wc, int fr, int fq) const {
        const int row0 = u.pm * 256 + wr * 64 + fr, col0 = u.pn * 256 + wc * 32 + 8 * fq;
        const int pn = u.pn;
        const bool ropelane = ((wc & 1) == 0) && fq < 2;
        const int i0 = fq * 4;
        f32x4 bv[2][2];
#pragma unroll
        for (int bj = 0; bj < 2; ++bj)
#pragma unroll
            for (int n = 0; n < 2; ++n) bv[bj][n] = *(const f32x4*)(bias + col0 + bj * 128 + 4 * n);
#pragma unroll
        for (int ai = 0; ai < 2; ++ai)
#pragma unroll
            for (int m = 0; m < 4; ++m) {
                const int row = row0 + ai * 128 + m * 16;
                bf16_t* rowp = O + (size_t)row * fp::NIN + col0;
#pragma unroll
                for (int bj = 0; bj < 2; ++bj) {
                    f32x4 v0 = acc[ai][bj][m][0] + bv[bj][0], v1 = acc[ai][bj][m][1] + bv[bj][1];
                    if (pn < 4 || (pn == 4 && bj == 0)) {
                        if (ropelane) {
                            const f32x4 ca = *(const f32x4*)(cs + (size_t)row * 8 + i0), cb = *(const f32x4*)(cs + (size_t)row * 8 + i0 + 2);
                            f32x4 r0, r1;
                            r0.x = v0.x * ca.x - v0.y * ca.y; r0.y = v0.y * ca.x + v0.x * ca.y;
                            r0.z = v0.z * ca.z - v0.w * ca.w; r0.w = v0.w * ca.z + v0.z * ca.w;
                            r1.x = v1.x * cb.x - v1.y * cb.y; r1.y = v1.y * cb.x + v1.x * cb.y;
                            r1.z = v1.z * cb.z - v1.w * cb.w; r1.w = v1.w * cb.z + v1.z * cb.w;
                            v0 = r0; v1 = r1;
                        }
                        if (pn < 4) { v0 = v0 * fp::QSCALE; v1 = v1 * fp::QSCALE; }
                    } else if (pn >= 13) {
#pragma unroll
                        for (int q = 0; q < 4; ++q) { v0[q] = fast_sigmoid(v0[q]); v1[q] = fast_sigmoid(v1[q]); }
                    }
                    u32x4 w; w.x = pg8::cvt_pk_bf16(v0[0], v0[1]); w.y = pg8::cvt_pk_bf16(v0[2], v0[3]); w.z = pg8::cvt_pk_bf16(v1[0], v1[1]); w.w = pg8::cvt_pk_bf16(v1[2], v1[3]);
                    *(u32x4*)(rowp + bj * 128) = w;
                }
            }
    }
};

__device__ __forceinline__ void phase2(const MkArgs& a, Frame& F) {
    const int f_tid = fresh_tid(F), f_lane = f_tid & 63, f_wave = F.wave;
    unsigned char* ws = a.ws;
#if MOE_FP8
    const int ncv = n_conv_wgs(F.G), Gg = F.G - ncv;
    constexpr int NIT_ALL = NE * ((2048 / 128) * (4096 / 32) + (2048 / 128) * (2048 / 32));
    const int nsplit = ncv > 0 ? (int)((long)NIT_ALL * CONV_SPLIT / 1024) : NIT_ALL;
    if (F.bid >= Gg) { moe_convert(a, F, (F.bid - Gg) * fp::NW + F.wave, ncv * fp::NW, false, 0, nsplit);
#if DRY_PROBE == 2
        moe_convert(a, F, (F.bid - Gg) * fp::NW + F.wave, ncv * fp::NW, true);
#endif
        return; }
#else
    const int Gg = F.G;
#endif
    DenseSched S{(const bf16_t*)(ws + wsf::H1), (const bf16_t*)(ws + wsf::WIN_T), 2048, 2048, NTOK / 256, fp::NIN / 256, Gg, F.bid, F.wave};
    EpiIn E{(bf16_t*)(ws + wsf::PROJB), (const float*)(ws + wsf::BINP), (const f32x2*)(ws + wsf::CS)};
    pg8::gemm_phase<EpiIn, DenseSched>(F.lds, S, E);
#if MOE_FP8
    if (ncv > 0 && nsplit < NIT_ALL) { __syncthreads(); moe_convert(a, F, F.bid * fp::NW + F.wave, Gg * fp::NW, false, nsplit, NIT_ALL); }
#endif
}
__device__ __forceinline__ f32x4 mfma16(bf16x8 a, bf16x8 b, f32x4 c) { return __builtin_amdgcn_mfma_f32_16x16x32_bf16(a, b, c, 0, 0, 0); }
__device__ __forceinline__ float exp2_fast(float x) { return __builtin_amdgcn_exp2f(x); }
typedef short v4i16_t __attribute__((ext_vector_type(4)));
__device__ __forceinline__ bf16x8 tr_frag(const LAS bf16_t* base, int stride, int lane) {
    const LAS bf16_t* p = base + (8 * (lane >> 4) + ((lane & 15) >> 2)) * stride + 4 * (lane & 3);
    const v4i16_t lo = __builtin_amdgcn_ds_read_tr16_b64_v4i16((LAS v4i16_t*)p), hi = __builtin_amdgcn_ds_read_tr16_b64_v4i16((LAS v4i16_t*)(p + 4 * stride));
    return __builtin_shufflevector(lo, hi, 0, 1, 2, 3, 4, 5, 6, 7);
}

__device__ __forceinline__ void attn_unit(const MkArgs& a, Frame& F, int unit) {
    const int f_tid = fresh_tid(F), f_lane = f_tid & 63, f_wave = F.wave;
    const int b = unit >> 7, hk = (unit >> 6) & 1, n = unit & 63;
    const bf16_t* PB = (const bf16_t*)(a.ws + wsf::PROJB);
    bf16_t* OA = (bf16_t*)(a.ws + wsf::OAT);
    const size_t tok0 = (size_t)b * S + (size_t)n * 128;
    LAS bf16_t* Ks = (LAS bf16_t*)F.lds;
    LAS bf16_t* Vs = (LAS bf16_t*)(F.lds + 36864);
    LAS bf16_t* Pw = (LAS bf16_t*)(F.lds + 36864 + 39168 + f_wave * 5376);
#pragma unroll
    for (int i = 0; i < 4; ++i) {
        const int q = f_tid + 512 * i, row = q >> 3, ch = q & 7;
        u32x4 kv = (u32x4){0u, 0u, 0u, 0u}, vv = kv;
        if (n > 0 || row >= 128) {
            const bf16_t* src = PB + (tok0 - 128 + row) * fp::NIN + hk * 64 + ch * 8;
            kv = *(const u32x4*)(src + fp::PB_K); vv = *(const u32x4*)(src + fp::PB_V);
        }
        *(LAS u32x4*)(Ks + row * 72 + ch * 8) = kv;
        *(LAS u32x4*)(Vs + row * 72 + ch * 8) = vv;
    }
    if (f_tid < 128) *(LAS u32x4*)(Vs + (256 + (f_tid >> 3)) * 72 + (f_tid & 7) * 8) = (u32x4){0u, 0u, 0u, 0u};
    __syncthreads();
    const int c16 = f_lane & 15, grp = f_lane >> 4, h = hk * 8 + f_wave;
    const float sink2 = a.sinks[h] * fp::LOG2E;
    bf16x8 qn[2];
#pragma unroll
    for (int ks = 0; ks < 2; ++ks) qn[ks] = *(const bf16x8*)(PB + (tok0 + c16) * fp::NIN + fp::PB_Q + h * 64 + ks * 32 + grp * 8);
#pragma unroll 1
    for (int tt = 0; tt < 8; ++tt) {
        const size_t qtok = tok0 + tt * 16 + c16;
        bf16x8 qf[2];
        { const size_t ntok = tok0 + (tt < 7 ? tt + 1 : 7) * 16 + c16;
#pragma unroll
          for (int ks = 0; ks < 2; ++ks) { qf[ks] = qn[ks]; qn[ks] = *(const bf16x8*)(PB + ntok * fp::NIN + fp::PB_Q + h * 64 + ks * 32 + grp * 8); } }
        f32x4 sacc[9];
#pragma unroll
        for (int jq = 0; jq < 9; ++jq) {
            sacc[jq] = (f32x4){0.f, 0.f, 0.f, 0.f};
#pragma unroll
            for (int ks = 0; ks < 2; ++ks) { const bf16x8 kf = *(const LAS bf16x8*)(Ks + (16 * (tt + jq) + c16) * 72 + ks * 32 + grp * 8); sacc[jq] = mfma16(kf, qf[ks], sacc[jq]); }
        }
        float mx = sink2;
#pragma unroll
        for (int jq = 0; jq < 9; ++jq)
#pragma unroll
            for (int r = 0; r < 4; ++r) {
                const int diff = 128 + c16 - 16 * jq - 4 * grp - r, jrel = 16 * (tt + jq) + 4 * grp + r;
                const bool ok = diff >= 0 && diff < 128 && (n > 0 || jrel >= 128);
                sacc[jq][r] = ok ? sacc[jq][r] : -INFINITY;
                mx = fmaxf(mx, sacc[jq][r]);
            }
        mx = fmaxf(mx, __shfl_xor(mx, 16)); mx = fmaxf(mx, __shfl_xor(mx, 32));
        float ls = 0.f;
#pragma unroll
        for (int jq = 0; jq < 9; ++jq) {
            float p[4];
#pragma unroll
            for (int r = 0; r < 4; ++r) { p[r] = exp2_fast(sacc[jq][r] - mx); ls += p[r]; }
            *(LAS u32x2*)(Pw + c16 * 168 + 16 * jq + 4 * grp) = (u32x2){pk2(p[0], p[1]), pk2(p[2], p[3])};
        }
        *(LAS u32x2*)(Pw + c16 * 168 + 144 + 4 * grp) = (u32x2){0u, 0u};
        ls += __shfl_xor(ls, 16); ls += __shfl_xor(ls, 32);
        ls += exp2_fast(sink2 - mx);
        const float inv = 1.f / ls;
        LDS_WAIT();
        f32x4 oacc[4];
#pragma unroll
        for (int dt = 0; dt < 4; ++dt) oacc[dt] = (f32x4){0.f, 0.f, 0.f, 0.f};
#pragma unroll
        for (int k2 = 0; k2 < 5; ++k2) {
            const bf16x8 pb = *(const LAS bf16x8*)(Pw + c16 * 168 + 32 * k2 + 8 * grp);
#pragma unroll
            for (int dt = 0; dt < 4; ++dt) { const bf16x8 va = tr_frag(Vs + (16 * tt + 32 * k2) * 72 + 16 * dt, 72, f_lane); oacc[dt] = mfma16(va, pb, oacc[dt]); }
        }
#pragma unroll
        for (int dt = 0; dt < 4; ++dt)
            *(u32x2*)(OA + qtok * 1024 + h * 64 + 16 * dt + 4 * grp) = (u32x2){pk2(oacc[dt][0] * inv, oacc[dt][1] * inv), pk2(oacc[dt][2] * inv, oacc[dt][3] * inv)};
        LDS_WAIT();
    }
    __syncthreads();
}

__device__ __forceinline__ void unpack8(const u32x4 v, float (&f)[8]) {
    f[0] = bflo(v.x); f[1] = bfhi(v.x); f[2] = bflo(v.y); f[3] = bfhi(v.y); f[4] = bflo(v.z); f[5] = bfhi(v.z); f[6] = bflo(v.w); f[7] = bfhi(v.w);
}
__device__ __forceinline__ void stage_vt(const bf16_t* PB, size_t tok0, int col0, LAS bf16_t* Vs, int tid) {
#pragma unroll
    for (int i = 0; i < 8; ++i) {
        const int q = tid + 512 * i, row = q >> 5, ch = q & 31;
        *(LAS u32x4*)(Vs + row * 272 + ch * 8) = *(const u32x4*)(PB + (tok0 + row) * fp::NIN + col0 + ch * 8);
    }
}

__device__ __forceinline__ void m1_unit(const MkArgs& a, Frame& F, int u) {
    const int f_tid = fresh_tid(F), f_lane = f_tid & 63, f_wave = F.wave;
    const int bh = u >> 6, c = u & 63, b = bh >> 2, h = bh & 3;
    const size_t tok0 = (size_t)b * S + (size_t)c * 128;
    unsigned char* ws = a.ws;
    const bf16_t* PB = (const bf16_t*)(ws + wsf::PROJB);
    LAS bf16_t* Kw = (LAS bf16_t*)F.lds;
    LAS bf16_t* Vt = (LAS bf16_t*)(F.lds + 34816);
    LAS float* gl = (LAS float*)(F.lds + 34816 + 69632);
    const float* GT = (const float*)(ws + wsf::GATES);
    const int tid = f_tid;
    LAS bf16_t* Raw = Vt;
    float gi = 0.f, gf = 0.f;
    if (tid < 128) { gi = GT[(tok0 + tid) * 8 + h]; gf = GT[(tok0 + tid) * 8 + 4 + h]; }
    u32x4 rawv[9];
#pragma unroll
    for (int i = 0; i < 9; ++i) {
        const int q = tid + 512 * i, row = (q >> 5) < 131 ? (q >> 5) : 130, ch = q & 31;
        const int back = (c * 128 + row - 3 >= 0) ? 3 - row : 0;
        rawv[i] = *(const u32x4*)(PB + (size_t)((long)tok0 - back) * fp::NIN + (ch < 16 ? fp::PB_MQ + h * 128 + ch * 8 : fp::PB_MK + h * 128 + (ch - 16) * 8));
    }
    u32x4 vreg[8];
#pragma unroll
    for (int i = 0; i < 8; ++i) { const int q = tid + 512 * i; vreg[i] = *(const u32x4*)(PB + (tok0 + (q >> 5)) * fp::NIN + fp::PB_MV + h * 256 + (q & 31) * 8); }
#pragma unroll
    for (int i = 0; i < 9; ++i) {
        const int q = tid + 512 * i, row = q >> 5, ch = q & 31;
        if (row < 131) *(LAS u32x4*)(Raw + row * 256 + ch * 8) = (c * 128 + row - 3 >= 0) ? rawv[i] : (u32x4){0u, 0u, 0u, 0u};
    }
    float li = 0.f, lf = 0.f;
    if (tid < 128) { li = softcap_f(gi); lf = logsigmoid_f(softcap_f(gf)); }
    float cum = lf;
#pragma unroll
    for (int o = 1; o < 64; o <<= 1) { const float t = __shfl_up(cum, o); if (f_lane >= o) cum += t; }
    if (tid == 63) gl[384] = cum;
    __syncthreads();
    if (tid >= 64 && tid < 128) cum += gl[384];
    if (tid == 127) gl[385] = cum;
    __syncthreads();
    const float g = gl[385];
    const float av = (tid < 128) ? (g - cum + li) : -INFINITY;
    const float wm = wave_max_f(av);
    if (f_lane == 0 && f_wave < 2) gl[386 + f_wave] = wm;
    __syncthreads();
    const float mloc = fmaxf(gl[386], gl[387]);
    if (tid < 128) {
        gl[256 + tid] = expf(av - mloc);
        ((float*)(ws + wsf::BCUM))[(size_t)bh * S + c * 128 + tid] = cum;
        ((float*)(ws + wsf::LOGI))[(size_t)bh * S + c * 128 + tid] = li;
    }
    if (tid == 0) { ((float*)(ws + wsf::GSUM))[u] = g; ((float*)(ws + wsf::MLOC))[u] = mloc; }
    __syncthreads();
#pragma unroll 2
    for (int i = 0; i < 8; ++i) {
        const int q = tid + 512 * i, row = q >> 5, ch = q & 31, isK = ch >= 16, cc = (ch & 15) * 8;
        const int cwcol = (isK ? 512 : 0) + h * 128 + cc;
        float acc[8];
#pragma unroll
        for (int e = 0; e < 8; ++e) acc[e] = 0.f;
#pragma unroll
        for (int j = 0; j < 4; ++j) {
            const u32x4 xv = *(const LAS u32x4*)(Raw + (row + j) * 256 + ch * 8);
            float xf[8]; unpack8(xv, xf);
            const f32x4 w0 = *(const f32x4*)(a.conv_qk + j * 1024 + cwcol), w1 = *(const f32x4*)(a.conv_qk + j * 1024 + cwcol + 4);
            acc[0] += w0.x * xf[0]; acc[1] += w0.y * xf[1]; acc[2] += w0.z * xf[2]; acc[3] += w0.w * xf[3];
            acc[4] += w1.x * xf[4]; acc[5] += w1.y * xf[5]; acc[6] += w1.z * xf[6]; acc[7] += w1.w * xf[7];
        }
        const float sc = isK ? 0.08838834764831845f : 1.f;
#pragma unroll
        for (int e = 0; e < 8; ++e) acc[e] = silu_f(acc[e]) * sc;
        const u32x4 o = (u32x4){pk2(acc[0], acc[1]), pk2(acc[2], acc[3]), pk2(acc[4], acc[5]), pk2(acc[6], acc[7])};
        bf16_t* dst = (bf16_t*)(ws + (isK ? wsf::KC : wsf::QC)) + (tok0 + row) * 512 + h * 128 + cc;
        *(u32x4*)dst = o;
        if (isK) {
            const float wr = gl[256 + row];
            *(LAS u32x4*)(Kw + row * 136 + cc) = (u32x4){pk2(acc[0] * wr, acc[1] * wr), pk2(acc[2] * wr, acc[3] * wr), pk2(acc[4] * wr, acc[5] * wr), pk2(acc[6] * wr, acc[7] * wr)};
        }
    }
    __syncthreads();
#pragma unroll
    for (int i = 0; i < 8; ++i) { const int q = tid + 512 * i; *(LAS u32x4*)(Vt + (q >> 5) * 272 + (q & 31) * 8) = vreg[i]; }
    __syncthreads();
    const int c16 = f_lane & 15, grp = f_lane >> 4, w = f_wave;
    f32x4 acc[8][2];
#pragma unroll
    for (int d = 0; d < 8; ++d) { acc[d][0] = (f32x4){0.f, 0.f, 0.f, 0.f}; acc[d][1] = acc[d][0]; }
#pragma unroll
    for (int ks = 0; ks < 4; ++ks) {
        bf16x8 bfr[2];
#pragma unroll
        for (int i = 0; i < 2; ++i) bfr[i] = tr_frag(Vt + (32 * ks) * 272 + 16 * (2 * w + i), 272, f_lane);
#pragma unroll
        for (int d = 0; d < 8; ++d) {
            const bf16x8 af = tr_frag(Kw + (32 * ks) * 136 + 16 * d, 136, f_lane);
            acc[d][0] = mfma16(af, bfr[0], acc[d][0]); acc[d][1] = mfma16(af, bfr[1], acc[d][1]);
        }
    }
    float* dct = (float*)(ws + wsf::DCT) + (size_t)u * 256 * 128;
#pragma unroll
    for (int d = 0; d < 8; ++d)
#pragma unroll
        for (int i = 0; i < 2; ++i) *(f32x4*)(dct + (size_t)(16 * (2 * w + i) + c16) * 128 + 16 * d + 4 * grp) = acc[d][i];
    if (tid < 128) {
        float s = 0.f;
#pragma unroll 16
        for (int r = 0; r < 128; ++r) s += bf2f(Kw[r * 136 + tid]);
        ((float*)(ws + wsf::DN))[(size_t)u * 128 + tid] = s;
    }
    __syncthreads();
}

__device__ __forceinline__ void phase3(const MkArgs& a, Frame& F) {
    const int f_tid = fresh_tid(F), f_lane = f_tid & 63, f_wave = F.wave;
    for (int u = F.bid; u < NB * HKV * (S / 128); u += F.G) attn_unit(a, F, u);
    for (int u = F.bid; u < NB * MH * NC; u += F.G) m1_unit(a, F, u);
}

__device__ __forceinline__ void phase4(const MkArgs& a, Frame& F) {
    ada_gemv(a, F, 4096 / 64, MODW / 64);
    __syncthreads();
    const int f_tid = fresh_tid(F), f_lane = f_tid & 63, f_wave = F.wave;
    unsigned char* ws = a.ws;
    LAS float* dec = (LAS float*)F.lds;
    LAS float* scl = dec + 512;
    LAS float* gl = scl + 512;
    gl[f_tid] = ((const float*)(ws + wsf::GSUM))[f_tid]; gl[512 + f_tid] = ((const float*)(ws + wsf::MLOC))[f_tid];
    __syncthreads();
    if (f_tid < 8) {
        const int bh = f_tid; float m = 0.f;
        for (int c = 0; c < NC; ++c) {
            const float g = gl[bh * NC + c], ml = gl[512 + bh * NC + c];
            if (F.bid == 0) ((float*)(ws + wsf::MPREV))[bh * NC + c] = m;
            const float mn = fmaxf(g + m, ml);
            dec[bh * 64 + c] = expf(g + m - mn); scl[bh * 64 + c] = expf(ml - mn); m = mn;
        }
    }
    __syncthreads();
    const int gt = F.vcu * fp::NT + f_tid, NGT = F.G * fp::NT;
    for (int it = gt; it < 8 * 16384; it += NGT) {
        const int bh = it >> 14, idx = it & 16383;
        const float* dct = (const float*)(ws + wsf::DCT) + (size_t)bh * 64 * 32768 + (size_t)idx * 2;
        bf16_t* cpt = (bf16_t*)(ws + wsf::CPT) + (size_t)bh * 64 * 32768 + (size_t)idx * 2;
        float C0 = 0.f, C1 = 0.f;
#pragma unroll 8
        for (int c = 0; c < NC; ++c) {
            const f32x2 d = *(const f32x2*)(dct + (size_t)c * 32768);
            *(unsigned*)(cpt + (size_t)c * 32768) = pk2(C0, C1);
            const float de = dec[bh * 64 + c], sc = scl[bh * 64 + c];
            C0 = de * C0 + sc * d.x; C1 = de * C1 + sc * d.y;
        }
    }
    for (int it = gt; it < 8 * 128; it += NGT) {
        const int bh = it >> 7, dk = it & 127; float nv = 0.f;
        const float* dnp = (const float*)(ws + wsf::DN) + (size_t)bh * NC * 128 + dk;
        float* npp = (float*)(ws + wsf::NPREV) + (size_t)bh * NC * 128 + dk;
#pragma unroll
        for (int h = 0; h < 2; ++h) {
            float d[32];
#pragma unroll
            for (int c = 0; c < 32; ++c) d[c] = dnp[(size_t)(32 * h + c) * 128];
#pragma unroll
            for (int c = 0; c < 32; ++c) { npp[(size_t)(32 * h + c) * 128] = nv; nv = dec[bh * 64 + 32 * h + c] * nv + scl[bh * 64 + 32 * h + c] * d[c]; }
        }
    }
}

__device__ __forceinline__ void m3_unit(const MkArgs& a, Frame& F, int u) {
    const int f_tid = fresh_tid(F), f_lane = f_tid & 63, f_wave = F.wave;
    const int bh = u >> 6, c = u & 63, b = bh >> 2, h = bh & 3;
    const size_t tok0 = (size_t)b * S + (size_t)c * 128;
    unsigned char* ws = a.ws;
    const bf16_t* PB = (const bf16_t*)(ws + wsf::PROJB);
    const bf16_t* QCp = (const bf16_t*)(ws + wsf::QC);
    const bf16_t* KCp = (const bf16_t*)(ws + wsf::KC);
    LAS bf16_t* KP = (LAS bf16_t*)F.lds;
    LAS bf16_t* Vt = (LAS bf16_t*)(F.lds + 34816);
    LAS float* fl = (LAS float*)(F.lds + 104448);
    LAS float* f_us = fl, *f_M = fl + 128, *f_iw = fl + 256, *f_rd = fl + 384, *f_qn = fl + 512, *f_np = fl + 640, *f_en = fl + 768, *f_ssq = fl + 1024, *f_misc = fl + 896;
    const int tid = f_tid;
#pragma unroll
    for (int i = 0; i < 4; ++i) { const int q = tid + 512 * i, row = q >> 4, ch = q & 15;
        *(LAS u32x4*)(KP + row * 136 + ch * 8) = *(const u32x4*)(KCp + (tok0 + row) * 512 + h * 128 + ch * 8); }
    stage_vt(PB, tok0, fp::PB_MV + h * 256, Vt, tid);
    const float mp = ((const float*)(ws + wsf::MPREV))[u];
    float bt = 0.f, us = -INFINITY;
    if (tid < 128) { bt = ((const float*)(ws + wsf::BCUM))[(size_t)bh * S + c * 128 + tid]; us = ((const float*)(ws + wsf::LOGI))[(size_t)bh * S + c * 128 + tid] - bt;
        f_np[tid] = ((const float*)(ws + wsf::NPREV))[(size_t)u * 128 + tid]; }
    float pm = us;
#pragma unroll
    for (int o = 1; o < 64; o <<= 1) { const float t = __shfl_up(pm, o); if (f_lane >= o) pm = fmaxf(pm, t); }
    if (tid == 63) f_misc[0] = pm;
    __syncthreads();
    if (tid >= 64 && tid < 128) pm = fmaxf(pm, f_misc[0]);
    if (tid < 128) {
        const float Mt = fmaxf(mp, pm);
        f_us[tid] = us; f_M[tid] = Mt; f_iw[tid] = expf(mp - Mt); f_en[tid] = expf(-(bt + Mt));
        float s = 0.f;
#pragma unroll 8
        for (int ch = 0; ch < 16; ++ch) { const u32x4 qv = *(const u32x4*)(QCp + (tok0 + tid) * 512 + h * 128 + ch * 8); float qf[8]; unpack8(qv, qf);
#pragma unroll
            for (int e = 0; e < 8; ++e) s += qf[e] * f_np[ch * 8 + e]; }
        f_qn[tid] = s;
    }
    __syncthreads();
    const int c16 = f_lane & 15, grp = f_lane >> 4, w = f_wave;
    u32x2 pp[8]; float rs = 0.f;
    {
        bf16x8 qf[4];
#pragma unroll
        for (int ks = 0; ks < 4; ++ks) qf[ks] = *(const bf16x8*)(QCp + (tok0 + 16 * w + c16) * 512 + h * 128 + 32 * ks + 8 * grp);
        const float Mt = f_M[16 * w + c16];
        const int t = 16 * w + c16, tq = t - 4 * grp;
        const LAS float* usb = f_us + 4 * grp;
#pragma unroll
        for (int st = 0; st < 8; ++st) {
            pp[st] = (u32x2){0u, 0u};
            if (st <= w) {
                f32x4 acc = (f32x4){0.f, 0.f, 0.f, 0.f};
#pragma unroll
                for (int ks = 0; ks < 4; ++ks) { const bf16x8 kf = *(const LAS bf16x8*)(KP + (16 * st + c16) * 136 + 32 * ks + 8 * grp); acc = mfma16(kf, qf[ks], acc); }
                float p[4];
                const f32x4 u4 = *(const LAS f32x4*)(usb + 16 * st);
#pragma unroll
                for (int r = 0; r < 4; ++r) { p[r] = (16 * st + r <= tq) ? acc[r] * expf(u4[r] - Mt) : 0.f; rs += p[r]; }
                pp[st] = (u32x2){pk2(p[0], p[1]), pk2(p[2], p[3])};
            }
        }
        rs += __shfl_xor(rs, 16); rs += __shfl_xor(rs, 32);
        if (grp == 0) { const float den = rs + f_iw[t] * f_qn[t]; f_rd[t] = 1.f / fmaxf(fabsf(den), f_en[t]); }
    }
    __syncthreads();
#pragma unroll
    for (int st = 0; st < 8; ++st) *(LAS u32x2*)(KP + (16 * w + c16) * 136 + 16 * st + 4 * grp) = pp[st];
    __syncthreads();
    bf16x8 vf[2][4], cf[2][4];
    const bf16_t* cpt = (const bf16_t*)(ws + wsf::CPT) + (size_t)u * 256 * 128;
#pragma unroll
    for (int i = 0; i < 2; ++i)
#pragma unroll
        for (int ks = 0; ks < 4; ++ks) {
            vf[i][ks] = tr_frag(Vt + (32 * ks) * 272 + 16 * (2 * w + i), 272, f_lane);
            cf[i][ks] = *(const bf16x8*)(cpt + (size_t)(16 * (2 * w + i) + c16) * 128 + 32 * ks + 8 * grp);
        }
    bf16_t* HMp = (bf16_t*)(ws + wsf::HM);
    bf16x8 qnx[4];
#pragma unroll
    for (int ks = 0; ks < 4; ++ks) qnx[ks] = *(const bf16x8*)(QCp + (tok0 + c16) * 512 + h * 128 + 32 * ks + 8 * grp);
#pragma unroll 1
    for (int tt = 0; tt < 8; ++tt) {
        bf16x8 pf[4], qf[4];
        const int tn = tt < 7 ? tt + 1 : 7;
#pragma unroll
        for (int ks = 0; ks < 4; ++ks) { pf[ks] = *(const LAS bf16x8*)(KP + (16 * tt + c16) * 136 + 32 * ks + 8 * grp);
            qf[ks] = qnx[ks]; qnx[ks] = *(const bf16x8*)(QCp + (tok0 + 16 * tn + c16) * 512 + h * 128 + 32 * ks + 8 * grp); }
        const int t = 16 * tt + c16; const float iw = f_iw[t], rd = f_rd[t];
        float ss = 0.f;
#pragma unroll
        for (int i = 0; i < 2; ++i) {
            f32x4 a1 = (f32x4){0.f, 0.f, 0.f, 0.f}, a2 = a1;
#pragma unroll
            for (int ks = 0; ks < 4; ++ks) { a1 = mfma16(vf[i][ks], pf[ks], a1); a2 = mfma16(cf[i][ks], qf[ks], a2); }
            const f32x4 hv = (a1 + a2 * iw) * rd;
            ss += (hv[0] * hv[0] + hv[1] * hv[1]) + (hv[2] * hv[2] + hv[3] * hv[3]);
            *(u32x2*)(HMp + (tok0 + t) * 1024 + h * 256 + 16 * (2 * w + i) + 4 * grp) = (u32x2){pk2(hv[0], hv[1]), pk2(hv[2], hv[3])};
        }
        ss += __shfl_xor(ss, 16); ss += __shfl_xor(ss, 32);
        if (grp == 0) f_ssq[t * 8 + w] = ss;
    }
    u32x2 mon[2];
#pragma unroll
    for (int i = 0; i < 2; ++i) mon[i] = *(const u32x2*)(PB + (tok0 + c16) * fp::NIN + fp::PB_MO + h * 256 + 16 * (2 * w + i) + 4 * grp);
    __syncthreads();
#pragma unroll 1
    for (int tt = 0; tt < 8; ++tt) {
        const int t = 16 * tt + c16, tn2 = 16 * (tt < 7 ? tt + 1 : 7) + c16;
        u32x2 moc[2];
#pragma unroll
        for (int i = 0; i < 2; ++i) { moc[i] = mon[i]; mon[i] = *(const u32x2*)(PB + (tok0 + tn2) * fp::NIN + fp::PB_MO + h * 256 + 16 * (2 * w + i) + 4 * grp); }
        const f32x4 s0 = *(const LAS f32x4*)(f_ssq + t * 8), s1 = *(const LAS f32x4*)(f_ssq + t * 8 + 4);
        const float rn = rsqrtf(((s0.x + s0.y) + (s0.z + s0.w) + (s1.x + s1.y) + (s1.z + s1.w)) * (1.f / 256.f) + EPS);
#pragma unroll
        for (int i = 0; i < 2; ++i) {
            const int dv0 = 16 * (2 * w + i) + 4 * grp;
            const f32x4 g4 = *(const f32x4*)(a.g_mlstm + h * 256 + dv0);
            const u32x2 mo = moc[i];
            u32x2* hp = (u32x2*)(HMp + (tok0 + t) * 1024 + h * 256 + dv0);
            const u32x2 hr = *hp;
            const float o0 = bflo(hr.x) * rn * g4.x * bflo(mo.x), o1 = bfhi(hr.x) * rn * g4.y * bfhi(mo.x);
            const float o2 = bflo(hr.y) * rn * g4.z * bflo(mo.y), o3 = bfhi(hr.y) * rn * g4.w * bfhi(mo.y);
            *hp = (u32x2){pk2(o0, o1), pk2(o2, o3)};
        }
    }
    __syncthreads();
}
__device__ __forceinline__ void phase5(const MkArgs& a, Frame& F) {
    const int f_tid = fresh_tid(F), f_lane = f_tid & 63, f_wave = F.wave;
    for (int u = F.bid; u < NB * MH * NC; u += F.G) m3_unit(a, F, u);
}
struct ProjSched {
    typedef DenseUnit UnitT;
    const bf16_t* A0; const bf16_t* A1; const bf16_t* B0; const bf16_t* B1; int K; int nM, nN, G, c, wave; int ntf, nt_total; unsigned a_jump, b_jump;
    __device__ __forceinline__ bool next(int i, DenseUnit& u) const { return pg8::static_tile(i * G + c, nM, nN, u.pm, u.pn); }
    __device__ __forceinline__ const void* a_buf() const { return A0; }
    __device__ __forceinline__ const void* b_buf() const { return B0; }
    __device__ __forceinline__ unsigned a_soff(const DenseUnit& u) const { return (unsigned)u.pm * 256u * 1024u * 2u; }
    __device__ __forceinline__ unsigned b_soff(const DenseUnit& u) const { return (unsigned)u.pn * 256u * 1024u * 2u; }
    __device__ __forceinline__ void a_offs(const DenseUnit&, int R0, int R1, int C0, int C1, unsigned (&o)[4]) const {
        o[0] = (unsigned)(R0 * 1024 + C0) * 2u; o[1] = (unsigned)(R1 * 1024 + C1) * 2u; o[2] = (unsigned)((R0 + 128) * 1024 + C0) * 2u; o[3] = (unsigned)((R1 + 128) * 1024 + C1) * 2u;
    }
};
struct EpiMerge {
    bf16_t* MG; const bf16_t* PB; bool skip;
    static constexpr float GMIN = 9.5367431640625e-07f;
    __device__ __forceinline__ void mid(f32x4 (&acc)[2][2][4][2], const DenseUnit& u, int wr, int wc, int fr, int fq) const {
        const int row0 = u.pm * 256 + wr * 64 + fr, col0 = u.pn * 256 + wc * 32 + 8 * fq;
#pragma unroll
        for (int ai = 0; ai < 2; ++ai)
#pragma unroll
            for (int mh = 0; mh < 2; ++mh) {
                u32x4 ga[2][2], gm[2][2];
#pragma unroll
                for (int m2 = 0; m2 < 2; ++m2)
#pragma unroll
                    for (int bj = 0; bj < 2; ++bj) { const size_t row = (size_t)(row0 + ai * 128 + (2 * mh + m2) * 16);
                        ga[m2][bj] = *(const u32x4*)(PB + row * fp::NIN + fp::PB_GA + col0 + bj * 128); gm[m2][bj] = *(const u32x4*)(PB + row * fp::NIN + fp::PB_GM + col0 + bj * 128); }
#pragma unroll
                for (int m2 = 0; m2 < 2; ++m2)
#pragma unroll
                    for (int bj = 0; bj < 2; ++bj) { const int m = 2 * mh + m2; float a[8], g[8]; unpack8(ga[m2][bj], a); unpack8(gm[m2][bj], g);
#pragma unroll
                        for (int e = 0; e < 8; ++e) a[e] *= __builtin_amdgcn_rcpf(fmaxf(g[e], GMIN));
                        acc[ai][bj][m][0] *= (f32x4){a[0], a[1], a[2], a[3]}; acc[ai][bj][m][1] *= (f32x4){a[4], a[5], a[6], a[7]}; }
            }
    }
    __device__ __forceinline__ void operator()(const f32x4 (&acc)[2][2][4][2], const DenseUnit& u, int wr, int wc, int fr, int fq) const {
        if (skip) {
#pragma unroll
            for (int ai = 0; ai < 2; ++ai)
#pragma unroll
                for (int bj = 0; bj < 2; ++bj)
#pragma unroll
                    for (int m = 0; m < 4; ++m)
#pragma unroll
                        for (int n = 0; n < 2; ++n) asm volatile("" :: "v"(acc[ai][bj][m][n]));
            return;
        }
        const int row0 = u.pm * 256 + wr * 64 + fr, col0 = u.pn * 256 + wc * 32 + 8 * fq;
#pragma unroll
        for (int ai = 0; ai < 2; ++ai) {
            u32x4 gm[4][2];
#pragma unroll
            for (int m = 0; m < 4; ++m)
#pragma unroll
                for (int bj = 0; bj < 2; ++bj) gm[m][bj] = *(const u32x4*)(PB + (size_t)(row0 + ai * 128 + m * 16) * fp::NIN + fp::PB_GM + col0 + bj * 128);
#pragma unroll
            for (int m = 0; m < 4; ++m)
#pragma unroll
                for (int bj = 0; bj < 2; ++bj) { const size_t row = (size_t)(row0 + ai * 128 + m * 16); float g[8]; unpack8(gm[m][bj], g);
#pragma unroll
                    for (int e = 0; e < 8; ++e) g[e] = fmaxf(g[e], GMIN);
                    const f32x4 v0 = acc[ai][bj][m][0], v1 = acc[ai][bj][m][1];
                    *(u32x4*)(MG + row * 2048 + col0 + bj * 128) = (u32x4){pg8::cvt_pk_bf16(g[0] * v0[0], g[1] * v0[1]), pg8::cvt_pk_bf16(g[2] * v0[2], g[3] * v0[3]),
                                                                         pg8::cvt_pk_bf16(g[4] * v1[0], g[5] * v1[1]), pg8::cvt_pk_bf16(g[6] * v1[2], g[7] * v1[3])}; }
        }
    }
};
__device__ __forceinline__ void phase6(const MkArgs& a, Frame& F, bool skip_epi = false) {
    const int f_tid = fresh_tid(F), f_lane = f_tid & 63, f_wave = F.wave;
    unsigned char* ws = a.ws;
    ProjSched S{(const bf16_t*)(ws + wsf::OAT), (const bf16_t*)(ws + wsf::HM), (const bf16_t*)(ws + wsf::WAP_T), (const bf16_t*)(ws + wsf::WMP_T), 1024, NTOK / 256, 2048 / 256, F.G, F.bid, F.wave, 16, 32,
                (unsigned)(wsf::HM - wsf::OAT) - 16u * 128u, (unsigned)(wsf::WMP_T - wsf::WAP_T) - 16u * 128u};
    EpiMerge E{(bf16_t*)(ws + wsf::MG), (const bf16_t*)(ws + wsf::PROJB), skip_epi};
    pg8::gemm_phase<EpiMerge, ProjSched, false, 0, true>(F.lds, S, E);
}
struct EpiPlain {
    bf16_t* O; int ldc;
    __device__ __forceinline__ void operator()(const f32x4 (&acc)[2][2][4][2], const DenseUnit& u, int wr, int wc, int fr, int fq) const {
        const int row0 = u.pm * 256 + wr * 64 + fr, col0 = u.pn * 256 + wc * 32 + 8 * fq;
#pragma unroll
        for (int ai = 0; ai < 2; ++ai)
#pragma unroll
            for (int m = 0; m < 4; ++m)
#pragma unroll
                for (int bj = 0; bj < 2; ++bj) {
                    const f32x4 v0 = acc[ai][bj][m][0], v1 = acc[ai][bj][m][1];
                    *(u32x4*)(O + (size_t)(row0 + ai * 128 + m * 16) * ldc + col0 + bj * 128) =
                        (u32x4){pg8::cvt_pk_bf16(v0[0], v0[1]), pg8::cvt_pk_bf16(v0[2], v0[3]), pg8::cvt_pk_bf16(v1[0], v1[1]), pg8::cvt_pk_bf16(v1[2], v1[3])};
                }
    }
};
__device__ __forceinline__ void phase7(const MkArgs& a, Frame& F) {
    const int f_tid = fresh_tid(F), f_lane = f_tid & 63, f_wave = F.wave;
    unsigned char* ws = a.ws;
    DenseSched S{(const bf16_t*)(ws + wsf::MG), (const bf16_t*)(ws + wsf::WOUT_T), 2048, 2048, NTOK / 256, 2048 / 256, F.G, F.bid, F.wave};
    EpiPlain E{(bf16_t*)(ws + wsf::Y), 2048};
    pg8::gemm_phase<EpiPlain, DenseSched>(F.lds, S, E);
}

__device__ __forceinline__ void phase8(const MkArgs& a, Frame& F) {
    const int f_tid = fresh_tid(F), f_lane = f_tid & 63, f_wave = F.wave;
    unsigned char* ws = a.ws;
    LAS float* t_gt1 = (LAS float*)F.lds, *t_gpo = t_gt1 + 2048, *t_gpr = t_gt1 + 4096, *t_sc2 = t_gt1 + 6144, *t_sh2 = t_gt1 + 8192;
    LAS float* lgp = (LAS float*)(F.lds + 40960);
    LAS int* cntl = (LAS int*)(F.lds + 57344);
    LAS int* basel = cntl + 32;
    LAS int* esel = cntl + 64;
    LAS int* eslot = cntl + 320;
    const float* mod = (const float*)(ws + wsf::MOD);
    const bf16_t* Yp = (const bf16_t*)(ws + wsf::Y);
    bf16_t* H2p = (bf16_t*)(ws + wsf::H2);
    bf16_t* X1p = (bf16_t*)(ws + wsf::X1);
    const bf16_t* WR = (const bf16_t*)(ws + wsf::WRT);
    int* cntg = (int*)(ws + wsf::CTL) + wsf::CW_CNT;
    const int tid = f_tid, lane = f_lane, w = f_wave;
    for (int blk = F.vcu; blk < NTOK / 64; blk += F.G) {
        const int b = (blk * 64) / S;
        for (int i = tid; i < 2048; i += fp::NT) {
            t_gt1[i] = mod[b * MODW + MOD_GT1 + i]; t_gpo[i] = a.g_post_mix[i]; t_gpr[i] = a.g_pre_ffn[i];
            t_sc2[i] = mod[b * MODW + MOD_SC2 + i]; t_sh2[i] = mod[b * MODW + MOD_SH2 + i];
        }
        if (tid < 32) cntl[tid] = 0;
        __syncthreads();
#pragma unroll 1
        for (int rr = 0; rr < 8; ++rr) {
            const size_t row = (size_t)blk * 64 + w * 8 + rr;
            u32x4 yp[4]; float ss = 0.f;
#pragma unroll
            for (int j = 0; j < 4; ++j) { yp[j] = *(const u32x4*)(Yp + row * 2048 + 8 * (64 * j + lane)); float f[8]; unpack8(yp[j], f);
#pragma unroll
                for (int e = 0; e < 8; ++e) ss += f[e] * f[e]; }
            const float r1 = rsqrtf(wave_sum_f(ss) * (1.f / D) + EPS);
            ss = 0.f;
#pragma unroll
            for (int j = 0; j < 4; ++j) {
                const int c0 = 8 * (64 * j + lane);
                float f[8]; unpack8(yp[j], f);
                const f32x4 xa = *(const f32x4*)(a.x + row * D + c0), xb = *(const f32x4*)(a.x + row * D + c0 + 4);
                const float xv[8] = {xa.x, xa.y, xa.z, xa.w, xb.x, xb.y, xb.z, xb.w};
                float v[8];
#pragma unroll
                for (int e = 0; e < 8; ++e) { v[e] = xv[e] + t_gt1[c0 + e] * (f[e] * r1 * t_gpo[c0 + e]); ss += v[e] * v[e]; }
                *(u32x4*)(X1p + row * D + c0) = (u32x4){pg8::cvt_pk_bf16(v[0], v[1]), pg8::cvt_pk_bf16(v[2], v[3]), pg8::cvt_pk_bf16(v[4], v[5]), pg8::cvt_pk_bf16(v[6], v[7])};
            }
            const float r2 = rsqrtf(wave_sum_f(ss) * (1.f / D) + EPS);
#pragma unroll
            for (int j = 0; j < 4; ++j) {
                const int c0 = 8 * (64 * j + lane);
                const u32x4 xr = *(const u32x4*)(X1p + row * D + c0);
                float xv[8]; unpack8(xr, xv);
                float hv[8];
#pragma unroll
                for (int e = 0; e < 8; ++e) hv[e] = xv[e] * r2 * t_gpr[c0 + e] * (1.f + t_sc2[c0 + e]) + t_sh2[c0 + e];
                *(u32x4*)(H2p + row * 2048 + c0) = (u32x4){pg8::cvt_pk_bf16(hv[0], hv[1]), pg8::cvt_pk_bf16(hv[2], hv[3]), pg8::cvt_pk_bf16(hv[4], hv[5]), pg8::cvt_pk_bf16(hv[6], hv[7])};
#if MOE_FP8
                *(u32x2*)(ws + wsf::H2F8 + row * 2048 + c0) = (u32x2){pk4_fp8(hv[0], hv[1], hv[2], hv[3]), pk4_fp8(hv[4], hv[5], hv[6], hv[7])};
#endif
            }
        }
        VM_WAIT();
        __syncthreads();
        {
            const int c16 = lane & 15, grp = lane >> 4, rt = w & 3, kh = w >> 2;
            f32x4 acc[2] = {(f32x4){0.f, 0.f, 0.f, 0.f}, (f32x4){0.f, 0.f, 0.f, 0.f}};
            int blkb = blk; asm volatile("" : "+s"(blkb));
            const bf16_t* ap = H2p + ((size_t)blkb * 64 + 16 * rt + c16) * 2048 + 8 * grp;
#pragma unroll 4
            for (int ks = kh * 32; ks < kh * 32 + 32; ++ks) {
                const bf16x8 af = *(const bf16x8*)(ap + 32 * ks);
#pragma unroll
                for (int et = 0; et < 2; ++et) {
                    const bf16x8 bh = *(const bf16x8*)(WR + (size_t)(16 * et + c16) * 2048 + 32 * ks + 8 * grp);
                    const bf16x8 bl = *(const bf16x8*)(WR + (size_t)32 * 2048 + (size_t)(16 * et + c16) * 2048 + 32 * ks + 8 * grp);
                    acc[et] = mfma16(af, bh, acc[et]); acc[et] = mfma16(af, bl, acc[et]);
                }
            }
#pragma unroll
            for (int et = 0; et < 2; ++et)
#pragma unroll
                for (int r = 0; r < 4; ++r) lgp[kh * 2048 + (16 * rt + 4 * grp + r) * 32 + 16 * et + c16] = acc[et][r];
        }
        __syncthreads();
        int blkc = blk; asm volatile("" : "+s"(blkc));
        if (tid < 64) {
            const size_t tok = (size_t)blkc * 64 + tid;
            float lgv[32];
#pragma unroll
            for (int e = 0; e < 32; ++e) lgv[e] = lgp[tid * 32 + e] + lgp[2048 + tid * 32 + e] + a.b_router[e];
            int idx[4]; float val[4];
            unsigned used = 0u;
#pragma unroll
            for (int k = 0; k < 4; ++k) {
                float best = -INFINITY; int bi = 0;
#pragma unroll
                for (int e = 0; e < 32; ++e) { const bool c = !((used >> e) & 1u) && lgv[e] > best; best = c ? lgv[e] : best; bi = c ? e : bi; }
                used |= 1u << bi; idx[k] = bi; val[k] = best;
            }
            float ex[4], sum = 0.f;
#pragma unroll
            for (int k = 0; k < 4; ++k) { ex[k] = expf(val[k] - val[0]); sum += ex[k]; }
#pragma unroll
            for (int k = 0; k < 4; ++k) {
                ((int*)(ws + wsf::TOPI))[tok * 4 + k] = idx[k]; ((float*)(ws + wsf::TOPW))[tok * 4 + k] = ex[k] / sum;
                const int e = a.route_i ? a.route_i[tok * 4 + k] : idx[k];
                esel[tid * 4 + k] = e;
                eslot[tid * 4 + k] = __hip_atomic_fetch_add(cntl + e, 1, __ATOMIC_RELAXED, __HIP_MEMORY_SCOPE_WORKGROUP);
            }
        }
        __syncthreads();
        if (tid < 32) { const int n = cntl[tid]; basel[tid] = n > 0 ? __hip_atomic_fetch_add(cntg + tid, n, __ATOMIC_RELAXED, __HIP_MEMORY_SCOPE_AGENT) : 0; }
        __syncthreads();
        if (tid < 256) { const int e = esel[tid]; ((int*)(ws + wsf::LIST))[(size_t)e * NPAIR + basel[e] + eslot[tid]] = (blkc * 64 + (tid >> 2)) * 4 + (tid & 3); }
        __syncthreads();
    }
}

struct MoeUnit { int e, m0, pn, rows; };
struct MoeSched {
    typedef MoeUnit UnitT;
    const bf16_t* A; int a_shift; const bf16_t* Wt; size_t wstride; int K; int nN;
    const int* list; const LAS int* tstart; const LAS int* cnt; int nM; int G, c, wave;
    __device__ __forceinline__ bool next(int i, MoeUnit& u) const {
        const int nwg = nM * nN, L = i * G + c; if (L >= nwg) return false;
        int wgid = L; { const int q = nwg / 8, r = nwg % 8, xcd = wgid % 8, off = wgid / 8; wgid = (xcd < r ? xcd * (q + 1) : r * (q + 1) + (xcd - r) * q) + off; }
        constexpr int WG = 4;
        const int nig = WG * nN, gid = wgid / nig, fm = gid * WG, gsz = (nM - fm) < WG ? (nM - fm) : WG;
        const int mt = fm + ((wgid % nig) % gsz); u.pn = (wgid % nig) / gsz;
        int e = 0;
        for (int k = 1; k < NE; ++k) e += (__builtin_amdgcn_readfirstlane(tstart[k]) <= mt) ? 1 : 0;
        u.e = e; u.m0 = (mt - __builtin_amdgcn_readfirstlane(tstart[e])) * 256; const int left = __builtin_amdgcn_readfirstlane(cnt[e]) - u.m0; u.rows = left < 256 ? left : 256;
        return true;
    }
    __device__ __forceinline__ const void* a_buf() const { return A; }
    __device__ __forceinline__ const void* b_buf() const { return Wt; }
    __device__ __forceinline__ unsigned a_soff(const MoeUnit&) const { return 0u; }
    __device__ __forceinline__ unsigned b_soff(const MoeUnit& u) const { return ((unsigned)u.e * (unsigned)wstride + (unsigned)u.pn * 256u * (unsigned)K) * 2u; }
    __device__ __forceinline__ unsigned rowoff(const MoeUnit& u, int r, int C) const {
        const int rc = r < u.rows ? r : u.rows - 1;
        const int id = list[(size_t)u.e * NPAIR + u.m0 + rc] >> a_shift;
        return ((unsigned)id * (unsigned)K + (unsigned)C) * 2u;
    }
    __device__ __forceinline__ void a_offs(const MoeUnit& u, int R0, int R1, int C0, int C1, unsigned (&o)[4]) const {
        o[0] = rowoff(u, R0, C0); o[1] = rowoff(u, R1, C1); o[2] = rowoff(u, R0 + 128, C0); o[3] = rowoff(u, R1 + 128, C1);
    }
};
__device__ __forceinline__ void moe_tables(const MkArgs& a, Frame& F, LAS int*& cnt, LAS int*& tstart) {
    const int f_tid = fresh_tid(F);
    cnt = (LAS int*)(F.lds + LDS_TAB); tstart = cnt + 32;
    const int* cntg = (const int*)(a.ws + wsf::CTL) + wsf::CW_CNT;
    if (f_tid < 32) cnt[f_tid] = __hip_atomic_load(cntg + f_tid, RLX_AGENT);
    __syncthreads();
    if (f_tid == 0) { int s = 0; for (int e = 0; e < NE; ++e) { tstart[e] = s; s += (cnt[e] + 255) >> 8; } tstart[NE] = s; }
    __syncthreads();
}
template <bool F8> struct EpiGateUpT {
    bf16_t* ACT; const float* bias; const int* list; bool skip;
    __device__ __forceinline__ void operator()(const f32x4 (&acc)[2][2][4][2], const MoeUnit& u, int wr, int wc, int fr, int fq) const {
        if (skip) {
#pragma unroll
            for (int ai = 0; ai < 2; ++ai)
#pragma unroll
                for (int bj = 0; bj < 2; ++bj)
#pragma unroll
                    for (int m = 0; m < 4; ++m)
#pragma unroll
                        for (int n = 0; n < 2; ++n) asm volatile("" :: "v"(acc[ai][bj][m][n]));
            return;
        }
        const int col0 = u.pn * 256 + wc * 32 + 8 * fq;
        f32x4 bv[2][2];
#pragma unroll
        for (int bj = 0; bj < 2; ++bj)
#pragma unroll
            for (int n = 0; n < 2; ++n) bv[bj][n] = *(const f32x4*)(bias + (size_t)u.e * 4096 + col0 + bj * 128 + 4 * n);
        int pr[8];
#pragma unroll
        for (int q = 0; q < 8; ++q) { const int r = (q >> 2) * 128 + wr * 64 + (q & 3) * 16 + fr; pr[q] = list[(size_t)u.e * NPAIR + u.m0 + (r < u.rows ? r : 0)]; if (r >= u.rows) pr[q] = -1; }
#pragma unroll
        for (int ai = 0; ai < 2; ++ai)
#pragma unroll
            for (int m = 0; m < 4; ++m) {
                const int pair = pr[ai * 4 + m];
                if (pair >= 0) {
#pragma unroll
                    for (int bj = 0; bj < 2; ++bj) {
                        const f32x4 v0 = acc[ai][bj][m][0] * (F8 ? W8INV : 1.f) + bv[bj][0], v1 = acc[ai][bj][m][1] * (F8 ? W8INV : 1.f) + bv[bj][1];
                        const float gu[8] = {v0[0], v0[1], v0[2], v0[3], v1[0], v1[1], v1[2], v1[3]};
                        float o[4];
#pragma unroll
                        for (int j = 0; j < 4; ++j) {
                            const float glu = fminf(gu[2 * j], 7.0f), lin = fminf(fmaxf(gu[2 * j + 1], -7.0f), 7.0f);
                            o[j] = glu * fast_sigmoid(1.702f * glu) * (lin + 1.f);
                        }
                        if constexpr (F8) *(unsigned*)((unsigned char*)ACT + (size_t)pair * 2048 + (col0 + bj * 128) / 2) = pk4_fp8_nc(o[0], o[1], o[2], o[3]);
                        else *(u32x2*)(ACT + (size_t)pair * 2048 + (col0 + bj * 128) / 2) = (u32x2){pg8::cvt_pk_bf16(o[0], o[1]), pg8::cvt_pk_bf16(o[2], o[3])};
                    }
                }
            }
    }
};
template <bool F8> struct EpiDownT {
    bf16_t* YP; const float* bias; const int* list; const float* wgt;
    __device__ __forceinline__ void operator()(const f32x4 (&acc)[2][2][4][2], const MoeUnit& u, int wr, int wc, int fr, int fq) const {
        const int col0 = u.pn * 256 + wc * 32 + 8 * fq;
        f32x4 bv[2][2];
#pragma unroll
        for (int bj = 0; bj < 2; ++bj)
#pragma unroll
            for (int n = 0; n < 2; ++n) bv[bj][n] = *(const f32x4*)(bias + (size_t)u.e * 2048 + col0 + bj * 128 + 4 * n);
        int pr[8]; float wq[8];
#pragma unroll
        for (int q = 0; q < 8; ++q) { const int r = (q >> 2) * 128 + wr * 64 + (q & 3) * 16 + fr; pr[q] = list[(size_t)u.e * NPAIR + u.m0 + (r < u.rows ? r : 0)]; if (r >= u.rows) pr[q] = -1; }
#pragma unroll
        for (int q = 0; q < 8; ++q) wq[q] = wgt[pr[q] >= 0 ? pr[q] : 0];
#pragma unroll
        for (int ai = 0; ai < 2; ++ai)
#pragma unroll
            for (int m = 0; m < 4; ++m) {
                const int pair = pr[ai * 4 + m];
                if (pair >= 0) {
                    const float wv = wq[ai * 4 + m];
#pragma unroll
                    for (int bj = 0; bj < 2; ++bj) {
                        const f32x4 v0 = (acc[ai][bj][m][0] * (F8 ? W8INV : 1.f) + bv[bj][0]) * wv, v1 = (acc[ai][bj][m][1] * (F8 ? W8INV : 1.f) + bv[bj][1]) * wv;
                        if constexpr (F8) *(u32x2*)((unsigned char*)YP + (size_t)pair * 2048 + col0 + bj * 128) =
                            (u32x2){pk4_fp8(v0[0] * YP8SCALE, v0[1] * YP8SCALE, v0[2] * YP8SCALE, v0[3] * YP8SCALE), pk4_fp8(v1[0] * YP8SCALE, v1[1] * YP8SCALE, v1[2] * YP8SCALE, v1[3] * YP8SCALE)};
                        else *(u32x4*)(YP + (size_t)pair * 2048 + col0 + bj * 128) =
                            (u32x4){pg8::cvt_pk_bf16(v0[0], v0[1]), pg8::cvt_pk_bf16(v0[2], v0[3]), pg8::cvt_pk_bf16(v1[0], v1[1]), pg8::cvt_pk_bf16(v1[2], v1[3])};
                    }
                }
            }
    }
};
__device__ __forceinline__ void phase9(const MkArgs& a, Frame& F, bool skip_epi = false) {
    unsigned char* ws = a.ws;
    LAS int* cnt; LAS int* tstart; moe_tables(a, F, cnt, tstart);
#if MOE_FP8
    MoeSched S{(const bf16_t*)(ws + wsf::H2F8), 2, (const bf16_t*)(ws + wsf::WGU8), (size_t)4096 * 1024, 1024, 16, (const int*)(ws + wsf::LIST), tstart, cnt, __builtin_amdgcn_readfirstlane(tstart[NE]), F.G, F.bid, F.wave};
    EpiGateUpT<true> E{(bf16_t*)(ws + wsf::ACT8), a.b_gate_up, (const int*)(ws + wsf::LIST), skip_epi};
    if (EPI_SKIP_PROBE >= 2 && skip_epi) pg8::gemm_phase<EpiGateUpT<true>, MoeSched, true, EPI_SKIP_PROBE - 1>(F.lds, S, E);
    else pg8::gemm_phase<EpiGateUpT<true>, MoeSched, true>(F.lds, S, E);
#else
    MoeSched S{(const bf16_t*)(ws + wsf::H2), 2, (const bf16_t*)(ws + wsf::WGU_T), (size_t)4096 * 2048, 2048, 16, (const int*)(ws + wsf::LIST), tstart, cnt, __builtin_amdgcn_readfirstlane(tstart[NE]), F.G, F.bid, F.wave};
    EpiGateUpT<false> E{(bf16_t*)(ws + wsf::ACT), a.b_gate_up, (const int*)(ws + wsf::LIST), skip_epi};
    pg8::gemm_phase<EpiGateUpT<false>, MoeSched, false>(F.lds, S, E);
#endif
}
__device__ __forceinline__ void phase10(const MkArgs& a, Frame& F) {
    unsigned char* ws = a.ws;
    LAS int* cnt; LAS int* tstart; moe_tables(a, F, cnt, tstart);
    const float* wgt = a.route_w ? a.route_w : (const float*)(ws + wsf::TOPW);
#if MOE_FP8
    MoeSched S{(const bf16_t*)(ws + wsf::ACT8), 0, (const bf16_t*)(ws + wsf::WDN8), (size_t)2048 * 1024, 1024, 8, (const int*)(ws + wsf::LIST), tstart, cnt, __builtin_amdgcn_readfirstlane(tstart[NE]), F.G, F.bid, F.wave};
    EpiDownT<true> E{(bf16_t*)(ws + wsf::YP), a.b_down, (const int*)(ws + wsf::LIST), wgt};
    pg8::gemm_phase<EpiDownT<true>, MoeSched, true>(F.lds, S, E);
#else
    MoeSched S{(const bf16_t*)(ws + wsf::ACT), 0, (const bf16_t*)(ws + wsf::WDN_T), (size_t)2048 * 2048, 2048, 8, (const int*)(ws + wsf::LIST), tstart, cnt, __builtin_amdgcn_readfirstlane(tstart[NE]), F.G, F.bid, F.wave};
    EpiDownT<false> E{(bf16_t*)(ws + wsf::YP), a.b_down, (const int*)(ws + wsf::LIST), wgt};
    pg8::gemm_phase<EpiDownT<false>, MoeSched, false>(F.lds, S, E);
#endif
}

__device__ __forceinline__ void phase11(const MkArgs& a, Frame& F) {
    const int f_tid = fresh_tid(F), f_lane = f_tid & 63, f_wave = F.wave;
    unsigned char* ws = a.ws;
    const float* mod = (const float*)(ws + wsf::MOD);
    const bf16_t* YPp = (const bf16_t*)(ws + wsf::YP);
    const bf16_t* X1p = (const bf16_t*)(ws + wsf::X1);
    const int gw = F.vcu * fp::NW + f_wave, NGW = F.G * fp::NW, lane = f_lane;
    if (gw >= NTOK) return;
#if MOE_FP8
    u32x2 yq[16];
#else
    u32x4 yq[16];
#endif
    u32x4 xq[4];
#if MOE_FP8
#define P11_YLOAD(prow, j) (*(const u32x2*)((const unsigned char*)YPp + (prow) * 2048 + 8 * (64 * (j) + lane)))
#else
#define P11_YLOAD(prow, j) (*(const u32x4*)(YPp + (prow) * 2048 + 8 * (64 * (j) + lane)))
#endif
#define P11_LOAD(m_) do { const size_t m__ = (size_t)(m_); \
        _Pragma("unroll") for (int k = 0; k < 4; ++k) _Pragma("unroll") for (int j = 0; j < 4; ++j) yq[k * 4 + j] = P11_YLOAD((m__ * 4 + k), j); \
        _Pragma("unroll") for (int j = 0; j < 4; ++j) xq[j] = *(const u32x4*)(X1p + m__ * D + 8 * (64 * j + lane)); } while (0)
    P11_LOAD(gw);
    for (int m = gw; m < NTOK; m += NGW) {
        const int b = m / S;
        float yv[32]; u32x4 xv[4];
#pragma unroll
        for (int i = 0; i < 32; ++i) yv[i] = 0.f;
#pragma unroll
        for (int k = 0; k < 4; ++k)
#pragma unroll
            for (int j = 0; j < 4; ++j) { float f[8];
#if MOE_FP8
                unpack8_fp8(yq[k * 4 + j], f);
#else
                unpack8(yq[k * 4 + j], f);
#endif
#pragma unroll
                for (int e = 0; e < 8; ++e) yv[8 * j + e] += f[e]; }
#pragma unroll
        for (int i = 0; i < 4; ++i) xv[i] = xq[i];
        { const int mn = m + NGW < NTOK ? m + NGW : m; P11_LOAD(mn); }
        float ss = 0.f;
#pragma unroll
        for (int i = 0; i < 32; ++i) { if (MOE_FP8) yv[i] *= (1.f / YP8SCALE); ss += yv[i] * yv[i]; }
        const float r = rsqrtf(wave_sum_f(ss) * (1.f / D) + EPS);
#pragma unroll
        for (int j = 0; j < 4; ++j) {
            const int c0 = 8 * (64 * j + lane);
            float xf[8]; unpack8(xv[j], xf);
#pragma unroll
            for (int hq = 0; hq < 2; ++hq) {
                const f32x4 xr = (f32x4){xf[4 * hq], xf[4 * hq + 1], xf[4 * hq + 2], xf[4 * hq + 3]};
                const f32x4 gt = *(const f32x4*)(mod + b * MODW + MOD_GT2 + c0 + 4 * hq), gp = *(const f32x4*)(a.g_post_ffn + c0 + 4 * hq);
                f32x4 o;
                o.x = xr.x + gt.x * (yv[8 * j + 4 * hq + 0] * r * gp.x); o.y = xr.y + gt.y * (yv[8 * j + 4 * hq + 1] * r * gp.y);
                o.z = xr.z + gt.z * (yv[8 * j + 4 * hq + 2] * r * gp.z); o.w = xr.w + gt.w * (yv[8 * j + 4 * hq + 3] * r * gp.w);
                *(f32x4*)(a.out + (size_t)m * D + c0 + 4 * hq) = o;
            }
        }
    }
#undef P11_LOAD
#undef P11_YLOAD
}
constexpr int N_PHASES = 12;
#ifndef P0_PARTS
#define P0_PARTS 7
#endif
#ifndef EPI_SKIP_PROBE
#define EPI_SKIP_PROBE 0
#endif
#ifndef REP_MASK
#define REP_MASK 0
#endif
__global__ void __launch_bounds__(fp::NT, 2) mk_fwd(MkArgs a) {
    extern __shared__ __attribute__((aligned(16))) unsigned char lds_raw[];
    Frame F;
    F.lds = (LAS unsigned char*)lds_raw;
    F.wave = __builtin_amdgcn_readfirstlane((int)threadIdx.x >> 6);
    F.G = gridDim.x; F.bid = blockIdx.x; F.vcu = (F.G % 8 == 0) ? (F.bid % 8) * (F.G / 8) + F.bid / 8 : F.bid;
    volatile LAS unsigned* misc = (volatile LAS unsigned*)(F.lds + LDS_MISC);
    if (F.wave == 0) misc[lane_id()] = 0u;
    __syncthreads();
    XcdBarrier bar = xcd_barrier_post((unsigned*)(a.ws + wsf::CTL) + wsf::CW_BAR, misc + 8, F.wave == 0 && lane_id() == 0);
    const int lo = a.ph_lo, hi = a.ph_hi;
#define IN(k) (lo <= (k) && (k) < hi)
#define SEAM(k) do { if (IN(k) && IN((k) + 1)) xcd_barrier(bar, F.wave == 0 && lane_id() == 0); } while (0)
    if (IN(0)) { phase0(a, F); if ((REP_MASK >> 0) & 1) phase0(a, F, P0_PARTS); } SEAM(0);
    if (IN(1)) { phase1(a, F); if ((REP_MASK >> 1) & 1) phase1(a, F); } SEAM(1);
    if (IN(2)) { phase2(a, F); if ((REP_MASK >> 2) & 1) phase2(a, F); } SEAM(2);
#if NPH > 3
    if (IN(3)) { phase3(a, F); if ((REP_MASK >> 3) & 1) phase3(a, F); } SEAM(3);
#endif
#if NPH > 4
    if (IN(4)) { phase4(a, F); if ((REP_MASK >> 4) & 1) phase4(a, F); } SEAM(4);
#endif
#if NPH > 5
    if (IN(5)) { phase5(a, F); if ((REP_MASK >> 5) & 1) phase5(a, F); } SEAM(5);
#endif
#if NPH > 6
    if (IN(6)) { phase6(a, F); if ((REP_MASK >> 6) & 1) phase6(a, F, EPI_SKIP_PROBE != 0); } SEAM(6);
#endif
#if NPH > 7
    if (IN(7)) { phase7(a, F); if ((REP_MASK >> 7) & 1) phase7(a, F); } SEAM(7);
#endif
#if NPH > 8
    if (IN(8)) { phase8(a, F); if ((REP_MASK >> 8) & 1) phase8(a, F); } SEAM(8);
#endif
#if NPH > 9
    if (IN(9)) { phase9(a, F); if ((REP_MASK >> 9) & 1) phase9(a, F, EPI_SKIP_PROBE != 0); } SEAM(9);
#endif
#if NPH > 10
    if (IN(10)) { phase10(a, F); if ((REP_MASK >> 10) & 1) phase10(a, F); } SEAM(10);
#endif
#if NPH > 11
    if (IN(11)) { phase11(a, F); if ((REP_MASK >> 11) & 1) phase11(a, F); }
#endif
#undef IN
#undef SEAM
}

static void fill_args(MkArgs& a, void* const* d_in, void* d_out, void* d_ws) {
    a.x = (const float*)d_in[0]; a.c = (const float*)d_in[1]; a.positions = (const int*)d_in[2]; a.w_ada = (const float*)d_in[3]; a.b_ada = (const float*)d_in[4];
    a.g_pre_mix = (const float*)d_in[5]; a.g_post_mix = (const float*)d_in[6]; a.g_pre_ffn = (const float*)d_in[7]; a.g_post_ffn = (const float*)d_in[8];
    a.w_in = (const float*)d_in[9]; a.b_in = (const float*)d_in[10]; a.conv_qk = (const float*)d_in[11]; a.sinks = (const float*)d_in[12]; a.g_mlstm = (const float*)d_in[13];
    a.w_attn_proj = (const float*)d_in[14]; a.w_mlstm_proj = (const float*)d_in[15]; a.w_out = (const float*)d_in[16]; a.w_router = (const float*)d_in[17]; a.b_router = (const float*)d_in[18];
    a.w_gate_up = (const float*)d_in[19]; a.b_gate_up = (const float*)d_in[20]; a.w_down = (const float*)d_in[21]; a.b_down = (const float*)d_in[22];
    a.out = (float*)d_out; a.ws = (unsigned char*)d_ws; a.route_i = nullptr; a.route_w = nullptr; a.ph_lo = 0; a.ph_hi = 0;
}
static int mk_setup() {
    static int grid = 0;
    if (grid == 0) {
        int dev = 0, cus = 0;
        if (hipGetDevice(&dev) != hipSuccess || hipDeviceGetAttribute(&cus, hipDeviceAttributeMultiprocessorCount, dev) != hipSuccess) { grid = -1; return grid; }
        if (hipFuncSetAttribute((const void*)mk_fwd, hipFuncAttributeMaxDynamicSharedMemorySize, LDS_BYTES) != hipSuccess) { grid = -1; return grid; }
        int per_cu = 0;
        if (hipOccupancyMaxActiveBlocksPerMultiprocessor(&per_cu, (const void*)mk_fwd, fp::NT, LDS_BYTES) != hipSuccess || per_cu < 1) { (void)hipGetLastError(); }
        grid = cus;
    }
    return grid;
}

extern "C" void kernel_launch(void* const* d_in, const int* in_sizes, int n_in, void* d_out, int out_size, void* d_ws, size_t ws_size, hipStream_t stream) {
    if (n_in != 23 || ws_size < wsf::END) return;
    const int grid = mk_setup();
    if (grid <= 0) return;
    if (hipMemsetAsync((unsigned char*)d_ws + wsf::CTL, 0, 65536, stream) != hipSuccess) return;
    MkArgs a{}; fill_args(a, d_in, d_out, d_ws);
    a.ph_lo = 0; a.ph_hi = N_PHASES;
    hipLaunchKernelGGL(mk_fwd, dim3(grid), dim3(fp::NT), LDS_BYTES, stream, a);
}
```

```cpp
#include <hip/hip_runtime.h>
#include <stdint.h>
#include <math.h>
#define NPH 12
#define MOE_FP8 1
#define REP_MASK 0
#define CONV_WGS 80
#define DRY_PROBE 0
#define EPI_SKIP_PROBE 0
#define CONV_SPLIT 1024
#define STAGGER_NG 1
#define STAGGER_STEP 1
#define P0_PARTS 7
#define LDS_LAYOUT 0
namespace cfg {
constexpr int D = 2048, NB = 2, S = 8192, NTOK = NB * S;
constexpr int HQ = 16, HKV = 2, HD = 64, QW = 1024;
constexpr int MH = 4, MDV = 256, MDK = 128, MQKW = 512, MVW = 1024, CL = 128, NC = S / CL;
constexpr int NE = 32, TOPK = 4, DFF = 2048, NPAIR = NTOK * TOPK;
constexpr int INW = 8456;
constexpr int OFF_AQ = 0, OFF_AK = 1024, OFF_AV = 1152, OFF_MQ = 1280, OFF_MK = 1792, OFF_MV = 2304, OFF_MO = 3328,
              OFF_MI = 4352, OFF_MF = 4356, OFF_GA = 4360, OFF_GM = 6408;
constexpr float EPS = 1e-6f;
constexpr int MOD_SH1 = 0, MOD_SC1 = 2048, MOD_GT1 = 4096, MOD_SH2 = 6144, MOD_SC2 = 8192, MOD_GT2 = 10240, MODW = 12288;
}
using namespace cfg;
__device__ __forceinline__ float silu_f(float x) { return x / (1.f + expf(-x)); }
__device__ __forceinline__ float sigmoid_f(float x) { return 1.f / (1.f + expf(-x)); }
__device__ __forceinline__ void rope_cs(int pos, int i, float& c, float& s) {
    const float invf[8] = {1.0f, 0.1939227432012558f, 0.03760603070259094f, 0.007292664609849453f,
                           0.0014142135623842478f, 0.00027424818836152554f, 5.3182957344688475e-05f, 1.0313385246263351e-05f};
    float f = i == 0 ? invf[0] : i == 1 ? invf[1] : i == 2 ? invf[2] : i == 3 ? invf[3] : i == 4 ? invf[4] : i == 5 ? invf[5] : i == 6 ? invf[6] : invf[7];
    float ang = (float)pos * f;
    double t = (double)ang * 0.15915494309189535;
    t -= rint(t);
    float tf = (float)t;
    s = __builtin_amdgcn_sinf(tf);
    c = __builtin_amdgcn_cosf(tf);
}
__device__ __forceinline__ float softcap_f(float z) { return 15.f * tanhf(z / 15.f); }
__device__ __forceinline__ float logsigmoid_f(float z) { return fminf(z, 0.f) - log1pf(expf(-fabsf(z))); }
#ifndef MOE_FP8
#define MOE_FP8 1
#endif
#ifndef CONV_WGS
#define CONV_WGS 80
#endif
#ifndef STAGGER_NG
#define STAGGER_NG 1
#endif
#ifndef STAGGER_STEP
#define STAGGER_STEP 1
#endif
#ifndef CONV_SPLIT
#define CONV_SPLIT 1024
#endif
#ifndef LDS_LAYOUT
#define LDS_LAYOUT 0
#endif
#ifndef DRY_PROBE
#define DRY_PROBE 0
#endif
#ifndef EPI_SKIP_PROBE
#define EPI_SKIP_PROBE 0
#endif
#ifndef P0_PARTS
#define P0_PARTS 7
#endif
#ifndef REP_MASK
#define REP_MASK 0
#endif
#define GAS __attribute__((address_space(1)))
#define LAS __attribute__((address_space(3)))
typedef unsigned short bf16_t;
typedef short bf16x8 __attribute__((ext_vector_type(8)));
typedef short bf16x4 __attribute__((ext_vector_type(4)));
typedef float f32x4 __attribute__((ext_vector_type(4)));
typedef float f32x2 __attribute__((ext_vector_type(2)));
typedef unsigned u32x4 __attribute__((ext_vector_type(4)));
typedef unsigned u32x2 __attribute__((ext_vector_type(2)));
#define RLX_AGENT __ATOMIC_RELAXED, __HIP_MEMORY_SCOPE_AGENT
#define LDS_WAIT() asm volatile("s_waitcnt lgkmcnt(0)" ::: "memory")
#define VM_WAIT() asm volatile("s_waitcnt vmcnt(0)" ::: "memory")

__device__ __forceinline__ unsigned f2bf(float f) { unsigned u = __builtin_bit_cast(unsigned, f); return (u + 0x7fffu + ((u >> 16) & 1u)) >> 16; }
__device__ __forceinline__ unsigned pk2(float lo, float hi) { return f2bf(lo) | (f2bf(hi) << 16); }
__device__ __forceinline__ float bf2f(unsigned short h) { return __builtin_bit_cast(float, (unsigned)h << 16); }
__device__ __forceinline__ float bflo(unsigned w) { return __builtin_bit_cast(float, w << 16); }
__device__ __forceinline__ float bfhi(unsigned w) { return __builtin_bit_cast(float, w & 0xffff0000u); }
__device__ __forceinline__ unsigned pk4_fp8(float a, float b, float c, float d) {
    a = __builtin_amdgcn_fmed3f(a, -448.f, 448.f); b = __builtin_amdgcn_fmed3f(b, -448.f, 448.f); c = __builtin_amdgcn_fmed3f(c, -448.f, 448.f); d = __builtin_amdgcn_fmed3f(d, -448.f, 448.f);
    int r = __builtin_amdgcn_cvt_pk_fp8_f32(a, b, 0, false); r = __builtin_amdgcn_cvt_pk_fp8_f32(c, d, r, true); return (unsigned)r;
}
__device__ __forceinline__ unsigned pk4_fp8_nc(float a, float b, float c, float d) { int r = __builtin_amdgcn_cvt_pk_fp8_f32(a, b, 0, false); r = __builtin_amdgcn_cvt_pk_fp8_f32(c, d, r, true); return (unsigned)r; }
constexpr float YP8SCALE = 16.f;
constexpr float W8SCALE = 64.f, W8INV = 1.f / 64.f;
__device__ __forceinline__ void unpack8_fp8(const u32x2 v, float (&f)[8]) {
    const f32x2 a = __builtin_amdgcn_cvt_pk_f32_fp8((int)v.x, false), b = __builtin_amdgcn_cvt_pk_f32_fp8((int)v.x, true);
    const f32x2 c = __builtin_amdgcn_cvt_pk_f32_fp8((int)v.y, false), d = __builtin_amdgcn_cvt_pk_f32_fp8((int)v.y, true);
    f[0] = a.x; f[1] = a.y; f[2] = b.x; f[3] = b.y; f[4] = c.x; f[5] = c.y; f[6] = d.x; f[7] = d.y;
}
__device__ __forceinline__ float fast_sigmoid(float x) { return __builtin_amdgcn_rcpf(1.f + __builtin_amdgcn_exp2f(-1.4426950408889634f * x)); }

namespace fp {
constexpr int NW = 8, NT = NW * 64;
constexpr int NIN = 8448;
constexpr int PB_Q = 0, PB_K = 1024, PB_V = 1152, PB_MQ = 1280, PB_MK = 1792, PB_MV = 2304, PB_MO = 3328, PB_GA = 4352, PB_GM = 6400;
constexpr float QSCALE = 0.125f * 1.4426950408889634f;
constexpr float LOG2E = 1.4426950408889634f;
}

namespace wsf {
constexpr size_t AL(size_t x) { return (x + 255) & ~(size_t)255; }
constexpr size_t CTL = 0, CTL_BYTES = 1u << 20;
constexpr size_t MODP = CTL + CTL_BYTES;
constexpr size_t MOD = AL(MODP + (size_t)16 * 2 * MODW * 4);
constexpr size_t BINP = AL(MOD + (size_t)2 * MODW * 4);
constexpr size_t CS = AL(BINP + (size_t)fp::NIN * 4);
constexpr size_t WRT = AL(CS + (size_t)NTOK * 8 * 8);
constexpr size_t WIN_T = AL(WRT + (size_t)2 * 32 * 2048 * 2);
constexpr size_t WAP_T = AL(WIN_T + (size_t)fp::NIN * 2048 * 2);
constexpr size_t WMP_T = AL(WAP_T + (size_t)2048 * 1024 * 2);
constexpr size_t WOUT_T = AL(WMP_T + (size_t)2048 * 1024 * 2);
constexpr size_t WGU_T = AL(WOUT_T + (size_t)2048 * 2048 * 2);
#if MOE_FP8
constexpr size_t WDN_T = WGU_T;
constexpr size_t GATES = WGU_T;
#else
constexpr size_t WDN_T = AL(WGU_T + (size_t)32 * 4096 * 2048 * 2);
constexpr size_t GATES = AL(WDN_T + (size_t)32 * 2048 * 2048 * 2);
#endif
constexpr size_t BCUM = AL(GATES + (size_t)NTOK * 8 * 4);
constexpr size_t LOGI = AL(BCUM + (size_t)8 * S * 4);
constexpr size_t GSUM = AL(LOGI + (size_t)8 * S * 4);
constexpr size_t MLOC = AL(GSUM + 512 * 4);
constexpr size_t MPREV = AL(MLOC + 512 * 4);
constexpr size_t DN = AL(MPREV + 512 * 4);
constexpr size_t NPREV = AL(DN + (size_t)512 * 128 * 4);
constexpr size_t DCT = AL(NPREV + (size_t)512 * 128 * 4);
constexpr size_t Y = AL(DCT + (size_t)512 * 256 * 128 * 4);
constexpr size_t X1 = AL(Y + (size_t)NTOK * 2048 * 2);
constexpr size_t H2 = AL(X1 + (size_t)NTOK * 2048 * 4);
constexpr size_t TOPI = AL(H2 + (size_t)NTOK * 2048 * 2);
constexpr size_t TOPW = AL(TOPI + (size_t)NPAIR * 4);
constexpr size_t LIST = AL(TOPW + (size_t)NPAIR * 4);
constexpr size_t LISTW = AL(LIST + (size_t)NE * NPAIR * 4);
constexpr size_t PROJB = AL(LISTW + (size_t)NE * NPAIR * 4);
constexpr size_t ACT = PROJB;
constexpr size_t YPREG = AL(PROJB + (size_t)NTOK * fp::NIN * 2);
constexpr size_t H1 = YPREG;
constexpr size_t MG = AL(H1 + (size_t)NTOK * 2048 * 2);
constexpr size_t OAT = AL(MG + (size_t)NTOK * 2048 * 2);
constexpr size_t HM = AL(OAT + (size_t)NTOK * 1024 * 2);
constexpr size_t QC = AL(HM + (size_t)NTOK * 1024 * 2);
constexpr size_t KC = AL(QC + (size_t)NTOK * 512 * 2);
constexpr size_t CPT = AL(KC + (size_t)NTOK * 512 * 2);
constexpr size_t YP = YPREG;
constexpr size_t F8BASE = AL(CPT + (size_t)512 * 256 * 128 * 2) > AL(YP + (size_t)NPAIR * 2048 * 2) ? AL(CPT + (size_t)512 * 256 * 128 * 2) : AL(YP + (size_t)NPAIR * 2048 * 2);
constexpr size_t WGU8 = F8BASE;
constexpr size_t WDN8 = AL(WGU8 + (size_t)32 * 4096 * 2048);
constexpr size_t H2F8 = AL(WDN8 + (size_t)32 * 2048 * 2048);
constexpr size_t ACT8 = AL(H2F8 + (size_t)NTOK * 2048);
constexpr size_t END = AL(ACT8 + (size_t)NPAIR * 2048);
static_assert((size_t)NPAIR * 2048 * 2 <= (size_t)NTOK * fp::NIN * 2, "ACT fits over PROJB");
constexpr int CW_BAR = 4096;
constexpr int CW_CNT = 8192;
}

constexpr int RING_BYTES = 131072;
constexpr int LDS_TAB = RING_BYTES;
constexpr int LDS_MISC = RING_BYTES + 8192;
constexpr int LDS_BYTES = 147456;

#define XB_TMO      128
#define XB_XCNT(j)  (256  + 64 * (j))
#define XB_XSUB(j)  (1280 + 64 * (j))
#define XB_XGEN(j)  (2304 + 64 * (j))
#define XB_TOP      3328
#define XB_TOPGEN   3392
#define XCD_BAR_WORDS 3456
#define XB_SPIN_CAP (1u << 18)
__device__ __forceinline__ unsigned xb_ld(unsigned* p)              { return __hip_atomic_load(p, __ATOMIC_RELAXED, __HIP_MEMORY_SCOPE_AGENT); }
__device__ __forceinline__ unsigned xb_add(unsigned* p, unsigned v) { return __hip_atomic_fetch_add(p, v, __ATOMIC_RELAXED, __HIP_MEMORY_SCOPE_AGENT); }
__device__ __forceinline__ unsigned xb_xcc_id() { return (unsigned)__builtin_amdgcn_s_getreg((3 << 11) | 20) & 0xFu; }
#define XB_SPIN(cond, bar) do { unsigned _sp = 0; while (cond) { __builtin_amdgcn_s_sleep(1); \
    if ((++_sp & 255u) == 0u) { if (xb_ld(&(bar)[XB_TMO])) break; if (_sp > XB_SPIN_CAP) { atomicAdd(&(bar)[XB_TMO], 1u); break; } } } } while (0)
struct XcdBarrier { unsigned* bar; unsigned x; volatile LAS unsigned* st; };
__device__ __forceinline__ XcdBarrier xcd_barrier_post(unsigned* bar, volatile LAS unsigned* st, bool t0) {
    XcdBarrier b; b.bar = bar; b.x = xb_xcc_id(); b.st = st;
    if (t0) (void)xb_add(&bar[XB_XCNT(b.x)], 1u);
    return b;
}
__device__ __forceinline__ void xcd_barrier_complete(unsigned* bar, unsigned x, unsigned& nloc, unsigned& nx) {
    const unsigned G = gridDim.x * gridDim.y * gridDim.z;
    unsigned sum, cnt, mine, sp = 0u;
    for (;;) {
        sum = 0u; cnt = 0u; mine = 0u;
#pragma unroll
        for (unsigned j = 0; j < 16; ++j) { const unsigned c = xb_ld(&bar[XB_XCNT(j)]); sum += c; cnt += (c > 0u) ? 1u : 0u; mine = (j == x) ? c : mine; }
        if (sum == G) break;
        __builtin_amdgcn_s_sleep(1);
        if ((++sp & 255u) == 0u) { if (xb_ld(&bar[XB_TMO])) break; if (sp > XB_SPIN_CAP) { atomicAdd(&bar[XB_TMO], 1u); break; } }
    }
    nloc = mine > 0u ? mine : 1u; nx = cnt > 0u ? cnt : 1u;
}
__device__ __forceinline__ void xcd_barrier(const XcdBarrier& b, bool t0) {
    asm volatile("s_waitcnt vmcnt(0)" ::: "memory");
    __syncthreads();
    if (t0) {
        unsigned* bar = b.bar;
        __builtin_amdgcn_s_waitcnt(0);
        unsigned nloc = b.st[0], nx = b.st[1];
        if (nloc == 0u) { xcd_barrier_complete(bar, b.x, nloc, nx); b.st[0] = nloc; b.st[1] = nx; }
        const unsigned old = xb_add(&bar[XB_XSUB(b.x)], 1u);
        const unsigned gen = old / nloc;
        if (old + 1u == (gen + 1u) * nloc) {
            __builtin_amdgcn_fence(__ATOMIC_RELEASE, "agent");
            asm volatile("s_waitcnt vmcnt(0)" ::: "memory");
            const unsigned og = xb_add(&bar[XB_TOP], 1u);
            const unsigned tg = og / nx;
            if (og + 1u == (tg + 1u) * nx) xb_add(&bar[XB_TOPGEN], 1u);
            else XB_SPIN(xb_ld(&bar[XB_TOPGEN]) == tg, bar);
            __builtin_amdgcn_fence(__ATOMIC_ACQUIRE, "agent");
            xb_add(&bar[XB_XGEN(b.x)], 1u);
            asm volatile("s_waitcnt vmcnt(0)" ::: "memory");
        } else {
            XB_SPIN(xb_ld(&bar[XB_XGEN(b.x)]) == gen, bar);
            __builtin_amdgcn_fence(__ATOMIC_ACQUIRE, "agent");
            asm volatile("s_waitcnt vmcnt(0)" ::: "memory");
        }
    }
    __syncthreads();
}

namespace pg8 {
constexpr int BM = 256, BK = 64, HALF = 128, HTB = HALF * BK * 2, STAGE_BYTES = 8 * HTB, NXCD = 8, WGM = 8;
#if LDS_LAYOUT == 2
__host__ __device__ __forceinline__ int lds_byte(int r, int c) { const int st = (r >> 4) * 2 + (c >> 5), rr = r & 15, cc = c & 31; return st * 1024 + rr * 64 + ((((cc >> 3) ^ (rr >> 2)) & 3) << 4) + (cc & 7) * 2; }
__host__ __device__ __forceinline__ void stage_rc(int b, int& R, int& C) { const int st = b / 1024, sb = b % 1024, rr = sb / 64, pc = (sb % 64) / 16; R = (st >> 1) * 16 + rr; C = (st & 1) * 32 + (((pc ^ (rr >> 2)) & 3) << 3) + (sb % 16) / 2; }
#elif LDS_LAYOUT == 1
__host__ __device__ __forceinline__ int lds_byte(int r, int c) { const int st = (r >> 4) * 2 + (c >> 5), rr = r & 15, cc = c & 31; return st * 1024 + (cc >> 3) * 256 + rr * 16 + (cc & 7) * 2; }
__host__ __device__ __forceinline__ void stage_rc(int b, int& R, int& C) { const int st = b / 1024, sb = b % 1024; R = (st >> 1) * 16 + (sb % 256) / 16; C = (st & 1) * 32 + (sb / 256) * 8 + (sb % 16) / 2; }
#else
__host__ __device__ __forceinline__ int lds_byte(int r, int c) { const int st = (r >> 4) * 2 + (c >> 5), rr = r & 15, cc = c & 31, ob = rr * 64 + cc * 2; return st * 1024 + (ob ^ (((ob >> 9) & 1) << 5)); }
__host__ __device__ __forceinline__ void stage_rc(int b, int& R, int& C) { const int st = b / 1024, sb = b % 1024, swz = sb ^ (((sb >> 9) & 1) << 5); R = (st >> 1) * 16 + swz / 64; C = (st & 1) * 32 + (swz % 64) / 2; }
#endif
__host__ __device__ __forceinline__ int perm32(int rho) { const int n = rho >> 4, i = rho & 15; return 8 * (i >> 2) + 4 * n + (i & 3); }
typedef int v8i32_t __attribute__((ext_vector_type(8)));
template <bool F8> struct FragSel { typedef bf16x8 T; };
typedef short s16x16_t __attribute__((ext_vector_type(16)));
template <> struct FragSel<true> { typedef s16x16_t T; };
template <bool F8> __device__ __forceinline__ typename FragSel<F8>::T ld_frag(const LAS unsigned char* p) {
    if constexpr (F8) { const bf16x8 lo = *(const LAS bf16x8*)p, hi = *(const LAS bf16x8*)(p + 1024); return __builtin_shufflevector(lo, hi, 0, 1, 2, 3, 4, 5, 6, 7, 8, 9, 10, 11, 12, 13, 14, 15); }
    else return *(const LAS bf16x8*)p;
}
__device__ __forceinline__ f32x4 mma_frag(bf16x8 a, bf16x8 b, f32x4 c) { return __builtin_amdgcn_mfma_f32_16x16x32_bf16(a, b, c, 0, 0, 0); }
__device__ __forceinline__ f32x4 mma_frag(s16x16_t a, s16x16_t b, f32x4 c) {
    const v8i32_t av = __builtin_bit_cast(v8i32_t, a), bv = __builtin_bit_cast(v8i32_t, b);
    asm volatile("v_mfma_scale_f32_16x16x128_f8f6f4 %0, %1, %2, %0, %3, %3 op_sel_hi:[0,0,0]" : "+v"(c) : "v"(av), "v"(bv), "v"(0x7f7f7f7f));
    return c;
}
__device__ __forceinline__ unsigned cvt_pk_bf16(float lo, float hi) { unsigned r; asm volatile("v_cvt_pk_bf16_f32 %0, %1, %2" : "=v"(r) : "v"(lo), "v"(hi)); return r; }

__device__ __forceinline__ bool static_tile(int L, int nM, int nN, int& pm, int& pn) {
    const int nwg = nM * nN; if (L >= nwg) return false;
    int wgid = L; { const int q = nwg / NXCD, r = nwg % NXCD, xcd = wgid % NXCD, off = wgid / NXCD; wgid = (xcd < r ? xcd * (q + 1) : r * (q + 1) + (xcd - r) * q) + off; }
    const int nig = WGM * nN, gid = wgid / nig, fm = gid * WGM, gsz = (nM - fm) < WGM ? (nM - fm) : WGM;
    pm = fm + ((wgid % nig) % gsz); pn = (wgid % nig) / gsz; return true;
}

typedef int v8i32 __attribute__((ext_vector_type(8)));
template <class Epi, class Sched, bool FP8 = false, int PROBE = 0, bool MID = false>
__device__ __forceinline__ void gemm_phase(LAS unsigned char* lds, const Sched& S, const Epi& E) {
    typedef typename Sched::UnitT Unit;
    const int wid = S.wave, lane = (int)__builtin_amdgcn_mbcnt_hi(~0u, __builtin_amdgcn_mbcnt_lo(~0u, 0u)), tid = (wid << 6) | lane, wr = wid >> 2, wc = wid & 3, fr = lane & 15, fq = lane >> 4;
    const int K = S.K;
    int nt = K / BK; if constexpr (MID) nt = S.nt_total;
    int R[2], C[2];
    unsigned voffB[2];
#pragma unroll
    for (int i = 0; i < 2; ++i) { stage_rc(tid * 16 + i * 8192, R[i], C[i]); const int Rb = (R[i] & ~31) + perm32(R[i] & 31); voffB[i] = (unsigned)(Rb * K + C[i]) * 2u; }
    const unsigned kstep = (unsigned)(BK * 2);
    const unsigned hstepB = (unsigned)HALF * (unsigned)K * 2u;
    const unsigned ldsw = (unsigned)wid * 1024u;
    const int aoff = lds_byte(wr * 64 + fr, fq * 8), boff = lds_byte(wc * 32 + fr, fq * 8);
#define PG8_SA(b, h) (((b) * 2 + (h)) * HTB)
#define PG8_SB(b, h) ((4 + (b) * 2 + (h)) * HTB)
    const __amdgpu_buffer_rsrc_t rA = __builtin_amdgcn_make_buffer_rsrc((void*)S.a_buf(), 0, -1, 0x00020000), rB = __builtin_amdgcn_make_buffer_rsrc((void*)S.b_buf(), 0, -1, 0x00020000);
#define PG8_STAGE2(bufoff, rs, soff, o0, o1) do { \
        __builtin_amdgcn_raw_ptr_buffer_load_lds(rs, (LAS void*)(lds + (bufoff) + ldsw), 16, (int)(o0), (int)(soff), 0, 0); \
        __builtin_amdgcn_raw_ptr_buffer_load_lds(rs, (LAS void*)(lds + (bufoff) + ldsw + 8192), 16, (int)(o1), (int)(soff), 0, 0); } while (0)
#define PG8_STAGEA(bufoff, soff, o0, o1) PG8_STAGE2(bufoff, rA, soff, o0, o1)
#define PG8_STAGEB(bufoff, soff) PG8_STAGE2(bufoff, rB, soff, voffB[0], voffB[1])
    typedef typename pg8::FragSel<FP8>::T FragT;
    constexpr int NK = FP8 ? 1 : 2;
#define PG8_LDA(dst, b, h) do { if constexpr (PROBE == 4) break; _Pragma("unroll") for (int m = 0; m < 4; ++m) _Pragma("unroll") for (int k = 0; k < NK; ++k) dst[m][k] = pg8::ld_frag<FP8>(lds + PG8_SA(b, h) + aoff + m * 2048 + k * 1024); } while (0)
#define PG8_LDB(dst, b, h) do { if constexpr (PROBE == 4) break; _Pragma("unroll") for (int n = 0; n < 2; ++n) _Pragma("unroll") for (int k = 0; k < NK; ++k) dst[n][k] = pg8::ld_frag<FP8>(lds + PG8_SB(b, h) + boff + n * 2048 + k * 1024); } while (0)
#define PG8_MMA(ai, bj, At, Bt) do { if constexpr (PROBE == 3) break; __builtin_amdgcn_s_setprio(1); if constexpr (FP8) asm volatile("s_nop 1"); _Pragma("unroll") for (int m = 0; m < 4; ++m) _Pragma("unroll") for (int n = 0; n < 2; ++n) _Pragma("unroll") for (int k = 0; k < NK; ++k) \
        acc[ai][bj][m][n] = pg8::mma_frag(Bt[n][k], At[m][k], acc[ai][bj][m][n]); __builtin_amdgcn_s_setprio(0); } while (0)
#define PG8_WAIT_V(n) asm volatile("s_waitcnt vmcnt(" #n ")" ::: "memory")
#define PG8_WAIT_L(n) asm volatile("s_waitcnt lgkmcnt(" #n ")" ::: "memory")
#define PG8_BAR __builtin_amdgcn_s_barrier()
#define PG8_SCHED __builtin_amdgcn_sched_barrier(0)
    Unit cur, nxt; int ui = 0;
    if (!S.next(0, cur)) return;
    f32x4 acc[2][2][4][2];
#pragma unroll
    for (int a = 0; a < 2; ++a)
#pragma unroll
        for (int b = 0; b < 2; ++b)
#pragma unroll
            for (int m = 0; m < 4; ++m)
#pragma unroll
                for (int n = 0; n < 2; ++n) { float z0, z1, z2, z3; asm volatile("v_mov_b32 %0, 0\n\tv_mov_b32 %1, 0\n\tv_mov_b32 %2, 0\n\tv_mov_b32 %3, 0" : "=v"(z0), "=v"(z1), "=v"(z2), "=v"(z3)); acc[a][b][m][n] = (f32x4){z0, z1, z2, z3}; }
    FragT At[4][NK], B0[2][NK], B1[2][NK];
    if constexpr (PROBE == 4) { _Pragma("unroll") for (int m = 0; m < 4; ++m) _Pragma("unroll") for (int k = 0; k < NK; ++k) At[m][k] = FragT{}; _Pragma("unroll") for (int n = 0; n < 2; ++n) _Pragma("unroll") for (int k = 0; k < NK; ++k) { B0[n][k] = FragT{}; B1[n][k] = FragT{}; } }
    unsigned ca[4], na[4];
    S.a_offs(cur, R[0], R[1], C[0], C[1], ca);
    unsigned cA = (unsigned)__builtin_amdgcn_readfirstlane((int)S.a_soff(cur)), cB = (unsigned)__builtin_amdgcn_readfirstlane((int)S.b_soff(cur));
    PG8_STAGEB(PG8_SB(0, 0), cB); PG8_STAGEB(PG8_SB(0, 1), cB + hstepB); PG8_STAGEA(PG8_SA(0, 0), cA, ca[0], ca[1]); PG8_STAGEA(PG8_SA(0, 1), cA, ca[2], ca[3]);
    if (wr == 1) PG8_BAR;
    PG8_WAIT_V(2); PG8_BAR;
    PG8_STAGEB(PG8_SB(1, 0), cB + kstep); PG8_STAGEA(PG8_SA(1, 0), cA + kstep, ca[0], ca[1]); PG8_STAGEB(PG8_SB(1, 1), cB + hstepB + kstep);
    PG8_WAIT_V(6); PG8_BAR;
#define PG8_TRIP(a1, a2, b2, a3, b3, x0, x1, x2, x3) do { \
            PG8_LDB(B0, 0, 0); PG8_LDB(B1, 0, 1); PG8_SCHED; PG8_LDA(At, 0, 0); PG8_STAGEA(PG8_SA(1, 1), a1, ca[2], ca[3]); \
            PG8_WAIT_V(8); PG8_WAIT_L(0); PG8_BAR; PG8_MMA(0, 0, At, B0); PG8_MMA(0, 1, At, B1); PG8_BAR; PG8_SCHED; \
            PG8_LDA(At, 0, 1); PG8_STAGEB(PG8_SB(0, 0), b2); PG8_STAGEB(PG8_SB(0, 1), (b2) + hstepB); PG8_STAGEA(PG8_SA(0, 0), a2, x0, x1); \
            PG8_WAIT_V(8); PG8_WAIT_L(0); PG8_BAR; if constexpr (PROBE != 1) { PG8_MMA(1, 0, At, B0); PG8_MMA(1, 1, At, B1); } PG8_BAR; PG8_SCHED; \
            PG8_LDB(B0, 1, 0); PG8_LDB(B1, 1, 1); PG8_SCHED; PG8_LDA(At, 1, 0); PG8_STAGEA(PG8_SA(0, 1), a2, x2, x3); \
            PG8_WAIT_V(8); PG8_WAIT_L(0); PG8_BAR; PG8_MMA(0, 0, At, B0); PG8_MMA(0, 1, At, B1); PG8_BAR; PG8_SCHED; \
            PG8_LDA(At, 1, 1); PG8_STAGEB(PG8_SB(1, 0), b3); PG8_STAGEB(PG8_SB(1, 1), (b3) + hstepB); PG8_STAGEA(PG8_SA(1, 0), a3, x0, x1); \
            PG8_WAIT_V(8); PG8_WAIT_L(0); PG8_BAR; if constexpr (PROBE != 1) { PG8_MMA(1, 0, At, B0); PG8_MMA(1, 1, At, B1); } PG8_BAR; PG8_SCHED; } while (0)
    for (;;) {
        const bool has_next = S.next(ui + 1, nxt);
        unsigned nA = cA, nB = cB;
#pragma unroll
        for (int i = 0; i < 4; ++i) na[i] = ca[i];
        if (has_next) { nA = (unsigned)__builtin_amdgcn_readfirstlane((int)S.a_soff(nxt)); nB = (unsigned)__builtin_amdgcn_readfirstlane((int)S.b_soff(nxt)); S.a_offs(nxt, R[0], R[1], C[0], C[1], na); }
        for (int t = 0; t < nt; t += 2) {
            const bool last = (t == nt - 2);
            unsigned ja1 = 0u, ja2 = 0u, jb2 = 0u;
            if constexpr (MID) { if (t == S.ntf) E.mid(acc, cur, wr, wc, fr, fq); if (t >= S.ntf) ja1 = S.a_jump; if (t + 2 >= S.ntf) { ja2 = S.a_jump; jb2 = S.b_jump; } }
            const unsigned a1 = cA + (unsigned)(t + 1) * kstep + ja1;
            const unsigned a2 = last ? nA : cA + (unsigned)(t + 2) * kstep + ja2, b2 = last ? nB : cB + (unsigned)(t + 2) * kstep + jb2;
            const unsigned x0 = last ? na[0] : ca[0], x1 = last ? na[1] : ca[1], x2 = last ? na[2] : ca[2], x3 = last ? na[3] : ca[3];
            PG8_TRIP(a1, a2, b2, a2 + kstep, b2 + kstep, x0, x1, x2, x3);
        }
        if (wr == 0) PG8_BAR;
        if constexpr (FP8) asm volatile("s_nop 15\n\ts_nop 15" ::: "memory");
        E(acc, cur, wr, wc, fr, fq);
        if (!has_next) break;
#pragma unroll
        for (int a = 0; a < 2; ++a)
#pragma unroll
            for (int b = 0; b < 2; ++b)
#pragma unroll
                for (int m = 0; m < 4; ++m)
#pragma unroll
                    for (int n = 0; n < 2; ++n) { float z0, z1, z2, z3; asm volatile("v_mov_b32 %0, 0\n\tv_mov_b32 %1, 0\n\tv_mov_b32 %2, 0\n\tv_mov_b32 %3, 0" : "=v"(z0), "=v"(z1), "=v"(z2), "=v"(z3)); acc[a][b][m][n] = (f32x4){z0, z1, z2, z3}; }
        cur = nxt; cA = nA; cB = nB; ++ui;
#pragma unroll
        for (int i = 0; i < 4; ++i) ca[i] = na[i];
        if (wr == 1) PG8_BAR;
    }
    PG8_WAIT_V(0);
    PG8_BAR;
#undef PG8_SA
#undef PG8_SB
#undef PG8_TRIP
#undef PG8_STAGE2
#undef PG8_STAGEA
#undef PG8_STAGEB
#undef PG8_LDA
#undef PG8_LDB
#undef PG8_MMA
#undef PG8_WAIT_V
#undef PG8_WAIT_L
#undef PG8_BAR
#undef PG8_SCHED
}
}

struct DenseUnit { int pm, pn; };
struct DenseSched {
    typedef DenseUnit UnitT;
    const bf16_t* A; const bf16_t* Bt; int lda; int K; int nM, nN, G, c, wave;
    __device__ __forceinline__ bool next(int i, DenseUnit& u) const { return pg8::static_tile(i * G + c, nM, nN, u.pm, u.pn); }
    __device__ __forceinline__ const void* a_buf() const { return A; }
    __device__ __forceinline__ const void* b_buf() const { return Bt; }
    __device__ __forceinline__ unsigned a_soff(const DenseUnit& u) const { return (unsigned)u.pm * 256u * (unsigned)lda * 2u; }
    __device__ __forceinline__ unsigned b_soff(const DenseUnit& u) const { return (unsigned)u.pn * 256u * (unsigned)K * 2u; }
    __device__ __forceinline__ void a_offs(const DenseUnit&, int R0, int R1, int C0, int C1, unsigned (&o)[4]) const {
        o[0] = (unsigned)(R0 * lda + C0) * 2u; o[1] = (unsigned)(R1 * lda + C1) * 2u; o[2] = (unsigned)((R0 + 128) * lda + C0) * 2u; o[3] = (unsigned)((R1 + 128) * lda + C1) * 2u;
    }
};
struct MkArgs {
    const float* x; const float* c; const int* positions; const float* w_ada; const float* b_ada;
    const float* g_pre_mix; const float* g_post_mix; const float* g_pre_ffn; const float* g_post_ffn;
    const float* w_in; const float* b_in; const float* conv_qk; const float* sinks; const float* g_mlstm;
    const float* w_attn_proj; const float* w_mlstm_proj; const float* w_out; const float* w_router; const float* b_router;
    const float* w_gate_up; const float* b_gate_up; const float* w_down; const float* b_down;
    float* out; unsigned char* ws;
    const int* route_i; const float* route_w;
    int ph_lo, ph_hi;
};

struct Frame {
    LAS unsigned char* lds;
    int G, bid, vcu, wave;
};
__device__ __forceinline__ int lane_id() { return (int)__builtin_amdgcn_mbcnt_hi(~0u, __builtin_amdgcn_mbcnt_lo(~0u, 0u)); }
__device__ __forceinline__ int fresh_tid(const Frame& F) { return (F.wave << 6) | lane_id(); }

__device__ __forceinline__ float wave_sum_f(float v) {
#pragma unroll
    for (int o = 1; o < 64; o <<= 1) v += __shfl_xor(v, o);
    return v;
}
__device__ __forceinline__ float wave_max_f(float v) {
#pragma unroll
    for (int o = 1; o < 64; o <<= 1) v = fmaxf(v, __shfl_xor(v, o));
    return v;
}

__device__ __forceinline__ int in_src_col(int n) {
    if (n < 1152) { const int d = n & 63; if (d < 16) return (n & ~63) + (d >> 1) + 8 * (d & 1); return n; }
    if (n < 4352) return n;
    return n + 8;
}

template <bool MAP>
__device__ __forceinline__ void p0_transpose_item(const float* __restrict__ W, int K, int N, bf16_t* WT, LAS float* scr, int kb, int nb, int lane) {
    const int k0 = 64 * kb, n0 = 32 * nb;
    const int sc = MAP ? in_src_col(n0 + (lane & 31)) : n0 + (lane & 31);
#pragma unroll 8
    for (int i = 0; i < 32; ++i) { const int kk = 2 * i + (lane >> 5); scr[kk * 33 + (lane & 31)] = W[(size_t)(k0 + kk) * N + sc]; }
    LDS_WAIT(); asm volatile("" ::: "memory");
    const int c = lane & 7;
#pragma unroll
    for (int j = 0; j < 4; ++j) { const int n = (lane >> 3) + 8 * j; const LAS float* s = scr + (8 * c) * 33 + n;
        u32x4 o; o.x = pk2(s[0 * 33], s[1 * 33]); o.y = pk2(s[2 * 33], s[3 * 33]); o.z = pk2(s[4 * 33], s[5 * 33]); o.w = pk2(s[6 * 33], s[7 * 33]);
        *(u32x4*)(WT + (size_t)(n0 + n) * K + k0 + 8 * c) = o; }
    LDS_WAIT(); asm volatile("" ::: "memory");
}

struct ConvItem { const float* ub; unsigned char* db; unsigned lo, dlo; };
__device__ __forceinline__ ConvItem conv_item_addr(const MkArgs& a, int it, int lane, int& N) {
    constexpr int KB = 2048 / 128, I_GU = KB * (4096 / 32), I_DN = KB * (2048 / 32);
    const float* W; unsigned char* WT; int q, NB;
    if (it < NE * I_GU) { const int e = it / I_GU; q = it % I_GU; N = 4096; NB = 128; W = a.w_gate_up + (size_t)e * 2048 * 4096; WT = a.ws + wsf::WGU8 + (size_t)e * 4096 * 2048; }
    else { const int r = it - NE * I_GU, e = r / I_DN; q = r % I_DN; N = 2048; NB = 64; W = a.w_down + (size_t)e * 2048 * 2048; WT = a.ws + wsf::WDN8 + (size_t)e * 2048 * 2048; }
    const int k0 = 128 * (q / NB), n0 = 32 * (q % NB);
    ConvItem c; c.ub = W + (size_t)k0 * N + n0; c.db = WT + (size_t)n0 * 2048 + k0;
    c.lo = (unsigned)((lane >> 3) * N + (lane & 7) * 4) * 4u; c.dlo = (unsigned)((lane >> 3) * 2048 + 16 * (lane & 7));
    return c;
}
__device__ __forceinline__ void conv_item_load(const ConvItem& c, int N, f32x4 (&v)[16]) {
#pragma unroll
    for (int i = 0; i < 16; ++i) v[i] = __builtin_nontemporal_load((const f32x4*)((const unsigned char*)(c.ub + (size_t)(8 * i) * N) + c.lo));
}
__device__ __forceinline__ void conv_item_store(const ConvItem& c, const f32x4 (&v)[16], LAS float* scr, int lane, bool dry = false) {
    const int kr = lane >> 3, n4 = (lane & 7) * 4;
#pragma unroll
    for (int i = 0; i < 16; ++i) { const int k = 8 * i + kr, rot = 20 * (i >> 1); LAS float* row = scr + k * 33;
        row[(n4 + 0 + rot) & 31] = v[i].x; row[(n4 + 1 + rot) & 31] = v[i].y; row[(n4 + 2 + rot) & 31] = v[i].z; row[(n4 + 3 + rot) & 31] = v[i].w; }
    LDS_WAIT(); asm volatile("" ::: "memory");
    const int cblk = lane & 7;
#pragma unroll
    for (int j = 0; j < 4; ++j) {
        const int n = (lane >> 3) + 8 * j;
        const LAS float* sp = scr + (16 * cblk) * 33 + ((n + 20 * cblk) & 31);
        u32x4 o;
        o.x = pk4_fp8(sp[0 * 33] * W8SCALE, sp[1 * 33] * W8SCALE, sp[2 * 33] * W8SCALE, sp[3 * 33] * W8SCALE);
        o.y = pk4_fp8(sp[4 * 33] * W8SCALE, sp[5 * 33] * W8SCALE, sp[6 * 33] * W8SCALE, sp[7 * 33] * W8SCALE);
        o.z = pk4_fp8(sp[8 * 33] * W8SCALE, sp[9 * 33] * W8SCALE, sp[10 * 33] * W8SCALE, sp[11 * 33] * W8SCALE);
        o.w = pk4_fp8(sp[12 * 33] * W8SCALE, sp[13 * 33] * W8SCALE, sp[14 * 33] * W8SCALE, sp[15 * 33] * W8SCALE);
        if (!dry) *(u32x4*)(c.db + (size_t)(8 * j) * 2048 + c.dlo) = o; else asm volatile("" :: "v"(o.x), "v"(o.y), "v"(o.z), "v"(o.w));
    }
    LDS_WAIT(); asm volatile("" ::: "memory");
}
__device__ __forceinline__ void conv_loads_asm(const ConvItem& c, int N, f32x4 (&v)[16]) {
#pragma unroll
    for (int i = 0; i < 16; ++i) { const float* p = c.ub + (size_t)(8 * i) * N;
        asm volatile("global_load_dwordx4 %0, %1, %2 nt" : "=&v"(v[i]) : "v"(c.lo), "s"(p)); }
}
#define CONV_WAIT(n, v) do { \
    asm volatile("s_waitcnt vmcnt(" #n ")" : "+v"(v[0]), "+v"(v[1]), "+v"(v[2]), "+v"(v[3]), "+v"(v[4]), "+v"(v[5]), "+v"(v[6]), "+v"(v[7]) :: "memory"); \
    asm volatile("" : "+v"(v[8]), "+v"(v[9]), "+v"(v[10]), "+v"(v[11]), "+v"(v[12]), "+v"(v[13]), "+v"(v[14]), "+v"(v[15]) :: "memory"); } while (0)
__device__ __forceinline__ void conv_item_store_asm(const ConvItem& c, const f32x4 (&v)[16], LAS float* scr, int lane) {
    const int kr = lane >> 3, n4 = (lane & 7) * 4;
#pragma unroll
    for (int i = 0; i < 16; ++i) { const int k = 8 * i + kr, rot = 20 * (i >> 1); LAS float* row = scr + k * 33;
        row[(n4 + 0 + rot) & 31] = v[i].x; row[(n4 + 1 + rot) & 31] = v[i].y; row[(n4 + 2 + rot) & 31] = v[i].z; row[(n4 + 3 + rot) & 31] = v[i].w; }
    LDS_WAIT(); asm volatile("" ::: "memory");
    const int cblk = lane & 7;
#pragma unroll
    for (int j = 0; j < 4; ++j) {
        const int n = (lane >> 3) + 8 * j;
        const LAS float* sp = scr + (16 * cblk) * 33 + ((n + 20 * cblk) & 31);
        u32x4 o;
        o.x = pk4_fp8(sp[0 * 33] * W8SCALE, sp[1 * 33] * W8SCALE, sp[2 * 33] * W8SCALE, sp[3 * 33] * W8SCALE);
        o.y = pk4_fp8(sp[4 * 33] * W8SCALE, sp[5 * 33] * W8SCALE, sp[6 * 33] * W8SCALE, sp[7 * 33] * W8SCALE);
        o.z = pk4_fp8(sp[8 * 33] * W8SCALE, sp[9 * 33] * W8SCALE, sp[10 * 33] * W8SCALE, sp[11 * 33] * W8SCALE);
        o.w = pk4_fp8(sp[12 * 33] * W8SCALE, sp[13 * 33] * W8SCALE, sp[14 * 33] * W8SCALE, sp[15 * 33] * W8SCALE);
        unsigned char* p = c.db + (size_t)(8 * j) * 2048;
        asm volatile("global_store_dwordx4 %0, %1, %2\n\ts_nop 2" :: "v"(c.dlo), "v"(o), "s"(p) : "memory");
    }
    LDS_WAIT(); asm volatile("" ::: "memory");
}
__device__ __forceinline__ void moe_convert(const MkArgs& a, Frame& F, int widx, int nw, bool dry = false, int it0 = 0, int it1 = -1) {
    const int lane = lane_id();
    LAS float* scr = (LAS float*)(F.lds + F.wave * 16896);
    constexpr int NIT_ALL = NE * ((2048 / 128) * (4096 / 32) + (2048 / 128) * (2048 / 32));
    const int NIT = it1 < 0 ? NIT_ALL : it1;
    widx += it0;
    if (widx >= NIT) return;
    (void)dry;
    asm volatile("s_waitcnt vmcnt(0)" ::: "memory");
    f32x4 va[16], vb[16]; int Na, Nb;
#define CONV_CL(i_) ((i_) < NIT ? (i_) : NIT - 1)
    ConvItem ca = conv_item_addr(a, widx, lane, Na), cb = conv_item_addr(a, CONV_CL(widx + nw), lane, Nb);
    conv_loads_asm(ca, Na, va);
    conv_loads_asm(cb, Nb, vb);
    CONV_WAIT(16, va);
    conv_item_store_asm(ca, va, scr, lane);
    ca = conv_item_addr(a, CONV_CL(widx + 2 * nw), lane, Na); conv_loads_asm(ca, Na, va);
    for (int it = widx + nw; it < NIT; it += 2 * nw) {
        CONV_WAIT(20, vb);
        conv_item_store_asm(cb, vb, scr, lane);
        cb = conv_item_addr(a, CONV_CL(it + 2 * nw), lane, Nb); conv_loads_asm(cb, Nb, vb);
        CONV_WAIT(20, va);
        conv_item_store_asm(ca, va, scr, lane);
        ca = conv_item_addr(a, CONV_CL(it + 3 * nw), lane, Na); conv_loads_asm(ca, Na, va);
    }
#undef CONV_CL
    CONV_WAIT(0, va); CONV_WAIT(0, vb);
}
__device__ __forceinline__ int n_conv_wgs(int G) { return G == 256 ? CONV_WGS : 0; }

struct TrItem { const float* src; bf16_t* dst; int N, perm; };
__device__ __forceinline__ TrItem tr_item_addr(const MkArgs& a, int it, int lane) {
    constexpr int I_IN = 32 * (fp::NIN / 32), I_AP = 16 * 64, I_MP = 16 * 64;
    const float* W; bf16_t* WT; int K, N, nblk, r = it, perm = 0, shift = 0;
    unsigned char* ws = a.ws;
    if (r < I_IN) { W = a.w_in; WT = (bf16_t*)(ws + wsf::WIN_T); K = 2048; N = INW; nblk = fp::NIN / 32; }
    else if ((r -= I_IN) < I_AP) { W = a.w_attn_proj; WT = (bf16_t*)(ws + wsf::WAP_T); K = 1024; N = 2048; nblk = 64; }
    else if ((r -= I_AP) < I_MP) { W = a.w_mlstm_proj; WT = (bf16_t*)(ws + wsf::WMP_T); K = 1024; N = 2048; nblk = 64; }
    else { r -= I_MP; W = a.w_out; WT = (bf16_t*)(ws + wsf::WOUT_T); K = 2048; N = 2048; nblk = 64; }
    const int kb = r / nblk, nb = r % nblk, k0 = 64 * kb, n0 = 32 * nb;
    if (it < I_IN) { perm = (n0 < 1152 && (n0 & 32) == 0) ? 1 : 0; shift = n0 >= 4352 ? 8 : 0; }
    TrItem t; t.src = W + (size_t)(k0 + (lane >> 3)) * N + n0 + shift + (lane & 7) * 4; t.dst = WT + (size_t)(n0 + (lane >> 3)) * K + k0 + 8 * (lane & 7); t.N = N; t.perm = perm | (K << 1);
    return t;
}
__device__ __forceinline__ void tr_item_load(const TrItem& t, f32x4 (&v)[8]) {
#pragma unroll
    for (int i = 0; i < 8; ++i) v[i] = *(const f32x4*)(t.src + (size_t)(8 * i) * t.N);
}
__device__ __forceinline__ void tr_item_store(const TrItem& t, const f32x4 (&v)[8], LAS float* scr, int lane) {
    const int kr = lane >> 3, n4 = (lane & 7) * 4, K = t.perm >> 1;
#pragma unroll
    for (int i = 0; i < 8; ++i) { const int k = 8 * i + kr, rot = 4 * (i >> 2); LAS float* row = scr + k * 33 + ((n4 + rot) & 31);
        row[0] = v[i].x; row[1] = v[i].y; row[2] = v[i].z; row[3] = v[i].w; }
    LDS_WAIT(); asm volatile("" ::: "memory");
    const int cb = lane & 7;
#pragma unroll
    for (int j = 0; j < 4; ++j) {
        const int n = (lane >> 3) + 8 * j;
        int c = n; if ((t.perm & 1) && n < 16) c = (n >> 1) + 8 * (n & 1);
        const LAS float* sp = scr + (8 * cb) * 33 + ((c + 4 * (cb >> 2)) & 31);
        u32x4 o; o.x = pk2(sp[0 * 33], sp[1 * 33]); o.y = pk2(sp[2 * 33], sp[3 * 33]); o.z = pk2(sp[4 * 33], sp[5 * 33]); o.w = pk2(sp[6 * 33], sp[7 * 33]);
        *(u32x4*)(t.dst + (size_t)(8 * j) * K) = o;
    }
    LDS_WAIT(); asm volatile("" ::: "memory");
}

__device__ __forceinline__ void ada_gemv(const MkArgs& a, Frame& F, int blk_lo, int blk_hi) {
    const int f_tid = fresh_tid(F), f_lane = f_tid & 63, f_wave = F.wave;
    LAS float* sc = (LAS float*)F.lds;
    LAS float* red = sc + 4096;
    if (blk_lo + F.vcu >= blk_hi) return;
    for (int i = f_tid; i < 2 * D; i += fp::NT) sc[i] = silu_f(a.c[i]);
    __syncthreads();
    const int k0 = f_wave * 256 + (f_lane >> 5) * 128;
    for (int cblk = blk_lo + F.vcu; cblk < blk_hi; cblk += F.G) {
        const float* wp = a.w_ada + (size_t)k0 * MODW + cblk * 32 + (f_lane & 31);
        float a0 = 0.f, a1 = 0.f;
#pragma unroll 32
        for (int k = 0; k < 128; ++k) { const float w = wp[(size_t)k * MODW]; a0 += w * sc[k0 + k]; a1 += w * sc[2048 + k0 + k]; }
        red[(f_wave * 2 + 0) * 64 + f_lane] = a0; red[(f_wave * 2 + 1) * 64 + f_lane] = a1;
        __syncthreads();
        if (f_tid < 64) { const int b = f_tid >> 5, j = f_tid & 31; float sum = a.b_ada[cblk * 32 + j];
#pragma unroll
          for (int w8 = 0; w8 < 8; ++w8) sum += red[(w8 * 2 + b) * 64 + j] + red[(w8 * 2 + b) * 64 + 32 + j];
          ((float*)(a.ws + wsf::MOD))[b * MODW + cblk * 32 + j] = sum; }
        __syncthreads();
    }
}

__device__ __forceinline__ void phase0(const MkArgs& a, Frame& F, int parts = 7) {
    const int f_tid = fresh_tid(F), f_lane = f_tid & 63, f_wave = F.wave;
    unsigned char* ws = a.ws;
    const int gw = F.vcu * fp::NW + f_wave, NGW = F.G * fp::NW;
    if (parts & 1) {
        LAS float* scr = (LAS float*)(F.lds + f_wave * 8448);
        constexpr int NITEMS = 32 * (fp::NIN / 32) + 16 * 64 + 16 * 64 + 32 * 64;
        if (gw < NITEMS) {
            f32x4 va[8], vb[8];
            TrItem ta = tr_item_addr(a, gw, f_lane), tb;
            tr_item_load(ta, va);
            for (int it = gw; it < NITEMS; it += 2 * NGW) {
                const int i1 = it + NGW, i2 = it + 2 * NGW;
                tb = tr_item_addr(a, i1 < NITEMS ? i1 : NITEMS - 1, f_lane); tr_item_load(tb, vb);
                tr_item_store(ta, va, scr, f_lane);
                if (i1 >= NITEMS) break;
                ta = tr_item_addr(a, i2 < NITEMS ? i2 : NITEMS - 1, f_lane); tr_item_load(ta, va);
                tr_item_store(tb, vb, scr, f_lane);
            }
        }
    }
#if MOE_FP8
    __syncthreads();
    if (n_conv_wgs(F.G) == 0) moe_convert(a, F, gw, NGW);
#if DRY_PROBE
    moe_convert(a, F, gw, NGW, true);
#endif
#endif
    __syncthreads();
    if (parts & 2) ada_gemv(a, F, 0, 4096 / 32);
    if (!(parts & 4)) return;
    const int gt = F.vcu * fp::NT + f_tid, NGT = F.G * fp::NT;
    for (int i = gt; i < NTOK * 8; i += NGT) { float cs, sn; rope_cs(a.positions[i >> 3], i & 7, cs, sn); ((f32x2*)(ws + wsf::CS))[i] = (f32x2){cs, sn}; }
    for (int i = gt; i < fp::NIN; i += NGT) ((float*)(ws + wsf::BINP))[i] = a.b_in[in_src_col(i)];
    for (int i = gt; i < 32 * 2048; i += NGT) {
        const int e = i >> 11, k = i & 2047; const float w = a.w_router[k * 32 + e]; const unsigned hi = f2bf(w); const float rem = w - __builtin_bit_cast(float, hi << 16);
        ((bf16_t*)(ws + wsf::WRT))[i] = (bf16_t)hi; ((bf16_t*)(ws + wsf::WRT))[32 * 2048 + i] = (bf16_t)f2bf(rem);
    }
}

__device__ __forceinline__ void phase1(const MkArgs& a, Frame& F) {
    const int f_tid = fresh_tid(F), f_lane = f_tid & 63, f_wave = F.wave;
    unsigned char* ws = a.ws;
    const float* mod = (const float*)(ws + wsf::MOD);
    LAS float* lmod = (LAS float*)F.lds;
    LAS float* wg = (LAS float*)(F.lds + 32768);
    for (int i = f_tid; i < 2048 * 8; i += fp::NT) wg[(i & 7) * 2048 + (i >> 3)] = a.w_in[(size_t)(i >> 3) * INW + OFF_MI + (i & 7)];
    for (int blk = F.vcu; blk < NTOK / 64; blk += F.G) {
        const int b = (blk * 64) / S;
        __syncthreads();
        for (int i = f_tid; i < 2048; i += fp::NT) { lmod[i] = mod[b * MODW + i]; lmod[2048 + i] = a.g_pre_mix[i] * (1.f + mod[b * MODW + 2048 + i]); }
        __syncthreads();
#pragma unroll 1
        for (int rr = 0; rr < 8; ++rr) {
            const int m = blk * 64 + f_wave * 8 + rr;
            const GAS f32x4* xr = (const GAS f32x4*)(a.x + (size_t)m * D);
            f32x4 xv[8]; float ss = 0.f;
#pragma unroll
            for (int j = 0; j < 8; ++j) { xv[j] = xr[64 * j + f_lane]; ss += (xv[j].x * xv[j].x + xv[j].y * xv[j].y) + (xv[j].z * xv[j].z + xv[j].w * xv[j].w); }
            const float r = rsqrtf(wave_sum_f(ss) * (1.f / D) + EPS);
            float g8[8];
#pragma unroll
            for (int e = 0; e < 8; ++e) g8[e] = 0.f;
            GAS u32x2* o8 = (GAS u32x2*)(ws + wsf::H1 + (size_t)m * D * 2);
#pragma unroll
            for (int j = 0; j < 8; ++j) {
                const int c0 = 4 * (64 * j + f_lane);
                const f32x4 v = xv[j];
                const f32x4 sh = *(const LAS f32x4*)(lmod + c0), gs = *(const LAS f32x4*)(lmod + 2048 + c0);
                f32x4 h;
                h.x = v.x * r * gs.x + sh.x; h.y = v.y * r * gs.y + sh.y;
                h.z = v.z * r * gs.z + sh.z; h.w = v.w * r * gs.w + sh.w;
                o8[64 * j + f_lane] = (u32x2){pg8::cvt_pk_bf16(h.x, h.y), pg8::cvt_pk_bf16(h.z, h.w)};
#pragma unroll
                for (int e = 0; e < 8; ++e) { const f32x4 w = *(const LAS f32x4*)(wg + e * 2048 + c0); g8[e] += (h.x * w.x + h.y * w.y) + (h.z * w.z + h.w * w.w); }
            }
            float mine = 0.f;
#pragma unroll
            for (int e = 0; e < 8; ++e) { const float s8 = wave_sum_f(g8[e]); if (f_lane == e) mine = s8; }
            if (f_lane < 8) ((float*)(ws + wsf::GATES))[(size_t)m * 8 + f_lane] = mine + a.b_in[OFF_MI + f_lane];
        }
    }
}

struct EpiIn {
    bf16_t* O; const float* bias; const f32x2* cs; bool skip; bool nostore;
    __device__ __forceinline__ void operator()(const f32x4 (&acc)[2][2][4][2], const DenseUnit& u, int wr, int wc, int fr, int fq) const {
        if (skip) {
#pragma unroll
            for (int ai = 0; ai < 2; ++ai)
#pragma unroll
                for (int bj = 0; bj < 2; ++bj)
#pragma unroll
                    for (int m = 0; m < 4; ++m)
#pragma unroll
                        for (int n = 0; n < 2; ++n) asm volatile("" :: "v"(acc[ai][bj][m][n]));
            return;
        }
        const int row0 = u.pm * 256 + wr * 64 + fr, col0 = u.pn * 256 + wc * 32 + 8 * fq;
        const int pn = u.pn;
        const bool ropelane = ((wc & 1) == 0) && fq < 2;
        const int i0 = fq * 4;
        f32x4 bv[2][2];
#pragma unroll
        for (int bj = 0; bj < 2; ++bj)
#pragma unroll
            for (int n = 0; n < 2; ++n) bv[bj][n] = *(const f32x4*)(bias + col0 + bj * 128 + 4 * n);
#pragma unroll
        for (int ai = 0; ai < 2; ++ai)
#pragma unroll
            for (int m = 0; m < 4; ++m) {
                const int row = row0 + ai * 128 + m * 16;
                bf16_t* rowp = O + (size_t)row * fp::NIN + col0;
#pragma unroll
                for (int bj = 0; bj < 2; ++bj) {
                    f32x4 v0 = acc[ai][bj][m][0] + bv[bj][0], v1 = acc[ai][bj][m][1] + bv[bj][1];
                    if (pn < 4 || (pn == 4 && bj == 0)) {
                        if (ropelane) {
                            const f32x4 ca = *(const f32x4*)(cs + (size_t)row * 8 + i0), cb = *(const f32x4*)(cs + (size_t)row * 8 + i0 + 2);
                            f32x4 r0, r1;
                            r0.x = v0.x * ca.x - v0.y * ca.y; r0.y = v0.y * ca.x + v0.x * ca.y;
                            r0.z = v0.z * ca.z - v0.w * ca.w; r0.w = v0.w * ca.z + v0.z * ca.w;
                            r1.x = v1.x * cb.x - v1.y * cb.y; r1.y = v1.y * cb.x + v1.x * cb.y;
                            r1.z = v1.z * cb.z - v1.w * cb.w; r1.w = v1.w * cb.z + v1.z * cb.w;
                            v0 = r0; v1 = r1;
                        }
                        if (pn < 4) { v0 = v0 * fp::QSCALE; v1 = v1 * fp::QSCALE; }
                    } else if (pn >= 13 && pn < 17) {
#pragma unroll
                        for (int q = 0; q < 4; ++q) { v0[q] = fast_sigmoid(v0[q]); v1[q] = fast_sigmoid(v1[q]); }
                    }
                    u32x4 w; w.x = pg8::cvt_pk_bf16(v0[0], v0[1]); w.y = pg8::cvt_pk_bf16(v0[2], v0[3]); w.z = pg8::cvt_pk_bf16(v1[0], v1[1]); w.w = pg8::cvt_pk_bf16(v1[2], v1[3]);
#if EPI_SKIP_PROBE == 6
                    if (nostore) asm volatile("" :: "v"(w)); else
#endif
                    *(u32x4*)(rowp + bj * 128) = w;
                }
            }
    }
};

__device__ __forceinline__ void phase2(const MkArgs& a, Frame& F, bool skip_epi = false) {
    const int f_tid = fresh_tid(F), f_lane = f_tid & 63, f_wave = F.wave;
    unsigned char* ws = a.ws;
#if MOE_FP8
    const int ncv = n_conv_wgs(F.G), Gg = F.G - ncv;
    constexpr int NIT_ALL = NE * ((2048 / 128) * (4096 / 32) + (2048 / 128) * (2048 / 32));
    const int nsplit = ncv > 0 ? (int)((long)NIT_ALL * CONV_SPLIT / 1024) : NIT_ALL;
    if (F.bid >= Gg) { moe_convert(a, F, (F.bid - Gg) * fp::NW + F.wave, ncv * fp::NW, false, 0, nsplit);
#if DRY_PROBE == 2
        moe_convert(a, F, (F.bid - Gg) * fp::NW + F.wave, ncv * fp::NW, true);
#endif
        return; }
#else
    const int Gg = F.G;
#endif
#if MOE_FP8 && STAGGER_NG > 1
    const int stg = (ncv > 0 && nsplit < NIT_ALL) ? ((F.bid >> 3) % STAGGER_NG) * STAGGER_STEP : 0;
    const int nsplit2 = nsplit + stg * Gg * fp::NW;
    if (stg > 0) { moe_convert(a, F, F.bid * fp::NW + F.wave, Gg * fp::NW, false, nsplit, nsplit2 < NIT_ALL ? nsplit2 : NIT_ALL); __syncthreads(); }
#else
    const int nsplit2 = nsplit;
#endif
    DenseSched S{(const bf16_t*)(ws + wsf::H1), (const bf16_t*)(ws + wsf::WIN_T), 2048, 2048, NTOK / 256, fp::NIN / 256, Gg, F.bid, F.wave};
    EpiIn E{(bf16_t*)(ws + wsf::PROJB), (const float*)(ws + wsf::BINP), (const f32x2*)(ws + wsf::CS), skip_epi && EPI_SKIP_PROBE != 6, skip_epi && EPI_SKIP_PROBE == 6};
    pg8::gemm_phase<EpiIn, DenseSched>(F.lds, S, E);
#if MOE_FP8
    if (ncv > 0 && nsplit2 < NIT_ALL) { __syncthreads(); moe_convert(a, F, F.bid * fp::NW + F.wave, Gg * fp::NW, false, nsplit2, NIT_ALL); }
#endif
}
__device__ __forceinline__ f32x4 mfma16(bf16x8 a, bf16x8 b, f32x4 c) { return __builtin_amdgcn_mfma_f32_16x16x32_bf16(a, b, c, 0, 0, 0); }
__device__ __forceinline__ float exp2_fast(float x) { return __builtin_amdgcn_exp2f(x); }
typedef short v4i16_t __attribute__((ext_vector_type(4)));
__device__ __forceinline__ bf16x8 tr_frag(const LAS bf16_t* base, int stride, int lane) {
    const LAS bf16_t* p = base + (8 * (lane >> 4) + ((lane & 15) >> 2)) * stride + 4 * (lane & 3);
    const v4i16_t lo = __builtin_amdgcn_ds_read_tr16_b64_v4i16((LAS v4i16_t*)p), hi = __builtin_amdgcn_ds_read_tr16_b64_v4i16((LAS v4i16_t*)(p + 4 * stride));
    return __builtin_shufflevector(lo, hi, 0, 1, 2, 3, 4, 5, 6, 7);
}

__device__ __forceinline__ void attn_unit(const MkArgs& a, Frame& F, int unit) {
    const int f_tid = fresh_tid(F), f_lane = f_tid & 63, f_wave = F.wave;
    const int b = unit >> 7, hk = (unit >> 6) & 1, n = unit & 63;
    const bf16_t* PB = (const bf16_t*)(a.ws + wsf::PROJB);
    bf16_t* OA = (bf16_t*)(a.ws + wsf::OAT);
    const size_t tok0 = (size_t)b * S + (size_t)n * 128;
    LAS bf16_t* Ks = (LAS bf16_t*)F.lds;
    LAS bf16_t* Vs = (LAS bf16_t*)(F.lds + 36864);
    LAS bf16_t* Pw = (LAS bf16_t*)(F.lds + 36864 + 39168 + f_wave * 5376);
#pragma unroll
    for (int i = 0; i < 4; ++i) {
        const int q = f_tid + 512 * i, row = q >> 3, ch = q & 7;
        u32x4 kv = (u32x4){0u, 0u, 0u, 0u}, vv = kv;
        if (n > 0 || row >= 128) {
            const bf16_t* src = PB + (tok0 - 128 + row) * fp::NIN + hk * 64 + ch * 8;
            kv = *(const u32x4*)(src + fp::PB_K); vv = *(const u32x4*)(src + fp::PB_V);
        }
        *(LAS u32x4*)(Ks + row * 72 + ch * 8) = kv;
        *(LAS u32x4*)(Vs + row * 72 + ch * 8) = vv;
    }
    if (f_tid < 128) *(LAS u32x4*)(Vs + (256 + (f_tid >> 3)) * 72 + (f_tid & 7) * 8) = (u32x4){0u, 0u, 0u, 0u};
    __syncthreads();
    const int c16 = f_lane & 15, grp = f_lane >> 4, h = hk * 8 + f_wave;
    const float sink2 = a.sinks[h] * fp::LOG2E;
    bf16x8 qn[2];
#pragma unroll
    for (int ks = 0; ks < 2; ++ks) qn[ks] = *(const bf16x8*)(PB + (tok0 + c16) * fp::NIN + fp::PB_Q + h * 64 + ks * 32 + grp * 8);
    u32x2 po[4] = {(u32x2){0u, 0u}, (u32x2){0u, 0u}, (u32x2){0u, 0u}, (u32x2){0u, 0u}};
#pragma unroll 1
    for (int tt = 0; tt < 8; ++tt) {
        { const size_t ptok = tok0 + (tt > 0 ? tt - 1 : 0) * 16 + c16;
#pragma unroll
          for (int dt = 0; dt < 4; ++dt) *(u32x2*)(OA + ptok * 1024 + h * 64 + 16 * dt + 4 * grp) = po[dt]; }
        bf16x8 qf[2];
        { const size_t ntok = tok0 + (tt < 7 ? tt + 1 : 7) * 16 + c16;
#pragma unroll
          for (int ks = 0; ks < 2; ++ks) { qf[ks] = qn[ks]; qn[ks] = *(const bf16x8*)(PB + ntok * fp::NIN + fp::PB_Q + h * 64 + ks * 32 + grp * 8); } }
        f32x4 sacc[9];
#pragma unroll
        for (int jq = 0; jq < 9; ++jq) {
            sacc[jq] = (f32x4){0.f, 0.f, 0.f, 0.f};
#pragma unroll
            for (int ks = 0; ks < 2; ++ks) { const bf16x8 kf = *(const LAS bf16x8*)(Ks + (16 * (tt + jq) + c16) * 72 + ks * 32 + grp * 8); sacc[jq] = mfma16(kf, qf[ks], sacc[jq]); }
        }
        float mx = sink2;
#pragma unroll
        for (int jq = 0; jq < 9; ++jq)
#pragma unroll
            for (int r = 0; r < 4; ++r) {
                const int diff = 128 + c16 - 16 * jq - 4 * grp - r, jrel = 16 * (tt + jq) + 4 * grp + r;
                const bool ok = diff >= 0 && diff < 128 && (n > 0 || jrel >= 128);
                sacc[jq][r] = ok ? sacc[jq][r] : -INFINITY;
                mx = fmaxf(mx, sacc[jq][r]);
            }
        mx = fmaxf(mx, __shfl_xor(mx, 16)); mx = fmaxf(mx, __shfl_xor(mx, 32));
        float ls = 0.f;
#pragma unroll
        for (int jq = 0; jq < 9; ++jq) {
            float p[4];
#pragma unroll
            for (int r = 0; r < 4; ++r) { p[r] = exp2_fast(sacc[jq][r] - mx); ls += p[r]; }
            *(LAS u32x2*)(Pw + c16 * 168 + 16 * jq + 4 * grp) = (u32x2){pk2(p[0], p[1]), pk2(p[2], p[3])};
        }
        *(LAS u32x2*)(Pw + c16 * 168 + 144 + 4 * grp) = (u32x2){0u, 0u};
        ls += __shfl_xor(ls, 16); ls += __shfl_xor(ls, 32);
        ls += exp2_fast(sink2 - mx);
        const float inv = 1.f / ls;
        LDS_WAIT();
        f32x4 oacc[4];
#pragma unroll
        for (int dt = 0; dt < 4; ++dt) oacc[dt] = (f32x4){0.f, 0.f, 0.f, 0.f};
#pragma unroll
        for (int k2 = 0; k2 < 5; ++k2) {
            const bf16x8 pb = *(const LAS bf16x8*)(Pw + c16 * 168 + 32 * k2 + 8 * grp);
#pragma unroll
            for (int dt = 0; dt < 4; ++dt) { const bf16x8 va = tr_frag(Vs + (16 * tt + 32 * k2) * 72 + 16 * dt, 72, f_lane); oacc[dt] = mfma16(va, pb, oacc[dt]); }
        }
#pragma unroll
        for (int dt = 0; dt < 4; ++dt) po[dt] = (u32x2){pk2(oacc[dt][0] * inv, oacc[dt][1] * inv), pk2(oacc[dt][2] * inv, oacc[dt][3] * inv)};
        LDS_WAIT();
    }
#pragma unroll
    for (int dt = 0; dt < 4; ++dt) *(u32x2*)(OA + (tok0 + 7 * 16 + c16) * 1024 + h * 64 + 16 * dt + 4 * grp) = po[dt];
    __syncthreads();
}

__device__ __forceinline__ void unpack8(const u32x4 v, float (&f)[8]) {
    f[0] = bflo(v.x); f[1] = bfhi(v.x); f[2] = bflo(v.y); f[3] = bfhi(v.y); f[4] = bflo(v.z); f[5] = bfhi(v.z); f[6] = bflo(v.w); f[7] = bfhi(v.w);
}
__device__ __forceinline__ void stage_vt(const bf16_t* PB, size_t tok0, int col0, LAS bf16_t* Vs, int tid) {
#pragma unroll
    for (int i = 0; i < 8; ++i) {
        const int q = tid + 512 * i, row = q >> 5, ch = q & 31;
        *(LAS u32x4*)(Vs + row * 272 + ch * 8) = *(const u32x4*)(PB + (tok0 + row) * fp::NIN + col0 + ch * 8);
    }
}

__device__ __forceinline__ void m1_unit(const MkArgs& a, Frame& F, int u) {
    const int f_tid = fresh_tid(F), f_lane = f_tid & 63, f_wave = F.wave;
    const int bh = u >> 6, c = u & 63, b = bh >> 2, h = bh & 3;
    const size_t tok0 = (size_t)b * S + (size_t)c * 128;
    unsigned char* ws = a.ws;
    const bf16_t* PB = (const bf16_t*)(ws + wsf::PROJB);
    LAS bf16_t* Kw = (LAS bf16_t*)F.lds;
    LAS bf16_t* Vt = (LAS bf16_t*)(F.lds + 34816);
    LAS float* gl = (LAS float*)(F.lds + 34816 + 69632);
    const float* GT = (const float*)(ws + wsf::GATES);
    const int tid = f_tid;
    LAS bf16_t* Raw = Vt;
    float gi = 0.f, gf = 0.f;
    if (tid < 128) { gi = GT[(tok0 + tid) * 8 + h]; gf = GT[(tok0 + tid) * 8 + 4 + h]; }
    u32x4 rawv[9];
#pragma unroll
    for (int i = 0; i < 9; ++i) {
        const int q = tid + 512 * i, row = (q >> 5) < 131 ? (q >> 5) : 130, ch = q & 31;
        const int back = (c * 128 + row - 3 >= 0) ? 3 - row : 0;
        rawv[i] = *(const u32x4*)(PB + (size_t)((long)tok0 - back) * fp::NIN + (ch < 16 ? fp::PB_MQ + h * 128 + ch * 8 : fp::PB_MK + h * 128 + (ch - 16) * 8));
    }
    u32x4 vreg[8];
#pragma unroll
    for (int i = 0; i < 8; ++i) { const int q = tid + 512 * i; vreg[i] = *(const u32x4*)(PB + (tok0 + (q >> 5)) * fp::NIN + fp::PB_MV + h * 256 + (q & 31) * 8); }
#pragma unroll
    for (int i = 0; i < 9; ++i) {
        const int q = tid + 512 * i, row = q >> 5, ch = q & 31;
        if (row < 131) *(LAS u32x4*)(Raw + row * 256 + ch * 8) = (c * 128 + row - 3 >= 0) ? rawv[i] : (u32x4){0u, 0u, 0u, 0u};
    }
    float li = 0.f, lf = 0.f;
    if (tid < 128) { li = softcap_f(gi); lf = logsigmoid_f(softcap_f(gf)); }
    float cum = lf;
#pragma unroll
    for (int o = 1; o < 64; o <<= 1) { const float t = __shfl_up(cum, o); if (f_lane >= o) cum += t; }
    if (tid == 63) gl[384] = cum;
    __syncthreads();
    if (tid >= 64 && tid < 128) cum += gl[384];
    if (tid == 127) gl[385] = cum;
    __syncthreads();
    const float g = gl[385];
    const float av = (tid < 128) ? (g - cum + li) : -INFINITY;
    const float wm = wave_max_f(av);
    if (f_lane == 0 && f_wave < 2) gl[386 + f_wave] = wm;
    __syncthreads();
    const float mloc = fmaxf(gl[386], gl[387]);
    if (tid < 128) {
        gl[256 + tid] = expf(av - mloc);
        ((float*)(ws + wsf::BCUM))[(size_t)bh * S + c * 128 + tid] = cum;
        ((float*)(ws + wsf::LOGI))[(size_t)bh * S + c * 128 + tid] = li;
    }
    if (tid == 0) { ((float*)(ws + wsf::GSUM))[u] = g; ((float*)(ws + wsf::MLOC))[u] = mloc; }
    __syncthreads();
#pragma unroll 2
    for (int i = 0; i < 8; ++i) {
        const int q = tid + 512 * i, row = q >> 5, ch = q & 31, isK = ch >= 16, cc = (ch & 15) * 8;
        const int cwcol = (isK ? 512 : 0) + h * 128 + cc;
        float acc[8];
#pragma unroll
        for (int e = 0; e < 8; ++e) acc[e] = 0.f;
#pragma unroll
        for (int j = 0; j < 4; ++j) {
            const u32x4 xv = *(const LAS u32x4*)(Raw + (row + j) * 256 + ch * 8);
            float xf[8]; unpack8(xv, xf);
            const f32x4 w0 = *(const f32x4*)(a.conv_qk + j * 1024 + cwcol), w1 = *(const f32x4*)(a.conv_qk + j * 1024 + cwcol + 4);
            acc[0] += w0.x * xf[0]; acc[1] += w0.y * xf[1]; acc[2] += w0.z * xf[2]; acc[3] += w0.w * xf[3];
            acc[4] += w1.x * xf[4]; acc[5] += w1.y * xf[5]; acc[6] += w1.z * xf[6]; acc[7] += w1.w * xf[7];
        }
        const float sc = isK ? 0.08838834764831845f : 1.f;
#pragma unroll
        for (int e = 0; e < 8; ++e) acc[e] = silu_f(acc[e]) * sc;
        const u32x4 o = (u32x4){pk2(acc[0], acc[1]), pk2(acc[2], acc[3]), pk2(acc[4], acc[5]), pk2(acc[6], acc[7])};
        bf16_t* dst = (bf16_t*)(ws + (isK ? wsf::KC : wsf::QC)) + (tok0 + row) * 512 + h * 128 + cc;
        *(u32x4*)dst = o;
        if (isK) {
            const float wr = gl[256 + row];
            *(LAS u32x4*)(Kw + row * 136 + cc) = (u32x4){pk2(acc[0] * wr, acc[1] * wr), pk2(acc[2] * wr, acc[3] * wr), pk2(acc[4] * wr, acc[5] * wr), pk2(acc[6] * wr, acc[7] * wr)};
        }
    }
    __syncthreads();
#pragma unroll
    for (int i = 0; i < 8; ++i) { const int q = tid + 512 * i; *(LAS u32x4*)(Vt + (q >> 5) * 272 + (q & 31) * 8) = vreg[i]; }
    __syncthreads();
    const int c16 = f_lane & 15, grp = f_lane >> 4, w = f_wave;
    f32x4 acc[8][2];
#pragma unroll
    for (int d = 0; d < 8; ++d) { acc[d][0] = (f32x4){0.f, 0.f, 0.f, 0.f}; acc[d][1] = acc[d][0]; }
#pragma unroll
    for (int ks = 0; ks < 4; ++ks) {
        bf16x8 bfr[2];
#pragma unroll
        for (int i = 0; i < 2; ++i) bfr[i] = tr_frag(Vt + (32 * ks) * 272 + 16 * (2 * w + i), 272, f_lane);
#pragma unroll
        for (int d = 0; d < 8; ++d) {
            const bf16x8 af = tr_frag(Kw + (32 * ks) * 136 + 16 * d, 136, f_lane);
            acc[d][0] = mfma16(af, bfr[0], acc[d][0]); acc[d][1] = mfma16(af, bfr[1], acc[d][1]);
        }
    }
    bf16_t* dct = (bf16_t*)(ws + wsf::DCT) + (size_t)u * 256 * 128;
#pragma unroll
    for (int d = 0; d < 8; ++d)
#pragma unroll
        for (int i = 0; i < 2; ++i) *(u32x2*)(dct + (size_t)(16 * (2 * w + i) + c16) * 128 + 16 * d + 4 * grp) = (u32x2){pk2(acc[d][i][0], acc[d][i][1]), pk2(acc[d][i][2], acc[d][i][3])};
    if (tid < 128) {
        float s = 0.f;
#pragma unroll 16
        for (int r = 0; r < 128; ++r) s += bf2f(Kw[r * 136 + tid]);
        ((float*)(ws + wsf::DN))[(size_t)u * 128 + tid] = s;
    }
    __syncthreads();
}

__device__ __forceinline__ void phase3(const MkArgs& a, Frame& F) {
    const int f_tid = fresh_tid(F), f_lane = f_tid & 63, f_wave = F.wave;
    for (int u = F.bid; u < NB * HKV * (S / 128); u += F.G) attn_unit(a, F, u);
    for (int u = F.bid; u < NB * MH * NC; u += F.G) m1_unit(a, F, u);
}

__device__ __forceinline__ void phase4(const MkArgs& a, Frame& F) {
    ada_gemv(a, F, 4096 / 32, MODW / 32);
    __syncthreads();
    const int f_tid = fresh_tid(F), f_lane = f_tid & 63, f_wave = F.wave;
    unsigned char* ws = a.ws;
    LAS float* dec = (LAS float*)F.lds;
    LAS float* scl = dec + 512;
    LAS float* gl = scl + 512;
    gl[f_tid] = ((const float*)(ws + wsf::GSUM))[f_tid]; gl[512 + f_tid] = ((const float*)(ws + wsf::MLOC))[f_tid];
    __syncthreads();
    if (f_tid < 8) {
        const int bh = f_tid; float m = 0.f;
        for (int c = 0; c < NC; ++c) {
            const float g = gl[bh * NC + c], ml = gl[512 + bh * NC + c];
            if (F.bid == 0) ((float*)(ws + wsf::MPREV))[bh * NC + c] = m;
            const float mn = fmaxf(g + m, ml);
            dec[bh * 64 + c] = expf(g + m - mn); scl[bh * 64 + c] = expf(ml - mn); m = mn;
        }
    }
    __syncthreads();
    const int gt = F.vcu * fp::NT + f_tid, NGT = F.G * fp::NT;
    for (int it = gt; it < 8 * 16384; it += NGT) {
        const int bh = it >> 14, idx = it & 16383;
        const bf16_t* dct = (const bf16_t*)(ws + wsf::DCT) + (size_t)bh * 64 * 32768 + (size_t)idx * 2;
        bf16_t* cpt = (bf16_t*)(ws + wsf::CPT) + (size_t)bh * 64 * 32768 + (size_t)idx * 2;
        float C0 = 0.f, C1 = 0.f;
#pragma unroll 8
        for (int c = 0; c < NC; ++c) {
            const unsigned d = *(const unsigned*)(dct + (size_t)c * 32768);
            *(unsigned*)(cpt + (size_t)c * 32768) = pk2(C0, C1);
            const float de = dec[bh * 64 + c], sc = scl[bh * 64 + c];
            C0 = de * C0 + sc * bflo(d); C1 = de * C1 + sc * bfhi(d);
        }
    }
    for (int it = gt; it < 8 * 128; it += NGT) {
        const int bh = it >> 7, dk = it & 127; float nv = 0.f;
        const float* dnp = (const float*)(ws + wsf::DN) + (size_t)bh * NC * 128 + dk;
        float* npp = (float*)(ws + wsf::NPREV) + (size_t)bh * NC * 128 + dk;
#pragma unroll
        for (int h = 0; h < 2; ++h) {
            float d[32];
#pragma unroll
            for (int c = 0; c < 32; ++c) d[c] = dnp[(size_t)(32 * h + c) * 128];
#pragma unroll
            for (int c = 0; c < 32; ++c) { npp[(size_t)(32 * h + c) * 128] = nv; nv = dec[bh * 64 + 32 * h + c] * nv + scl[bh * 64 + 32 * h + c] * d[c]; }
        }
    }
}

__device__ __forceinline__ void m3_unit(const MkArgs& a, Frame& F, int u) {
    const int f_tid = fresh_tid(F), f_lane = f_tid & 63, f_wave = F.wave;
    const int bh = u >> 6, c = u & 63, b = bh >> 2, h = bh & 3;
    const size_t tok0 = (size_t)b * S + (size_t)c * 128;
    unsigned char* ws = a.ws;
    const bf16_t* PB = (const bf16_t*)(ws + wsf::PROJB);
    const bf16_t* QCp = (const bf16_t*)(ws + wsf::QC);
    const bf16_t* KCp = (const bf16_t*)(ws + wsf::KC);
    LAS bf16_t* KP = (LAS bf16_t*)F.lds;
    LAS bf16_t* Vt = (LAS bf16_t*)(F.lds + 34816);
    LAS float* fl = (LAS float*)(F.lds + 104448);
    LAS float* f_us = fl, *f_M = fl + 128, *f_iw = fl + 256, *f_rd = fl + 384, *f_qn = fl + 512, *f_np = fl + 640, *f_en = fl + 768, *f_ssq = fl + 1024, *f_misc = fl + 896;
    const int tid = f_tid;
#pragma unroll
    for (int i = 0; i < 4; ++i) { const int q = tid + 512 * i, row = q >> 4, ch = q & 15;
        *(LAS u32x4*)(KP + row * 136 + ch * 8) = *(const u32x4*)(KCp + (tok0 + row) * 512 + h * 128 + ch * 8); }
    stage_vt(PB, tok0, fp::PB_MV + h * 256, Vt, tid);
    const float mp = ((const float*)(ws + wsf::MPREV))[u];
    float bt = 0.f, us = -INFINITY;
    if (tid < 128) { bt = ((const float*)(ws + wsf::BCUM))[(size_t)bh * S + c * 128 + tid]; us = ((const float*)(ws + wsf::LOGI))[(size_t)bh * S + c * 128 + tid] - bt;
        f_np[tid] = ((const float*)(ws + wsf::NPREV))[(size_t)u * 128 + tid]; }
    float pm = us;
#pragma unroll
    for (int o = 1; o < 64; o <<= 1) { const float t = __shfl_up(pm, o); if (f_lane >= o) pm = fmaxf(pm, t); }
    if (tid == 63) f_misc[0] = pm;
    __syncthreads();
    if (tid >= 64 && tid < 128) pm = fmaxf(pm, f_misc[0]);
    if (tid < 128) {
        const float Mt = fmaxf(mp, pm);
        f_us[tid] = us; f_M[tid] = Mt; f_iw[tid] = expf(mp - Mt); f_en[tid] = expf(-(bt + Mt));
    }
    {
        const int row = tid >> 2, qt = tid & 3;
        u32x4 qv[4];
#pragma unroll
        for (int j = 0; j < 4; ++j) qv[j] = *(const u32x4*)(QCp + (tok0 + row) * 512 + h * 128 + (4 * qt + j) * 8);
        float s = 0.f;
#pragma unroll
        for (int j = 0; j < 4; ++j) { float qf[8]; unpack8(qv[j], qf);
#pragma unroll
            for (int e = 0; e < 8; ++e) s += qf[e] * f_np[(4 * qt + j) * 8 + e]; }
        s += __shfl_xor(s, 1); s += __shfl_xor(s, 2);
        if (qt == 0) f_qn[row] = s;
    }
    __syncthreads();
    const int c16 = f_lane & 15, grp = f_lane >> 4, w = f_wave;
    u32x2 pp[8]; float rs = 0.f;
    {
        bf16x8 qf[4];
#pragma unroll
        for (int ks = 0; ks < 4; ++ks) qf[ks] = *(const bf16x8*)(QCp + (tok0 + 16 * w + c16) * 512 + h * 128 + 32 * ks + 8 * grp);
        const float Mt = f_M[16 * w + c16];
        const int t = 16 * w + c16, tq = t - 4 * grp;
        const LAS float* usb = f_us + 4 * grp;
#pragma unroll
        for (int st = 0; st < 8; ++st) {
            pp[st] = (u32x2){0u, 0u};
            if (st <= w) {
                f32x4 acc = (f32x4){0.f, 0.f, 0.f, 0.f};
#pragma unroll
                for (int ks = 0; ks < 4; ++ks) { const bf16x8 kf = *(const LAS bf16x8*)(KP + (16 * st + c16) * 136 + 32 * ks + 8 * grp); acc = mfma16(kf, qf[ks], acc); }
                float p[4];
                const f32x4 u4 = *(const LAS f32x4*)(usb + 16 * st);
#pragma unroll
                for (int r = 0; r < 4; ++r) { p[r] = (16 * st + r <= tq) ? acc[r] * expf(u4[r] - Mt) : 0.f; rs += p[r]; }
                pp[st] = (u32x2){pk2(p[0], p[1]), pk2(p[2], p[3])};
            }
        }
        rs += __shfl_xor(rs, 16); rs += __shfl_xor(rs, 32);
        if (grp == 0) { const float den = rs + f_iw[t] * f_qn[t]; f_rd[t] = 1.f / fmaxf(fabsf(den), f_en[t]); }
    }
    __syncthreads();
#pragma unroll
    for (int st = 0; st < 8; ++st) *(LAS u32x2*)(KP + (16 * w + c16) * 136 + 16 * st + 4 * grp) = pp[st];
    __syncthreads();
    bf16x8 vf[2][4], cf[2][4];
    const bf16_t* cpt = (const bf16_t*)(ws + wsf::CPT) + (size_t)u * 256 * 128;
#pragma unroll
    for (int i = 0; i < 2; ++i)
#pragma unroll
        for (int ks = 0; ks < 4; ++ks) {
            vf[i][ks] = tr_frag(Vt + (32 * ks) * 272 + 16 * (2 * w + i), 272, f_lane);
            cf[i][ks] = *(const bf16x8*)(cpt + (size_t)(16 * (2 * w + i) + c16) * 128 + 32 * ks + 8 * grp);
        }
    bf16_t* HMp = (bf16_t*)(ws + wsf::HM);
    bf16x8 qnx[4];
#pragma unroll
    for (int ks = 0; ks < 4; ++ks) qnx[ks] = *(const bf16x8*)(QCp + (tok0 + c16) * 512 + h * 128 + 32 * ks + 8 * grp);
#pragma unroll 1
    for (int tt = 0; tt < 8; ++tt) {
        bf16x8 pf[4], qf[4];
        const int tn = tt < 7 ? tt + 1 : 7;
#pragma unroll
        for (int ks = 0; ks < 4; ++ks) { pf[ks] = *(const LAS bf16x8*)(KP + (16 * tt + c16) * 136 + 32 * ks + 8 * grp);
            qf[ks] = qnx[ks]; qnx[ks] = *(const bf16x8*)(QCp + (tok0 + 16 * tn + c16) * 512 + h * 128 + 32 * ks + 8 * grp); }
        const int t = 16 * tt + c16; const float iw = f_iw[t], rd = f_rd[t];
        float ss = 0.f;
#pragma unroll
        for (int i = 0; i < 2; ++i) {
            f32x4 a1 = (f32x4){0.f, 0.f, 0.f, 0.f}, a2 = a1;
#pragma unroll
            for (int ks = 0; ks < 4; ++ks) { a1 = mfma16(vf[i][ks], pf[ks], a1); a2 = mfma16(cf[i][ks], qf[ks], a2); }
            const f32x4 hv = (a1 + a2 * iw) * rd;
            ss += (hv[0] * hv[0] + hv[1] * hv[1]) + (hv[2] * hv[2] + hv[3] * hv[3]);
            *(u32x2*)(HMp + (tok0 + t) * 1024 + h * 256 + 16 * (2 * w + i) + 4 * grp) = (u32x2){pk2(hv[0], hv[1]), pk2(hv[2], hv[3])};
        }
        ss += __shfl_xor(ss, 16); ss += __shfl_xor(ss, 32);
        if (grp == 0) f_ssq[t * 8 + w] = ss;
    }
    u32x2 mon[2];
#pragma unroll
    for (int i = 0; i < 2; ++i) mon[i] = *(const u32x2*)(PB + (tok0 + c16) * fp::NIN + fp::PB_MO + h * 256 + 16 * (2 * w + i) + 4 * grp);
    f32x4 g4v[2]; u32x2 hn[2];
#pragma unroll
    for (int i = 0; i < 2; ++i) { g4v[i] = *(const f32x4*)(a.g_mlstm + h * 256 + 16 * (2 * w + i) + 4 * grp); hn[i] = *(const u32x2*)(HMp + (tok0 + c16) * 1024 + h * 256 + 16 * (2 * w + i) + 4 * grp); }
    __syncthreads();
#pragma unroll 1
    for (int tt = 0; tt < 8; ++tt) {
        const int t = 16 * tt + c16, tn2 = 16 * (tt < 7 ? tt + 1 : 7) + c16;
        u32x2 moc[2], hc[2];
#pragma unroll
        for (int i = 0; i < 2; ++i) { moc[i] = mon[i]; mon[i] = *(const u32x2*)(PB + (tok0 + tn2) * fp::NIN + fp::PB_MO + h * 256 + 16 * (2 * w + i) + 4 * grp);
            hc[i] = hn[i]; hn[i] = *(const u32x2*)(HMp + (tok0 + tn2) * 1024 + h * 256 + 16 * (2 * w + i) + 4 * grp); }
        const f32x4 s0 = *(const LAS f32x4*)(f_ssq + t * 8), s1 = *(const LAS f32x4*)(f_ssq + t * 8 + 4);
        const float rn = rsqrtf(((s0.x + s0.y) + (s0.z + s0.w) + (s1.x + s1.y) + (s1.z + s1.w)) * (1.f / 256.f) + EPS);
#pragma unroll
        for (int i = 0; i < 2; ++i) {
            const int dv0 = 16 * (2 * w + i) + 4 * grp;
            const f32x4 g4 = g4v[i];
            const u32x2 mo = moc[i];
            u32x2* hp = (u32x2*)(HMp + (tok0 + t) * 1024 + h * 256 + dv0);
            const u32x2 hr = hc[i];
            const float o0 = bflo(hr.x) * rn * g4.x * bflo(mo.x), o1 = bfhi(hr.x) * rn * g4.y * bfhi(mo.x);
            const float o2 = bflo(hr.y) * rn * g4.z * bflo(mo.y), o3 = bfhi(hr.y) * rn * g4.w * bfhi(mo.y);
            *hp = (u32x2){pk2(o0, o1), pk2(o2, o3)};
        }
    }
    __syncthreads();
}
__device__ __forceinline__ void phase5(const MkArgs& a, Frame& F) {
    const int f_tid = fresh_tid(F), f_lane = f_tid & 63, f_wave = F.wave;
    for (int u = F.bid; u < NB * MH * NC; u += F.G) m3_unit(a, F, u);
}
struct ProjSched {
    typedef DenseUnit UnitT;
    const bf16_t* A0; const bf16_t* A1; const bf16_t* B0; const bf16_t* B1; int K; int nM, nN, G, c, wave; int ntf, nt_total; unsigned a_jump, b_jump;
    __device__ __forceinline__ bool next(int i, DenseUnit& u) const { return pg8::static_tile(i * G + c, nM, nN, u.pm, u.pn); }
    __device__ __forceinline__ const void* a_buf() const { return A0; }
    __device__ __forceinline__ const void* b_buf() const { return B0; }
    __device__ __forceinline__ unsigned a_soff(const DenseUnit& u) const { return (unsigned)u.pm * 256u * 1024u * 2u; }
    __device__ __forceinline__ unsigned b_soff(const DenseUnit& u) const { return (unsigned)u.pn * 256u * 1024u * 2u; }
    __device__ __forceinline__ void a_offs(const DenseUnit&, int R0, int R1, int C0, int C1, unsigned (&o)[4]) const {
        o[0] = (unsigned)(R0 * 1024 + C0) * 2u; o[1] = (unsigned)(R1 * 1024 + C1) * 2u; o[2] = (unsigned)((R0 + 128) * 1024 + C0) * 2u; o[3] = (unsigned)((R1 + 128) * 1024 + C1) * 2u;
    }
};
struct EpiMerge {
    bf16_t* MG; const bf16_t* PB; bool skip;
    static constexpr float GMIN = 9.5367431640625e-07f;
    __device__ __forceinline__ void mid(f32x4 (&acc)[2][2][4][2], const DenseUnit& u, int wr, int wc, int fr, int fq) const {
        const int row0 = u.pm * 256 + wr * 64 + fr, col0 = u.pn * 256 + wc * 32 + 8 * fq;
#pragma unroll
        for (int ai = 0; ai < 2; ++ai)
#pragma unroll
            for (int mh = 0; mh < 2; ++mh) {
                u32x4 ga[2][2], gm[2][2];
#pragma unroll
                for (int m2 = 0; m2 < 2; ++m2)
#pragma unroll
                    for (int bj = 0; bj < 2; ++bj) { const size_t row = (size_t)(row0 + ai * 128 + (2 * mh + m2) * 16);
                        ga[m2][bj] = *(const u32x4*)(PB + row * fp::NIN + fp::PB_GA + col0 + bj * 128); gm[m2][bj] = *(const u32x4*)(PB + row * fp::NIN + fp::PB_GM + col0 + bj * 128); }
#pragma unroll
                for (int m2 = 0; m2 < 2; ++m2)
#pragma unroll
                    for (int bj = 0; bj < 2; ++bj) { const int m = 2 * mh + m2; float a[8], g[8]; unpack8(ga[m2][bj], a); unpack8(gm[m2][bj], g);
#pragma unroll
                        for (int e = 0; e < 8; ++e) a[e] = fast_sigmoid(a[e]) * __builtin_amdgcn_rcpf(fmaxf(fast_sigmoid(g[e]), GMIN));
                        acc[ai][bj][m][0] *= (f32x4){a[0], a[1], a[2], a[3]}; acc[ai][bj][m][1] *= (f32x4){a[4], a[5], a[6], a[7]}; }
            }
    }
    __device__ __forceinline__ void operator()(const f32x4 (&acc)[2][2][4][2], const DenseUnit& u, int wr, int wc, int fr, int fq) const {
        if (skip) {
#pragma unroll
            for (int ai = 0; ai < 2; ++ai)
#pragma unroll
                for (int bj = 0; bj < 2; ++bj)
#pragma unroll
                    for (int m = 0; m < 4; ++m)
#pragma unroll
                        for (int n = 0; n < 2; ++n) asm volatile("" :: "v"(acc[ai][bj][m][n]));
            return;
        }
        const int row0 = u.pm * 256 + wr * 64 + fr, col0 = u.pn * 256 + wc * 32 + 8 * fq;
#pragma unroll
        for (int ai = 0; ai < 2; ++ai) {
            u32x4 gm[4][2];
#pragma unroll
            for (int m = 0; m < 4; ++m)
#pragma unroll
                for (int bj = 0; bj < 2; ++bj) gm[m][bj] = *(const u32x4*)(PB + (size_t)(row0 + ai * 128 + m * 16) * fp::NIN + fp::PB_GM + col0 + bj * 128);
#pragma unroll
            for (int m = 0; m < 4; ++m)
#pragma unroll
                for (int bj = 0; bj < 2; ++bj) { const size_t row = (size_t)(row0 + ai * 128 + m * 16); float g[8]; unpack8(gm[m][bj], g);
#pragma unroll
                    for (int e = 0; e < 8; ++e) g[e] = fmaxf(fast_sigmoid(g[e]), GMIN);
                    const f32x4 v0 = acc[ai][bj][m][0], v1 = acc[ai][bj][m][1];
                    *(u32x4*)(MG + row * 2048 + col0 + bj * 128) = (u32x4){pg8::cvt_pk_bf16(g[0] * v0[0], g[1] * v0[1]), pg8::cvt_pk_bf16(g[2] * v0[2], g[3] * v0[3]),
                                                                         pg8::cvt_pk_bf16(g[4] * v1[0], g[5] * v1[1]), pg8::cvt_pk_bf16(g[6] * v1[2], g[7] * v1[3])}; }
        }
    }
};
__device__ __forceinline__ void phase6(const MkArgs& a, Frame& F, bool skip_epi = false) {
    const int f_tid = fresh_tid(F), f_lane = f_tid & 63, f_wave = F.wave;
    unsigned char* ws = a.ws;
    ProjSched S{(const bf16_t*)(ws + wsf::OAT), (const bf16_t*)(ws + wsf::HM), (const bf16_t*)(ws + wsf::WAP_T), (const bf16_t*)(ws + wsf::WMP_T), 1024, NTOK / 256, 2048 / 256, F.G, F.bid, F.wave, 16, 32,
                (unsigned)(wsf::HM - wsf::OAT) - 16u * 128u, (unsigned)(wsf::WMP_T - wsf::WAP_T) - 16u * 128u};
    EpiMerge E{(bf16_t*)(ws + wsf::MG), (const bf16_t*)(ws + wsf::PROJB), skip_epi};
    pg8::gemm_phase<EpiMerge, ProjSched, false, 0, true>(F.lds, S, E);
}
struct EpiPlain {
    bf16_t* O; int ldc;
    __device__ __forceinline__ void operator()(const f32x4 (&acc)[2][2][4][2], const DenseUnit& u, int wr, int wc, int fr, int fq) const {
        const int row0 = u.pm * 256 + wr * 64 + fr, col0 = u.pn * 256 + wc * 32 + 8 * fq;
#pragma unroll
        for (int ai = 0; ai < 2; ++ai)
#pragma unroll
            for (int m = 0; m < 4; ++m)
#pragma unroll
                for (int bj = 0; bj < 2; ++bj) {
                    const f32x4 v0 = acc[ai][bj][m][0], v1 = acc[ai][bj][m][1];
                    *(u32x4*)(O + (size_t)(row0 + ai * 128 + m * 16) * ldc + col0 + bj * 128) =
                        (u32x4){pg8::cvt_pk_bf16(v0[0], v0[1]), pg8::cvt_pk_bf16(v0[2], v0[3]), pg8::cvt_pk_bf16(v1[0], v1[1]), pg8::cvt_pk_bf16(v1[2], v1[3])};
                }
    }
};
__device__ __forceinline__ void phase7(const MkArgs& a, Frame& F) {
    const int f_tid = fresh_tid(F), f_lane = f_tid & 63, f_wave = F.wave;
    unsigned char* ws = a.ws;
    DenseSched S{(const bf16_t*)(ws + wsf::MG), (const bf16_t*)(ws + wsf::WOUT_T), 2048, 2048, NTOK / 256, 2048 / 256, F.G, F.bid, F.wave};
    EpiPlain E{(bf16_t*)(ws + wsf::Y), 2048};
    pg8::gemm_phase<EpiPlain, DenseSched>(F.lds, S, E);
}

__device__ __forceinline__ void phase8(const MkArgs& a, Frame& F) {
    const int f_tid = fresh_tid(F), f_lane = f_tid & 63, f_wave = F.wave;
    unsigned char* ws = a.ws;
    LAS float* t_gt1 = (LAS float*)F.lds, *t_gpo = t_gt1 + 2048, *t_gpr = t_gt1 + 4096, *t_sc2 = t_gt1 + 6144, *t_sh2 = t_gt1 + 8192;
    LAS float* lgp = (LAS float*)(F.lds + 40960);
    LAS int* cntl = (LAS int*)(F.lds + 57344);
    LAS int* basel = cntl + 32;
    LAS int* esel = cntl + 64;
    LAS int* eslot = cntl + 320;
    LAS float* wsel = (LAS float*)(cntl + 576);
    LAS float* r2l = (LAS float*)(cntl + 832);
    const float* mod = (const float*)(ws + wsf::MOD);
    const bf16_t* Yp = (const bf16_t*)(ws + wsf::Y);
    bf16_t* H2p = (bf16_t*)(ws + wsf::H2);
    bf16_t* X1p = (bf16_t*)(ws + wsf::X1);
    const bf16_t* WR = (const bf16_t*)(ws + wsf::WRT);
    int* cntg = (int*)(ws + wsf::CTL) + wsf::CW_CNT;
    const int tid = f_tid, lane = f_lane, w = f_wave;
    for (int blk = F.vcu; blk < NTOK / 64; blk += F.G) {
        const int b = (blk * 64) / S;
        for (int i = tid; i < 2048; i += fp::NT) {
            t_gt1[i] = mod[b * MODW + MOD_GT1 + i]; t_gpo[i] = a.g_post_mix[i]; t_gpr[i] = a.g_pre_ffn[i] * (1.f + mod[b * MODW + MOD_SC2 + i]);
            t_sh2[i] = mod[b * MODW + MOD_SH2 + i];
        }
        if (tid < 32) cntl[tid] = 0;
        __syncthreads();
#pragma unroll 1
        for (int rr = 0; rr < 8; ++rr) {
            const size_t row = (size_t)blk * 64 + w * 8 + rr;
            u32x4 yp[4]; f32x4 xq[4][2]; float ss = 0.f;
#pragma unroll
            for (int j = 0; j < 4; ++j) yp[j] = *(const u32x4*)(Yp + row * 2048 + 8 * (64 * j + lane));
#pragma unroll
            for (int j = 0; j < 4; ++j) { xq[j][0] = *(const f32x4*)(a.x + row * D + 8 * (64 * j + lane)); xq[j][1] = *(const f32x4*)(a.x + row * D + 8 * (64 * j + lane) + 4); }
#pragma unroll
            for (int j = 0; j < 4; ++j) { float f[8]; unpack8(yp[j], f);
#pragma unroll
                for (int e = 0; e < 8; ++e) ss += f[e] * f[e]; }
            const float r1 = rsqrtf(wave_sum_f(ss) * (1.f / D) + EPS);
            ss = 0.f;
            u32x4 x1p[4];
#pragma unroll
            for (int j = 0; j < 4; ++j) {
                const int c0 = 8 * (64 * j + lane);
                float f[8]; unpack8(yp[j], f);
                const f32x4 xa = xq[j][0], xb = xq[j][1];
                const float xv[8] = {xa.x, xa.y, xa.z, xa.w, xb.x, xb.y, xb.z, xb.w};
                float v[8];
#pragma unroll
                for (int e = 0; e < 8; ++e) { v[e] = xv[e] + t_gt1[c0 + e] * (f[e] * r1 * t_gpo[c0 + e]); ss += v[e] * v[e]; }
                x1p[j] = (u32x4){pg8::cvt_pk_bf16(v[0], v[1]), pg8::cvt_pk_bf16(v[2], v[3]), pg8::cvt_pk_bf16(v[4], v[5]), pg8::cvt_pk_bf16(v[6], v[7])};
                *(u32x4*)(X1p + row * D + c0) = x1p[j];
            }
            const float r2 = rsqrtf(wave_sum_f(ss) * (1.f / D) + EPS);
            if (lane == 0) r2l[w * 8 + rr] = r2;
#pragma unroll
            for (int j = 0; j < 4; ++j) {
                const int c0 = 8 * (64 * j + lane);
                float xv[8]; unpack8(x1p[j], xv);
                float hv[8];
#pragma unroll
                for (int e = 0; e < 8; ++e) hv[e] = (xv[e] * r2) * t_gpr[c0 + e] + t_sh2[c0 + e];
#if CHECK_BUILD
                *(u32x4*)(H2p + row * 2048 + c0) = (u32x4){pg8::cvt_pk_bf16(hv[0], hv[1]), pg8::cvt_pk_bf16(hv[2], hv[3]), pg8::cvt_pk_bf16(hv[4], hv[5]), pg8::cvt_pk_bf16(hv[6], hv[7])};
#endif
#if MOE_FP8
                *(u32x2*)(ws + wsf::H2F8 + row * 2048 + c0) = (u32x2){pk4_fp8(hv[0], hv[1], hv[2], hv[3]), pk4_fp8(hv[4], hv[5], hv[6], hv[7])};
#endif
            }
        }
        VM_WAIT();
        __syncthreads();
        {
            const int c16 = lane & 15, grp = lane >> 4, rt = w & 3, kh = w >> 2;
            f32x4 acc[2] = {(f32x4){0.f, 0.f, 0.f, 0.f}, (f32x4){0.f, 0.f, 0.f, 0.f}};
            int blkb = blk; asm volatile("" : "+s"(blkb));
            const bf16_t* ap = X1p + ((size_t)blkb * 64 + 16 * rt + c16) * 2048 + 8 * grp;
            const float r2r = r2l[16 * rt + c16];
#pragma unroll 4
            for (int ks = kh * 32; ks < kh * 32 + 32; ++ks) {
                const u32x4 xr = *(const u32x4*)(ap + 32 * ks);
                float xv[8]; unpack8(xr, xv);
                const LAS float* tg = t_gpr + 32 * ks + 8 * grp; const LAS float* ts = t_sh2 + 32 * ks + 8 * grp;
                const f32x4 g0 = *(const LAS f32x4*)tg, g1 = *(const LAS f32x4*)(tg + 4), s0 = *(const LAS f32x4*)ts, s1 = *(const LAS f32x4*)(ts + 4);
                const u32x4 hw = (u32x4){pg8::cvt_pk_bf16((xv[0] * r2r) * g0.x + s0.x, (xv[1] * r2r) * g0.y + s0.y), pg8::cvt_pk_bf16((xv[2] * r2r) * g0.z + s0.z, (xv[3] * r2r) * g0.w + s0.w),
                                       pg8::cvt_pk_bf16((xv[4] * r2r) * g1.x + s1.x, (xv[5] * r2r) * g1.y + s1.y), pg8::cvt_pk_bf16((xv[6] * r2r) * g1.z + s1.z, (xv[7] * r2r) * g1.w + s1.w)};
                const bf16x8 af = __builtin_bit_cast(bf16x8, hw);
#pragma unroll
                for (int et = 0; et < 2; ++et) {
                    const bf16x8 bh = *(const bf16x8*)(WR + (size_t)(16 * et + c16) * 2048 + 32 * ks + 8 * grp);
                    const bf16x8 bl = *(const bf16x8*)(WR + (size_t)32 * 2048 + (size_t)(16 * et + c16) * 2048 + 32 * ks + 8 * grp);
                    acc[et] = mfma16(af, bh, acc[et]); acc[et] = mfma16(af, bl, acc[et]);
                }
            }
#pragma unroll
            for (int et = 0; et < 2; ++et)
#pragma unroll
                for (int r = 0; r < 4; ++r) lgp[kh * 2048 + (16 * rt + 4 * grp + r) * 32 + 16 * et + c16] = acc[et][r];
        }
        __syncthreads();
        int blkc = blk; asm volatile("" : "+s"(blkc));
        if (tid < 64) {
            const size_t tok = (size_t)blkc * 64 + tid;
            float lgv[32];
#pragma unroll
            for (int e = 0; e < 32; ++e) lgv[e] = lgp[tid * 32 + e] + lgp[2048 + tid * 32 + e] + a.b_router[e];
            int idx[4]; float val[4];
            unsigned used = 0u;
#pragma unroll
            for (int k = 0; k < 4; ++k) {
                float best = -INFINITY; int bi = 0;
#pragma unroll
                for (int e = 0; e < 32; ++e) { const bool c = !((used >> e) & 1u) && lgv[e] > best; best = c ? lgv[e] : best; bi = c ? e : bi; }
                used |= 1u << bi; idx[k] = bi; val[k] = best;
            }
            float ex[4], sum = 0.f;
#pragma unroll
            for (int k = 0; k < 4; ++k) { ex[k] = expf(val[k] - val[0]); sum += ex[k]; }
#pragma unroll
            for (int k = 0; k < 4; ++k) {
                ((int*)(ws + wsf::TOPI))[tok * 4 + k] = idx[k]; ((float*)(ws + wsf::TOPW))[tok * 4 + k] = ex[k] / sum;
                const int e = a.route_i ? a.route_i[tok * 4 + k] : idx[k];
                esel[tid * 4 + k] = e;
                wsel[tid * 4 + k] = a.route_w ? a.route_w[tok * 4 + k] : ex[k] / sum;
                eslot[tid * 4 + k] = __hip_atomic_fetch_add(cntl + e, 1, __ATOMIC_RELAXED, __HIP_MEMORY_SCOPE_WORKGROUP);
            }
        }
        __syncthreads();
        if (tid < 32) { const int n = cntl[tid]; basel[tid] = n > 0 ? __hip_atomic_fetch_add(cntg + tid, n, __ATOMIC_RELAXED, __HIP_MEMORY_SCOPE_AGENT) : 0; }
        __syncthreads();
        if (tid < 256) { const int e = esel[tid]; const size_t li = (size_t)e * NPAIR + basel[e] + eslot[tid]; ((int*)(ws + wsf::LIST))[li] = (blkc * 64 + (tid >> 2)) * 4 + (tid & 3); ((float*)(ws + wsf::LISTW))[li] = wsel[tid]; }
        __syncthreads();
    }
}

struct MoeUnit { int e, m0, pn, rows; };
struct MoeSched {
    typedef MoeUnit UnitT;
    const bf16_t* A; int a_shift; const bf16_t* Wt; size_t wstride; int K; int nN;
    const int* list; const LAS int* tstart; const LAS int* cnt; int nM; int G, c, wave;
    __device__ __forceinline__ bool next(int i, MoeUnit& u) const {
        const int nwg = nM * nN, L = i * G + c; if (L >= nwg) return false;
        int wgid = L; { const int q = nwg / 8, r = nwg % 8, xcd = wgid % 8, off = wgid / 8; wgid = (xcd < r ? xcd * (q + 1) : r * (q + 1) + (xcd - r) * q) + off; }
        constexpr int WG = 4;
        const int nig = WG * nN, gid = wgid / nig, fm = gid * WG, gsz = (nM - fm) < WG ? (nM - fm) : WG;
        const int mt = fm + ((wgid % nig) % gsz); u.pn = (wgid % nig) / gsz;
        int e = 0;
        for (int k = 1; k < NE; ++k) e += (__builtin_amdgcn_readfirstlane(tstart[k]) <= mt) ? 1 : 0;
        u.e = e; u.m0 = (mt - __builtin_amdgcn_readfirstlane(tstart[e])) * 256; const int left = __builtin_amdgcn_readfirstlane(cnt[e]) - u.m0; u.rows = left < 256 ? left : 256;
        return true;
    }
    __device__ __forceinline__ const void* a_buf() const { return A; }
    __device__ __forceinline__ const void* b_buf() const { return Wt; }
    __device__ __forceinline__ unsigned a_soff(const MoeUnit&) const { return 0u; }
    __device__ __forceinline__ unsigned b_soff(const MoeUnit& u) const { return ((unsigned)u.e * (unsigned)wstride + (unsigned)u.pn * 256u * (unsigned)K) * 2u; }
    __device__ __forceinline__ unsigned rowoff(const MoeUnit& u, int r, int C) const {
        const int rc = r < u.rows ? r : u.rows - 1;
        const int id = list[(size_t)u.e * NPAIR + u.m0 + rc] >> a_shift;
        return ((unsigned)id * (unsigned)K + (unsigned)C) * 2u;
    }
    __device__ __forceinline__ void a_offs(const MoeUnit& u, int R0, int R1, int C0, int C1, unsigned (&o)[4]) const {
        o[0] = rowoff(u, R0, C0); o[1] = rowoff(u, R1, C1); o[2] = rowoff(u, R0 + 128, C0); o[3] = rowoff(u, R1 + 128, C1);
    }
};
__device__ __forceinline__ void moe_tables(const MkArgs& a, Frame& F, LAS int*& cnt, LAS int*& tstart) {
    const int f_tid = fresh_tid(F);
    cnt = (LAS int*)(F.lds + LDS_TAB); tstart = cnt + 32;
    const int* cntg = (const int*)(a.ws + wsf::CTL) + wsf::CW_CNT;
    if (f_tid < 32) cnt[f_tid] = __hip_atomic_load(cntg + f_tid, RLX_AGENT);
    __syncthreads();
    if (f_tid == 0) { int s = 0; for (int e = 0; e < NE; ++e) { tstart[e] = s; s += (cnt[e] + 255) >> 8; } tstart[NE] = s; }
    __syncthreads();
}
template <bool F8> struct EpiGateUpT {
    bf16_t* ACT; const float* bias; const int* list; bool skip;
    __device__ __forceinline__ void operator()(const f32x4 (&acc)[2][2][4][2], const MoeUnit& u, int wr, int wc, int fr, int fq) const {
        if (skip) {
#pragma unroll
            for (int ai = 0; ai < 2; ++ai)
#pragma unroll
                for (int bj = 0; bj < 2; ++bj)
#pragma unroll
                    for (int m = 0; m < 4; ++m)
#pragma unroll
                        for (int n = 0; n < 2; ++n) asm volatile("" :: "v"(acc[ai][bj][m][n]));
            return;
        }
        const int col0 = u.pn * 256 + wc * 32 + 8 * fq;
        f32x4 bv[2][2];
#pragma unroll
        for (int bj = 0; bj < 2; ++bj)
#pragma unroll
            for (int n = 0; n < 2; ++n) bv[bj][n] = *(const f32x4*)(bias + (size_t)u.e * 4096 + col0 + bj * 128 + 4 * n);
        int pr[8];
#pragma unroll
        for (int q = 0; q < 8; ++q) { const int r = (q >> 2) * 128 + wr * 64 + (q & 3) * 16 + fr; pr[q] = list[(size_t)u.e * NPAIR + u.m0 + (r < u.rows ? r : 0)]; if (r >= u.rows) pr[q] = -1; }
#pragma unroll
        for (int ai = 0; ai < 2; ++ai)
#pragma unroll
            for (int m = 0; m < 4; ++m) {
                const int pair = pr[ai * 4 + m];
                if (pair >= 0) {
#pragma unroll
                    for (int bj = 0; bj < 2; ++bj) {
                        const f32x4 v0 = acc[ai][bj][m][0] * (F8 ? W8INV : 1.f) + bv[bj][0], v1 = acc[ai][bj][m][1] * (F8 ? W8INV : 1.f) + bv[bj][1];
                        const float gu[8] = {v0[0], v0[1], v0[2], v0[3], v1[0], v1[1], v1[2], v1[3]};
                        float o[4];
#pragma unroll
                        for (int j = 0; j < 4; ++j) {
                            const float glu = fminf(gu[2 * j], 7.0f), lin = fminf(fmaxf(gu[2 * j + 1], -7.0f), 7.0f);
                            o[j] = glu * fast_sigmoid(1.702f * glu) * (lin + 1.f);
                        }
                        if constexpr (F8) *(unsigned*)((unsigned char*)ACT + (size_t)pair * 2048 + (col0 + bj * 128) / 2) = pk4_fp8_nc(o[0], o[1], o[2], o[3]);
                        else *(u32x2*)(ACT + (size_t)pair * 2048 + (col0 + bj * 128) / 2) = (u32x2){pg8::cvt_pk_bf16(o[0], o[1]), pg8::cvt_pk_bf16(o[2], o[3])};
                    }
                }
            }
    }
};
template <bool F8> struct EpiDownT {
    bf16_t* YP; const float* bias; const int* list; const float* wgt;
    __device__ __forceinline__ void operator()(const f32x4 (&acc)[2][2][4][2], const MoeUnit& u, int wr, int wc, int fr, int fq) const {
        const int col0 = u.pn * 256 + wc * 32 + 8 * fq;
        f32x4 bv[2][2];
#pragma unroll
        for (int bj = 0; bj < 2; ++bj)
#pragma unroll
            for (int n = 0; n < 2; ++n) bv[bj][n] = *(const f32x4*)(bias + (size_t)u.e * 2048 + col0 + bj * 128 + 4 * n);
        int pr[8]; float wq[8];
#pragma unroll
        for (int q = 0; q < 8; ++q) { const int r = (q >> 2) * 128 + wr * 64 + (q & 3) * 16 + fr; pr[q] = list[(size_t)u.e * NPAIR + u.m0 + (r < u.rows ? r : 0)]; if (r >= u.rows) pr[q] = -1; }
#pragma unroll
        for (int q = 0; q < 8; ++q) { const int r = (q >> 2) * 128 + wr * 64 + (q & 3) * 16 + fr; wq[q] = wgt[(size_t)u.e * NPAIR + u.m0 + (r < u.rows ? r : 0)]; }
#pragma unroll
        for (int ai = 0; ai < 2; ++ai)
#pragma unroll
            for (int m = 0; m < 4; ++m) {
                const int pair = pr[ai * 4 + m];
                if (pair >= 0) {
                    const float wv = wq[ai * 4 + m];
#pragma unroll
                    for (int bj = 0; bj < 2; ++bj) {
                        const f32x4 v0 = (acc[ai][bj][m][0] * (F8 ? W8INV : 1.f) + bv[bj][0]) * wv, v1 = (acc[ai][bj][m][1] * (F8 ? W8INV : 1.f) + bv[bj][1]) * wv;
                        if constexpr (F8) *(u32x2*)((unsigned char*)YP + (size_t)pair * 2048 + col0 + bj * 128) =
                            (u32x2){pk4_fp8(v0[0] * YP8SCALE, v0[1] * YP8SCALE, v0[2] * YP8SCALE, v0[3] * YP8SCALE), pk4_fp8(v1[0] * YP8SCALE, v1[1] * YP8SCALE, v1[2] * YP8SCALE, v1[3] * YP8SCALE)};
                        else *(u32x4*)(YP + (size_t)pair * 2048 + col0 + bj * 128) =
                            (u32x4){pg8::cvt_pk_bf16(v0[0], v0[1]), pg8::cvt_pk_bf16(v0[2], v0[3]), pg8::cvt_pk_bf16(v1[0], v1[1]), pg8::cvt_pk_bf16(v1[2], v1[3])};
                    }
                }
            }
    }
};
__device__ __forceinline__ void phase9(const MkArgs& a, Frame& F, bool skip_epi = false) {
    unsigned char* ws = a.ws;
    LAS int* cnt; LAS int* tstart; moe_tables(a, F, cnt, tstart);
#if MOE_FP8
    MoeSched S{(const bf16_t*)(ws + wsf::H2F8), 2, (const bf16_t*)(ws + wsf::WGU8), (size_t)4096 * 1024, 1024, 16, (const int*)(ws + wsf::LIST), tstart, cnt, __builtin_amdgcn_readfirstlane(tstart[NE]), F.G, F.bid, F.wave};
    EpiGateUpT<true> E{(bf16_t*)(ws + wsf::ACT8), a.b_gate_up, (const int*)(ws + wsf::LIST), skip_epi};
    if (EPI_SKIP_PROBE >= 2 && skip_epi) pg8::gemm_phase<EpiGateUpT<true>, MoeSched, true, EPI_SKIP_PROBE - 1>(F.lds, S, E);
    else pg8::gemm_phase<EpiGateUpT<true>, MoeSched, true>(F.lds, S, E);
#else
    MoeSched S{(const bf16_t*)(ws + wsf::H2), 2, (const bf16_t*)(ws + wsf::WGU_T), (size_t)4096 * 2048, 2048, 16, (const int*)(ws + wsf::LIST), tstart, cnt, __builtin_amdgcn_readfirstlane(tstart[NE]), F.G, F.bid, F.wave};
    EpiGateUpT<false> E{(bf16_t*)(ws + wsf::ACT), a.b_gate_up, (const int*)(ws + wsf::LIST), skip_epi};
    pg8::gemm_phase<EpiGateUpT<false>, MoeSched, false>(F.lds, S, E);
#endif
}
__device__ __forceinline__ void phase10(const MkArgs& a, Frame& F) {
    unsigned char* ws = a.ws;
    LAS int* cnt; LAS int* tstart; moe_tables(a, F, cnt, tstart);
    const float* wgt = (const float*)(ws + wsf::LISTW);
#if MOE_FP8
    MoeSched S{(const bf16_t*)(ws + wsf::ACT8), 0, (const bf16_t*)(ws + wsf::WDN8), (size_t)2048 * 1024, 1024, 8, (const int*)(ws + wsf::LIST), tstart, cnt, __builtin_amdgcn_readfirstlane(tstart[NE]), F.G, F.bid, F.wave};
    EpiDownT<true> E{(bf16_t*)(ws + wsf::YP), a.b_down, (const int*)(ws + wsf::LIST), wgt};
    pg8::gemm_phase<EpiDownT<true>, MoeSched, true>(F.lds, S, E);
#else
    MoeSched S{(const bf16_t*)(ws + wsf::ACT), 0, (const bf16_t*)(ws + wsf::WDN_T), (size_t)2048 * 2048, 2048, 8, (const int*)(ws + wsf::LIST), tstart, cnt, __builtin_amdgcn_readfirstlane(tstart[NE]), F.G, F.bid, F.wave};
    EpiDownT<false> E{(bf16_t*)(ws + wsf::YP), a.b_down, (const int*)(ws + wsf::LIST), wgt};
    pg8::gemm_phase<EpiDownT<false>, MoeSched, false>(F.lds, S, E);
#endif
}

__device__ __forceinline__ void phase11(const MkArgs& a, Frame& F) {
    const int f_tid = fresh_tid(F), f_lane = f_tid & 63, f_wave = F.wave;
    unsigned char* ws = a.ws;
    const float* mod = (const float*)(ws + wsf::MOD);
    const bf16_t* YPp = (const bf16_t*)(ws + wsf::YP);
    const bf16_t* X1p = (const bf16_t*)(ws + wsf::X1);
    const int gw = F.vcu * fp::NW + f_wave, NGW = F.G * fp::NW, lane = f_lane;
    if (gw >= NTOK) return;
#if MOE_FP8
    u32x2 yq[16];
#else
    u32x4 yq[16];
#endif
    u32x4 xq[4];
#if MOE_FP8
#define P11_YLOAD(prow, j) (*(const u32x2*)((const unsigned char*)YPp + (prow) * 2048 + 8 * (64 * (j) + lane)))
#else
#define P11_YLOAD(prow, j) (*(const u32x4*)(YPp + (prow) * 2048 + 8 * (64 * (j) + lane)))
#endif
#define P11_LOAD(m_) do { const size_t m__ = (size_t)(m_); \
        _Pragma("unroll") for (int k = 0; k < 4; ++k) _Pragma("unroll") for (int j = 0; j < 4; ++j) yq[k * 4 + j] = P11_YLOAD((m__ * 4 + k), j); \
        _Pragma("unroll") for (int j = 0; j < 4; ++j) xq[j] = *(const u32x4*)(X1p + m__ * D + 8 * (64 * j + lane)); } while (0)
    for (int bb = 0; bb < NB; ++bb) {
        const int lo = bb * S, hi = lo + S;
        const int mstart = gw >= lo ? gw : gw + ((lo - gw + NGW - 1) / NGW) * NGW;
        if (mstart >= hi) continue;
        float gg[32];
#pragma unroll
        for (int j = 0; j < 4; ++j)
#pragma unroll
            for (int hq = 0; hq < 2; ++hq) {
                const int c0 = 8 * (64 * j + lane) + 4 * hq;
                const f32x4 gt = *(const f32x4*)(mod + bb * MODW + MOD_GT2 + c0), gp = *(const f32x4*)(a.g_post_ffn + c0);
                gg[8 * j + 4 * hq + 0] = gt.x * gp.x; gg[8 * j + 4 * hq + 1] = gt.y * gp.y; gg[8 * j + 4 * hq + 2] = gt.z * gp.z; gg[8 * j + 4 * hq + 3] = gt.w * gp.w;
            }
        float o[32];
#define P11_CONSUME() do { \
            float yv[32]; u32x4 xv[4]; \
            _Pragma("unroll") for (int i = 0; i < 32; ++i) yv[i] = 0.f; \
            _Pragma("unroll") for (int k = 0; k < 4; ++k) _Pragma("unroll") for (int j = 0; j < 4; ++j) { float f[8]; unpack8_fp8(yq[k * 4 + j], f); _Pragma("unroll") for (int e = 0; e < 8; ++e) yv[8 * j + e] += f[e]; } \
            _Pragma("unroll") for (int i = 0; i < 4; ++i) xv[i] = xq[i]; \
            { const int mn = mnext < hi ? mnext : mcur; P11_LOAD(mn); } \
            float ss = 0.f; \
            _Pragma("unroll") for (int i = 0; i < 32; ++i) { yv[i] *= (1.f / YP8SCALE); ss += yv[i] * yv[i]; } \
            const float r = rsqrtf(wave_sum_f(ss) * (1.f / D) + EPS); \
            _Pragma("unroll") for (int j = 0; j < 4; ++j) { float xf[8]; unpack8(xv[j], xf); _Pragma("unroll") for (int e = 0; e < 8; ++e) o[8 * j + e] = xf[e] + gg[8 * j + e] * (yv[8 * j + e] * r); } } while (0)
#define P11_STORE(m_) do { _Pragma("unroll") for (int j = 0; j < 4; ++j) _Pragma("unroll") for (int hq = 0; hq < 2; ++hq) \
            *(f32x4*)(a.out + (size_t)(m_) * D + 8 * (64 * j + lane) + 4 * hq) = (f32x4){o[8 * j + 4 * hq], o[8 * j + 4 * hq + 1], o[8 * j + 4 * hq + 2], o[8 * j + 4 * hq + 3]}; } while (0)
        P11_LOAD(mstart);
        { const int mcur = mstart, mnext = mstart + NGW; P11_CONSUME(); }
        for (int m = mstart + NGW; m < hi; m += NGW) {
            P11_STORE(m - NGW);
            const int mcur = m, mnext = m + NGW; P11_CONSUME();
        }
        { int ml = mstart; while (ml + NGW < hi) ml += NGW; P11_STORE(ml); }
    }
#undef P11_CONSUME
#undef P11_STORE
#undef P11_LOAD
#undef P11_YLOAD
}
constexpr int N_PHASES = 12;
#ifndef P0_PARTS
#define P0_PARTS 7
#endif
#ifndef EPI_SKIP_PROBE
#define EPI_SKIP_PROBE 0
#endif
#ifndef REP_MASK
#define REP_MASK 0
#endif
__global__ void __launch_bounds__(fp::NT, 2) mk_fwd(MkArgs a) {
    extern __shared__ __attribute__((aligned(16))) unsigned char lds_raw[];
    Frame F;
    F.lds = (LAS unsigned char*)lds_raw;
    F.wave = __builtin_amdgcn_readfirstlane((int)threadIdx.x >> 6);
    F.G = gridDim.x; F.bid = blockIdx.x; F.vcu = (F.G % 8 == 0) ? (F.bid % 8) * (F.G / 8) + F.bid / 8 : F.bid;
    volatile LAS unsigned* misc = (volatile LAS unsigned*)(F.lds + LDS_MISC);
    if (F.wave == 0) misc[lane_id()] = 0u;
    __syncthreads();
    XcdBarrier bar = xcd_barrier_post((unsigned*)(a.ws + wsf::CTL) + wsf::CW_BAR, misc + 8, F.wave == 0 && lane_id() == 0);
    const int lo = a.ph_lo, hi = a.ph_hi;
#define IN(k) (lo <= (k) && (k) < hi)
#define SEAM(k) do { if (IN(k) && IN((k) + 1)) xcd_barrier(bar, F.wave == 0 && lane_id() == 0); } while (0)
    if (IN(0)) { phase0(a, F); if ((REP_MASK >> 0) & 1) phase0(a, F, P0_PARTS); } SEAM(0);
    if (IN(1)) { phase1(a, F); if ((REP_MASK >> 1) & 1) phase1(a, F); } SEAM(1);
    if (IN(2)) { phase2(a, F); if ((REP_MASK >> 2) & 1) { __syncthreads(); phase2(a, F, EPI_SKIP_PROBE != 0); } } SEAM(2);
#if NPH > 3
    if (IN(3)) { phase3(a, F); if ((REP_MASK >> 3) & 1) phase3(a, F); } SEAM(3);
#endif
#if NPH > 4
    if (IN(4)) { phase4(a, F); if ((REP_MASK >> 4) & 1) phase4(a, F); } SEAM(4);
#endif
#if NPH > 5
    if (IN(5)) { phase5(a, F); if ((REP_MASK >> 5) & 1) phase5(a, F); } SEAM(5);
#endif
#if NPH > 6
    if (IN(6)) { phase6(a, F); if ((REP_MASK >> 6) & 1) phase6(a, F, EPI_SKIP_PROBE != 0); } SEAM(6);
#endif
#if NPH > 7
    if (IN(7)) { phase7(a, F); if ((REP_MASK >> 7) & 1) phase7(a, F); } SEAM(7);
#endif
#if NPH > 8
    if (IN(8)) { phase8(a, F); if ((REP_MASK >> 8) & 1) phase8(a, F); } SEAM(8);
#endif
#if NPH > 9
    if (IN(9)) { phase9(a, F); if ((REP_MASK >> 9) & 1) phase9(a, F, EPI_SKIP_PROBE != 0); } SEAM(9);
#endif
#if NPH > 10
    if (IN(10)) { phase10(a, F); if ((REP_MASK >> 10) & 1) phase10(a, F); } SEAM(10);
#endif
#if NPH > 11
    if (IN(11)) { phase11(a, F); if ((REP_MASK >> 11) & 1) phase11(a, F); }
#endif
#undef IN
#undef SEAM
}

static void fill_args(MkArgs& a, void* const* d_in, void* d_out, void* d_ws) {
    a.x = (const float*)d_in[0]; a.c = (const float*)d_in[1]; a.positions = (const int*)d_in[2]; a.w_ada = (const float*)d_in[3]; a.b_ada = (const float*)d_in[4];
    a.g_pre_mix = (const float*)d_in[5]; a.g_post_mix = (const float*)d_in[6]; a.g_pre_ffn = (const float*)d_in[7]; a.g_post_ffn = (const float*)d_in[8];
    a.w_in = (const float*)d_in[9]; a.b_in = (const float*)d_in[10]; a.conv_qk = (const float*)d_in[11]; a.sinks = (const float*)d_in[12]; a.g_mlstm = (const float*)d_in[13];
    a.w_attn_proj = (const float*)d_in[14]; a.w_mlstm_proj = (const float*)d_in[15]; a.w_out = (const float*)d_in[16]; a.w_router = (const float*)d_in[17]; a.b_router = (const float*)d_in[18];
    a.w_gate_up = (const float*)d_in[19]; a.b_gate_up = (const float*)d_in[20]; a.w_down = (const float*)d_in[21]; a.b_down = (const float*)d_in[22];
    a.out = (float*)d_out; a.ws = (unsigned char*)d_ws; a.route_i = nullptr; a.route_w = nullptr; a.ph_lo = 0; a.ph_hi = 0;
}
static int mk_setup() {
    static int grid = 0;
    if (grid == 0) {
        int dev = 0, cus = 0;
        if (hipGetDevice(&dev) != hipSuccess || hipDeviceGetAttribute(&cus, hipDeviceAttributeMultiprocessorCount, dev) != hipSuccess) { grid = -1; return grid; }
        if (hipFuncSetAttribute((const void*)mk_fwd, hipFuncAttributeMaxDynamicSharedMemorySize, LDS_BYTES) != hipSuccess) { grid = -1; return grid; }
        int per_cu = 0;
        if (hipOccupancyMaxActiveBlocksPerMultiprocessor(&per_cu, (const void*)mk_fwd, fp::NT, LDS_BYTES) != hipSuccess || per_cu < 1) { (void)hipGetLastError(); }
        grid = cus;
    }
    return grid;
}

extern "C" void kernel_launch(void* const* d_in, const int* in_sizes, int n_in, void* d_out, int out_size, void* d_ws, size_t ws_size, hipStream_t stream) {
    if (n_in != 23 || ws_size < wsf::END) return;
    const int grid = mk_setup();
    if (grid <= 0) return;
    if (hipMemsetAsync((unsigned char*)d_ws + wsf::CTL, 0, 65536, stream) != hipSuccess) return;
    MkArgs a{}; fill_args(a, d_in, d_out, d_ws);
    a.ph_lo = 0; a.ph_hi = N_PHASES;
    hipLaunchKernelGGL(mk_fwd, dim3(grid), dim3(fp::NT), LDS_BYTES, stream, a);
}
```

```cpp
#include <hip/hip_runtime.h>
#include <stdint.h>
#include <math.h>
#define NPH 12
#define MOE_FP8 1
#define REP_MASK 0
#define CONV_WGS 80
#define DRY_PROBE 0
#define EPI_SKIP_PROBE 0
#define CONV_SPLIT 1024
#define STAGGER_NG 1
#define STAGGER_STEP 1
#define P0_PARTS 7
#define LDS_LAYOUT 0
namespace cfg {
constexpr int D = 2048, NB = 2, S = 8192, NTOK = NB * S;
constexpr int HQ = 16, HKV = 2, HD = 64, QW = 1024;
constexpr int MH = 4, MDV = 256, MDK = 128, MQKW = 512, MVW = 1024, CL = 128, NC = S / CL;
constexpr int NE = 32, TOPK = 4, DFF = 2048, NPAIR = NTOK * TOPK;
constexpr int INW = 8456;
constexpr int OFF_AQ = 0, OFF_AK = 1024, OFF_AV = 1152, OFF_MQ = 1280, OFF_MK = 1792, OFF_MV = 2304, OFF_MO = 3328,
              OFF_MI = 4352, OFF_MF = 4356, OFF_GA = 4360, OFF_GM = 6408;
constexpr float EPS = 1e-6f;
constexpr int MOD_SH1 = 0, MOD_SC1 = 2048, MOD_GT1 = 4096, MOD_SH2 = 6144, MOD_SC2 = 8192, MOD_GT2 = 10240, MODW = 12288;
}
using namespace cfg;
__device__ __forceinline__ float silu_f(float x) { return x / (1.f + expf(-x)); }
__device__ __forceinline__ float sigmoid_f(float x) { return 1.f / (1.f + expf(-x)); }
__device__ __forceinline__ void rope_cs(int pos, int i, float& c, float& s) {
    const float invf[8] = {1.0f, 0.1939227432012558f, 0.03760603070259094f, 0.007292664609849453f,
                           0.0014142135623842478f, 0.00027424818836152554f, 5.3182957344688475e-05f, 1.0313385246263351e-05f};
    float f = i == 0 ? invf[0] : i == 1 ? invf[1] : i == 2 ? invf[2] : i == 3 ? invf[3] : i == 4 ? invf[4] : i == 5 ? invf[5] : i == 6 ? invf[6] : invf[7];
    float ang = (float)pos * f;
    double t = (double)ang * 0.15915494309189535;
    t -= rint(t);
    float tf = (float)t;
    s = __builtin_amdgcn_sinf(tf);
    c = __builtin_amdgcn_cosf(tf);
}
__device__ __forceinline__ float softcap_f(float z) { return 15.f * tanhf(z / 15.f); }
__device__ __forceinline__ float logsigmoid_f(float z) { return fminf(z, 0.f) - log1pf(expf(-fabsf(z))); }
#ifndef MOE_FP8
#define MOE_FP8 1
#endif
#ifndef CONV_WGS
#define CONV_WGS 80
#endif
#ifndef STAGGER_NG
#define STAGGER_NG 1
#endif
#ifndef STAGGER_STEP
#define STAGGER_STEP 1
#endif
#ifndef CONV_SPLIT
#define CONV_SPLIT 1024
#endif
#ifndef LDS_LAYOUT
#define LDS_LAYOUT 0
#endif
#ifndef DRY_PROBE
#define DRY_PROBE 0
#endif
#ifndef EPI_SKIP_PROBE
#define EPI_SKIP_PROBE 0
#endif
#ifndef P0_PARTS
#define P0_PARTS 7
#endif
#ifndef REP_MASK
#define REP_MASK 0
#endif
#define GAS __attribute__((address_space(1)))
#define LAS __attribute__((address_space(3)))
typedef unsigned short bf16_t;
typedef short bf16x8 __attribute__((ext_vector_type(8)));
typedef short bf16x4 __attribute__((ext_vector_type(4)));
typedef float f32x4 __attribute__((ext_vector_type(4)));
typedef float f32x2 __attribute__((ext_vector_type(2)));
typedef unsigned u32x4 __attribute__((ext_vector_type(4)));
typedef unsigned u32x2 __attribute__((ext_vector_type(2)));
#define RLX_AGENT __ATOMIC_RELAXED, __HIP_MEMORY_SCOPE_AGENT
#define LDS_WAIT() asm volatile("s_waitcnt lgkmcnt(0)" ::: "memory")
#define VM_WAIT() asm volatile("s_waitcnt vmcnt(0)" ::: "memory")

__device__ __forceinline__ unsigned f2bf(float f) { unsigned u = __builtin_bit_cast(unsigned, f); return (u + 0x7fffu + ((u >> 16) & 1u)) >> 16; }
__device__ __forceinline__ unsigned pk2(float lo, float hi) { return f2bf(lo) | (f2bf(hi) << 16); }
__device__ __forceinline__ float bf2f(unsigned short h) { return __builtin_bit_cast(float, (unsigned)h << 16); }
__device__ __forceinline__ float bflo(unsigned w) { return __builtin_bit_cast(float, w << 16); }
__device__ __forceinline__ float bfhi(unsigned w) { return __builtin_bit_cast(float, w & 0xffff0000u); }
__device__ __forceinline__ unsigned pk4_fp8(float a, float b, float c, float d) {
    a = __builtin_amdgcn_fmed3f(a, -448.f, 448.f); b = __builtin_amdgcn_fmed3f(b, -448.f, 448.f); c = __builtin_amdgcn_fmed3f(c, -448.f, 448.f); d = __builtin_amdgcn_fmed3f(d, -448.f, 448.f);
    int r = __builtin_amdgcn_cvt_pk_fp8_f32(a, b, 0, false); r = __builtin_amdgcn_cvt_pk_fp8_f32(c, d, r, true); return (unsigned)r;
}
__device__ __forceinline__ unsigned pk4_fp8_nc(float a, float b, float c, float d) { int r = __builtin_amdgcn_cvt_pk_fp8_f32(a, b, 0, false); r = __builtin_amdgcn_cvt_pk_fp8_f32(c, d, r, true); return (unsigned)r; }
constexpr float YP8SCALE = 16.f;
constexpr float W8SCALE = 64.f, W8INV = 1.f / 64.f;
__device__ __forceinline__ void unpack8_fp8(const u32x2 v, float (&f)[8]) {
    const f32x2 a = __builtin_amdgcn_cvt_pk_f32_fp8((int)v.x, false), b = __builtin_amdgcn_cvt_pk_f32_fp8((int)v.x, true);
    const f32x2 c = __builtin_amdgcn_cvt_pk_f32_fp8((int)v.y, false), d = __builtin_amdgcn_cvt_pk_f32_fp8((int)v.y, true);
    f[0] = a.x; f[1] = a.y; f[2] = b.x; f[3] = b.y; f[4] = c.x; f[5] = c.y; f[6] = d.x; f[7] = d.y;
}
__device__ __forceinline__ float fast_sigmoid(float x) { return __builtin_amdgcn_rcpf(1.f + __builtin_amdgcn_exp2f(-1.4426950408889634f * x)); }

namespace fp {
constexpr int NW = 8, NT = NW * 64;
constexpr int NIN = 8448;
constexpr int PB_Q = 0, PB_K = 1024, PB_V = 1152, PB_MQ = 1280, PB_MK = 1792, PB_MV = 2304, PB_MO = 3328, PB_GA = 4352, PB_GM = 6400;
constexpr float QSCALE = 0.125f * 1.4426950408889634f;
constexpr float LOG2E = 1.4426950408889634f;
}

namespace wsf {
constexpr size_t AL(size_t x) { return (x + 255) & ~(size_t)255; }
constexpr size_t CTL = 0, CTL_BYTES = 1u << 20;
constexpr size_t MODP = CTL + CTL_BYTES;
constexpr size_t MOD = AL(MODP + (size_t)16 * 2 * MODW * 4);
constexpr size_t BINP = AL(MOD + (size_t)2 * MODW * 4);
constexpr size_t CS = AL(BINP + (size_t)fp::NIN * 4);
constexpr size_t WRT = AL(CS + (size_t)NTOK * 8 * 8);
constexpr size_t WIN_T = AL(WRT + (size_t)2 * 32 * 2048 * 2);
constexpr size_t WAP_T = AL(WIN_T + (size_t)fp::NIN * 2048 * 2);
constexpr size_t WMP_T = AL(WAP_T + (size_t)2048 * 1024 * 2);
constexpr size_t WOUT_T = AL(WMP_T + (size_t)2048 * 1024 * 2);
constexpr size_t WGU_T = AL(WOUT_T + (size_t)2048 * 2048 * 2);
#if MOE_FP8
constexpr size_t WDN_T = WGU_T;
constexpr size_t GATES = WGU_T;
#else
constexpr size_t WDN_T = AL(WGU_T + (size_t)32 * 4096 * 2048 * 2);
constexpr size_t GATES = AL(WDN_T + (size_t)32 * 2048 * 2048 * 2);
#endif
constexpr size_t BCUM = AL(GATES + (size_t)NTOK * 8 * 4);
constexpr size_t LOGI = AL(BCUM + (size_t)8 * S * 4);
constexpr size_t GSUM = AL(LOGI + (size_t)8 * S * 4);
constexpr size_t MLOC = AL(GSUM + 512 * 4);
constexpr size_t MPREV = AL(MLOC + 512 * 4);
constexpr size_t DN = AL(MPREV + 512 * 4);
constexpr size_t NPREV = AL(DN + (size_t)512 * 128 * 4);
constexpr size_t DCT = AL(NPREV + (size_t)512 * 128 * 4);
constexpr size_t Y = AL(DCT + (size_t)512 * 256 * 128 * 4);
constexpr size_t X1 = AL(Y + (size_t)NTOK * 2048 * 2);
constexpr size_t H2 = AL(X1 + (size_t)NTOK * 2048 * 4);
constexpr size_t TOPI = AL(H2 + (size_t)NTOK * 2048 * 2);
constexpr size_t TOPW = AL(TOPI + (size_t)NPAIR * 4);
constexpr size_t LIST = AL(TOPW + (size_t)NPAIR * 4);
constexpr size_t LISTW = AL(LIST + (size_t)NE * NPAIR * 4);
constexpr size_t PROJB = AL(LISTW + (size_t)NE * NPAIR * 4);
constexpr size_t ACT = PROJB;
constexpr size_t YPREG = AL(PROJB + (size_t)NTOK * fp::NIN * 2);
constexpr size_t H1 = YPREG;
constexpr size_t MG = AL(H1 + (size_t)NTOK * 2048 * 2);
constexpr size_t OAT = AL(MG + (size_t)NTOK * 2048 * 2);
constexpr size_t HM = AL(OAT + (size_t)NTOK * 1024 * 2);
constexpr size_t QC = AL(HM + (size_t)NTOK * 1024 * 2);
constexpr size_t KC = AL(QC + (size_t)NTOK * 512 * 2);
constexpr size_t CPT = AL(KC + (size_t)NTOK * 512 * 2);
constexpr size_t YP = YPREG;
constexpr size_t F8BASE = AL(CPT + (size_t)512 * 256 * 128 * 2) > AL(YP + (size_t)NPAIR * 2048 * 2) ? AL(CPT + (size_t)512 * 256 * 128 * 2) : AL(YP + (size_t)NPAIR * 2048 * 2);
constexpr size_t WGU8 = F8BASE;
constexpr size_t WDN8 = AL(WGU8 + (size_t)32 * 4096 * 2048);
constexpr size_t H2F8 = AL(WDN8 + (size_t)32 * 2048 * 2048);
constexpr size_t ACT8 = AL(H2F8 + (size_t)NTOK * 2048);
constexpr size_t END = AL(ACT8 + (size_t)NPAIR * 2048);
static_assert((size_t)NPAIR * 2048 * 2 <= (size_t)NTOK * fp::NIN * 2, "ACT fits over PROJB");
constexpr int CW_BAR = 4096;
constexpr int CW_CNT = 8192;
}

constexpr int RING_BYTES = 131072;
constexpr int LDS_TAB = RING_BYTES;
constexpr int LDS_MISC = RING_BYTES + 8192;
constexpr int LDS_BYTES = 147456;

#define XB_TMO      128
#define XB_XCNT(j)  (256  + 64 * (j))
#define XB_XSUB(j)  (1280 + 64 * (j))
#define XB_XGEN(j)  (2304 + 64 * (j))
#define XB_TOP      3328
#define XB_TOPGEN   3392
#define XCD_BAR_WORDS 3456
#define XB_SPIN_CAP (1u << 18)
__device__ __forceinline__ unsigned xb_ld(unsigned* p)              { return __hip_atomic_load(p, __ATOMIC_RELAXED, __HIP_MEMORY_SCOPE_AGENT); }
__device__ __forceinline__ unsigned xb_add(unsigned* p, unsigned v) { return __hip_atomic_fetch_add(p, v, __ATOMIC_RELAXED, __HIP_MEMORY_SCOPE_AGENT); }
__device__ __forceinline__ unsigned xb_xcc_id() { return (unsigned)__builtin_amdgcn_s_getreg((3 << 11) | 20) & 0xFu; }
#define XB_SPIN(cond, bar) do { unsigned _sp = 0; while (cond) { __builtin_amdgcn_s_sleep(1); \
    if ((++_sp & 255u) == 0u) { if (xb_ld(&(bar)[XB_TMO])) break; if (_sp > XB_SPIN_CAP) { atomicAdd(&(bar)[XB_TMO], 1u); break; } } } } while (0)
struct XcdBarrier { unsigned* bar; unsigned x; volatile LAS unsigned* st; };
__device__ __forceinline__ XcdBarrier xcd_barrier_post(unsigned* bar, volatile LAS unsigned* st, bool t0) {
    XcdBarrier b; b.bar = bar; b.x = xb_xcc_id(); b.st = st;
    if (t0) (void)xb_add(&bar[XB_XCNT(b.x)], 1u);
    return b;
}
__device__ __forceinline__ void xcd_barrier_complete(unsigned* bar, unsigned x, unsigned& nloc, unsigned& nx) {
    const unsigned G = gridDim.x * gridDim.y * gridDim.z;
    unsigned sum, cnt, mine, sp = 0u;
    for (;;) {
        sum = 0u; cnt = 0u; mine = 0u;
#pragma unroll
        for (unsigned j = 0; j < 16; ++j) { const unsigned c = xb_ld(&bar[XB_XCNT(j)]); sum += c; cnt += (c > 0u) ? 1u : 0u; mine = (j == x) ? c : mine; }
        if (sum == G) break;
        __builtin_amdgcn_s_sleep(1);
        if ((++sp & 255u) == 0u) { if (xb_ld(&bar[XB_TMO])) break; if (sp > XB_SPIN_CAP) { atomicAdd(&bar[XB_TMO], 1u); break; } }
    }
    nloc = mine > 0u ? mine : 1u; nx = cnt > 0u ? cnt : 1u;
}
__device__ __forceinline__ void xcd_barrier(const XcdBarrier& b, bool t0) {
    asm volatile("s_waitcnt vmcnt(0)" ::: "memory");
    __syncthreads();
    if (t0) {
        unsigned* bar = b.bar;
        __builtin_amdgcn_s_waitcnt(0);
        unsigned nloc = b.st[0], nx = b.st[1];
        if (nloc == 0u) { xcd_barrier_complete(bar, b.x, nloc, nx); b.st[0] = nloc; b.st[1] = nx; }
        const unsigned old = xb_add(&bar[XB_XSUB(b.x)], 1u);
        const unsigned gen = old / nloc;
        if (old + 1u == (gen + 1u) * nloc) {
            __builtin_amdgcn_fence(__ATOMIC_RELEASE, "agent");
            asm volatile("s_waitcnt vmcnt(0)" ::: "memory");
            const unsigned og = xb_add(&bar[XB_TOP], 1u);
            const unsigned tg = og / nx;
            if (og + 1u == (tg + 1u) * nx) xb_add(&bar[XB_TOPGEN], 1u);
            else XB_SPIN(xb_ld(&bar[XB_TOPGEN]) == tg, bar);
            __builtin_amdgcn_fence(__ATOMIC_ACQUIRE, "agent");
            xb_add(&bar[XB_XGEN(b.x)], 1u);
            asm volatile("s_waitcnt vmcnt(0)" ::: "memory");
        } else {
            XB_SPIN(xb_ld(&bar[XB_XGEN(b.x)]) == gen, bar);
            __builtin_amdgcn_fence(__ATOMIC_ACQUIRE, "agent");
            asm volatile("s_waitcnt vmcnt(0)" ::: "memory");
        }
    }
    __syncthreads();
}

namespace pg8 {
constexpr int BM = 256, BK = 64, HALF = 128, HTB = HALF * BK * 2, STAGE_BYTES = 8 * HTB, NXCD = 8, WGM = 4;
#if LDS_LAYOUT == 2
__host__ __device__ __forceinline__ int lds_byte(int r, int c) { const int st = (r >> 4) * 2 + (c >> 5), rr = r & 15, cc = c & 31; return st * 1024 + rr * 64 + ((((cc >> 3) ^ (rr >> 2)) & 3) << 4) + (cc & 7) * 2; }
__host__ __device__ __forceinline__ void stage_rc(int b, int& R, int& C) { const int st = b / 1024, sb = b % 1024, rr = sb / 64, pc = (sb % 64) / 16; R = (st >> 1) * 16 + rr; C = (st & 1) * 32 + (((pc ^ (rr >> 2)) & 3) << 3) + (sb % 16) / 2; }
#elif LDS_LAYOUT == 1
__host__ __device__ __forceinline__ int lds_byte(int r, int c) { const int st = (r >> 4) * 2 + (c >> 5), rr = r & 15, cc = c & 31; return st * 1024 + (cc >> 3) * 256 + rr * 16 + (cc & 7) * 2; }
__host__ __device__ __forceinline__ void stage_rc(int b, int& R, int& C) { const int st = b / 1024, sb = b % 1024; R = (st >> 1) * 16 + (sb % 256) / 16; C = (st & 1) * 32 + (sb / 256) * 8 + (sb % 16) / 2; }
#else
__host__ __device__ __forceinline__ int lds_byte(int r, int c) { const int st = (r >> 4) * 2 + (c >> 5), rr = r & 15, cc = c & 31, ob = rr * 64 + cc * 2; return st * 1024 + (ob ^ (((ob >> 9) & 1) << 5)); }
__host__ __device__ __forceinline__ void stage_rc(int b, int& R, int& C) { const int st = b / 1024, sb = b % 1024, swz = sb ^ (((sb >> 9) & 1) << 5); R = (st >> 1) * 16 + swz / 64; C = (st & 1) * 32 + (swz % 64) / 2; }
#endif
__host__ __device__ __forceinline__ int perm32(int rho) { const int n = rho >> 4, i = rho & 15; return 8 * (i >> 2) + 4 * n + (i & 3); }
typedef int v8i32_t __attribute__((ext_vector_type(8)));
template <bool F8> struct FragSel { typedef bf16x8 T; };
typedef short s16x16_t __attribute__((ext_vector_type(16)));
template <> struct FragSel<true> { typedef s16x16_t T; };
template <bool F8> __device__ __forceinline__ typename FragSel<F8>::T ld_frag(const LAS unsigned char* p) {
    if constexpr (F8) { const bf16x8 lo = *(const LAS bf16x8*)p, hi = *(const LAS bf16x8*)(p + 1024); return __builtin_shufflevector(lo, hi, 0, 1, 2, 3, 4, 5, 6, 7, 8, 9, 10, 11, 12, 13, 14, 15); }
    else return *(const LAS bf16x8*)p;
}
__device__ __forceinline__ f32x4 mma_frag(bf16x8 a, bf16x8 b, f32x4 c) { return __builtin_amdgcn_mfma_f32_16x16x32_bf16(a, b, c, 0, 0, 0); }
__device__ __forceinline__ f32x4 mma_frag(s16x16_t a, s16x16_t b, f32x4 c) {
    const v8i32_t av = __builtin_bit_cast(v8i32_t, a), bv = __builtin_bit_cast(v8i32_t, b);
    asm volatile("v_mfma_scale_f32_16x16x128_f8f6f4 %0, %1, %2, %0, %3, %3 op_sel_hi:[0,0,0]" : "+v"(c) : "v"(av), "v"(bv), "v"(0x7f7f7f7f));
    return c;
}
__device__ __forceinline__ unsigned cvt_pk_bf16(float lo, float hi) { unsigned r; asm volatile("v_cvt_pk_bf16_f32 %0, %1, %2" : "=v"(r) : "v"(lo), "v"(hi)); return r; }

__device__ __forceinline__ bool static_tile(int L, int nM, int nN, int& pm, int& pn) {
    const int nwg = nM * nN; if (L >= nwg) return false;
    int wgid = L; { const int q = nwg / NXCD, r = nwg % NXCD, xcd = wgid % NXCD, off = wgid / NXCD; wgid = (xcd < r ? xcd * (q + 1) : r * (q + 1) + (xcd - r) * q) + off; }
    const int nig = WGM * nN, gid = wgid / nig, fm = gid * WGM, gsz = (nM - fm) < WGM ? (nM - fm) : WGM;
    pm = fm + ((wgid % nig) % gsz); pn = (wgid % nig) / gsz; return true;
}

typedef int v8i32 __attribute__((ext_vector_type(8)));
template <class Epi, class Sched, bool FP8 = false, int PROBE = 0, bool MID = false>
__device__ __forceinline__ void gemm_phase(LAS unsigned char* lds, const Sched& S, const Epi& E) {
    typedef typename Sched::UnitT Unit;
    const int wid = S.wave, lane = (int)__builtin_amdgcn_mbcnt_hi(~0u, __builtin_amdgcn_mbcnt_lo(~0u, 0u)), tid = (wid << 6) | lane, wr = wid >> 2, wc = wid & 3, fr = lane & 15, fq = lane >> 4;
    const int K = S.K;
    int nt = K / BK; if constexpr (MID) nt = S.nt_total;
    int R[2], C[2];
    unsigned voffB[2];
#pragma unroll
    for (int i = 0; i < 2; ++i) { stage_rc(tid * 16 + i * 8192, R[i], C[i]); const int Rb = (R[i] & ~31) + perm32(R[i] & 31); voffB[i] = (unsigned)(Rb * K + C[i]) * 2u; }
    const unsigned kstep = (unsigned)(BK * 2);
    const unsigned hstepB = (unsigned)HALF * (unsigned)K * 2u;
    const unsigned ldsw = (unsigned)wid * 1024u;
    const int aoff = lds_byte(wr * 64 + fr, fq * 8), boff = lds_byte(wc * 32 + fr, fq * 8);
#define PG8_SA(b, h) (((b) * 2 + (h)) * HTB)
#define PG8_SB(b, h) ((4 + (b) * 2 + (h)) * HTB)
    const __amdgpu_buffer_rsrc_t rA = __builtin_amdgcn_make_buffer_rsrc((void*)S.a_buf(), 0, -1, 0x00020000), rB = __builtin_amdgcn_make_buffer_rsrc((void*)S.b_buf(), 0, -1, 0x00020000);
#define PG8_STAGE2(bufoff, rs, soff, o0, o1) do { \
        __builtin_amdgcn_raw_ptr_buffer_load_lds(rs, (LAS void*)(lds + (bufoff) + ldsw), 16, (int)(o0), (int)(soff), 0, 0); \
        __builtin_amdgcn_raw_ptr_buffer_load_lds(rs, (LAS void*)(lds + (bufoff) + ldsw + 8192), 16, (int)(o1), (int)(soff), 0, 0); } while (0)
#define PG8_STAGEA(bufoff, soff, o0, o1) PG8_STAGE2(bufoff, rA, soff, o0, o1)
#define PG8_STAGEB(bufoff, soff) PG8_STAGE2(bufoff, rB, soff, voffB[0], voffB[1])
    typedef typename pg8::FragSel<FP8>::T FragT;
    constexpr int NK = FP8 ? 1 : 2;
#define PG8_LDA(dst, b, h) do { if constexpr (PROBE == 4) break; _Pragma("unroll") for (int m = 0; m < 4; ++m) _Pragma("unroll") for (int k = 0; k < NK; ++k) dst[m][k] = pg8::ld_frag<FP8>(lds + PG8_SA(b, h) + aoff + m * 2048 + k * 1024); } while (0)
#define PG8_LDB(dst, b, h) do { if constexpr (PROBE == 4) break; _Pragma("unroll") for (int n = 0; n < 2; ++n) _Pragma("unroll") for (int k = 0; k < NK; ++k) dst[n][k] = pg8::ld_frag<FP8>(lds + PG8_SB(b, h) + boff + n * 2048 + k * 1024); } while (0)
#define PG8_MMA(ai, bj, At, Bt) do { if constexpr (PROBE == 3) break; __builtin_amdgcn_s_setprio(1); if constexpr (FP8) asm volatile("s_nop 1"); _Pragma("unroll") for (int m = 0; m < 4; ++m) _Pragma("unroll") for (int n = 0; n < 2; ++n) _Pragma("unroll") for (int k = 0; k < NK; ++k) \
        acc[ai][bj][m][n] = pg8::mma_frag(Bt[n][k], At[m][k], acc[ai][bj][m][n]); __builtin_amdgcn_s_setprio(0); } while (0)
#define PG8_WAIT_V(n) asm volatile("s_waitcnt vmcnt(" #n ")" ::: "memory")
#define PG8_WAIT_L(n) asm volatile("s_waitcnt lgkmcnt(" #n ")" ::: "memory")
#define PG8_BAR __builtin_amdgcn_s_barrier()
#define PG8_SCHED __builtin_amdgcn_sched_barrier(0)
    Unit cur, nxt; int ui = 0;
    if (!S.next(0, cur)) return;
    f32x4 acc[2][2][4][2];
#pragma unroll
    for (int a = 0; a < 2; ++a)
#pragma unroll
        for (int b = 0; b < 2; ++b)
#pragma unroll
            for (int m = 0; m < 4; ++m)
#pragma unroll
                for (int n = 0; n < 2; ++n) { float z0, z1, z2, z3; asm volatile("v_mov_b32 %0, 0\n\tv_mov_b32 %1, 0\n\tv_mov_b32 %2, 0\n\tv_mov_b32 %3, 0" : "=v"(z0), "=v"(z1), "=v"(z2), "=v"(z3)); acc[a][b][m][n] = (f32x4){z0, z1, z2, z3}; }
    FragT At[4][NK], B0[2][NK], B1[2][NK];
    if constexpr (PROBE == 4) { _Pragma("unroll") for (int m = 0; m < 4; ++m) _Pragma("unroll") for (int k = 0; k < NK; ++k) At[m][k] = FragT{}; _Pragma("unroll") for (int n = 0; n < 2; ++n) _Pragma("unroll") for (int k = 0; k < NK; ++k) { B0[n][k] = FragT{}; B1[n][k] = FragT{}; } }
    unsigned ca[4], na[4];
    S.a_offs(cur, R[0], R[1], C[0], C[1], ca);
    unsigned cA = (unsigned)__builtin_amdgcn_readfirstlane((int)S.a_soff(cur)), cB = (unsigned)__builtin_amdgcn_readfirstlane((int)S.b_soff(cur));
    PG8_STAGEB(PG8_SB(0, 0), cB); PG8_STAGEB(PG8_SB(0, 1), cB + hstepB); PG8_STAGEA(PG8_SA(0, 0), cA, ca[0], ca[1]); PG8_STAGEA(PG8_SA(0, 1), cA, ca[2], ca[3]);
    if (wr == 1) PG8_BAR;
    PG8_WAIT_V(2); PG8_BAR;
    PG8_STAGEB(PG8_SB(1, 0), cB + kstep); PG8_STAGEA(PG8_SA(1, 0), cA + kstep, ca[0], ca[1]); PG8_STAGEB(PG8_SB(1, 1), cB + hstepB + kstep);
    PG8_WAIT_V(6); PG8_BAR;
#define PG8_TRIP(a1, a2, b2, a3, b3, x0, x1, x2, x3) do { \
            PG8_LDB(B0, 0, 0); PG8_LDB(B1, 0, 1); PG8_SCHED; PG8_LDA(At, 0, 0); PG8_STAGEA(PG8_SA(1, 1), a1, ca[2], ca[3]); \
            PG8_WAIT_V(8); PG8_WAIT_L(0); PG8_BAR; PG8_MMA(0, 0, At, B0); PG8_MMA(0, 1, At, B1); PG8_BAR; PG8_SCHED; \
            PG8_LDA(At, 0, 1); PG8_STAGEB(PG8_SB(0, 0), b2); PG8_STAGEB(PG8_SB(0, 1), (b2) + hstepB); PG8_STAGEA(PG8_SA(0, 0), a2, x0, x1); \
            PG8_WAIT_V(8); PG8_WAIT_L(0); PG8_BAR; if constexpr (PROBE != 1) { PG8_MMA(1, 0, At, B0); PG8_MMA(1, 1, At, B1); } PG8_BAR; PG8_SCHED; \
            PG8_LDB(B0, 1, 0); PG8_LDB(B1, 1, 1); PG8_SCHED; PG8_LDA(At, 1, 0); PG8_STAGEA(PG8_SA(0, 1), a2, x2, x3); \
            PG8_WAIT_V(8); PG8_WAIT_L(0); PG8_BAR; PG8_MMA(0, 0, At, B0); PG8_MMA(0, 1, At, B1); PG8_BAR; PG8_SCHED; \
            PG8_LDA(At, 1, 1); PG8_STAGEB(PG8_SB(1, 0), b3); PG8_STAGEB(PG8_SB(1, 1), (b3) + hstepB); PG8_STAGEA(PG8_SA(1, 0), a3, x0, x1); \
            PG8_WAIT_V(8); PG8_WAIT_L(0); PG8_BAR; if constexpr (PROBE != 1) { PG8_MMA(1, 0, At, B0); PG8_MMA(1, 1, At, B1); } PG8_BAR; PG8_SCHED; } while (0)
    for (;;) {
        const bool has_next = S.next(ui + 1, nxt);
        unsigned nA = cA, nB = cB;
#pragma unroll
        for (int i = 0; i < 4; ++i) na[i] = ca[i];
        if (has_next) { nA = (unsigned)__builtin_amdgcn_readfirstlane((int)S.a_soff(nxt)); nB = (unsigned)__builtin_amdgcn_readfirstlane((int)S.b_soff(nxt)); S.a_offs(nxt, R[0], R[1], C[0], C[1], na); }
        for (int t = 0; t < nt; t += 2) {
            const bool last = (t == nt - 2);
            unsigned ja1 = 0u, ja2 = 0u, jb2 = 0u;
            if constexpr (MID) { if (t == S.ntf) E.mid(acc, cur, wr, wc, fr, fq); if (t >= S.ntf) ja1 = S.a_jump; if (t + 2 >= S.ntf) { ja2 = S.a_jump; jb2 = S.b_jump; } }
            const unsigned a1 = cA + (unsigned)(t + 1) * kstep + ja1;
            const unsigned a2 = last ? nA : cA + (unsigned)(t + 2) * kstep + ja2, b2 = last ? nB : cB + (unsigned)(t + 2) * kstep + jb2;
            const unsigned x0 = last ? na[0] : ca[0], x1 = last ? na[1] : ca[1], x2 = last ? na[2] : ca[2], x3 = last ? na[3] : ca[3];
            PG8_TRIP(a1, a2, b2, a2 + kstep, b2 + kstep, x0, x1, x2, x3);
        }
        if (wr == 0) PG8_BAR;
        if constexpr (FP8) asm volatile("s_nop 15\n\ts_nop 15" ::: "memory");
        E(acc, cur, wr, wc, fr, fq);
        if (!has_next) break;
#pragma unroll
        for (int a = 0; a < 2; ++a)
#pragma unroll
            for (int b = 0; b < 2; ++b)
#pragma unroll
                for (int m = 0; m < 4; ++m)
#pragma unroll
                    for (int n = 0; n < 2; ++n) { float z0, z1, z2, z3; asm volatile("v_mov_b32 %0, 0\n\tv_mov_b32 %1, 0\n\tv_mov_b32 %2, 0\n\tv_mov_b32 %3, 0" : "=v"(z0), "=v"(z1), "=v"(z2), "=v"(z3)); acc[a][b][m][n] = (f32x4){z0, z1, z2, z3}; }
        cur = nxt; cA = nA; cB = nB; ++ui;
#pragma unroll
        for (int i = 0; i < 4; ++i) ca[i] = na[i];
        if (wr == 1) PG8_BAR;
    }
    PG8_WAIT_V(0);
    PG8_BAR;
#undef PG8_SA
#undef PG8_SB
#undef PG8_TRIP
#undef PG8_STAGE2
#undef PG8_STAGEA
#undef PG8_STAGEB
#undef PG8_LDA
#undef PG8_LDB
#undef PG8_MMA
#undef PG8_WAIT_V
#undef PG8_WAIT_L
#undef PG8_BAR
#undef PG8_SCHED
}
}

struct DenseUnit { int pm, pn; };
struct DenseSched {
    typedef DenseUnit UnitT;
    const bf16_t* A; const bf16_t* Bt; int lda; int K; int nM, nN, G, c, wave;
    __device__ __forceinline__ bool next(int i, DenseUnit& u) const { return pg8::static_tile(i * G + c, nM, nN, u.pm, u.pn); }
    __device__ __forceinline__ const void* a_buf() const { return A; }
    __device__ __forceinline__ const void* b_buf() const { return Bt; }
    __device__ __forceinline__ unsigned a_soff(const DenseUnit& u) const { return (unsigned)u.pm * 256u * (unsigned)lda * 2u; }
    __device__ __forceinline__ unsigned b_soff(const DenseUnit& u) const { return (unsigned)u.pn * 256u * (unsigned)K * 2u; }
    __device__ __forceinline__ void a_offs(const DenseUnit&, int R0, int R1, int C0, int C1, unsigned (&o)[4]) const {
        o[0] = (unsigned)(R0 * lda + C0) * 2u; o[1] = (unsigned)(R1 * lda + C1) * 2u; o[2] = (unsigned)((R0 + 128) * lda + C0) * 2u; o[3] = (unsigned)((R1 + 128) * lda + C1) * 2u;
    }
};
struct MkArgs {
    const float* x; const float* c; const int* positions; const float* w_ada; const float* b_ada;
    const float* g_pre_mix; const float* g_post_mix; const float* g_pre_ffn; const float* g_post_ffn;
    const float* w_in; const float* b_in; const float* conv_qk; const float* sinks; const float* g_mlstm;
    const float* w_attn_proj; const float* w_mlstm_proj; const float* w_out; const float* w_router; const float* b_router;
    const float* w_gate_up; const float* b_gate_up; const float* w_down; const float* b_down;
    float* out; unsigned char* ws;
    const int* route_i; const float* route_w;
    int ph_lo, ph_hi;
};

struct Frame {
    LAS unsigned char* lds;
    int G, bid, vcu, wave;
};
__device__ __forceinline__ int lane_id() { return (int)__builtin_amdgcn_mbcnt_hi(~0u, __builtin_amdgcn_mbcnt_lo(~0u, 0u)); }
__device__ __forceinline__ int fresh_tid(const Frame& F) { return (F.wave << 6) | lane_id(); }

template <int CTRL> __device__ __forceinline__ float dpp_mov(float v) { return __builtin_bit_cast(float, __builtin_amdgcn_update_dpp(0, __builtin_bit_cast(int, v), CTRL, 0xF, 0xF, true)); }
__device__ __forceinline__ float rdlane_f(float v, int l) { return __builtin_bit_cast(float, __builtin_amdgcn_readlane(__builtin_bit_cast(int, v), l)); }
__device__ __forceinline__ float wave_sum_f(float v) {
    v += dpp_mov<0xB1>(v); v += dpp_mov<0x4E>(v); v += dpp_mov<0x124>(v); v += dpp_mov<0x128>(v);
    return (rdlane_f(v, 0) + rdlane_f(v, 16)) + (rdlane_f(v, 32) + rdlane_f(v, 48));
}
__device__ __forceinline__ float wave_max_f(float v) {
    v = fmaxf(v, dpp_mov<0xB1>(v)); v = fmaxf(v, dpp_mov<0x4E>(v)); v = fmaxf(v, dpp_mov<0x124>(v)); v = fmaxf(v, dpp_mov<0x128>(v));
    return fmaxf(fmaxf(rdlane_f(v, 0), rdlane_f(v, 16)), fmaxf(rdlane_f(v, 32), rdlane_f(v, 48)));
}

__device__ __forceinline__ int in_src_col(int n) {
    if (n < 1152) { const int d = n & 63; if (d < 16) return (n & ~63) + (d >> 1) + 8 * (d & 1); return n; }
    if (n < 4352) return n;
    return n + 8;
}

template <bool MAP>
__device__ __forceinline__ void p0_transpose_item(const float* __restrict__ W, int K, int N, bf16_t* WT, LAS float* scr, int kb, int nb, int lane) {
    const int k0 = 64 * kb, n0 = 32 * nb;
    const int sc = MAP ? in_src_col(n0 + (lane & 31)) : n0 + (lane & 31);
#pragma unroll 8
    for (int i = 0; i < 32; ++i) { const int kk = 2 * i + (lane >> 5); scr[kk * 33 + (lane & 31)] = W[(size_t)(k0 + kk) * N + sc]; }
    LDS_WAIT(); asm volatile("" ::: "memory");
    const int c = lane & 7;
#pragma unroll
    for (int j = 0; j < 4; ++j) { const int n = (lane >> 3) + 8 * j; const LAS float* s = scr + (8 * c) * 33 + n;
        u32x4 o; o.x = pk2(s[0 * 33], s[1 * 33]); o.y = pk2(s[2 * 33], s[3 * 33]); o.z = pk2(s[4 * 33], s[5 * 33]); o.w = pk2(s[6 * 33], s[7 * 33]);
        *(u32x4*)(WT + (size_t)(n0 + n) * K + k0 + 8 * c) = o; }
    LDS_WAIT(); asm volatile("" ::: "memory");
}

struct ConvItem { const float* ub; unsigned char* db; unsigned lo, dlo; };
__device__ __forceinline__ ConvItem conv_item_addr(const MkArgs& a, int it, int lane, int& N) {
    constexpr int KB = 2048 / 128, I_GU = KB * (4096 / 32), I_DN = KB * (2048 / 32);
    const float* W; unsigned char* WT; int q, NB;
    if (it < NE * I_GU) { const int e = it / I_GU; q = it % I_GU; N = 4096; NB = 128; W = a.w_gate_up + (size_t)e * 2048 * 4096; WT = a.ws + wsf::WGU8 + (size_t)e * 4096 * 2048; }
    else { const int r = it - NE * I_GU, e = r / I_DN; q = r % I_DN; N = 2048; NB = 64; W = a.w_down + (size_t)e * 2048 * 2048; WT = a.ws + wsf::WDN8 + (size_t)e * 2048 * 2048; }
    const int k0 = 128 * (q / NB), n0 = 32 * (q % NB);
    ConvItem c; c.ub = W + (size_t)k0 * N + n0; c.db = WT + (size_t)n0 * 2048 + k0;
    c.lo = (unsigned)((lane >> 3) * N + (lane & 7) * 4) * 4u; c.dlo = (unsigned)((lane >> 3) * 2048 + 16 * (lane & 7));
    return c;
}
__device__ __forceinline__ void conv_item_load(const ConvItem& c, int N, f32x4 (&v)[16]) {
#pragma unroll
    for (int i = 0; i < 16; ++i) v[i] = __builtin_nontemporal_load((const f32x4*)((const unsigned char*)(c.ub + (size_t)(8 * i) * N) + c.lo));
}
__device__ __forceinline__ void conv_item_store(const ConvItem& c, const f32x4 (&v)[16], LAS float* scr, int lane, bool dry = false) {
    const int kr = lane >> 3, n4 = (lane & 7) * 4;
#pragma unroll
    for (int i = 0; i < 16; ++i) { const int k = 8 * i + kr, rot = 20 * (i >> 1); LAS float* row = scr + k * 33;
        row[(n4 + 0 + rot) & 31] = v[i].x; row[(n4 + 1 + rot) & 31] = v[i].y; row[(n4 + 2 + rot) & 31] = v[i].z; row[(n4 + 3 + rot) & 31] = v[i].w; }
    LDS_WAIT(); asm volatile("" ::: "memory");
    const int cblk = lane & 7;
#pragma unroll
    for (int j = 0; j < 4; ++j) {
        const int n = (lane >> 3) + 8 * j;
        const LAS float* sp = scr + (16 * cblk) * 33 + ((n + 20 * cblk) & 31);
        u32x4 o;
        o.x = pk4_fp8(sp[0 * 33] * W8SCALE, sp[1 * 33] * W8SCALE, sp[2 * 33] * W8SCALE, sp[3 * 33] * W8SCALE);
        o.y = pk4_fp8(sp[4 * 33] * W8SCALE, sp[5 * 33] * W8SCALE, sp[6 * 33] * W8SCALE, sp[7 * 33] * W8SCALE);
        o.z = pk4_fp8(sp[8 * 33] * W8SCALE, sp[9 * 33] * W8SCALE, sp[10 * 33] * W8SCALE, sp[11 * 33] * W8SCALE);
        o.w = pk4_fp8(sp[12 * 33] * W8SCALE, sp[13 * 33] * W8SCALE, sp[14 * 33] * W8SCALE, sp[15 * 33] * W8SCALE);
        if (!dry) *(u32x4*)(c.db + (size_t)(8 * j) * 2048 + c.dlo) = o; else asm volatile("" :: "v"(o.x), "v"(o.y), "v"(o.z), "v"(o.w));
    }
    LDS_WAIT(); asm volatile("" ::: "memory");
}
__device__ __forceinline__ void conv_loads_asm(const ConvItem& c, int N, f32x4 (&v)[16]) {
#pragma unroll
    for (int i = 0; i < 16; ++i) { const float* p = c.ub + (size_t)(8 * i) * N;
        asm volatile("global_load_dwordx4 %0, %1, %2" : "=&v"(v[i]) : "v"(c.lo), "s"(p)); }
}
#define CONV_WAIT(n, v) do { \
    asm volatile("s_waitcnt vmcnt(" #n ")" : "+v"(v[0]), "+v"(v[1]), "+v"(v[2]), "+v"(v[3]), "+v"(v[4]), "+v"(v[5]), "+v"(v[6]), "+v"(v[7]) :: "memory"); \
    asm volatile("" : "+v"(v[8]), "+v"(v[9]), "+v"(v[10]), "+v"(v[11]), "+v"(v[12]), "+v"(v[13]), "+v"(v[14]), "+v"(v[15]) :: "memory"); } while (0)
__device__ __forceinline__ void conv_item_store_asm(const ConvItem& c, const f32x4 (&v)[16], LAS float* scr, int lane) {
    const int kr = lane >> 3, n4 = (lane & 7) * 4;
#pragma unroll
    for (int i = 0; i < 16; ++i) { const int k = 8 * i + kr, rot = 20 * (i >> 1); LAS float* row = scr + k * 33;
        row[(n4 + 0 + rot) & 31] = v[i].x; row[(n4 + 1 + rot) & 31] = v[i].y; row[(n4 + 2 + rot) & 31] = v[i].z; row[(n4 + 3 + rot) & 31] = v[i].w; }
    LDS_WAIT(); asm volatile("" ::: "memory");
    const int cblk = lane & 7;
#pragma unroll
    for (int j = 0; j < 4; ++j) {
        const int n = (lane >> 3) + 8 * j;
        const LAS float* sp = scr + (16 * cblk) * 33 + ((n + 20 * cblk) & 31);
        u32x4 o;
        o.x = pk4_fp8(sp[0 * 33] * W8SCALE, sp[1 * 33] * W8SCALE, sp[2 * 33] * W8SCALE, sp[3 * 33] * W8SCALE);
        o.y = pk4_fp8(sp[4 * 33] * W8SCALE, sp[5 * 33] * W8SCALE, sp[6 * 33] * W8SCALE, sp[7 * 33] * W8SCALE);
        o.z = pk4_fp8(sp[8 * 33] * W8SCALE, sp[9 * 33] * W8SCALE, sp[10 * 33] * W8SCALE, sp[11 * 33] * W8SCALE);
        o.w = pk4_fp8(sp[12 * 33] * W8SCALE, sp[13 * 33] * W8SCALE, sp[14 * 33] * W8SCALE, sp[15 * 33] * W8SCALE);
        unsigned char* p = c.db + (size_t)(8 * j) * 2048;
        asm volatile("global_store_dwordx4 %0, %1, %2\n\ts_nop 2" :: "v"(c.dlo), "v"(o), "s"(p) : "memory");
    }
    LDS_WAIT(); asm volatile("" ::: "memory");
}
__device__ __forceinline__ void moe_convert(const MkArgs& a, Frame& F, int widx, int nw, bool dry = false, int it0 = 0, int it1 = -1) {
    const int lane = lane_id();
    LAS float* scr = (LAS float*)(F.lds + F.wave * 16896);
    constexpr int NIT_ALL = NE * ((2048 / 128) * (4096 / 32) + (2048 / 128) * (2048 / 32));
    const int NIT = it1 < 0 ? NIT_ALL : it1;
    widx += it0;
    if (widx >= NIT) return;
    (void)dry;
    asm volatile("s_waitcnt vmcnt(0)" ::: "memory");
    f32x4 va[16], vb[16]; int Na, Nb;
#define CONV_CL(i_) ((i_) < NIT ? (i_) : NIT - 1)
    ConvItem ca = conv_item_addr(a, widx, lane, Na), cb = conv_item_addr(a, CONV_CL(widx + nw), lane, Nb);
    conv_loads_asm(ca, Na, va);
    conv_loads_asm(cb, Nb, vb);
    CONV_WAIT(16, va);
    conv_item_store_asm(ca, va, scr, lane);
    ca = conv_item_addr(a, CONV_CL(widx + 2 * nw), lane, Na); conv_loads_asm(ca, Na, va);
    for (int it = widx + nw; it < NIT; it += 2 * nw) {
        CONV_WAIT(20, vb);
        conv_item_store_asm(cb, vb, scr, lane);
        cb = conv_item_addr(a, CONV_CL(it + 2 * nw), lane, Nb); conv_loads_asm(cb, Nb, vb);
        CONV_WAIT(20, va);
        conv_item_store_asm(ca, va, scr, lane);
        ca = conv_item_addr(a, CONV_CL(it + 3 * nw), lane, Na); conv_loads_asm(ca, Na, va);
    }
#undef CONV_CL
    CONV_WAIT(0, va); CONV_WAIT(0, vb);
}
__device__ __forceinline__ int n_conv_wgs(int G) { return G == 256 ? CONV_WGS : 0; }

struct TrItem { const float* src; bf16_t* dst; int N, perm; };
__device__ __forceinline__ TrItem tr_item_addr(const MkArgs& a, int it, int lane) {
    constexpr int I_IN = 32 * (fp::NIN / 32), I_AP = 16 * 64, I_MP = 16 * 64;
    const float* W; bf16_t* WT; int K, N, nblk, r = it, perm = 0, shift = 0;
    unsigned char* ws = a.ws;
    if (r < I_IN) { W = a.w_in; WT = (bf16_t*)(ws + wsf::WIN_T); K = 2048; N = INW; nblk = fp::NIN / 32; }
    else if ((r -= I_IN) < I_AP) { W = a.w_attn_proj; WT = (bf16_t*)(ws + wsf::WAP_T); K = 1024; N = 2048; nblk = 64; }
    else if ((r -= I_AP) < I_MP) { W = a.w_mlstm_proj; WT = (bf16_t*)(ws + wsf::WMP_T); K = 1024; N = 2048; nblk = 64; }
    else { r -= I_MP; W = a.w_out; WT = (bf16_t*)(ws + wsf::WOUT_T); K = 2048; N = 2048; nblk = 64; }
    const int kb = r / nblk, nb = r % nblk, k0 = 64 * kb, n0 = 32 * nb;
    if (it < I_IN) { perm = (n0 < 1152 && (n0 & 32) == 0) ? 1 : 0; shift = n0 >= 4352 ? 8 : 0; }
    TrItem t; t.src = W + (size_t)(k0 + (lane >> 3)) * N + n0 + shift + (lane & 7) * 4; t.dst = WT + (size_t)(n0 + (lane >> 3)) * K + k0 + 8 * (lane & 7); t.N = N; t.perm = perm | (K << 1);
    return t;
}
__device__ __forceinline__ void tr_item_load(const TrItem& t, f32x4 (&v)[8]) {
#pragma unroll
    for (int i = 0; i < 8; ++i) v[i] = *(const f32x4*)(t.src + (size_t)(8 * i) * t.N);
}
__device__ __forceinline__ void tr_item_store(const TrItem& t, const f32x4 (&v)[8], LAS float* scr, int lane) {
    const int kr = lane >> 3, n4 = (lane & 7) * 4, K = t.perm >> 1;
#pragma unroll
    for (int i = 0; i < 8; ++i) { const int k = 8 * i + kr, rot = 4 * (i >> 2); LAS float* row = scr + k * 33 + ((n4 + rot) & 31);
        row[0] = v[i].x; row[1] = v[i].y; row[2] = v[i].z; row[3] = v[i].w; }
    LDS_WAIT(); asm volatile("" ::: "memory");
    const int cb = lane & 7;
#pragma unroll
    for (int j = 0; j < 4; ++j) {
        const int n = (lane >> 3) + 8 * j;
        int c = n; if ((t.perm & 1) && n < 16) c = (n >> 1) + 8 * (n & 1);
        const LAS float* sp = scr + (8 * cb) * 33 + ((c + 4 * (cb >> 2)) & 31);
        u32x4 o; o.x = pk2(sp[0 * 33], sp[1 * 33]); o.y = pk2(sp[2 * 33], sp[3 * 33]); o.z = pk2(sp[4 * 33], sp[5 * 33]); o.w = pk2(sp[6 * 33], sp[7 * 33]);
        *(u32x4*)(t.dst + (size_t)(8 * j) * K) = o;
    }
    LDS_WAIT(); asm volatile("" ::: "memory");
}

__device__ __forceinline__ void ada_gemv(const MkArgs& a, Frame& F, int blk_lo, int blk_hi) {
    const int f_tid = fresh_tid(F), f_lane = f_tid & 63, f_wave = F.wave;
    LAS float* sc = (LAS float*)F.lds;
    LAS float* red = sc + 4096;
    if (blk_lo + F.vcu >= blk_hi) return;
    for (int i = f_tid; i < 2 * D; i += fp::NT) sc[i] = silu_f(a.c[i]);
    __syncthreads();
    const int k0 = f_wave * 256 + (f_lane >> 5) * 128;
    for (int cblk = blk_lo + F.vcu; cblk < blk_hi; cblk += F.G) {
        const float* wp = a.w_ada + (size_t)k0 * MODW + cblk * 32 + (f_lane & 31);
        float a0 = 0.f, a1 = 0.f;
#pragma unroll 32
        for (int k = 0; k < 128; ++k) { const float w = wp[(size_t)k * MODW]; a0 += w * sc[k0 + k]; a1 += w * sc[2048 + k0 + k]; }
        red[(f_wave * 2 + 0) * 64 + f_lane] = a0; red[(f_wave * 2 + 1) * 64 + f_lane] = a1;
        __syncthreads();
        if (f_tid < 64) { const int b = f_tid >> 5, j = f_tid & 31; float sum = a.b_ada[cblk * 32 + j];
#pragma unroll
          for (int w8 = 0; w8 < 8; ++w8) sum += red[(w8 * 2 + b) * 64 + j] + red[(w8 * 2 + b) * 64 + 32 + j];
          ((float*)(a.ws + wsf::MOD))[b * MODW + cblk * 32 + j] = sum; }
        __syncthreads();
    }
}

__device__ __forceinline__ void phase0(const MkArgs& a, Frame& F, int parts = 7) {
    const int f_tid = fresh_tid(F), f_lane = f_tid & 63, f_wave = F.wave;
    unsigned char* ws = a.ws;
    const int gw = F.vcu * fp::NW + f_wave, NGW = F.G * fp::NW;
    if (parts & 1) {
        LAS float* scr = (LAS float*)(F.lds + f_wave * 8448);
        constexpr int NITEMS = 32 * (fp::NIN / 32) + 16 * 64 + 16 * 64 + 32 * 64;
        if (gw < NITEMS) {
            f32x4 va[8], vb[8];
            TrItem ta = tr_item_addr(a, gw, f_lane), tb;
            tr_item_load(ta, va);
            for (int it = gw; it < NITEMS; it += 2 * NGW) {
                const int i1 = it + NGW, i2 = it + 2 * NGW;
                tb = tr_item_addr(a, i1 < NITEMS ? i1 : NITEMS - 1, f_lane); tr_item_load(tb, vb);
                tr_item_store(ta, va, scr, f_lane);
                if (i1 >= NITEMS) break;
                ta = tr_item_addr(a, i2 < NITEMS ? i2 : NITEMS - 1, f_lane); tr_item_load(ta, va);
                tr_item_store(tb, vb, scr, f_lane);
            }
        }
    }
#if MOE_FP8
    __syncthreads();
    if (n_conv_wgs(F.G) == 0) moe_convert(a, F, gw, NGW);
#if DRY_PROBE
    moe_convert(a, F, gw, NGW, true);
#endif
#endif
    __syncthreads();
    if (parts & 2) ada_gemv(a, F, 0, 4096 / 32);
    if (!(parts & 4)) return;
    const int gt = F.vcu * fp::NT + f_tid, NGT = F.G * fp::NT;
    for (int i = gt; i < NTOK * 8; i += NGT) { float cs, sn; rope_cs(a.positions[i >> 3], i & 7, cs, sn); ((f32x2*)(ws + wsf::CS))[i] = (f32x2){cs, sn}; }
    for (int i = gt; i < fp::NIN; i += NGT) ((float*)(ws + wsf::BINP))[i] = a.b_in[in_src_col(i)];
    for (int i = gt; i < 32 * 2048; i += NGT) {
        const int e = i >> 11, k = i & 2047; const float w = a.w_router[k * 32 + e]; const unsigned hi = f2bf(w); const float rem = w - __builtin_bit_cast(float, hi << 16);
        ((bf16_t*)(ws + wsf::WRT))[i] = (bf16_t)hi; ((bf16_t*)(ws + wsf::WRT))[32 * 2048 + i] = (bf16_t)f2bf(rem);
    }
}

__device__ __forceinline__ void phase1(const MkArgs& a, Frame& F) {
    const int f_tid = fresh_tid(F), f_lane = f_tid & 63, f_wave = F.wave;
    unsigned char* ws = a.ws;
    const float* mod = (const float*)(ws + wsf::MOD);
    LAS float* lmod = (LAS float*)F.lds;
    LAS float* wg = (LAS float*)(F.lds + 32768);
    for (int i = f_tid; i < 2048 * 8; i += fp::NT) wg[(i & 7) * 2048 + (i >> 3)] = a.w_in[(size_t)(i >> 3) * INW + OFF_MI + (i & 7)];
    for (int blk = F.vcu; blk < NTOK / 64; blk += F.G) {
        const int b = (blk * 64) / S;
        __syncthreads();
        for (int i = f_tid; i < 2048; i += fp::NT) { lmod[i] = mod[b * MODW + i]; lmod[2048 + i] = a.g_pre_mix[i] * (1.f + mod[b * MODW + 2048 + i]); }
        __syncthreads();
#pragma unroll 1
        for (int rr = 0; rr < 8; ++rr) {
            const int m = blk * 64 + f_wave * 8 + rr;
            const GAS f32x4* xr = (const GAS f32x4*)(a.x + (size_t)m * D);
            f32x4 xv[8]; float ss = 0.f;
#pragma unroll
            for (int j = 0; j < 8; ++j) { xv[j] = xr[64 * j + f_lane]; ss += (xv[j].x * xv[j].x + xv[j].y * xv[j].y) + (xv[j].z * xv[j].z + xv[j].w * xv[j].w); }
            const float r = rsqrtf(wave_sum_f(ss) * (1.f / D) + EPS);
            float g8[8];
#pragma unroll
            for (int e = 0; e < 8; ++e) g8[e] = 0.f;
            GAS u32x2* o8 = (GAS u32x2*)(ws + wsf::H1 + (size_t)m * D * 2);
#pragma unroll
            for (int j = 0; j < 8; ++j) {
                const int c0 = 4 * (64 * j + f_lane);
                const f32x4 v = xv[j];
                const f32x4 sh = *(const LAS f32x4*)(lmod + c0), gs = *(const LAS f32x4*)(lmod + 2048 + c0);
                f32x4 h;
                h.x = v.x * r * gs.x + sh.x; h.y = v.y * r * gs.y + sh.y;
                h.z = v.z * r * gs.z + sh.z; h.w = v.w * r * gs.w + sh.w;
                o8[64 * j + f_lane] = (u32x2){pg8::cvt_pk_bf16(h.x, h.y), pg8::cvt_pk_bf16(h.z, h.w)};
#pragma unroll
                for (int e = 0; e < 8; ++e) { const f32x4 w = *(const LAS f32x4*)(wg + e * 2048 + c0); g8[e] += (h.x * w.x + h.y * w.y) + (h.z * w.z + h.w * w.w); }
            }
            float mine = 0.f;
#pragma unroll
            for (int e = 0; e < 8; ++e) { const float s8 = wave_sum_f(g8[e]); if (f_lane == e) mine = s8; }
            if (f_lane < 8) ((float*)(ws + wsf::GATES))[(size_t)m * 8 + f_lane] = mine + a.b_in[OFF_MI + f_lane];
        }
    }
}

struct EpiIn {
    bf16_t* O; const float* bias; const f32x2* cs; bool skip; bool nostore;
    __device__ __forceinline__ void operator()(const f32x4 (&acc)[2][2][4][2], const DenseUnit& u, int wr, int wc, int fr, int fq) const {
        if (skip) {
#pragma unroll
            for (int ai = 0; ai < 2; ++ai)
#pragma unroll
                for (int bj = 0; bj < 2; ++bj)
#pragma unroll
                    for (int m = 0; m < 4; ++m)
#pragma unroll
                        for (int n = 0; n < 2; ++n) asm volatile("" :: "v"(acc[ai][bj][m][n]));
            return;
        }
        const int row0 = u.pm * 256 + wr * 64 + fr, col0 = u.pn * 256 + wc * 32 + 8 * fq;
        const int pn = u.pn;
        const bool ropelane = ((wc & 1) == 0) && fq < 2;
        const int i0 = fq * 4;
        f32x4 bv[2][2];
#pragma unroll
        for (int bj = 0; bj < 2; ++bj)
#pragma unroll
            for (int n = 0; n < 2; ++n) bv[bj][n] = *(const f32x4*)(bias + col0 + bj * 128 + 4 * n);
#pragma unroll
        for (int ai = 0; ai < 2; ++ai)
#pragma unroll
            for (int m = 0; m < 4; ++m) {
                const int row = row0 + ai * 128 + m * 16;
                bf16_t* rowp = O + (size_t)row * fp::NIN + col0;
#pragma unroll
                for (int bj = 0; bj < 2; ++bj) {
                    f32x4 v0 = acc[ai][bj][m][0] + bv[bj][0], v1 = acc[ai][bj][m][1] + bv[bj][1];
                    if (pn < 4 || (pn == 4 && bj == 0)) {
                        if (ropelane) {
                            const f32x4 ca = *(const f32x4*)(cs + (size_t)row * 8 + i0), cb = *(const f32x4*)(cs + (size_t)row * 8 + i0 + 2);
                            f32x4 r0, r1;
                            r0.x = v0.x * ca.x - v0.y * ca.y; r0.y = v0.y * ca.x + v0.x * ca.y;
                            r0.z = v0.z * ca.z - v0.w * ca.w; r0.w = v0.w * ca.z + v0.z * ca.w;
                            r1.x = v1.x * cb.x - v1.y * cb.y; r1.y = v1.y * cb.x + v1.x * cb.y;
                            r1.z = v1.z * cb.z - v1.w * cb.w; r1.w = v1.w * cb.z + v1.z * cb.w;
                            v0 = r0; v1 = r1;
                        }
                        if (pn < 4) { v0 = v0 * fp::QSCALE; v1 = v1 * fp::QSCALE; }
                    } else if (pn >= 13 && pn < 17) {
#pragma unroll
                        for (int q = 0; q < 4; ++q) { v0[q] = fast_sigmoid(v0[q]); v1[q] = fast_sigmoid(v1[q]); }
                    }
                    u32x4 w; w.x = pg8::cvt_pk_bf16(v0[0], v0[1]); w.y = pg8::cvt_pk_bf16(v0[2], v0[3]); w.z = pg8::cvt_pk_bf16(v1[0], v1[1]); w.w = pg8::cvt_pk_bf16(v1[2], v1[3]);
#if EPI_SKIP_PROBE == 6
                    if (nostore) asm volatile("" :: "v"(w)); else
#endif
                    *(u32x4*)(rowp + bj * 128) = w;
                }
            }
    }
};

__device__ __forceinline__ void phase2(const MkArgs& a, Frame& F, bool skip_epi = false) {
    const int f_tid = fresh_tid(F), f_lane = f_tid & 63, f_wave = F.wave;
    unsigned char* ws = a.ws;
#if MOE_FP8
    const int ncv = n_conv_wgs(F.G), Gg = F.G - ncv;
    constexpr int NIT_ALL = NE * ((2048 / 128) * (4096 / 32) + (2048 / 128) * (2048 / 32));
    const int nsplit = ncv > 0 ? (int)((long)NIT_ALL * CONV_SPLIT / 1024) : NIT_ALL;
    if (F.bid >= Gg) { moe_convert(a, F, (F.bid - Gg) * fp::NW + F.wave, ncv * fp::NW, false, 0, nsplit);
#if DRY_PROBE == 2
        moe_convert(a, F, (F.bid - Gg) * fp::NW + F.wave, ncv * fp::NW, true);
#endif
        return; }
#else
    const int Gg = F.G;
#endif
#if MOE_FP8 && STAGGER_NG > 1
    const int stg = (ncv > 0 && nsplit < NIT_ALL) ? ((F.bid >> 3) % STAGGER_NG) * STAGGER_STEP : 0;
    const int nsplit2 = nsplit + stg * Gg * fp::NW;
    if (stg > 0) { moe_convert(a, F, F.bid * fp::NW + F.wave, Gg * fp::NW, false, nsplit, nsplit2 < NIT_ALL ? nsplit2 : NIT_ALL); __syncthreads(); }
#else
    const int nsplit2 = nsplit;
#endif
    DenseSched S{(const bf16_t*)(ws + wsf::H1), (const bf16_t*)(ws + wsf::WIN_T), 2048, 2048, NTOK / 256, fp::NIN / 256, Gg, F.bid, F.wave};
    EpiIn E{(bf16_t*)(ws + wsf::PROJB), (const float*)(ws + wsf::BINP), (const f32x2*)(ws + wsf::CS), skip_epi && EPI_SKIP_PROBE != 6, skip_epi && EPI_SKIP_PROBE == 6};
    pg8::gemm_phase<EpiIn, DenseSched>(F.lds, S, E);
#if MOE_FP8
    if (ncv > 0 && nsplit2 < NIT_ALL) { __syncthreads(); moe_convert(a, F, F.bid * fp::NW + F.wave, Gg * fp::NW, false, nsplit2, NIT_ALL); }
#endif
}
__device__ __forceinline__ f32x4 mfma16(bf16x8 a, bf16x8 b, f32x4 c) { return __builtin_amdgcn_mfma_f32_16x16x32_bf16(a, b, c, 0, 0, 0); }
__device__ __forceinline__ float exp2_fast(float x) { return __builtin_amdgcn_exp2f(x); }
typedef short v4i16_t __attribute__((ext_vector_type(4)));
__device__ __forceinline__ bf16x8 tr_frag(const LAS bf16_t* base, int stride, int lane) {
    const LAS bf16_t* p = base + (8 * (lane >> 4) + ((lane & 15) >> 2)) * stride + 4 * (lane & 3);
    const v4i16_t lo = __builtin_amdgcn_ds_read_tr16_b64_v4i16((LAS v4i16_t*)p), hi = __builtin_amdgcn_ds_read_tr16_b64_v4i16((LAS v4i16_t*)(p + 4 * stride));
    return __builtin_shufflevector(lo, hi, 0, 1, 2, 3, 4, 5, 6, 7);
}

__device__ __forceinline__ void attn_unit(const MkArgs& a, Frame& F, int unit) {
    const int f_tid = fresh_tid(F), f_lane = f_tid & 63, f_wave = F.wave;
    const int b = unit >> 7, hk = (unit >> 6) & 1, n = unit & 63;
    const bf16_t* PB = (const bf16_t*)(a.ws + wsf::PROJB);
    bf16_t* OA = (bf16_t*)(a.ws + wsf::OAT);
    const size_t tok0 = (size_t)b * S + (size_t)n * 128;
    LAS bf16_t* Ks = (LAS bf16_t*)F.lds;
    LAS bf16_t* Vs = (LAS bf16_t*)(F.lds + 36864);
    LAS bf16_t* Pw = (LAS bf16_t*)(F.lds + 36864 + 39168 + f_wave * 5376);
#pragma unroll
    for (int i = 0; i < 4; ++i) {
        const int q = f_tid + 512 * i, row = q >> 3, ch = q & 7;
        u32x4 kv = (u32x4){0u, 0u, 0u, 0u}, vv = kv;
        if (n > 0 || row >= 128) {
            const bf16_t* src = PB + (tok0 - 128 + row) * fp::NIN + hk * 64 + ch * 8;
            kv = *(const u32x4*)(src + fp::PB_K); vv = *(const u32x4*)(src + fp::PB_V);
        }
        *(LAS u32x4*)(Ks + row * 72 + ch * 8) = kv;
        *(LAS u32x4*)(Vs + row * 72 + ch * 8) = vv;
    }
    if (f_tid < 128) *(LAS u32x4*)(Vs + (256 + (f_tid >> 3)) * 72 + (f_tid & 7) * 8) = (u32x4){0u, 0u, 0u, 0u};
    __syncthreads();
    const int c16 = f_lane & 15, grp = f_lane >> 4, h = hk * 8 + f_wave;
    const float sink2 = a.sinks[h] * fp::LOG2E;
    bf16x8 qn[2];
#pragma unroll
    for (int ks = 0; ks < 2; ++ks) qn[ks] = *(const bf16x8*)(PB + (tok0 + c16) * fp::NIN + fp::PB_Q + h * 64 + ks * 32 + grp * 8);
    u32x2 po[4] = {(u32x2){0u, 0u}, (u32x2){0u, 0u}, (u32x2){0u, 0u}, (u32x2){0u, 0u}};
#pragma unroll 1
    for (int tt = 0; tt < 8; ++tt) {
        { const size_t ptok = tok0 + (tt > 0 ? tt - 1 : 0) * 16 + c16;
#pragma unroll
          for (int dt = 0; dt < 4; ++dt) *(u32x2*)(OA + ptok * 1024 + h * 64 + 16 * dt + 4 * grp) = po[dt]; }
        bf16x8 qf[2];
        { const size_t ntok = tok0 + (tt < 7 ? tt + 1 : 7) * 16 + c16;
#pragma unroll
          for (int ks = 0; ks < 2; ++ks) { qf[ks] = qn[ks]; qn[ks] = *(const bf16x8*)(PB + ntok * fp::NIN + fp::PB_Q + h * 64 + ks * 32 + grp * 8); } }
        f32x4 sacc[9];
#pragma unroll
        for (int jq = 0; jq < 9; ++jq) {
            sacc[jq] = (f32x4){0.f, 0.f, 0.f, 0.f};
#pragma unroll
            for (int ks = 0; ks < 2; ++ks) { const bf16x8 kf = *(const LAS bf16x8*)(Ks + (16 * (tt + jq) + c16) * 72 + ks * 32 + grp * 8); sacc[jq] = mfma16(kf, qf[ks], sacc[jq]); }
        }
        float mx = sink2;
#pragma unroll
        for (int jq = 0; jq < 9; ++jq)
#pragma unroll
            for (int r = 0; r < 4; ++r) {
                const int diff = 128 + c16 - 16 * jq - 4 * grp - r, jrel = 16 * (tt + jq) + 4 * grp + r;
                const bool ok = diff >= 0 && diff < 128 && (n > 0 || jrel >= 128);
                sacc[jq][r] = ok ? sacc[jq][r] : -INFINITY;
                mx = fmaxf(mx, sacc[jq][r]);
            }
        mx = fmaxf(mx, __shfl_xor(mx, 16)); mx = fmaxf(mx, __shfl_xor(mx, 32));
        float ls = 0.f;
#pragma unroll
        for (int jq = 0; jq < 9; ++jq) {
            float p[4];
#pragma unroll
            for (int r = 0; r < 4; ++r) { p[r] = exp2_fast(sacc[jq][r] - mx); ls += p[r]; }
            *(LAS u32x2*)(Pw + c16 * 168 + 16 * jq + 4 * grp) = (u32x2){pk2(p[0], p[1]), pk2(p[2], p[3])};
        }
        *(LAS u32x2*)(Pw + c16 * 168 + 144 + 4 * grp) = (u32x2){0u, 0u};
        ls += __shfl_xor(ls, 16); ls += __shfl_xor(ls, 32);
        ls += exp2_fast(sink2 - mx);
        const float inv = 1.f / ls;
        LDS_WAIT();
        f32x4 oacc[4];
#pragma unroll
        for (int dt = 0; dt < 4; ++dt) oacc[dt] = (f32x4){0.f, 0.f, 0.f, 0.f};
#pragma unroll
        for (int k2 = 0; k2 < 5; ++k2) {
            const bf16x8 pb = *(const LAS bf16x8*)(Pw + c16 * 168 + 32 * k2 + 8 * grp);
#pragma unroll
            for (int dt = 0; dt < 4; ++dt) { const bf16x8 va = tr_frag(Vs + (16 * tt + 32 * k2) * 72 + 16 * dt, 72, f_lane); oacc[dt] = mfma16(va, pb, oacc[dt]); }
        }
#pragma unroll
        for (int dt = 0; dt < 4; ++dt) po[dt] = (u32x2){pk2(oacc[dt][0] * inv, oacc[dt][1] * inv), pk2(oacc[dt][2] * inv, oacc[dt][3] * inv)};
        LDS_WAIT();
    }
#pragma unroll
    for (int dt = 0; dt < 4; ++dt) *(u32x2*)(OA + (tok0 + 7 * 16 + c16) * 1024 + h * 64 + 16 * dt + 4 * grp) = po[dt];
    __syncthreads();
}

__device__ __forceinline__ void unpack8(const u32x4 v, float (&f)[8]) {
    f[0] = bflo(v.x); f[1] = bfhi(v.x); f[2] = bflo(v.y); f[3] = bfhi(v.y); f[4] = bflo(v.z); f[5] = bfhi(v.z); f[6] = bflo(v.w); f[7] = bfhi(v.w);
}
__device__ __forceinline__ void stage_vt(const bf16_t* PB, size_t tok0, int col0, LAS bf16_t* Vs, int tid) {
#pragma unroll
    for (int i = 0; i < 8; ++i) {
        const int q = tid + 512 * i, row = q >> 5, ch = q & 31;
        *(LAS u32x4*)(Vs + row * 272 + ch * 8) = *(const u32x4*)(PB + (tok0 + row) * fp::NIN + col0 + ch * 8);
    }
}

__device__ __forceinline__ void m1_unit(const MkArgs& a, Frame& F, int u) {
    const int f_tid = fresh_tid(F), f_lane = f_tid & 63, f_wave = F.wave;
    const int bh = u >> 6, c = u & 63, b = bh >> 2, h = bh & 3;
    const size_t tok0 = (size_t)b * S + (size_t)c * 128;
    unsigned char* ws = a.ws;
    const bf16_t* PB = (const bf16_t*)(ws + wsf::PROJB);
    LAS bf16_t* Kw = (LAS bf16_t*)F.lds;
    LAS bf16_t* Vt = (LAS bf16_t*)(F.lds + 34816);
    LAS float* gl = (LAS float*)(F.lds + 34816 + 69632);
    const float* GT = (const float*)(ws + wsf::GATES);
    const int tid = f_tid;
    LAS bf16_t* Raw = Vt;
    float gi = 0.f, gf = 0.f;
    if (tid < 128) { gi = GT[(tok0 + tid) * 8 + h]; gf = GT[(tok0 + tid) * 8 + 4 + h]; }
    u32x4 rawv[9];
#pragma unroll
    for (int i = 0; i < 9; ++i) {
        const int q = tid + 512 * i, row = (q >> 5) < 131 ? (q >> 5) : 130, ch = q & 31;
        const int back = (c * 128 + row - 3 >= 0) ? 3 - row : 0;
        rawv[i] = *(const u32x4*)(PB + (size_t)((long)tok0 - back) * fp::NIN + (ch < 16 ? fp::PB_MQ + h * 128 + ch * 8 : fp::PB_MK + h * 128 + (ch - 16) * 8));
    }
    u32x4 vreg[8];
#pragma unroll
    for (int i = 0; i < 8; ++i) { const int q = tid + 512 * i; vreg[i] = *(const u32x4*)(PB + (tok0 + (q >> 5)) * fp::NIN + fp::PB_MV + h * 256 + (q & 31) * 8); }
#pragma unroll
    for (int i = 0; i < 9; ++i) {
        const int q = tid + 512 * i, row = q >> 5, ch = q & 31;
        if (row < 131) *(LAS u32x4*)(Raw + row * 256 + ch * 8) = (c * 128 + row - 3 >= 0) ? rawv[i] : (u32x4){0u, 0u, 0u, 0u};
    }
    float li = 0.f, lf = 0.f;
    if (tid < 128) { li = softcap_f(gi); lf = logsigmoid_f(softcap_f(gf)); }
    float cum = lf;
#pragma unroll
    for (int o = 1; o < 64; o <<= 1) { const float t = __shfl_up(cum, o); if (f_lane >= o) cum += t; }
    if (tid == 63) gl[384] = cum;
    __syncthreads();
    if (tid >= 64 && tid < 128) cum += gl[384];
    if (tid == 127) gl[385] = cum;
    __syncthreads();
    const float g = gl[385];
    const float av = (tid < 128) ? (g - cum + li) : -INFINITY;
    const float wm = wave_max_f(av);
    if (f_lane == 0 && f_wave < 2) gl[386 + f_wave] = wm;
    __syncthreads();
    const float mloc = fmaxf(gl[386], gl[387]);
    if (tid < 128) {
        gl[256 + tid] = expf(av - mloc);
        ((float*)(ws + wsf::BCUM))[(size_t)bh * S + c * 128 + tid] = cum;
        ((float*)(ws + wsf::LOGI))[(size_t)bh * S + c * 128 + tid] = li;
    }
    if (tid == 0) { ((float*)(ws + wsf::GSUM))[u] = g; ((float*)(ws + wsf::MLOC))[u] = mloc; }
    __syncthreads();
#pragma unroll 2
    for (int i = 0; i < 8; ++i) {
        const int q = tid + 512 * i, row = q >> 5, ch = q & 31, isK = ch >= 16, cc = (ch & 15) * 8;
        const int cwcol = (isK ? 512 : 0) + h * 128 + cc;
        float acc[8];
#pragma unroll
        for (int e = 0; e < 8; ++e) acc[e] = 0.f;
#pragma unroll
        for (int j = 0; j < 4; ++j) {
            const u32x4 xv = *(const LAS u32x4*)(Raw + (row + j) * 256 + ch * 8);
            float xf[8]; unpack8(xv, xf);
            const f32x4 w0 = *(const f32x4*)(a.conv_qk + j * 1024 + cwcol), w1 = *(const f32x4*)(a.conv_qk + j * 1024 + cwcol + 4);
            acc[0] += w0.x * xf[0]; acc[1] += w0.y * xf[1]; acc[2] += w0.z * xf[2]; acc[3] += w0.w * xf[3];
            acc[4] += w1.x * xf[4]; acc[5] += w1.y * xf[5]; acc[6] += w1.z * xf[6]; acc[7] += w1.w * xf[7];
        }
        const float sc = isK ? 0.08838834764831845f : 1.f;
#pragma unroll
        for (int e = 0; e < 8; ++e) acc[e] = silu_f(acc[e]) * sc;
        const u32x4 o = (u32x4){pk2(acc[0], acc[1]), pk2(acc[2], acc[3]), pk2(acc[4], acc[5]), pk2(acc[6], acc[7])};
        bf16_t* dst = (bf16_t*)(ws + (isK ? wsf::KC : wsf::QC)) + (tok0 + row) * 512 + h * 128 + cc;
        *(u32x4*)dst = o;
        if (isK) {
            const float wr = gl[256 + row];
            *(LAS u32x4*)(Kw + row * 136 + cc) = (u32x4){pk2(acc[0] * wr, acc[1] * wr), pk2(acc[2] * wr, acc[3] * wr), pk2(acc[4] * wr, acc[5] * wr), pk2(acc[6] * wr, acc[7] * wr)};
        }
    }
    __syncthreads();
#pragma unroll
    for (int i = 0; i < 8; ++i) { const int q = tid + 512 * i; *(LAS u32x4*)(Vt + (q >> 5) * 272 + (q & 31) * 8) = vreg[i]; }
    __syncthreads();
    const int c16 = f_lane & 15, grp = f_lane >> 4, w = f_wave;
    f32x4 acc[8][2];
#pragma unroll
    for (int d = 0; d < 8; ++d) { acc[d][0] = (f32x4){0.f, 0.f, 0.f, 0.f}; acc[d][1] = acc[d][0]; }
#pragma unroll
    for (int ks = 0; ks < 4; ++ks) {
        bf16x8 bfr[2];
#pragma unroll
        for (int i = 0; i < 2; ++i) bfr[i] = tr_frag(Vt + (32 * ks) * 272 + 16 * (2 * w + i), 272, f_lane);
#pragma unroll
        for (int d = 0; d < 8; ++d) {
            const bf16x8 af = tr_frag(Kw + (32 * ks) * 136 + 16 * d, 136, f_lane);
            acc[d][0] = mfma16(af, bfr[0], acc[d][0]); acc[d][1] = mfma16(af, bfr[1], acc[d][1]);
        }
    }
    bf16_t* dct = (bf16_t*)(ws + wsf::DCT) + (size_t)u * 256 * 128;
#pragma unroll
    for (int d = 0; d < 8; ++d)
#pragma unroll
        for (int i = 0; i < 2; ++i) *(u32x2*)(dct + (size_t)(16 * (2 * w + i) + c16) * 128 + 16 * d + 4 * grp) = (u32x2){pk2(acc[d][i][0], acc[d][i][1]), pk2(acc[d][i][2], acc[d][i][3])};
    if (tid < 128) {
        float s = 0.f;
#pragma unroll 16
        for (int r = 0; r < 128; ++r) s += bf2f(Kw[r * 136 + tid]);
        ((float*)(ws + wsf::DN))[(size_t)u * 128 + tid] = s;
    }
    __syncthreads();
}

__device__ __forceinline__ void phase3(const MkArgs& a, Frame& F) {
    const int f_tid = fresh_tid(F), f_lane = f_tid & 63, f_wave = F.wave;
    for (int u = F.bid; u < NB * HKV * (S / 128); u += F.G) attn_unit(a, F, u);
    for (int u = F.bid; u < NB * MH * NC; u += F.G) m1_unit(a, F, u);
}

__device__ __forceinline__ void phase4(const MkArgs& a, Frame& F) {
    ada_gemv(a, F, 4096 / 32, MODW / 32);
    __syncthreads();
    const int f_tid = fresh_tid(F), f_lane = f_tid & 63, f_wave = F.wave;
    unsigned char* ws = a.ws;
    LAS float* dec = (LAS float*)F.lds;
    LAS float* scl = dec + 512;
    LAS float* gl = scl + 512;
    gl[f_tid] = ((const float*)(ws + wsf::GSUM))[f_tid]; gl[512 + f_tid] = ((const float*)(ws + wsf::MLOC))[f_tid];
    __syncthreads();
    if (f_tid < 8) {
        const int bh = f_tid; float m = 0.f;
        for (int c = 0; c < NC; ++c) {
            const float g = gl[bh * NC + c], ml = gl[512 + bh * NC + c];
            if (F.bid == 0) ((float*)(ws + wsf::MPREV))[bh * NC + c] = m;
            const float mn = fmaxf(g + m, ml);
            dec[bh * 64 + c] = expf(g + m - mn); scl[bh * 64 + c] = expf(ml - mn); m = mn;
        }
    }
    __syncthreads();
    const int gt = F.vcu * fp::NT + f_tid, NGT = F.G * fp::NT;
    for (int it = gt; it < 8 * 16384; it += NGT) {
        const int bh = it >> 14, idx = it & 16383;
        const bf16_t* dct = (const bf16_t*)(ws + wsf::DCT) + (size_t)bh * 64 * 32768 + (size_t)idx * 2;
        bf16_t* cpt = (bf16_t*)(ws + wsf::CPT) + (size_t)bh * 64 * 32768 + (size_t)idx * 2;
        float C0 = 0.f, C1 = 0.f;
#pragma unroll 8
        for (int c = 0; c < NC; ++c) {
            const unsigned d = *(const unsigned*)(dct + (size_t)c * 32768);
            *(unsigned*)(cpt + (size_t)c * 32768) = pk2(C0, C1);
            const float de = dec[bh * 64 + c], sc = scl[bh * 64 + c];
            C0 = de * C0 + sc * bflo(d); C1 = de * C1 + sc * bfhi(d);
        }
    }
    for (int it = gt; it < 8 * 128; it += NGT) {
        const int bh = it >> 7, dk = it & 127; float nv = 0.f;
        const float* dnp = (const float*)(ws + wsf::DN) + (size_t)bh * NC * 128 + dk;
        float* npp = (float*)(ws + wsf::NPREV) + (size_t)bh * NC * 128 + dk;
#pragma unroll
        for (int h = 0; h < 2; ++h) {
            float d[32];
#pragma unroll
            for (int c = 0; c < 32; ++c) d[c] = dnp[(size_t)(32 * h + c) * 128];
#pragma unroll
            for (int c = 0; c < 32; ++c) { npp[(size_t)(32 * h + c) * 128] = nv; nv = dec[bh * 64 + 32 * h + c] * nv + scl[bh * 64 + 32 * h + c] * d[c]; }
        }
    }
}

__device__ __forceinline__ void m3_unit(const MkArgs& a, Frame& F, int u) {
    const int f_tid = fresh_tid(F), f_lane = f_tid & 63, f_wave = F.wave;
    const int bh = u >> 6, c = u & 63, b = bh >> 2, h = bh & 3;
    const size_t tok0 = (size_t)b * S + (size_t)c * 128;
    unsigned char* ws = a.ws;
    const bf16_t* PB = (const bf16_t*)(ws + wsf::PROJB);
    const bf16_t* QCp = (const bf16_t*)(ws + wsf::QC);
    const bf16_t* KCp = (const bf16_t*)(ws + wsf::KC);
    LAS bf16_t* KP = (LAS bf16_t*)F.lds;
    LAS bf16_t* Vt = (LAS bf16_t*)(F.lds + 34816);
    LAS float* fl = (LAS float*)(F.lds + 104448);
    LAS float* f_us = fl, *f_M = fl + 128, *f_iw = fl + 256, *f_rd = fl + 384, *f_qn = fl + 512, *f_np = fl + 640, *f_en = fl + 768, *f_ssq = fl + 1024, *f_misc = fl + 896;
    const int tid = f_tid;
#pragma unroll
    for (int i = 0; i < 4; ++i) { const int q = tid + 512 * i, row = q >> 4, ch = q & 15;
        *(LAS u32x4*)(KP + row * 136 + ch * 8) = *(const u32x4*)(KCp + (tok0 + row) * 512 + h * 128 + ch * 8); }
    stage_vt(PB, tok0, fp::PB_MV + h * 256, Vt, tid);
    const float mp = ((const float*)(ws + wsf::MPREV))[u];
    float bt = 0.f, us = -INFINITY;
    if (tid < 128) { bt = ((const float*)(ws + wsf::BCUM))[(size_t)bh * S + c * 128 + tid]; us = ((const float*)(ws + wsf::LOGI))[(size_t)bh * S + c * 128 + tid] - bt;
        f_np[tid] = ((const float*)(ws + wsf::NPREV))[(size_t)u * 128 + tid]; }
    float pm = us;
#pragma unroll
    for (int o = 1; o < 64; o <<= 1) { const float t = __shfl_up(pm, o); if (f_lane >= o) pm = fmaxf(pm, t); }
    if (tid == 63) f_misc[0] = pm;
    __syncthreads();
    if (tid >= 64 && tid < 128) pm = fmaxf(pm, f_misc[0]);
    if (tid < 128) {
        const float Mt = fmaxf(mp, pm);
        f_us[tid] = us; f_M[tid] = Mt; f_iw[tid] = expf(mp - Mt); f_en[tid] = expf(-(bt + Mt));
    }
    {
        const int row = tid >> 2, qt = tid & 3;
        u32x4 qv[4];
#pragma unroll
        for (int j = 0; j < 4; ++j) qv[j] = *(const u32x4*)(QCp + (tok0 + row) * 512 + h * 128 + (4 * qt + j) * 8);
        float s = 0.f;
#pragma unroll
        for (int j = 0; j < 4; ++j) { float qf[8]; unpack8(qv[j], qf);
#pragma unroll
            for (int e = 0; e < 8; ++e) s += qf[e] * f_np[(4 * qt + j) * 8 + e]; }
        s += __shfl_xor(s, 1); s += __shfl_xor(s, 2);
        if (qt == 0) f_qn[row] = s;
    }
    __syncthreads();
    const int c16 = f_lane & 15, grp = f_lane >> 4, w = f_wave;
    u32x2 pp[8]; float rs = 0.f;
    {
        bf16x8 qf[4];
#pragma unroll
        for (int ks = 0; ks < 4; ++ks) qf[ks] = *(const bf16x8*)(QCp + (tok0 + 16 * w + c16) * 512 + h * 128 + 32 * ks + 8 * grp);
        const float Mt = f_M[16 * w + c16];
        const int t = 16 * w + c16, tq = t - 4 * grp;
        const LAS float* usb = f_us + 4 * grp;
#pragma unroll
        for (int st = 0; st < 8; ++st) {
            pp[st] = (u32x2){0u, 0u};
            if (st <= w) {
                f32x4 acc = (f32x4){0.f, 0.f, 0.f, 0.f};
#pragma unroll
                for (int ks = 0; ks < 4; ++ks) { const bf16x8 kf = *(const LAS bf16x8*)(KP + (16 * st + c16) * 136 + 32 * ks + 8 * grp); acc = mfma16(kf, qf[ks], acc); }
                float p[4];
                const f32x4 u4 = *(const LAS f32x4*)(usb + 16 * st);
#pragma unroll
                for (int r = 0; r < 4; ++r) { p[r] = (16 * st + r <= tq) ? acc[r] * expf(u4[r] - Mt) : 0.f; rs += p[r]; }
                pp[st] = (u32x2){pk2(p[0], p[1]), pk2(p[2], p[3])};
            }
        }
        rs += __shfl_xor(rs, 16); rs += __shfl_xor(rs, 32);
        if (grp == 0) { const float den = rs + f_iw[t] * f_qn[t]; f_rd[t] = 1.f / fmaxf(fabsf(den), f_en[t]); }
    }
    __syncthreads();
#pragma unroll
    for (int st = 0; st < 8; ++st) *(LAS u32x2*)(KP + (16 * w + c16) * 136 + 16 * st + 4 * grp) = pp[st];
    __syncthreads();
    bf16x8 vf[2][4], cf[2][4];
    const bf16_t* cpt = (const bf16_t*)(ws + wsf::CPT) + (size_t)u * 256 * 128;
#pragma unroll
    for (int i = 0; i < 2; ++i)
#pragma unroll
        for (int ks = 0; ks < 4; ++ks) {
            vf[i][ks] = tr_frag(Vt + (32 * ks) * 272 + 16 * (2 * w + i), 272, f_lane);
            cf[i][ks] = *(const bf16x8*)(cpt + (size_t)(16 * (2 * w + i) + c16) * 128 + 32 * ks + 8 * grp);
        }
    bf16_t* HMp = (bf16_t*)(ws + wsf::HM);
    bf16x8 qnx[4];
#pragma unroll
    for (int ks = 0; ks < 4; ++ks) qnx[ks] = *(const bf16x8*)(QCp + (tok0 + c16) * 512 + h * 128 + 32 * ks + 8 * grp);
#pragma unroll 1
    for (int tt = 0; tt < 8; ++tt) {
        bf16x8 pf[4], qf[4];
        const int tn = tt < 7 ? tt + 1 : 7;
#pragma unroll
        for (int ks = 0; ks < 4; ++ks) { pf[ks] = *(const LAS bf16x8*)(KP + (16 * tt + c16) * 136 + 32 * ks + 8 * grp);
            qf[ks] = qnx[ks]; qnx[ks] = *(const bf16x8*)(QCp + (tok0 + 16 * tn + c16) * 512 + h * 128 + 32 * ks + 8 * grp); }
        const int t = 16 * tt + c16; const float iw = f_iw[t], rd = f_rd[t];
        float ss = 0.f;
#pragma unroll
        for (int i = 0; i < 2; ++i) {
            f32x4 a1 = (f32x4){0.f, 0.f, 0.f, 0.f}, a2 = a1;
#pragma unroll
            for (int ks = 0; ks < 4; ++ks) { a1 = mfma16(vf[i][ks], pf[ks], a1); a2 = mfma16(cf[i][ks], qf[ks], a2); }
            const f32x4 hv = (a1 + a2 * iw) * rd;
            ss += (hv[0] * hv[0] + hv[1] * hv[1]) + (hv[2] * hv[2] + hv[3] * hv[3]);
            *(u32x2*)(HMp + (tok0 + t) * 1024 + h * 256 + 16 * (2 * w + i) + 4 * grp) = (u32x2){pk2(hv[0], hv[1]), pk2(hv[2], hv[3])};
        }
        ss += __shfl_xor(ss, 16); ss += __shfl_xor(ss, 32);
        if (grp == 0) f_ssq[t * 8 + w] = ss;
    }
    u32x2 mon[2];
#pragma unroll
    for (int i = 0; i < 2; ++i) mon[i] = *(const u32x2*)(PB + (tok0 + c16) * fp::NIN + fp::PB_MO + h * 256 + 16 * (2 * w + i) + 4 * grp);
    f32x4 g4v[2]; u32x2 hn[2];
#pragma unroll
    for (int i = 0; i < 2; ++i) { g4v[i] = *(const f32x4*)(a.g_mlstm + h * 256 + 16 * (2 * w + i) + 4 * grp); hn[i] = *(const u32x2*)(HMp + (tok0 + c16) * 1024 + h * 256 + 16 * (2 * w + i) + 4 * grp); }
    __syncthreads();
#pragma unroll 1
    for (int tt = 0; tt < 8; ++tt) {
        const int t = 16 * tt + c16, tn2 = 16 * (tt < 7 ? tt + 1 : 7) + c16;
        u32x2 moc[2], hc[2];
#pragma unroll
        for (int i = 0; i < 2; ++i) { moc[i] = mon[i]; mon[i] = *(const u32x2*)(PB + (tok0 + tn2) * fp::NIN + fp::PB_MO + h * 256 + 16 * (2 * w + i) + 4 * grp);
            hc[i] = hn[i]; hn[i] = *(const u32x2*)(HMp + (tok0 + tn2) * 1024 + h * 256 + 16 * (2 * w + i) + 4 * grp); }
        const f32x4 s0 = *(const LAS f32x4*)(f_ssq + t * 8), s1 = *(const LAS f32x4*)(f_ssq + t * 8 + 4);
        const float rn = rsqrtf(((s0.x + s0.y) + (s0.z + s0.w) + (s1.x + s1.y) + (s1.z + s1.w)) * (1.f / 256.f) + EPS);
#pragma unroll
        for (int i = 0; i < 2; ++i) {
            const int dv0 = 16 * (2 * w + i) + 4 * grp;
            const f32x4 g4 = g4v[i];
            const u32x2 mo = moc[i];
            u32x2* hp = (u32x2*)(HMp + (tok0 + t) * 1024 + h * 256 + dv0);
            const u32x2 hr = hc[i];
            const float o0 = bflo(hr.x) * rn * g4.x * bflo(mo.x), o1 = bfhi(hr.x) * rn * g4.y * bfhi(mo.x);
            const float o2 = bflo(hr.y) * rn * g4.z * bflo(mo.y), o3 = bfhi(hr.y) * rn * g4.w * bfhi(mo.y);
            *hp = (u32x2){pk2(o0, o1), pk2(o2, o3)};
        }
    }
    __syncthreads();
}
__device__ __forceinline__ void phase5(const MkArgs& a, Frame& F) {
    const int f_tid = fresh_tid(F), f_lane = f_tid & 63, f_wave = F.wave;
    for (int u = F.bid; u < NB * MH * NC; u += F.G) m3_unit(a, F, u);
}
struct ProjSched {
    typedef DenseUnit UnitT;
    const bf16_t* A0; const bf16_t* A1; const bf16_t* B0; const bf16_t* B1; int K; int nM, nN, G, c, wave; int ntf, nt_total; unsigned a_jump, b_jump;
    __device__ __forceinline__ bool next(int i, DenseUnit& u) const { return pg8::static_tile(i * G + c, nM, nN, u.pm, u.pn); }
    __device__ __forceinline__ const void* a_buf() const { return A0; }
    __device__ __forceinline__ const void* b_buf() const { return B0; }
    __device__ __forceinline__ unsigned a_soff(const DenseUnit& u) const { return (unsigned)u.pm * 256u * 1024u * 2u; }
    __device__ __forceinline__ unsigned b_soff(const DenseUnit& u) const { return (unsigned)u.pn * 256u * 1024u * 2u; }
    __device__ __forceinline__ void a_offs(const DenseUnit&, int R0, int R1, int C0, int C1, unsigned (&o)[4]) const {
        o[0] = (unsigned)(R0 * 1024 + C0) * 2u; o[1] = (unsigned)(R1 * 1024 + C1) * 2u; o[2] = (unsigned)((R0 + 128) * 1024 + C0) * 2u; o[3] = (unsigned)((R1 + 128) * 1024 + C1) * 2u;
    }
};
struct EpiMerge {
    bf16_t* MG; const bf16_t* PB; bool skip;
    static constexpr float GMIN = 9.5367431640625e-07f;
    __device__ __forceinline__ void mid(f32x4 (&acc)[2][2][4][2], const DenseUnit& u, int wr, int wc, int fr, int fq) const {
        const int row0 = u.pm * 256 + wr * 64 + fr, col0 = u.pn * 256 + wc * 32 + 8 * fq;
#pragma unroll
        for (int ai = 0; ai < 2; ++ai)
#pragma unroll
            for (int mh = 0; mh < 2; ++mh) {
                u32x4 ga[2][2], gm[2][2];
#pragma unroll
                for (int m2 = 0; m2 < 2; ++m2)
#pragma unroll
                    for (int bj = 0; bj < 2; ++bj) { const size_t row = (size_t)(row0 + ai * 128 + (2 * mh + m2) * 16);
                        ga[m2][bj] = *(const u32x4*)(PB + row * fp::NIN + fp::PB_GA + col0 + bj * 128); gm[m2][bj] = *(const u32x4*)(PB + row * fp::NIN + fp::PB_GM + col0 + bj * 128); }
#pragma unroll
                for (int m2 = 0; m2 < 2; ++m2)
#pragma unroll
                    for (int bj = 0; bj < 2; ++bj) { const int m = 2 * mh + m2; float a[8], g[8]; unpack8(ga[m2][bj], a); unpack8(gm[m2][bj], g);
#pragma unroll
                        for (int e = 0; e < 8; ++e) a[e] = fast_sigmoid(a[e]) * __builtin_amdgcn_rcpf(fmaxf(fast_sigmoid(g[e]), GMIN));
                        acc[ai][bj][m][0] *= (f32x4){a[0], a[1], a[2], a[3]}; acc[ai][bj][m][1] *= (f32x4){a[4], a[5], a[6], a[7]}; }
            }
    }
    __device__ __forceinline__ void operator()(const f32x4 (&acc)[2][2][4][2], const DenseUnit& u, int wr, int wc, int fr, int fq) const {
        if (skip) {
#pragma unroll
            for (int ai = 0; ai < 2; ++ai)
#pragma unroll
                for (int bj = 0; bj < 2; ++bj)
#pragma unroll
                    for (int m = 0; m < 4; ++m)
#pragma unroll
                        for (int n = 0; n < 2; ++n) asm volatile("" :: "v"(acc[ai][bj][m][n]));
            return;
        }
        const int row0 = u.pm * 256 + wr * 64 + fr, col0 = u.pn * 256 + wc * 32 + 8 * fq;
#pragma unroll
        for (int ai = 0; ai < 2; ++ai) {
            u32x4 gm[4][2];
#pragma unroll
            for (int m = 0; m < 4; ++m)
#pragma unroll
                for (int bj = 0; bj < 2; ++bj) gm[m][bj] = *(const u32x4*)(PB + (size_t)(row0 + ai * 128 + m * 16) * fp::NIN + fp::PB_GM + col0 + bj * 128);
#pragma unroll
            for (int m = 0; m < 4; ++m)
#pragma unroll
                for (int bj = 0; bj < 2; ++bj) { const size_t row = (size_t)(row0 + ai * 128 + m * 16); float g[8]; unpack8(gm[m][bj], g);
#pragma unroll
                    for (int e = 0; e < 8; ++e) g[e] = fmaxf(fast_sigmoid(g[e]), GMIN);
                    const f32x4 v0 = acc[ai][bj][m][0], v1 = acc[ai][bj][m][1];
                    *(u32x4*)(MG + row * 2048 + col0 + bj * 128) = (u32x4){pg8::cvt_pk_bf16(g[0] * v0[0], g[1] * v0[1]), pg8::cvt_pk_bf16(g[2] * v0[2], g[3] * v0[3]),
                                                                         pg8::cvt_pk_bf16(g[4] * v1[0], g[5] * v1[1]), pg8::cvt_pk_bf16(g[6] * v1[2], g[7] * v1[3])}; }
        }
    }
};
__device__ __forceinline__ void phase6(const MkArgs& a, Frame& F, bool skip_epi = false) {
    const int f_tid = fresh_tid(F), f_lane = f_tid & 63, f_wave = F.wave;
    unsigned char* ws = a.ws;
    ProjSched S{(const bf16_t*)(ws + wsf::OAT), (const bf16_t*)(ws + wsf::HM), (const bf16_t*)(ws + wsf::WAP_T), (const bf16_t*)(ws + wsf::WMP_T), 1024, NTOK / 256, 2048 / 256, F.G, F.bid, F.wave, 16, 32,
                (unsigned)(wsf::HM - wsf::OAT) - 16u * 128u, (unsigned)(wsf::WMP_T - wsf::WAP_T) - 16u * 128u};
    EpiMerge E{(bf16_t*)(ws + wsf::MG), (const bf16_t*)(ws + wsf::PROJB), skip_epi};
    pg8::gemm_phase<EpiMerge, ProjSched, false, 0, true>(F.lds, S, E);
}
struct EpiPlain {
    bf16_t* O; int ldc;
    __device__ __forceinline__ void operator()(const f32x4 (&acc)[2][2][4][2], const DenseUnit& u, int wr, int wc, int fr, int fq) const {
        const int row0 = u.pm * 256 + wr * 64 + fr, col0 = u.pn * 256 + wc * 32 + 8 * fq;
#pragma unroll
        for (int ai = 0; ai < 2; ++ai)
#pragma unroll
            for (int m = 0; m < 4; ++m)
#pragma unroll
                for (int bj = 0; bj < 2; ++bj) {
                    const f32x4 v0 = acc[ai][bj][m][0], v1 = acc[ai][bj][m][1];
                    *(u32x4*)(O + (size_t)(row0 + ai * 128 + m * 16) * ldc + col0 + bj * 128) =
                        (u32x4){pg8::cvt_pk_bf16(v0[0], v0[1]), pg8::cvt_pk_bf16(v0[2], v0[3]), pg8::cvt_pk_bf16(v1[0], v1[1]), pg8::cvt_pk_bf16(v1[2], v1[3])};
                }
    }
};
__device__ __forceinline__ void phase7(const MkArgs& a, Frame& F) {
    const int f_tid = fresh_tid(F), f_lane = f_tid & 63, f_wave = F.wave;
    unsigned char* ws = a.ws;
    DenseSched S{(const bf16_t*)(ws + wsf::MG), (const bf16_t*)(ws + wsf::WOUT_T), 2048, 2048, NTOK / 256, 2048 / 256, F.G, F.bid, F.wave};
    EpiPlain E{(bf16_t*)(ws + wsf::Y), 2048};
    pg8::gemm_phase<EpiPlain, DenseSched>(F.lds, S, E);
}

__device__ __forceinline__ void phase8(const MkArgs& a, Frame& F) {
    const int f_tid = fresh_tid(F), f_lane = f_tid & 63, f_wave = F.wave;
    unsigned char* ws = a.ws;
    LAS float* t_gt1 = (LAS float*)F.lds, *t_gpo = t_gt1 + 2048, *t_gpr = t_gt1 + 4096, *t_sc2 = t_gt1 + 6144, *t_sh2 = t_gt1 + 8192;
    LAS float* lgp = (LAS float*)(F.lds + 40960);
    LAS int* cntl = (LAS int*)(F.lds + 57344);
    LAS int* basel = cntl + 32;
    LAS int* esel = cntl + 64;
    LAS int* eslot = cntl + 320;
    LAS float* wsel = (LAS float*)(cntl + 576);
    LAS float* r2l = (LAS float*)(cntl + 832);
    const float* mod = (const float*)(ws + wsf::MOD);
    const bf16_t* Yp = (const bf16_t*)(ws + wsf::Y);
    bf16_t* H2p = (bf16_t*)(ws + wsf::H2);
    bf16_t* X1p = (bf16_t*)(ws + wsf::X1);
    const bf16_t* WR = (const bf16_t*)(ws + wsf::WRT);
    int* cntg = (int*)(ws + wsf::CTL) + wsf::CW_CNT;
    const int tid = f_tid, lane = f_lane, w = f_wave;
    for (int blk = F.vcu; blk < NTOK / 64; blk += F.G) {
        const int b = (blk * 64) / S;
        for (int i = tid; i < 2048; i += fp::NT) {
            t_gt1[i] = mod[b * MODW + MOD_GT1 + i]; t_gpo[i] = a.g_post_mix[i]; t_gpr[i] = a.g_pre_ffn[i] * (1.f + mod[b * MODW + MOD_SC2 + i]);
            t_sh2[i] = mod[b * MODW + MOD_SH2 + i];
        }
        if (tid < 32) cntl[tid] = 0;
        __syncthreads();
        u32x4 ypn[4]; f32x4 xqn[4][2];
        { const size_t row = (size_t)blk * 64 + w * 8;
#pragma unroll
          for (int j = 0; j < 4; ++j) ypn[j] = *(const u32x4*)(Yp + row * 2048 + 8 * (64 * j + lane));
#pragma unroll
          for (int j = 0; j < 4; ++j) { xqn[j][0] = *(const f32x4*)(a.x + row * D + 8 * (64 * j + lane)); xqn[j][1] = *(const f32x4*)(a.x + row * D + 8 * (64 * j + lane) + 4); } }
#pragma unroll
        for (int rr = 0; rr < 8; ++rr) {
            const size_t row = (size_t)blk * 64 + w * 8 + rr, rown = row + 1;
            u32x4 yp[4]; f32x4 xq[4][2]; float ss = 0.f;
#pragma unroll
            for (int j = 0; j < 4; ++j) { yp[j] = ypn[j]; if (rr < 7) ypn[j] = *(const u32x4*)(Yp + rown * 2048 + 8 * (64 * j + lane)); }
#pragma unroll
            for (int j = 0; j < 4; ++j) { xq[j][0] = xqn[j][0]; xq[j][1] = xqn[j][1]; if (rr < 7) { xqn[j][0] = *(const f32x4*)(a.x + rown * D + 8 * (64 * j + lane)); xqn[j][1] = *(const f32x4*)(a.x + rown * D + 8 * (64 * j + lane) + 4); } }
#pragma unroll
            for (int j = 0; j < 4; ++j) { float f[8]; unpack8(yp[j], f);
#pragma unroll
                for (int e = 0; e < 8; ++e) ss += f[e] * f[e]; }
            const float r1 = rsqrtf(wave_sum_f(ss) * (1.f / D) + EPS);
            ss = 0.f;
            u32x4 x1p[4];
#pragma unroll
            for (int j = 0; j < 4; ++j) {
                const int c0 = 8 * (64 * j + lane);
                float f[8]; unpack8(yp[j], f);
                const f32x4 xa = xq[j][0], xb = xq[j][1];
                const float xv[8] = {xa.x, xa.y, xa.z, xa.w, xb.x, xb.y, xb.z, xb.w};
                float v[8];
#pragma unroll
                for (int e = 0; e < 8; ++e) { v[e] = xv[e] + t_gt1[c0 + e] * (f[e] * r1 * t_gpo[c0 + e]); ss += v[e] * v[e]; }
                x1p[j] = (u32x4){pg8::cvt_pk_bf16(v[0], v[1]), pg8::cvt_pk_bf16(v[2], v[3]), pg8::cvt_pk_bf16(v[4], v[5]), pg8::cvt_pk_bf16(v[6], v[7])};
                *(u32x4*)(X1p + row * D + c0) = x1p[j];
            }
            const float r2 = rsqrtf(wave_sum_f(ss) * (1.f / D) + EPS);
            if (lane == 0) r2l[w * 8 + rr] = r2;
#pragma unroll
            for (int j = 0; j < 4; ++j) {
                const int c0 = 8 * (64 * j + lane);
                float xv[8]; unpack8(x1p[j], xv);
                float hv[8];
#pragma unroll
                for (int e = 0; e < 8; ++e) hv[e] = (xv[e] * r2) * t_gpr[c0 + e] + t_sh2[c0 + e];
#if CHECK_BUILD
                *(u32x4*)(H2p + row * 2048 + c0) = (u32x4){pg8::cvt_pk_bf16(hv[0], hv[1]), pg8::cvt_pk_bf16(hv[2], hv[3]), pg8::cvt_pk_bf16(hv[4], hv[5]), pg8::cvt_pk_bf16(hv[6], hv[7])};
#endif
#if MOE_FP8
                *(u32x2*)(ws + wsf::H2F8 + row * 2048 + c0) = (u32x2){pk4_fp8(hv[0], hv[1], hv[2], hv[3]), pk4_fp8(hv[4], hv[5], hv[6], hv[7])};
#endif
            }
        }
        VM_WAIT();
        __syncthreads();
        {
            const int c16 = lane & 15, grp = lane >> 4, rt = w & 3, kh = w >> 2;
            f32x4 acc[2] = {(f32x4){0.f, 0.f, 0.f, 0.f}, (f32x4){0.f, 0.f, 0.f, 0.f}};
            int blkb = blk; asm volatile("" : "+s"(blkb));
            const bf16_t* ap = X1p + ((size_t)blkb * 64 + 16 * rt + c16) * 2048 + 8 * grp;
            const float r2r = r2l[16 * rt + c16];
#pragma unroll 4
            for (int ks = kh * 32; ks < kh * 32 + 32; ++ks) {
                const u32x4 xr = *(const u32x4*)(ap + 32 * ks);
                float xv[8]; unpack8(xr, xv);
                const LAS float* tg = t_gpr + 32 * ks + 8 * grp; const LAS float* ts = t_sh2 + 32 * ks + 8 * grp;
                const f32x4 g0 = *(const LAS f32x4*)tg, g1 = *(const LAS f32x4*)(tg + 4), s0 = *(const LAS f32x4*)ts, s1 = *(const LAS f32x4*)(ts + 4);
                const u32x4 hw = (u32x4){pg8::cvt_pk_bf16((xv[0] * r2r) * g0.x + s0.x, (xv[1] * r2r) * g0.y + s0.y), pg8::cvt_pk_bf16((xv[2] * r2r) * g0.z + s0.z, (xv[3] * r2r) * g0.w + s0.w),
                                       pg8::cvt_pk_bf16((xv[4] * r2r) * g1.x + s1.x, (xv[5] * r2r) * g1.y + s1.y), pg8::cvt_pk_bf16((xv[6] * r2r) * g1.z + s1.z, (xv[7] * r2r) * g1.w + s1.w)};
                const bf16x8 af = __builtin_bit_cast(bf16x8, hw);
#pragma unroll
                for (int et = 0; et < 2; ++et) {
                    const bf16x8 bh = *(const bf16x8*)(WR + (size_t)(16 * et + c16) * 2048 + 32 * ks + 8 * grp);
                    const bf16x8 bl = *(const bf16x8*)(WR + (size_t)32 * 2048 + (size_t)(16 * et + c16) * 2048 + 32 * ks + 8 * grp);
                    acc[et] = mfma16(af, bh, acc[et]); acc[et] = mfma16(af, bl, acc[et]);
                }
            }
#pragma unroll
            for (int et = 0; et < 2; ++et)
#pragma unroll
                for (int r = 0; r < 4; ++r) lgp[kh * 2048 + (16 * rt + 4 * grp + r) * 32 + 16 * et + c16] = acc[et][r];
        }
        __syncthreads();
        int blkc = blk; asm volatile("" : "+s"(blkc));
        if (tid < 64) {
            const size_t tok = (size_t)blkc * 64 + tid;
            float lgv[32];
#pragma unroll
            for (int e = 0; e < 32; ++e) lgv[e] = lgp[tid * 32 + e] + lgp[2048 + tid * 32 + e] + a.b_router[e];
            int idx[4]; float val[4];
            unsigned used = 0u;
#pragma unroll
            for (int k = 0; k < 4; ++k) {
                float best = -INFINITY; int bi = 0;
#pragma unroll
                for (int e = 0; e < 32; ++e) { const bool c = !((used >> e) & 1u) && lgv[e] > best; best = c ? lgv[e] : best; bi = c ? e : bi; }
                used |= 1u << bi; idx[k] = bi; val[k] = best;
            }
            float ex[4], sum = 0.f;
#pragma unroll
            for (int k = 0; k < 4; ++k) { ex[k] = expf(val[k] - val[0]); sum += ex[k]; }
#pragma unroll
            for (int k = 0; k < 4; ++k) {
                ((int*)(ws + wsf::TOPI))[tok * 4 + k] = idx[k]; ((float*)(ws + wsf::TOPW))[tok * 4 + k] = ex[k] / sum;
                const int e = a.route_i ? a.route_i[tok * 4 + k] : idx[k];
                esel[tid * 4 + k] = e;
                wsel[tid * 4 + k] = a.route_w ? a.route_w[tok * 4 + k] : ex[k] / sum;
                eslot[tid * 4 + k] = __hip_atomic_fetch_add(cntl + e, 1, __ATOMIC_RELAXED, __HIP_MEMORY_SCOPE_WORKGROUP);
            }
        }
        __syncthreads();
        if (tid < 32) { const int n = cntl[tid]; basel[tid] = n > 0 ? __hip_atomic_fetch_add(cntg + tid, n, __ATOMIC_RELAXED, __HIP_MEMORY_SCOPE_AGENT) : 0; }
        __syncthreads();
        if (tid < 256) { const int e = esel[tid]; const size_t li = (size_t)e * NPAIR + basel[e] + eslot[tid]; ((int*)(ws + wsf::LIST))[li] = (blkc * 64 + (tid >> 2)) * 4 + (tid & 3); ((float*)(ws + wsf::LISTW))[li] = wsel[tid]; }
        __syncthreads();
    }
}

struct MoeUnit { int e, m0, pn, rows, cb; };
struct MoeSched {
    typedef MoeUnit UnitT;
    const bf16_t* A; int a_shift; const bf16_t* Wt; size_t wstride; int K; int nN;
    const int* list; const LAS int* tstart; const LAS int* cnt; int nM; int G, c, wave; int compact; int wgm;
    __device__ __forceinline__ bool next(int i, MoeUnit& u) const {
        const int nwg = nM * nN, L = i * G + c; if (L >= nwg) return false;
        int wgid = L; { const int q = nwg / 8, r = nwg % 8, xcd = wgid % 8, off = wgid / 8; wgid = (xcd < r ? xcd * (q + 1) : r * (q + 1) + (xcd - r) * q) + off; }
        const int WG = wgm;
        const int nig = WG * nN, gid = wgid / nig, fm = gid * WG, gsz = (nM - fm) < WG ? (nM - fm) : WG;
        const int mt = fm + ((wgid % nig) % gsz); u.pn = (wgid % nig) / gsz;
        int e = 0;
        for (int k = 1; k < NE; ++k) e += (__builtin_amdgcn_readfirstlane(tstart[k]) <= mt) ? 1 : 0;
        u.e = e; u.m0 = (mt - __builtin_amdgcn_readfirstlane(tstart[e])) * 256; const int left = __builtin_amdgcn_readfirstlane(cnt[e]) - u.m0; u.rows = left < 256 ? left : 256;
        u.cb = __builtin_amdgcn_readfirstlane(tstart[33 + e]) + u.m0;
        return true;
    }
    __device__ __forceinline__ const void* a_buf() const { return A; }
    __device__ __forceinline__ const void* b_buf() const { return Wt; }
    __device__ __forceinline__ unsigned a_soff(const MoeUnit&) const { return 0u; }
    __device__ __forceinline__ unsigned b_soff(const MoeUnit& u) const { return ((unsigned)u.e * (unsigned)wstride + (unsigned)u.pn * 256u * (unsigned)K) * 2u; }
    __device__ __forceinline__ unsigned rowoff(const MoeUnit& u, int r, int C) const {
        const int rc = r < u.rows ? r : u.rows - 1;
        const int id = compact ? u.cb + rc : (list[(size_t)u.e * NPAIR + u.m0 + rc] >> a_shift);
        return ((unsigned)id * (unsigned)K + (unsigned)C) * 2u;
    }
    __device__ __forceinline__ void a_offs(const MoeUnit& u, int R0, int R1, int C0, int C1, unsigned (&o)[4]) const {
        o[0] = rowoff(u, R0, C0); o[1] = rowoff(u, R1, C1); o[2] = rowoff(u, R0 + 128, C0); o[3] = rowoff(u, R1 + 128, C1);
    }
};
__device__ __forceinline__ void moe_tables(const MkArgs& a, Frame& F, LAS int*& cnt, LAS int*& tstart) {
    const int f_tid = fresh_tid(F);
    cnt = (LAS int*)(F.lds + LDS_TAB); tstart = cnt + 32;
    const int* cntg = (const int*)(a.ws + wsf::CTL) + wsf::CW_CNT;
    if (f_tid < 32) cnt[f_tid] = __hip_atomic_load(cntg + f_tid, RLX_AGENT);
    __syncthreads();
    if (f_tid == 0) { int s = 0, cs = 0; for (int e = 0; e < NE; ++e) { tstart[e] = s; tstart[33 + e] = cs; s += (cnt[e] + 255) >> 8; cs += cnt[e]; } tstart[NE] = s; }
    __syncthreads();
}
template <bool F8> struct EpiGateUpT {
    bf16_t* ACT; const float* bias; const int* list; bool skip;
    __device__ __forceinline__ void operator()(const f32x4 (&acc)[2][2][4][2], const MoeUnit& u, int wr, int wc, int fr, int fq) const {
        if (skip) {
#pragma unroll
            for (int ai = 0; ai < 2; ++ai)
#pragma unroll
                for (int bj = 0; bj < 2; ++bj)
#pragma unroll
                    for (int m = 0; m < 4; ++m)
#pragma unroll
                        for (int n = 0; n < 2; ++n) asm volatile("" :: "v"(acc[ai][bj][m][n]));
            return;
        }
        const int col0 = u.pn * 256 + wc * 32 + 8 * fq;
        f32x4 bv[2][2];
#pragma unroll
        for (int bj = 0; bj < 2; ++bj)
#pragma unroll
            for (int n = 0; n < 2; ++n) bv[bj][n] = *(const f32x4*)(bias + (size_t)u.e * 4096 + col0 + bj * 128 + 4 * n);
        int pr[8];
#pragma unroll
        for (int q = 0; q < 8; ++q) { const int r = (q >> 2) * 128 + wr * 64 + (q & 3) * 16 + fr; pr[q] = r < u.rows ? u.cb + r : -1; }
#pragma unroll
        for (int ai = 0; ai < 2; ++ai)
#pragma unroll
            for (int m = 0; m < 4; ++m) {
                const int pair = pr[ai * 4 + m];
                if (pair >= 0) {
#pragma unroll
                    for (int bj = 0; bj < 2; ++bj) {
                        const f32x4 v0 = acc[ai][bj][m][0] * (F8 ? W8INV : 1.f) + bv[bj][0], v1 = acc[ai][bj][m][1] * (F8 ? W8INV : 1.f) + bv[bj][1];
                        const float gu[8] = {v0[0], v0[1], v0[2], v0[3], v1[0], v1[1], v1[2], v1[3]};
                        float o[4];
#pragma unroll
                        for (int j = 0; j < 4; ++j) {
                            const float glu = fminf(gu[2 * j], 7.0f), lin = fminf(fmaxf(gu[2 * j + 1], -7.0f), 7.0f);
                            o[j] = glu * fast_sigmoid(1.702f * glu) * (lin + 1.f);
                        }
                        if constexpr (F8) *(unsigned*)((unsigned char*)ACT + (size_t)pair * 2048 + (col0 + bj * 128) / 2) = pk4_fp8_nc(o[0], o[1], o[2], o[3]);
                        else *(u32x2*)(ACT + (size_t)pair * 2048 + (col0 + bj * 128) / 2) = (u32x2){pg8::cvt_pk_bf16(o[0], o[1]), pg8::cvt_pk_bf16(o[2], o[3])};
                    }
                }
            }
    }
};
template <bool F8> struct EpiDownT {
    bf16_t* YP; const float* bias; const int* list; const float* wgt;
    __device__ __forceinline__ void operator()(const f32x4 (&acc)[2][2][4][2], const MoeUnit& u, int wr, int wc, int fr, int fq) const {
        const int col0 = u.pn * 256 + wc * 32 + 8 * fq;
        f32x4 bv[2][2];
#pragma unroll
        for (int bj = 0; bj < 2; ++bj)
#pragma unroll
            for (int n = 0; n < 2; ++n) bv[bj][n] = *(const f32x4*)(bias + (size_t)u.e * 2048 + col0 + bj * 128 + 4 * n);
        int pr[8]; float wq[8];
#pragma unroll
        for (int q = 0; q < 8; ++q) { const int r = (q >> 2) * 128 + wr * 64 + (q & 3) * 16 + fr; pr[q] = list[(size_t)u.e * NPAIR + u.m0 + (r < u.rows ? r : 0)]; if (r >= u.rows) pr[q] = -1; }
#pragma unroll
        for (int q = 0; q < 8; ++q) { const int r = (q >> 2) * 128 + wr * 64 + (q & 3) * 16 + fr; wq[q] = wgt[(size_t)u.e * NPAIR + u.m0 + (r < u.rows ? r : 0)]; }
#pragma unroll
        for (int ai = 0; ai < 2; ++ai)
#pragma unroll
            for (int m = 0; m < 4; ++m) {
                const int pair = pr[ai * 4 + m];
                if (pair >= 0) {
                    const float wv = wq[ai * 4 + m];
#pragma unroll
                    for (int bj = 0; bj < 2; ++bj) {
                        const f32x4 v0 = (acc[ai][bj][m][0] * (F8 ? W8INV : 1.f) + bv[bj][0]) * wv, v1 = (acc[ai][bj][m][1] * (F8 ? W8INV : 1.f) + bv[bj][1]) * wv;
                        if constexpr (F8) *(u32x2*)((unsigned char*)YP + (size_t)pair * 2048 + col0 + bj * 128) =
                            (u32x2){pk4_fp8(v0[0] * YP8SCALE, v0[1] * YP8SCALE, v0[2] * YP8SCALE, v0[3] * YP8SCALE), pk4_fp8(v1[0] * YP8SCALE, v1[1] * YP8SCALE, v1[2] * YP8SCALE, v1[3] * YP8SCALE)};
                        else *(u32x4*)(YP + (size_t)pair * 2048 + col0 + bj * 128) =
                            (u32x4){pg8::cvt_pk_bf16(v0[0], v0[1]), pg8::cvt_pk_bf16(v0[2], v0[3]), pg8::cvt_pk_bf16(v1[0], v1[1]), pg8::cvt_pk_bf16(v1[2], v1[3])};
                    }
                }
            }
    }
};
__device__ __forceinline__ void phase9(const MkArgs& a, Frame& F, bool skip_epi = false) {
    unsigned char* ws = a.ws;
    LAS int* cnt; LAS int* tstart; moe_tables(a, F, cnt, tstart);
#if MOE_FP8
    MoeSched S{(const bf16_t*)(ws + wsf::H2F8), 2, (const bf16_t*)(ws + wsf::WGU8), (size_t)4096 * 1024, 1024, 16, (const int*)(ws + wsf::LIST), tstart, cnt, __builtin_amdgcn_readfirstlane(tstart[NE]), F.G, F.bid, F.wave, 0, 8};
    EpiGateUpT<true> E{(bf16_t*)(ws + wsf::ACT8), a.b_gate_up, (const int*)(ws + wsf::LIST), skip_epi};
    if (EPI_SKIP_PROBE >= 2 && skip_epi) pg8::gemm_phase<EpiGateUpT<true>, MoeSched, true, EPI_SKIP_PROBE - 1>(F.lds, S, E);
    else pg8::gemm_phase<EpiGateUpT<true>, MoeSched, true>(F.lds, S, E);
#else
    MoeSched S{(const bf16_t*)(ws + wsf::H2), 2, (const bf16_t*)(ws + wsf::WGU_T), (size_t)4096 * 2048, 2048, 16, (const int*)(ws + wsf::LIST), tstart, cnt, __builtin_amdgcn_readfirstlane(tstart[NE]), F.G, F.bid, F.wave, 0, 8};
    EpiGateUpT<false> E{(bf16_t*)(ws + wsf::ACT), a.b_gate_up, (const int*)(ws + wsf::LIST), skip_epi};
    pg8::gemm_phase<EpiGateUpT<false>, MoeSched, false>(F.lds, S, E);
#endif
}
__device__ __forceinline__ void phase10(const MkArgs& a, Frame& F) {
    unsigned char* ws = a.ws;
    LAS int* cnt; LAS int* tstart; moe_tables(a, F, cnt, tstart);
    const float* wgt = (const float*)(ws + wsf::LISTW);
#if MOE_FP8
    MoeSched S{(const bf16_t*)(ws + wsf::ACT8), 0, (const bf16_t*)(ws + wsf::WDN8), (size_t)2048 * 1024, 1024, 8, (const int*)(ws + wsf::LIST), tstart, cnt, __builtin_amdgcn_readfirstlane(tstart[NE]), F.G, F.bid, F.wave, 1, 16};
    EpiDownT<true> E{(bf16_t*)(ws + wsf::YP), a.b_down, (const int*)(ws + wsf::LIST), wgt};
    pg8::gemm_phase<EpiDownT<true>, MoeSched, true>(F.lds, S, E);
#else
    MoeSched S{(const bf16_t*)(ws + wsf::ACT), 0, (const bf16_t*)(ws + wsf::WDN_T), (size_t)2048 * 2048, 2048, 8, (const int*)(ws + wsf::LIST), tstart, cnt, __builtin_amdgcn_readfirstlane(tstart[NE]), F.G, F.bid, F.wave, 1, 16};
    EpiDownT<false> E{(bf16_t*)(ws + wsf::YP), a.b_down, (const int*)(ws + wsf::LIST), wgt};
    pg8::gemm_phase<EpiDownT<false>, MoeSched, false>(F.lds, S, E);
#endif
}

__device__ __forceinline__ void phase11(const MkArgs& a, Frame& F) {
    const int f_tid = fresh_tid(F), f_lane = f_tid & 63, f_wave = F.wave;
    unsigned char* ws = a.ws;
    const float* mod = (const float*)(ws + wsf::MOD);
    const bf16_t* YPp = (const bf16_t*)(ws + wsf::YP);
    const bf16_t* X1p = (const bf16_t*)(ws + wsf::X1);
    const int gw = F.vcu * fp::NW + f_wave, NGW = F.G * fp::NW, lane = f_lane;
    if (gw >= NTOK) return;
#if MOE_FP8
    u32x2 yq[16];
#else
    u32x4 yq[16];
#endif
    u32x4 xq[4];
#if MOE_FP8
#define P11_YLOAD(prow, j) (*(const u32x2*)((const unsigned char*)YPp + (prow) * 2048 + 8 * (64 * (j) + lane)))
#else
#define P11_YLOAD(prow, j) (*(const u32x4*)(YPp + (prow) * 2048 + 8 * (64 * (j) + lane)))
#endif
#define P11_LOAD(m_) do { const size_t m__ = (size_t)(m_); \
        _Pragma("unroll") for (int k = 0; k < 4; ++k) _Pragma("unroll") for (int j = 0; j < 4; ++j) yq[k * 4 + j] = P11_YLOAD((m__ * 4 + k), j); \
        _Pragma("unroll") for (int j = 0; j < 4; ++j) xq[j] = *(const u32x4*)(X1p + m__ * D + 8 * (64 * j + lane)); } while (0)
    for (int bb = 0; bb < NB; ++bb) {
        const int lo = bb * S, hi = lo + S;
        const int mstart = gw >= lo ? gw : gw + ((lo - gw + NGW - 1) / NGW) * NGW;
        if (mstart >= hi) continue;
        float gg[32];
#pragma unroll
        for (int j = 0; j < 4; ++j)
#pragma unroll
            for (int hq = 0; hq < 2; ++hq) {
                const int c0 = 8 * (64 * j + lane) + 4 * hq;
                const f32x4 gt = *(const f32x4*)(mod + bb * MODW + MOD_GT2 + c0), gp = *(const f32x4*)(a.g_post_ffn + c0);
                gg[8 * j + 4 * hq + 0] = gt.x * gp.x; gg[8 * j + 4 * hq + 1] = gt.y * gp.y; gg[8 * j + 4 * hq + 2] = gt.z * gp.z; gg[8 * j + 4 * hq + 3] = gt.w * gp.w;
            }
        P11_LOAD(mstart);
        for (int m = mstart; m < hi; m += NGW) {
            float yv[32]; u32x4 xv[4];
#pragma unroll
            for (int i = 0; i < 32; ++i) yv[i] = 0.f;
#pragma unroll
            for (int k = 0; k < 4; ++k)
#pragma unroll
                for (int j = 0; j < 4; ++j) { float f[8];
#if MOE_FP8
                    unpack8_fp8(yq[k * 4 + j], f);
#else
                    unpack8(yq[k * 4 + j], f);
#endif
#pragma unroll
                    for (int e = 0; e < 8; ++e) yv[8 * j + e] += f[e]; }
#pragma unroll
            for (int i = 0; i < 4; ++i) xv[i] = xq[i];
            { const int mn = m + NGW < hi ? m + NGW : m; P11_LOAD(mn); }
            float ss = 0.f;
#pragma unroll
            for (int i = 0; i < 32; ++i) { if (MOE_FP8) yv[i] *= (1.f / YP8SCALE); ss += yv[i] * yv[i]; }
            const float r = rsqrtf(wave_sum_f(ss) * (1.f / D) + EPS);
#pragma unroll
            for (int j = 0; j < 4; ++j) {
                const int c0 = 8 * (64 * j + lane);
                float xf[8]; unpack8(xv[j], xf);
#pragma unroll
                for (int hq = 0; hq < 2; ++hq) {
                    f32x4 o;
                    o.x = xf[4 * hq + 0] + gg[8 * j + 4 * hq + 0] * (yv[8 * j + 4 * hq + 0] * r); o.y = xf[4 * hq + 1] + gg[8 * j + 4 * hq + 1] * (yv[8 * j + 4 * hq + 1] * r);
                    o.z = xf[4 * hq + 2] + gg[8 * j + 4 * hq + 2] * (yv[8 * j + 4 * hq + 2] * r); o.w = xf[4 * hq + 3] + gg[8 * j + 4 * hq + 3] * (yv[8 * j + 4 * hq + 3] * r);
                    *(f32x4*)(a.out + (size_t)m * D + c0 + 4 * hq) = o;
                }
            }
        }
    }
#undef P11_LOAD
#undef P11_YLOAD
}
constexpr int N_PHASES = 12;
#ifndef P0_PARTS
#define P0_PARTS 7
#endif
#ifndef EPI_SKIP_PROBE
#define EPI_SKIP_PROBE 0
#endif
#ifndef REP_MASK
#define REP_MASK 0
#endif
__global__ void __launch_bounds__(fp::NT, 2) mk_fwd(MkArgs a) {
    extern __shared__ __attribute__((aligned(16))) unsigned char lds_raw[];
    Frame F;
    F.lds = (LAS unsigned char*)lds_raw;
    F.wave = __builtin_amdgcn_readfirstlane((int)threadIdx.x >> 6);
    F.G = gridDim.x; F.bid = blockIdx.x; F.vcu = (F.G % 8 == 0) ? (F.bid % 8) * (F.G / 8) + F.bid / 8 : F.bid;
    volatile LAS unsigned* misc = (volatile LAS unsigned*)(F.lds + LDS_MISC);
    if (F.wave == 0) misc[lane_id()] = 0u;
    __syncthreads();
    XcdBarrier bar = xcd_barrier_post((unsigned*)(a.ws + wsf::CTL) + wsf::CW_BAR, misc + 8, F.wave == 0 && lane_id() == 0);
    const int lo = a.ph_lo, hi = a.ph_hi;
#define IN(k) (lo <= (k) && (k) < hi)
#define SEAM(k) do { if (IN(k) && IN((k) + 1)) xcd_barrier(bar, F.wave == 0 && lane_id() == 0); } while (0)
    if (IN(0)) { phase0(a, F); if ((REP_MASK >> 0) & 1) phase0(a, F, P0_PARTS); } SEAM(0);
    if (IN(1)) { phase1(a, F); if ((REP_MASK >> 1) & 1) phase1(a, F); } SEAM(1);
    if (IN(2)) { phase2(a, F); if ((REP_MASK >> 2) & 1) { __syncthreads(); phase2(a, F, EPI_SKIP_PROBE != 0); } } SEAM(2);
#if NPH > 3
    if (IN(3)) { phase3(a, F); if ((REP_MASK >> 3) & 1) phase3(a, F); } SEAM(3);
#endif
#if NPH > 4
    if (IN(4)) { phase4(a, F); if ((REP_MASK >> 4) & 1) phase4(a, F); } SEAM(4);
#endif
#if NPH > 5
    if (IN(5)) { phase5(a, F); if ((REP_MASK >> 5) & 1) phase5(a, F); } SEAM(5);
#endif
#if NPH > 6
    if (IN(6)) { phase6(a, F); if ((REP_MASK >> 6) & 1) phase6(a, F, EPI_SKIP_PROBE != 0); } SEAM(6);
#endif
#if NPH > 7
    if (IN(7)) { phase7(a, F); if ((REP_MASK >> 7) & 1) phase7(a, F); } SEAM(7);
#endif
#if NPH > 8
    if (IN(8)) { phase8(a, F); if ((REP_MASK >> 8) & 1) phase8(a, F); } SEAM(8);
#endif
#if NPH > 9
    if (IN(9)) { phase9(a, F); if ((REP_MASK >> 9) & 1) phase9(a, F, EPI_SKIP_PROBE != 0); } SEAM(9);
#endif
#if NPH > 10
    if (IN(10)) { phase10(a, F); if ((REP_MASK >> 10) & 1) phase10(a, F); } SEAM(10);
#endif
#if NPH > 11
    if (IN(11)) { phase11(a, F); if ((REP_MASK >> 11) & 1) phase11(a, F); }
#endif
#undef IN
#undef SEAM
}

static void fill_args(MkArgs& a, void* const* d_in, void* d_out, void* d_ws) {
    a.x = (const float*)d_in[0]; a.c = (const float*)d_in[1]; a.positions = (const int*)d_in[2]; a.w_ada = (const float*)d_in[3]; a.b_ada = (const float*)d_in[4];
    a.g_pre_mix = (const float*)d_in[5]; a.g_post_mix = (const float*)d_in[6]; a.g_pre_ffn = (const float*)d_in[7]; a.g_post_ffn = (const float*)d_in[8];
    a.w_in = (const float*)d_in[9]; a.b_in = (const float*)d_in[10]; a.conv_qk = (const float*)d_in[11]; a.sinks = (const float*)d_in[12]; a.g_mlstm = (const float*)d_in[13];
    a.w_attn_proj = (const float*)d_in[14]; a.w_mlstm_proj = (const float*)d_in[15]; a.w_out = (const float*)d_in[16]; a.w_router = (const float*)d_in[17]; a.b_router = (const float*)d_in[18];
    a.w_gate_up = (const float*)d_in[19]; a.b_gate_up = (const float*)d_in[20]; a.w_down = (const float*)d_in[21]; a.b_down = (const float*)d_in[22];
    a.out = (float*)d_out; a.ws = (unsigned char*)d_ws; a.route_i = nullptr; a.route_w = nullptr; a.ph_lo = 0; a.ph_hi = 0;
}
static int mk_setup() {
    static int grid = 0;
    if (grid == 0) {
        int dev = 0, cus = 0;
        if (hipGetDevice(&dev) != hipSuccess || hipDeviceGetAttribute(&cus, hipDeviceAttributeMultiprocessorCount, dev) != hipSuccess) { grid = -1; return grid; }
        if (hipFuncSetAttribute((const void*)mk_fwd, hipFuncAttributeMaxDynamicSharedMemorySize, LDS_BYTES) != hipSuccess) { grid = -1; return grid; }
        int per_cu = 0;
        if (hipOccupancyMaxActiveBlocksPerMultiprocessor(&per_cu, (const void*)mk_fwd, fp::NT, LDS_BYTES) != hipSuccess || per_cu < 1) { (void)hipGetLastError(); }
        grid = cus;
    }
    return grid;
}

extern "C" void kernel_launch(void* const* d_in, const int* in_sizes, int n_in, void* d_out, int out_size, void* d_ws, size_t ws_size, hipStream_t stream) {
    if (n_in != 23 || ws_size < wsf::END) return;
    const int grid = mk_setup();
    if (grid <= 0) return;
    if (hipMemsetAsync((unsigned char*)d_ws + wsf::CTL, 0, 65536, stream) != hipSuccess) return;
    MkArgs a{}; fill_args(a, d_in, d_out, d_ws);
    a.ph_lo = 0; a.ph_hi = N_PHASES;
    hipLaunchKernelGGL(mk_fwd, dim3(grid), dim3(fp::NT), LDS_BYTES, stream, a);
}
```
